# Optimizing an MI355X kernel written in HIP

```python
import math
import jax, jax.numpy as jnp
from jax import lax
import numpy as np

D_MODEL = 1024
BATCH = 32
SEQ = 2048
DEPTH = 1

CTX_LEN = 256
GRID_W = 64
S5_WIDTH = D_MODEL // 4
S5_CH_PER_GROUP = 16
S5_GROUPS = S5_WIDTH // S5_CH_PER_GROUP
S5_STATE = 64
CONV_HEAD_DIM = 64
CONV_WIDTH = D_MODEL - S5_WIDTH
CONV_HEADS = CONV_WIDTH // CONV_HEAD_DIM
CONV_ROW_WIDTH = CONV_WIDTH // 2
CONV_TAPS = 3
D_MIX = S5_WIDTH + CONV_WIDTH
D_IN_PROJ = S5_WIDTH + 3 * CONV_WIDTH
N_EXPERT_GROUPS = 4
EXPERTS_PER_GROUP = 4
N_EXPERTS = N_EXPERT_GROUPS * EXPERTS_PER_GROUP
TOP_K_IN_GROUP = 2
D_EXPERT = D_MODEL // 2
N_MOD = 6
RMS_EPS = 1e-6
DT_MIN = 1e-3
DT_MAX = 1e-1

kernel_name = 'hybrid_s5_shortconv_hmoe_prefix_dit'


def rmsnorm(x, g):
    xf = x.astype(jnp.float32)
    y = xf * lax.rsqrt(jnp.mean(xf * xf, axis=-1, keepdims=True) + RMS_EPS)
    return (y * g.astype(jnp.float32)).astype(x.dtype)


def ada_mod(cond, w_mod, b_mod):
    m = jax.nn.silu(cond) @ w_mod + b_mod
    return jnp.split(m[:, None, :], N_MOD, axis=-1)


def modulate(x, g, shift, scale):
    return rmsnorm(x, g) * (1.0 + scale) + shift


def s5_discretize(lam_re, lam_im, log_dt, b_re, b_im):
    lam = lax.complex(lam_re.astype(jnp.float32), lam_im.astype(jnp.float32))
    dt = jnp.exp(log_dt.astype(jnp.float32))[:, None]
    a_bar = jnp.exp(lam * dt)
    b = lax.complex(b_re.astype(jnp.float32), b_im.astype(jnp.float32))
    b_bar = ((a_bar - 1.0) / lam)[..., None] * b
    return a_bar, b_bar


def _linear_recurrence(e1, e2):
    a1, b1 = e1
    a2, b2 = e2
    return a1 * a2, a2 * b1 + b2


def s5_states(u, a_bar, b_bar, h0, reverse):
    bu = jnp.einsum('blgh,gph->blgp', u.astype(jnp.complex64), b_bar)
    if h0 is not None:
        first = -1 if reverse else 0
        bu = bu.at[:, first].add(a_bar * h0)
    a = jnp.broadcast_to(a_bar, (1, bu.shape[1]) + a_bar.shape)
    _, states = lax.associative_scan(_linear_recurrence, (a, bu), reverse=reverse, axis=1)
    return states


def s5_readout(u, st_f, st_b, c_f, c_b, d, w_glu, b_glu, dtype):
    bsz, n = u.shape[0], u.shape[1]
    y = (jnp.einsum('blgp,ghp->blgh', st_f, c_f).real
         + jnp.einsum('blgp,ghp->blgh', st_b, c_b).real
         + d.astype(jnp.float32).reshape(S5_GROUPS, S5_CH_PER_GROUP) * u)
    g = jax.nn.gelu(y.reshape(bsz, n, S5_WIDTH).astype(dtype))
    return g * jax.nn.sigmoid(g @ w_glu + b_glu)


def dwconv3(x, w, axis):
    n = x.shape[axis]
    pad = [(0, 0)] * x.ndim
    pad[axis] = (1, 1)
    xp = jnp.pad(x, pad)
    return (lax.slice_in_dim(xp, 0, n, axis=axis) * w[0]
            + lax.slice_in_dim(xp, 1, n + 1, axis=axis) * w[1]
            + lax.slice_in_dim(xp, 2, n + 2, axis=axis) * w[2])


def short_conv_latent(z, conv_w):
    b_g, c_g, v = jnp.split(z, 3, axis=-1)
    cv = c_g * v
    bsz, n, _ = cv.shape
    rows = n // GRID_W
    grid = cv.reshape(bsz, rows, GRID_W, CONV_WIDTH)
    row_part = dwconv3(grid[..., :CONV_ROW_WIDTH], conv_w[:, :CONV_ROW_WIDTH], axis=2)
    col_part = dwconv3(grid[..., CONV_ROW_WIDTH:], conv_w[:, CONV_ROW_WIDTH:], axis=1)
    conv = jnp.concatenate([row_part, col_part], axis=-1).reshape(bsz, n, CONV_WIDTH)
    return b_g * conv


def short_conv_context(z, conv_w):
    b_g, c_g, v = jnp.split(z, 3, axis=-1)
    return b_g * dwconv3(c_g * v, conv_w, axis=1)


def hier_moe(h, wg, bg, we, be, w1, w3, w2):
    shp = h.shape
    t = h.reshape(-1, shp[-1])
    g_prob = jax.nn.softmax((t @ wg + bg).astype(jnp.float32), axis=-1)
    g_p, g_idx = lax.top_k(g_prob, 1)
    e_logits = (t @ we + be).astype(jnp.float32).reshape(-1, N_EXPERT_GROUPS, EXPERTS_PER_GROUP)
    e_in = jnp.take_along_axis(e_logits, g_idx[:, :, None], axis=1)[:, 0]
    top_v, top_i = lax.top_k(e_in, TOP_K_IN_GROUP)
    weights = jax.nn.softmax(top_v, axis=-1) * g_p
    e_idx = g_idx * EXPERTS_PER_GROUP + top_i
    gates = jnp.einsum('tk,tke->te', weights,
                       jax.nn.one_hot(e_idx, N_EXPERTS, dtype=jnp.float32)).astype(h.dtype)
    out = jnp.zeros_like(t)
    for e in range(N_EXPERTS):
        he = jax.nn.silu(t @ w1[e]) * (t @ w3[e])
        out = out + gates[:, e:e + 1] * (he @ w2[e])
    return out.reshape(shp)


def setup_inputs(seed: int = 0) -> dict:
    key = jax.random.key(seed)
    ks = jax.random.split(key, 32)
    f32 = jnp.float32
    nrm = lambda k, shape, s: jax.random.normal(k, shape, f32) * s
    G, P, H = S5_GROUPS, S5_STATE, S5_CH_PER_GROUP
    lam_im = jnp.broadcast_to(jnp.pi * jnp.arange(P, dtype=f32), (DEPTH, 2, G, P))
    return {
        'x': nrm(ks[0], (BATCH, SEQ, D_MODEL), 1.0),
        'c': nrm(ks[1], (BATCH, D_MODEL), 1.0),
        'ctx': nrm(ks[2], (BATCH, CTX_LEN, D_MODEL), 1.0),
        'c_ctx': nrm(ks[3], (D_MODEL,), 1.0),
        'w_mod': nrm(ks[4], (DEPTH, D_MODEL, N_MOD * D_MODEL), 0.5 * D_MODEL ** -0.5),
        'b_mod': nrm(ks[5], (DEPTH, N_MOD * D_MODEL), 0.02),
        'norm1_g': 1.0 + nrm(ks[6], (DEPTH, D_MODEL), 0.05),
        'norm2_g': 1.0 + nrm(ks[7], (DEPTH, D_MODEL), 0.05),
        'w_in': nrm(ks[8], (DEPTH, D_MODEL, D_IN_PROJ), D_MODEL ** -0.5),
        's5_lambda_re': -0.5 + nrm(ks[9], (DEPTH, 2, G, P), 0.01),
        's5_lambda_im': lam_im + nrm(ks[10], (DEPTH, 2, G, P), 0.01),
        's5_log_dt': jax.random.uniform(ks[11], (DEPTH, 2, G), f32, math.log(DT_MIN), math.log(DT_MAX)),
        's5_b_re': nrm(ks[12], (DEPTH, 2, G, P, H), (2 * H) ** -0.5),
        's5_b_im': nrm(ks[13], (DEPTH, 2, G, P, H), (2 * H) ** -0.5),
        's5_c_re': nrm(ks[14], (DEPTH, 2, G, H, P), P ** -0.5),
        's5_c_im': nrm(ks[15], (DEPTH, 2, G, H, P), P ** -0.5),
        's5_d': nrm(ks[16], (DEPTH, S5_WIDTH), 1.0),
        'w_glu': nrm(ks[17], (DEPTH, S5_WIDTH, S5_WIDTH), S5_WIDTH ** -0.5),
        'b_glu': nrm(ks[18], (DEPTH, S5_WIDTH), 0.02),
        'conv_w': nrm(ks[19], (DEPTH, CONV_TAPS, CONV_WIDTH), CONV_TAPS ** -0.5),
        'w_out': nrm(ks[20], (DEPTH, D_MIX, D_MODEL), D_MIX ** -0.5),
        'router_group_w': nrm(ks[21], (DEPTH, D_MODEL, N_EXPERT_GROUPS), D_MODEL ** -0.5),
        'router_group_b': nrm(ks[22], (DEPTH, N_EXPERT_GROUPS), 0.01),
        'router_expert_w': nrm(ks[23], (DEPTH, D_MODEL, N_EXPERTS), D_MODEL ** -0.5),
        'router_expert_b': nrm(ks[24], (DEPTH, N_EXPERTS), 0.01),
        'expert_w1': nrm(ks[25], (DEPTH, N_EXPERTS, D_MODEL, D_EXPERT), D_MODEL ** -0.5),
        'expert_w3': nrm(ks[26], (DEPTH, N_EXPERTS, D_MODEL, D_EXPERT), D_MODEL ** -0.5),
        'expert_w2': nrm(ks[27], (DEPTH, N_EXPERTS, D_EXPERT, D_MODEL), D_EXPERT ** -0.5),
        'final_g': 1.0 + nrm(ks[28], (D_MODEL,), 0.05),
    }


def reference(x, c, ctx, c_ctx, w_mod, b_mod, norm1_g, norm2_g, w_in, s5_lambda_re, s5_lambda_im,
              s5_log_dt, s5_b_re, s5_b_im, s5_c_re, s5_c_im, s5_d, w_glu, b_glu, conv_w, w_out,
              router_group_w, router_group_b, router_expert_w, router_expert_b,
              expert_w1, expert_w3, expert_w2, final_g):
    f32 = jnp.float32
    bsz, n_tok, _ = x.shape
    n_ctx = ctx.shape[1]
    for l in range(DEPTH):
        last = l == DEPTH - 1
        mx = ada_mod(c, w_mod[l], b_mod[l])
        mc = ada_mod(c_ctx[None, :], w_mod[l], b_mod[l])
        a_f, bb_f = s5_discretize(s5_lambda_re[l, 0], s5_lambda_im[l, 0], s5_log_dt[l, 0],
                                  s5_b_re[l, 0], s5_b_im[l, 0])
        a_b, bb_b = s5_discretize(s5_lambda_re[l, 1], s5_lambda_im[l, 1], s5_log_dt[l, 1],
                                  s5_b_re[l, 1], s5_b_im[l, 1])
        cm_f = lax.complex(s5_c_re[l, 0].astype(f32), s5_c_im[l, 0].astype(f32))
        cm_b = lax.complex(s5_c_re[l, 1].astype(f32), s5_c_im[l, 1].astype(f32))

        hc = modulate(ctx, norm1_g[l], mc[0], mc[1])
        uc = (hc @ w_in[l][:, :S5_WIDTH]).astype(f32).reshape(bsz, n_ctx, S5_GROUPS, S5_CH_PER_GROUP)
        sc_f = s5_states(uc, a_f, bb_f, None, False)
        sc_b = s5_states(uc, a_b, bb_b, None, True)

        hx = modulate(x, norm1_g[l], mx[0], mx[1])
        zx = hx @ w_in[l]
        ux = zx[..., :S5_WIDTH].astype(f32).reshape(bsz, n_tok, S5_GROUPS, S5_CH_PER_GROUP)
        sx_f = s5_states(ux, a_f, bb_f, sc_f[:, -1], False)
        sx_b = s5_states(ux, a_b, bb_b, sc_b[:, 0], True)
        y_s5 = s5_readout(ux, sx_f, sx_b, cm_f, cm_b, s5_d[l], w_glu[l], b_glu[l], x.dtype)
        y_conv = short_conv_latent(zx[..., S5_WIDTH:], conv_w[l])
        yx = jnp.concatenate([y_s5, y_conv], axis=-1) @ w_out[l]
        x = x + mx[2] * yx
        x = x + mx[5] * hier_moe(modulate(x, norm2_g[l], mx[3], mx[4]), router_group_w[l],
                                 router_group_b[l], router_expert_w[l], router_expert_b[l],
                                 expert_w1[l], expert_w3[l], expert_w2[l])

        if not last:
            yc_s5 = s5_readout(uc, sc_f, sc_b, cm_f, cm_b, s5_d[l], w_glu[l], b_glu[l], ctx.dtype)
            yc_conv = short_conv_context(hc @ w_in[l][:, S5_WIDTH:], conv_w[l])
            ctx = ctx + mc[2] * (jnp.concatenate([yc_s5, yc_conv], axis=-1) @ w_out[l])
            ctx = ctx + mc[5] * hier_moe(modulate(ctx, norm2_g[l], mc[3], mc[4]), router_group_w[l],
                                         router_group_b[l], router_expert_w[l], router_expert_b[l],
                                         expert_w1[l], expert_w3[l], expert_w2[l])
    return rmsnorm(x, final_g)
```

```cpp
#include <hip/hip_runtime.h>
#include <hip/hip_cooperative_groups.h>
#include <cstdio>
namespace cg = cooperative_groups;

#ifndef MK_ONE_LAUNCH
#define MK_ONE_LAUNCH 0
#endif

#define DEV __device__ __forceinline__
#define LAS __attribute__((address_space(3)))
typedef unsigned short bf16_t;
typedef short bf16x8 __attribute__((ext_vector_type(8)));
typedef float f32x4 __attribute__((ext_vector_type(4)));
typedef float f32x2 __attribute__((ext_vector_type(2)));
typedef unsigned u32x4 __attribute__((ext_vector_type(4)));
typedef unsigned u32x2 __attribute__((ext_vector_type(2)));

constexpr int NB = 32, SEQ = 2048, DM = 1024, TOK = NB * SEQ, CTXL = 256, CTOK = NB * CTXL;
constexpr int NG = 16, NP = 64, NH = 16, LC = 64;
constexpr int NCH_LAT = TOK / LC, NCH_CTX = CTOK / LC, NCH_PAD = 1280, UGK = 1280;
constexpr int CONVW = 768, NMOD = 6 * DM;
constexpr int NEXP = 16, DEXP = 512, NBUCKET = 24, MAXTILES = 280;
constexpr float RMS_EPS = 1e-6f;

constexpr size_t MiB = 1u << 20;
constexpr size_t WS_CTL = 0;
constexpr size_t WS_MOD = 1 * MiB;
constexpr size_t WS_APOW = 2 * MiB;
constexpr size_t WS_BBAR = 4 * MiB;
constexpr size_t WS_KTAB = 5 * MiB;
constexpr size_t WS_SB13 = 7 * MiB;
constexpr size_t WS_SH2 = 9 * MiB;
constexpr size_t WS_RB = 10 * MiB;
constexpr size_t WS_TOKB = 10 * MiB + 65536;
constexpr size_t WS_TOKW = 11 * MiB;
constexpr size_t WS_TOKR = 12 * MiB;
constexpr size_t WS_SEGC = 12 * MiB + 512 * 1024;
constexpr size_t WS_PERM = 13 * MiB;
constexpr size_t WS_TILES = 14 * MiB;
constexpr size_t WS_RSQ1 = 16 * MiB;
constexpr size_t WS_RSQ2 = 20 * MiB;
constexpr size_t WS_WR = 24 * MiB;
constexpr size_t WS_WGLU = 25 * MiB;
constexpr size_t WS_WIN = 26 * MiB;
constexpr size_t WS_WOUT = 32 * MiB;
constexpr size_t WS_WE = 34 * MiB;
constexpr size_t WS_W2 = 42 * MiB;
constexpr size_t WS_W13 = 58 * MiB;
constexpr size_t WS_TR = 90 * MiB;
constexpr size_t WS_E = 130 * MiB;
constexpr size_t WS_UG = 150 * MiB;
constexpr size_t WS_G = 200 * MiB;
constexpr size_t WS_BG = 232 * MiB;
constexpr size_t WS_CV = 328 * MiB;
constexpr size_t WS_HX = 424 * MiB;
constexpr size_t WS_HID = WS_HX;
constexpr size_t WS_YMIX = 568 * MiB;
constexpr size_t WS_X1G = 696 * MiB;
constexpr size_t WS_END = 824 * MiB;

DEV unsigned cvt_pk_bf16(float lo, float hi) { unsigned r; asm volatile("v_cvt_pk_bf16_f32 %0, %1, %2" : "=v"(r) : "v"(lo), "v"(hi)); return r; }
DEV float bf2f(unsigned short h) { return __uint_as_float(((unsigned)h) << 16); }
DEV float bflo(unsigned w) { return __uint_as_float(w << 16); }
DEV float bfhi(unsigned w) { return __uint_as_float(w & 0xffff0000u); }
DEV float wave_sum(float v) {
#pragma unroll
    for (int o = 1; o < 64; o <<= 1) v += __shfl_xor(v, o);
    return v;
}
DEV float sigmoidf_(float x) { return __builtin_amdgcn_rcpf(1.0f + __expf(-x)); }
DEV float siluf_(float x) { return x * sigmoidf_(x); }
DEV float gelu_tanh(float x) { const float u = 0.7978845608028654f * (x + 0.044715f * x * x * x); return x * sigmoidf_(2.0f * u); }
DEV int ld_agent_i(const int* p) { return __hip_atomic_load(p, __ATOMIC_RELAXED, __HIP_MEMORY_SCOPE_AGENT); }

namespace pg8 {
constexpr int BM = 256, BK = 64, HALF = 128, HTB = HALF * BK * 2, STAGE_BYTES = 8 * HTB;
__host__ __device__ __forceinline__ int lds_byte(int r, int c) { const int st = (r >> 4) * 2 + (c >> 5), rr = r & 15, cc = c & 31, ob = rr * 64 + cc * 2; return st * 1024 + (ob ^ (((ob >> 9) & 1) << 5)); }
__host__ __device__ __forceinline__ void stage_rc(int b, int& R, int& C) { const int st = b / 1024, sb = b % 1024, swz = sb ^ (((sb >> 9) & 1) << 5); R = (st >> 1) * 16 + swz / 64; C = (st & 1) * 32 + (swz % 64) / 2; }
__host__ __device__ __forceinline__ int perm32(int rho) { const int n = rho >> 4, i = rho & 15; return 8 * (i >> 2) + 4 * n + (i & 3); }

struct Unit {
    const char* A0; const char* A1; const char* B0; const char* B1;
    int ksA, ksB;
    int p0, p1, p2, p3;
};
DEV const char* pa(const Unit& u, int kt) { return kt < u.ksA ? u.A0 + (size_t)kt * 128 : u.A1 + (size_t)(kt - u.ksA) * 128; }
DEV const char* pb(const Unit& u, int kt) { return kt < u.ksB ? u.B0 + (size_t)kt * 128 : u.B1 + (size_t)(kt - u.ksB) * 128; }

template <class Epi, class Sched>
DEV void gemm_phase(LAS unsigned char* lds, const Sched& S, const Epi& E) {
    const int tid = threadIdx.x, wid = __builtin_amdgcn_readfirstlane(tid >> 6), lane = tid & 63, wr = wid >> 2, wc = wid & 3, fr = lane & 15, fq = lane >> 4;
    const int nt = S.nt;
    int Rr[2], Cc[2];
    unsigned voffB[2], vA[4], vA2[4];
#pragma unroll
    for (int i = 0; i < 2; ++i) { stage_rc(tid * 16 + i * 8192, Rr[i], Cc[i]); const int Rb = Epi::PERM ? ((Rr[i] & ~31) + perm32(Rr[i] & 31)) : Rr[i];
        voffB[i] = (unsigned)Rb * S.ldb + (unsigned)Cc[i] * 2u; }
    const size_t hstepB = (size_t)HALF * S.ldb;
    const unsigned ldsw = (unsigned)wid * 1024u;
    const int aoff = lds_byte(wr * 64 + fr, fq * 8), boff = lds_byte(wc * 32 + fr, fq * 8);
#define PG8_SA(b, h) (((b) * 2 + (h)) * HTB)
#define PG8_SB(b, h) ((4 + (b) * 2 + (h)) * HTB)
#define PG8_STAGE(bufoff, gbase, v0, v1) do { \
        __builtin_amdgcn_global_load_lds((const unsigned*)((const char*)(gbase) + (v0)), (LAS unsigned*)(lds + (bufoff) + ldsw), 16, 0, 0); \
        __builtin_amdgcn_global_load_lds((const unsigned*)((const char*)(gbase) + (v1)), (LAS unsigned*)(lds + (bufoff) + ldsw + 8192), 16, 0, 0); } while (0)
#define PG8_LDA(dst, b, h) do { _Pragma("unroll") for (int m = 0; m < 4; ++m) _Pragma("unroll") for (int k = 0; k < 2; ++k) dst[m][k] = *(const LAS bf16x8*)(lds + PG8_SA(b, h) + aoff + m * 2048 + k * 1024); } while (0)
#define PG8_LDB(dst, b, h) do { _Pragma("unroll") for (int n = 0; n < 2; ++n) _Pragma("unroll") for (int k = 0; k < 2; ++k) dst[n][k] = *(const LAS bf16x8*)(lds + PG8_SB(b, h) + boff + n * 2048 + k * 1024); } while (0)
#define PG8_MMA(ai, bj, At, Bt) do { __builtin_amdgcn_s_setprio(1); _Pragma("unroll") for (int m = 0; m < 4; ++m) _Pragma("unroll") for (int n = 0; n < 2; ++n) _Pragma("unroll") for (int k = 0; k < 2; ++k) \
        acc[ai][bj][m][n] = __builtin_amdgcn_mfma_f32_16x16x32_bf16(Bt[n][k], At[m][k], acc[ai][bj][m][n], 0, 0, 0); __builtin_amdgcn_s_setprio(0); } while (0)
#define PG8_WAIT_V(n) asm volatile("s_waitcnt vmcnt(" #n ")" ::: "memory")
#define PG8_WAIT_L(n) asm volatile("s_waitcnt lgkmcnt(" #n ")" ::: "memory")
#define PG8_BAR __builtin_amdgcn_s_barrier()
#define PG8_SCHED __builtin_amdgcn_sched_barrier(0)
    Unit cur, nxt; int ui = 0;
    if (!S.next(0, cur)) return;
    f32x4 acc[2][2][4][2];
#pragma unroll
    for (int a = 0; a < 2; ++a)
#pragma unroll
        for (int b = 0; b < 2; ++b)
#pragma unroll
            for (int m = 0; m < 4; ++m)
#pragma unroll
                for (int n = 0; n < 2; ++n) acc[a][b][m][n] = (f32x4){0.f, 0.f, 0.f, 0.f};
    bf16x8 At[4][2], B0[2][2], B1[2][2];
    if constexpr (Sched::GATHER) S.rows(cur, Rr, Cc, vA);
    else {
#pragma unroll
        for (int h = 0; h < 2; ++h)
#pragma unroll
            for (int i = 0; i < 2; ++i) vA[h * 2 + i] = (unsigned)(h * HALF + Rr[i]) * S.lda + (unsigned)Cc[i] * 2u;
    }
    {
        const char* a0 = pa(cur, 0); const char* b0 = pb(cur, 0); const char* a1 = pa(cur, 1); const char* b1 = pb(cur, 1);
        PG8_STAGE(PG8_SB(0, 0), b0, voffB[0], voffB[1]); PG8_STAGE(PG8_SA(0, 0), a0, vA[0], vA[1]); PG8_STAGE(PG8_SB(0, 1), b0 + hstepB, voffB[0], voffB[1]); PG8_STAGE(PG8_SA(0, 1), a0, vA[2], vA[3]);
        if (wr == 1) PG8_BAR;
        PG8_WAIT_V(4); PG8_BAR;
        PG8_STAGE(PG8_SB(1, 0), b1, voffB[0], voffB[1]); PG8_STAGE(PG8_SA(1, 0), a1, vA[0], vA[1]); PG8_STAGE(PG8_SB(1, 1), b1 + hstepB, voffB[0], voffB[1]);
        PG8_WAIT_V(6); PG8_BAR;
    }
    for (;;) {
        const bool has_next = S.next(ui + 1, nxt);
        if (!has_next) nxt = cur;
        for (int t = 0; t < nt; t += 2) {
            const bool last = (t == nt - 2);
            const char* a1 = pa(cur, t + 1);
            const char* a2; const char* b2;
            if (last) { a2 = pa(nxt, 0); b2 = pb(nxt, 0);
                if constexpr (Sched::GATHER) { if (has_next) S.rows(nxt, Rr, Cc, vA2); else {
#pragma unroll
                    for (int q = 0; q < 4; ++q) vA2[q] = vA[q]; } }
            } else { a2 = pa(cur, t + 2); b2 = pb(cur, t + 2);
                if constexpr (Sched::GATHER) {
#pragma unroll
                    for (int q = 0; q < 4; ++q) vA2[q] = vA[q]; }
            }
            if constexpr (!Sched::GATHER) {
#pragma unroll
                for (int q = 0; q < 4; ++q) vA2[q] = vA[q];
            }
            const char* a3 = a2 + 128; const char* b3 = b2 + 128;
            PG8_LDB(B0, 0, 0); PG8_SCHED; PG8_LDA(At, 0, 0); PG8_STAGE(PG8_SA(1, 1), a1, vA[2], vA[3]);
            PG8_WAIT_L(8); PG8_BAR; PG8_WAIT_L(0); PG8_MMA(0, 0, At, B0); PG8_BAR; PG8_SCHED;
            PG8_LDB(B1, 0, 1); PG8_STAGE(PG8_SB(0, 0), b2, voffB[0], voffB[1]);
            PG8_BAR; PG8_WAIT_L(0); PG8_MMA(0, 1, At, B1); PG8_BAR;
            PG8_LDA(At, 0, 1); PG8_STAGE(PG8_SA(0, 0), a2, vA2[0], vA2[1]);
            PG8_BAR; PG8_WAIT_L(0); PG8_MMA(1, 0, At, B0); PG8_BAR; PG8_SCHED;
            PG8_STAGE(PG8_SB(0, 1), b2 + hstepB, voffB[0], voffB[1]);
            PG8_WAIT_V(6); PG8_BAR; PG8_MMA(1, 1, At, B1); PG8_BAR;
            PG8_LDB(B0, 1, 0); PG8_SCHED; PG8_LDA(At, 1, 0); PG8_STAGE(PG8_SA(0, 1), a2, vA2[2], vA2[3]);
            PG8_WAIT_L(8); PG8_BAR; PG8_WAIT_L(0); PG8_MMA(0, 0, At, B0); PG8_BAR; PG8_SCHED;
            PG8_LDB(B1, 1, 1); PG8_STAGE(PG8_SB(1, 0), b3, voffB[0], voffB[1]);
            PG8_BAR; PG8_WAIT_L(0); PG8_MMA(0, 1, At, B1); PG8_BAR;
            PG8_LDA(At, 1, 1); PG8_STAGE(PG8_SA(1, 0), a3, vA2[0], vA2[1]);
            PG8_BAR; PG8_WAIT_L(0); PG8_MMA(1, 0, At, B0); PG8_BAR; PG8_SCHED;
            PG8_STAGE(PG8_SB(1, 1), b3 + hstepB, voffB[0], voffB[1]);
            PG8_WAIT_V(6); PG8_BAR; PG8_MMA(1, 1, At, B1); PG8_BAR;
        }
        E(acc, cur, wr, wc, fr, fq);
        if (!has_next) break;
#pragma unroll
        for (int a = 0; a < 2; ++a)
#pragma unroll
            for (int b = 0; b < 2; ++b)
#pragma unroll
                for (int m = 0; m < 4; ++m)
#pragma unroll
                    for (int n = 0; n < 2; ++n) acc[a][b][m][n] = (f32x4){0.f, 0.f, 0.f, 0.f};
        cur = nxt; ++ui;
        if constexpr (Sched::GATHER) {
#pragma unroll
            for (int q = 0; q < 4; ++q) vA[q] = vA2[q];
        }
    }
    PG8_WAIT_V(0);
    if (wr == 0) PG8_BAR;
    PG8_BAR;
#undef PG8_SA
#undef PG8_SB
#undef PG8_STAGE
#undef PG8_LDA
#undef PG8_LDB
#undef PG8_MMA
#undef PG8_WAIT_V
#undef PG8_WAIT_L
#undef PG8_BAR
#undef PG8_SCHED
}

DEV void static_tile(int L, int nM, int nN, int& pm, int& pn) {
    const int nwg = nM * nN; int wgid = L;
    { const int q = nwg / 8, r = nwg % 8, xcd = wgid % 8, off = wgid / 8; wgid = (xcd < r ? xcd * (q + 1) : r * (q + 1) + (xcd - r) * q) + off; }
    const int nig = 8 * nN, gid = wgid / nig, fm = gid * 8, gsz = (nM - fm) < 8 ? (nM - fm) : 8;
    pm = fm + ((wgid % nig) % gsz); pn = (wgid % nig) / gsz;
}
}
using pg8::Unit;

struct Args { const float* in[29]; float* out; unsigned char* ws; int ph_lo, ph_hi; };
static_assert(sizeof(Args) == 31 * 8 + 8, "Args has no padding");
enum { I_X = 0, I_C, I_CTX, I_CCTX, I_WMOD, I_BMOD, I_N1G, I_N2G, I_WIN, I_LRE, I_LIM, I_LOGDT, I_BRE, I_BIM, I_CRE, I_CIM, I_S5D, I_WGLU, I_BGLU, I_CONVW, I_WOUT,
       I_RGW, I_RGB, I_REW, I_REB, I_W1, I_W3, I_W2, I_FING };

struct Frame {
    LAS unsigned char* lds;
    int tid, lane, wave, G, bx, vcu;
    const float* in[29]; float* out; unsigned char* ws;
};
#define WSP(T, off) ((T*)(F.ws + (off)))

DEV void p0_mod_item(Frame& F, int item) {
    LAS float* st = (LAS float*)F.lds;
    LAS float* red = (LAS float*)(F.lds + 33 * 512 * 4);
    const float* c = F.in[I_C]; const float* cc = F.in[I_CCTX]; const float* wm = F.in[I_WMOD]; const float* bm = F.in[I_BMOD];
    float* mod = WSP(float, WS_MOD);
    const int col = F.tid & 31, kc = F.tid >> 5, j0 = item * 32;
    float acc[33];
#pragma unroll
    for (int n = 0; n < 33; ++n) acc[n] = 0.f;
    for (int half = 0; half < 2; ++half) {
        __syncthreads();
        for (int idx = F.tid; idx < 33 * 512; idx += 512) { const int n = idx >> 9, kk = idx & 511; const float v = (n < 32) ? c[n * DM + half * 512 + kk] : cc[half * 512 + kk]; st[idx] = siluf_(v); }
        __syncthreads();
        for (int kk = kc; kk < 512; kk += 16) {
            const float w = wm[(size_t)(half * 512 + kk) * NMOD + j0 + col];
#pragma unroll
            for (int n = 0; n < 33; ++n) acc[n] += st[n * 512 + kk] * w;
        }
    }
#pragma unroll
    for (int n = 0; n < 33; ++n) red[(kc * 33 + n) * 32 + col] = acc[n];
    __syncthreads();
    for (int idx = F.tid; idx < 33 * 32; idx += 512) { const int n = idx >> 5, cl = idx & 31; float s = bm[j0 + cl];
#pragma unroll
        for (int q = 0; q < 16; ++q) s += red[(q * 33 + n) * 32 + cl];
        mod[n * NMOD + j0 + cl] = s; }
    __syncthreads();
}
DEV void p0_transpose_item(const float* W, int N, int k0, int n0, bf16_t* dst, int ldk, LAS float* scr, int lane) {
#pragma unroll 8
    for (int i = 0; i < 32; ++i) { const int kk = 2 * i + (lane >> 5); scr[kk * 33 + (lane & 31)] = W[(size_t)(k0 + kk) * N + n0 + (lane & 31)]; }
    asm volatile("s_waitcnt lgkmcnt(0)" ::: "memory");
    const int cch = lane & 7;
#pragma unroll
    for (int j = 0; j < 4; ++j) { const int n = (lane >> 3) + 8 * j; const LAS float* s = scr + (8 * cch) * 33 + n;
        u32x4 o; o.x = cvt_pk_bf16(s[0 * 33], s[1 * 33]); o.y = cvt_pk_bf16(s[2 * 33], s[3 * 33]); o.z = cvt_pk_bf16(s[4 * 33], s[5 * 33]); o.w = cvt_pk_bf16(s[6 * 33], s[7 * 33]);
        *(u32x4*)(dst + (size_t)n * ldk + k0 + 8 * cch) = o; }
    asm volatile("s_waitcnt lgkmcnt(0)" ::: "memory");
}
DEV void sincos_rev(double rev, double& s, double& c) {
    const double fr = rev - __builtin_rint(rev);
    const double q = __builtin_rint(fr * 4.0);
    const double y = (fr - q * 0.25) * 6.283185307179586476925;
    const double y2 = y * y;
    const double sy = y * (1.0 + y2 * (-1.0 / 6 + y2 * (1.0 / 120 + y2 * (-1.0 / 5040 + y2 * (1.0 / 362880 + y2 * (-1.0 / 39916800 + y2 * (1.0 / 6227020800.0)))))));
    const double cy = 1.0 + y2 * (-0.5 + y2 * (1.0 / 24 + y2 * (-1.0 / 720 + y2 * (1.0 / 40320 + y2 * (-1.0 / 3628800 + y2 * (1.0 / 479001600.0 + y2 * (-1.0 / 87178291200.0)))))));
    const int qi = ((int)q) & 3;
    s = (qi == 0) ? sy : (qi == 1) ? cy : (qi == 2) ? -sy : -cy;
    c = (qi == 0) ? cy : (qi == 1) ? -sy : (qi == 2) ? -cy : sy;
}
DEV double exp_d(double x) {
    const double k = __builtin_rint(x * 1.4426950408889634074);
    const double r = x - k * 0.69314718055994530942;
    double p = 1.0 / 6227020800.0;
    p = p * r + 1.0 / 479001600.0; p = p * r + 1.0 / 39916800.0; p = p * r + 1.0 / 3628800.0; p = p * r + 1.0 / 362880.0; p = p * r + 1.0 / 40320.0; p = p * r + 1.0 / 5040.0;
    p = p * r + 1.0 / 720.0; p = p * r + 1.0 / 120.0; p = p * r + 1.0 / 24.0; p = p * r + 1.0 / 6.0; p = p * r + 0.5; p = p * r + 1.0; p = p * r + 1.0;
    const long long e = (long long)k + 1023;
    return p * __builtin_bit_cast(double, (unsigned long long)e << 52);
}
DEV void p0_phase(Frame& F) {
    for (int it = F.bx; it < NMOD / 32; it += F.G) p0_mod_item(F, it);
    __syncthreads();
    {
        LAS float* scr = (LAS float*)(F.lds + F.wave * 8448);
        bf16_t* Win = WSP(bf16_t, WS_WIN); bf16_t* Wout = WSP(bf16_t, WS_WOUT); bf16_t* Wglu = WSP(bf16_t, WS_WGLU); bf16_t* W13 = WSP(bf16_t, WS_W13); bf16_t* W2 = WSP(bf16_t, WS_W2);
        const int gw = F.vcu * 8 + F.wave, NGW = F.G * 8;
        constexpr int I_IN = 16 * 80, I_OUT = 16 * 32, I_GLU = 4 * 8, I_E = 16 * 256;
        for (int it = gw; it < I_IN + I_OUT + I_GLU + 3 * I_E; it += NGW) {
            int r = it;
            if (r < I_IN) { const int kb = r / 80, nb = r % 80, n0 = nb * 32; int drow;
                if (n0 < 1024) drow = n0;
                else if (n0 < 1792) { const int j = n0 - 1024; drow = 1024 + (j >> 7) * 256 + (j & 127); }
                else { const int j = n0 - 1792; drow = 1024 + (j >> 7) * 256 + 128 + (j & 127); }
                p0_transpose_item(F.in[I_WIN], 2560, kb * 64, n0, Win + (size_t)drow * 1024, 1024, scr, F.lane); continue; }
            r -= I_IN;
            if (r < I_OUT) { const int kb = r / 32, nb = r % 32; p0_transpose_item(F.in[I_WOUT], 1024, kb * 64, nb * 32, Wout + (size_t)(nb * 32) * 1024, 1024, scr, F.lane); continue; }
            r -= I_OUT;
            if (r < I_GLU) { const int kb = r / 8, nb = r % 8; p0_transpose_item(F.in[I_WGLU], 256, kb * 64, nb * 32, Wglu + (size_t)(nb * 32) * 256, 256, scr, F.lane); continue; }
            r -= I_GLU;
            if (r < 2 * I_E) { const int which = r / I_E; const int rr = r % I_E; const int e = rr >> 8, rem = rr & 255, kb = rem >> 4, nb = rem & 15, n0 = nb * 32;
                const int drow = (n0 >> 7) * 256 + which * 128 + (n0 & 127);
                p0_transpose_item(F.in[which ? I_W3 : I_W1] + (size_t)e * 1024 * 512, 512, kb * 64, n0, W13 + ((size_t)e * 1024 + drow) * 1024, 1024, scr, F.lane); continue; }
            r -= 2 * I_E;
            { const int e = r >> 8, rem = r & 255, kb = rem >> 5, nb = rem & 31;
                p0_transpose_item(F.in[I_W2] + (size_t)e * 512 * 1024, 1024, kb * 64, nb * 32, W2 + ((size_t)e * 1024 + nb * 32) * 512, 512, scr, F.lane); }
        }
    }
    if (F.bx == F.G - 1) {
        bf16_t* Wr = WSP(bf16_t, WS_WR);
        for (int idx = F.tid; idx < 32 * 1024; idx += 512) { const int l = idx >> 10, k = idx & 1023;
            const float v = (l < 4) ? F.in[I_RGW][k * 4 + l] : (l < 20) ? F.in[I_REW][k * 16 + (l - 4)] : 0.f;
            Wr[idx] = (bf16_t)(cvt_pk_bf16(v, 0.f) & 0xffffu); }
    }
    {
        f32x2* APOW = WSP(f32x2, WS_APOW); f32x2* BBAR = WSP(f32x2, WS_BBAR);
        const int gt = F.bx * 512 + F.tid, NT = F.G * 512;
        for (int idx = gt; idx < 2 * 16 * 65 * 64; idx += NT) {
            const int p = idx & 63, j = (idx >> 6) % 65, dg = idx / (64 * 65);
            const double lre = F.in[I_LRE][dg * 64 + p], lim = F.in[I_LIM][dg * 64 + p], dt = exp_d((double)F.in[I_LOGDT][dg]);
            const double mag = exp_d(lre * dt * j); double s, c; sincos_rev(lim * dt * j * 0.15915494309189533577, s, c);
            APOW[idx] = (f32x2){(float)(mag * c), (float)(mag * s)};
        }
        for (int idx = gt; idx < 2 * 16 * 64 * 16; idx += NT) {
            const int dgp = idx >> 4, dg = dgp >> 6;
            const double lre = F.in[I_LRE][dgp], lim = F.in[I_LIM][dgp], dt = exp_d((double)F.in[I_LOGDT][dg]);
            const double mag = exp_d(lre * dt); double s, c; sincos_rev(lim * dt * 0.15915494309189533577, s, c);
            const double nr = mag * c - 1.0, ni = mag * s, d2 = lre * lre + lim * lim;
            const double qr = (nr * lre + ni * lim) / d2, qi = (ni * lre - nr * lim) / d2;
            const double br = F.in[I_BRE][idx], bi = F.in[I_BIM][idx];
            BBAR[idx] = (f32x2){(float)(qr * br - qi * bi), (float)(qr * bi + qi * br)};
        }
    }
}

DEV void p1_norm_row(Frame& F, const float* xrow, const float* g, const float* shift, const float* scale, bf16_t* orow) {
    const f32x4* xr = (const f32x4*)xrow + F.lane;
    f32x4 v[4]; float s = 0.f;
#pragma unroll
    for (int j = 0; j < 4; ++j) { v[j] = xr[64 * j]; s += (v[j].x * v[j].x + v[j].y * v[j].y) + (v[j].z * v[j].z + v[j].w * v[j].w); }
    const float rstd = 1.0f / sqrtf(wave_sum(s) * (1.f / DM) + RMS_EPS);
    u32x2* o8 = (u32x2*)orow + F.lane;
#pragma unroll
    for (int j = 0; j < 4; ++j) {
        const f32x4 gg = ((const f32x4*)g)[F.lane + 64 * j], sh = ((const f32x4*)shift)[F.lane + 64 * j], sc = ((const f32x4*)scale)[F.lane + 64 * j];
        const f32x4 y = (v[j] * rstd * gg) * (1.0f + sc) + sh;
        u32x2 w; w.x = cvt_pk_bf16(y.x, y.y); w.y = cvt_pk_bf16(y.z, y.w); o8[64 * j] = w;
    }
}
DEV void p1_phase(Frame& F) {
    const float* mod = WSP(float, WS_MOD);
    bf16_t* HX = WSP(bf16_t, WS_HX);
    const int gw = F.vcu * 8 + F.wave, NGW = F.G * 8;
    for (int m = gw; m < TOK + CTOK; m += NGW) {
        const bool isl = m < TOK; const int n = isl ? (m >> 11) : 32;
        const float* xr = isl ? F.in[I_X] + (size_t)m * DM : F.in[I_CTX] + (size_t)(m - TOK) * DM;
        p1_norm_row(F, xr, F.in[I_N1G], mod + n * NMOD, mod + n * NMOD + DM, HX + (size_t)m * DM);
    }
    const int gt = F.bx * 512 + F.tid, NT = F.G * 512;
    const f32x2* APOW = WSP(f32x2, WS_APOW); const f32x2* BBAR = WSP(f32x2, WS_BBAR);
    {
        float* KT = WSP(float, WS_KTAB);
        for (int idx = gt; idx < 2 * 16 * 64 * 256; idx += NT) {
            const int hp = idx & 15, h = (idx >> 4) & 15, j = (idx >> 8) & 63, dg = idx >> 14;
            float s = 0.f;
            for (int p = 0; p < 64; ++p) {
                const float cr = F.in[I_CRE][(dg * 16 + h) * 64 + p], ci = F.in[I_CIM][(dg * 16 + h) * 64 + p];
                const f32x2 a = APOW[(dg * 65 + j) * 64 + p], b = BBAR[(dg * 64 + p) * 16 + hp];
                const float ur = cr * a.x - ci * a.y, ui = cr * a.y + ci * a.x;
                s += ur * b.x - ui * b.y;
            }
            KT[idx] = s;
        }
    }
    {
        bf16_t* WE = WSP(bf16_t, WS_WE);
        for (int idx = gt; idx < 16 * 256 * 128; idx += NT) {
            const int k8 = idx & 127, n = (idx >> 7) & 255, g = idx >> 15;
            const int part = n >> 6, p = n & 63, dir = part >> 1, k = k8 >> 1, h0 = (k8 & 1) * 8;
            const int dg = dir * 16 + g; const f32x2 a = APOW[(dg * 65 + (dir ? k : 63 - k)) * 64 + p];
            float v[8];
#pragma unroll
            for (int q = 0; q < 8; ++q) { const f32x2 b = BBAR[(dg * 64 + p) * 16 + h0 + q]; v[q] = (part & 1) ? (a.x * b.y + a.y * b.x) : (a.x * b.x - a.y * b.y); }
            u32x4 o; o.x = cvt_pk_bf16(v[0], v[1]); o.y = cvt_pk_bf16(v[2], v[3]); o.z = cvt_pk_bf16(v[4], v[5]); o.w = cvt_pk_bf16(v[6], v[7]);
            *(u32x4*)(WE + ((size_t)(g * 256 + n) * 1024 + k8 * 8)) = o;
        }
    }
    {
        bf16_t* SH2 = WSP(bf16_t, WS_SH2);
        for (int idx = gt; idx < 256 * 1024; idx += NT) { const int r = idx >> 10, k = idx & 1023; const float v = (r < 32) ? mod[r * NMOD + 3 * DM + k] : 0.f; SH2[idx] = (bf16_t)(cvt_pk_bf16(v, 0.f) & 0xffffu); }
    }
    if (F.bx == F.G - 1) {
        float* rb = WSP(float, WS_RB);
        for (int idx = F.tid; idx < 32 * 32; idx += 512) { const int b = idx >> 5, l = idx & 31; float s = 0.f;
            if (l < 4) { for (int k = 0; k < DM; ++k) s += mod[b * NMOD + 3 * DM + k] * F.in[I_RGW][k * 4 + l]; s += F.in[I_RGB][l]; }
            else if (l < 20) { for (int k = 0; k < DM; ++k) s += mod[b * NMOD + 3 * DM + k] * F.in[I_REW][k * 16 + (l - 4)]; s += F.in[I_REB][l - 4]; }
            rb[idx] = s; }
    }
}

DEV void p2_fill_tr(Frame& F) {
    const float* KT = WSP(float, WS_KTAB); const f32x2* APOW = WSP(f32x2, WS_APOW); bf16_t* TR = WSP(bf16_t, WS_TR);
    const int gt = F.bx * 512 + F.tid, NT = F.G * 512;
    for (int idx = gt; idx < 16 * 1024 * 160; idx += NT) {
        const int k8 = idx % 160, n = (idx / 160) & 1023, g = idx / (160 * 1024);
        const int t = n >> 4, h = n & 15;
        float v[8];
        if (k8 < 128) { const int k = k8 >> 1, h0 = (k8 & 1) * 8;
            if (t > k) { const float* s = KT + (((0 * 16 + g) * 64 + (t - k)) * 256 + h * 16 + h0);
#pragma unroll
                for (int q = 0; q < 8; ++q) v[q] = s[q]; }
            else if (k > t) { const float* s = KT + (((1 * 16 + g) * 64 + (k - t)) * 256 + h * 16 + h0);
#pragma unroll
                for (int q = 0; q < 8; ++q) v[q] = s[q]; }
            else { const float* s0 = KT + (((0 * 16 + g) * 64) * 256 + h * 16 + h0); const float* s1 = KT + (((1 * 16 + g) * 64) * 256 + h * 16 + h0); const float dd = F.in[I_S5D][g * 16 + h];
#pragma unroll
                for (int q = 0; q < 8; ++q) v[q] = s0[q] + s1[q] + ((h0 + q == h) ? dd : 0.f); }
        } else { const int s0 = (k8 - 128) * 8, part = s0 >> 6, p0 = s0 & 63, dir = part >> 1, dg = dir * 16 + g, j = dir ? (64 - t) : (t + 1);
#pragma unroll
            for (int q = 0; q < 8; ++q) { const int p = p0 + q; const float cr = F.in[I_CRE][(dg * 16 + h) * 64 + p], ci = F.in[I_CIM][(dg * 16 + h) * 64 + p]; const f32x2 a = APOW[(dg * 65 + j) * 64 + p];
                v[q] = (part & 1) ? -(cr * a.y + ci * a.x) : (cr * a.x - ci * a.y); }
        }
        u32x4 o; o.x = cvt_pk_bf16(v[0], v[1]); o.y = cvt_pk_bf16(v[2], v[3]); o.z = cvt_pk_bf16(v[4], v[5]); o.w = cvt_pk_bf16(v[6], v[7]);
        *(u32x4*)(TR + ((size_t)(g * 1024 + n) * UGK + k8 * 8)) = o;
    }
}
struct SchedIn {
    static constexpr bool GATHER = false;
    int nt; unsigned lda, ldb; int G, c; const char* HX; const char* W;
    DEV bool next(int i, Unit& u) const {
        const int L = i * G + c; if (L >= 2560 + 32) return false;
        int pm, pn, ctx = 0;
        if (L < 2560) pg8::static_tile(L, 256, 10, pm, pn); else { pm = 256 + (L - 2560); pn = 0; ctx = 1; }
        u.A0 = HX + (size_t)pm * 256 * 2048; u.A1 = u.A0; u.B0 = W + (size_t)pn * 256 * 2048; u.B1 = u.B0; u.ksA = 1 << 20; u.ksB = 1 << 20;
        u.p0 = pm; u.p1 = pn; u.p2 = ctx; u.p3 = 0; return true;
    }
    DEV void rows(const Unit&, const int*, const int*, unsigned*) const {}
};
struct EpiIn {
    static constexpr bool PERM = true;
    bf16_t* UG; bf16_t* BG; bf16_t* CV;
    DEV void operator()(const f32x4 (&acc)[2][2][4][2], const Unit& u, int wr, int wc, int fr, int fq) const {
        const int pm = u.p0, pn = u.p1;
#pragma unroll
        for (int ai = 0; ai < 2; ++ai)
#pragma unroll
            for (int m = 0; m < 4; ++m) {
                const int r = ai * 128 + wr * 64 + m * 16 + fr;
                if (pn == 0) {
                    const int mm = pm * 256 + r;
                    const int chunk = mm >> 6, k = mm & 63;
#pragma unroll
                    for (int bj = 0; bj < 2; ++bj) { const int c = bj * 128 + wc * 32 + 8 * fq, g = c >> 4, h0 = c & 15;
                        const f32x4 v0 = acc[ai][bj][m][0], v1 = acc[ai][bj][m][1];
                        u32x4 w; w.x = cvt_pk_bf16(v0[0], v0[1]); w.y = cvt_pk_bf16(v0[2], v0[3]); w.z = cvt_pk_bf16(v1[0], v1[1]); w.w = cvt_pk_bf16(v1[2], v1[3]);
                        *(u32x4*)(UG + ((size_t)(g * NCH_PAD + chunk) * UGK + k * 16 + h0)) = w; }
                } else if (pn < 4) {
                    bf16_t* rowp = BG + (size_t)(pm * 256 + r) * CONVW + (pn - 1) * 256 + wc * 32 + 8 * fq;
#pragma unroll
                    for (int bj = 0; bj < 2; ++bj) { const f32x4 v0 = acc[ai][bj][m][0], v1 = acc[ai][bj][m][1];
                        u32x4 w; w.x = cvt_pk_bf16(v0[0], v0[1]); w.y = cvt_pk_bf16(v0[2], v0[3]); w.z = cvt_pk_bf16(v1[0], v1[1]); w.w = cvt_pk_bf16(v1[2], v1[3]);
                        *(u32x4*)(rowp + bj * 128) = w; }
                } else {
                    const f32x4 v0 = acc[ai][0][m][0] * acc[ai][1][m][0], v1 = acc[ai][0][m][1] * acc[ai][1][m][1];
                    u32x4 w; w.x = cvt_pk_bf16(v0[0], v0[1]); w.y = cvt_pk_bf16(v0[2], v0[3]); w.z = cvt_pk_bf16(v1[0], v1[1]); w.w = cvt_pk_bf16(v1[2], v1[3]);
                    *(u32x4*)(CV + (size_t)(pm * 256 + r) * CONVW + (pn - 4) * 128 + wc * 32 + 8 * fq) = w;
                }
            }
    }
};

struct SchedE {
    static constexpr bool GATHER = false;
    int nt; unsigned lda, ldb; int c; const char* UG; const char* WE;
    DEV bool next(int i, Unit& u) const {
        if (i > 0 || c >= 80) return false;
        const int g = c / 5, pm = c % 5;
        u.A0 = UG + ((size_t)g * NCH_PAD + pm * 256) * UGK * 2; u.A1 = u.A0; u.B0 = WE + (size_t)g * 256 * 2048; u.B1 = u.B0; u.ksA = 1 << 20; u.ksB = 1 << 20;
        u.p0 = pm; u.p1 = g; u.p2 = 0; u.p3 = 0; return true;
    }
    DEV void rows(const Unit&, const int*, const int*, unsigned*) const {}
};
struct EpiE {
    static constexpr bool PERM = false;
    float* E;
    DEV void operator()(const f32x4 (&acc)[2][2][4][2], const Unit& u, int wr, int wc, int fr, int fq) const {
        float* base = E + ((size_t)u.p1 * NCH_PAD + u.p0 * 256) * 256;
#pragma unroll
        for (int ai = 0; ai < 2; ++ai)
#pragma unroll
            for (int m = 0; m < 4; ++m) { float* rowp = base + (size_t)(ai * 128 + wr * 64 + m * 16 + fr) * 256 + wc * 32 + 4 * fq;
#pragma unroll
                for (int bj = 0; bj < 2; ++bj)
#pragma unroll
                    for (int n = 0; n < 2; ++n) *(f32x4*)(rowp + bj * 128 + n * 16) = acc[ai][bj][m][n]; }
    }
};
struct SchedSB {
    static constexpr bool GATHER = false;
    int nt; unsigned lda, ldb; int c; const char* SH2; const char* W13;
    DEV bool next(int i, Unit& u) const {
        if (i > 0 || c < 0 || c >= 64) return false;
        const int e = c >> 2, ti = c & 3;
        u.A0 = SH2; u.A1 = u.A0; u.B0 = W13 + ((size_t)e * 1024 + ti * 256) * 2048; u.B1 = u.B0; u.ksA = 1 << 20; u.ksB = 1 << 20;
        u.p0 = e; u.p1 = ti; u.p2 = 0; u.p3 = 0; return true;
    }
    DEV void rows(const Unit&, const int*, const int*, unsigned*) const {}
};
struct EpiSB {
    static constexpr bool PERM = false;
    float* SB;
    DEV void operator()(const f32x4 (&acc)[2][2][4][2], const Unit& u, int wr, int wc, int fr, int fq) const {
        if (wr != 0) return;
#pragma unroll
        for (int m = 0; m < 2; ++m) { const int b = m * 16 + fr; float* rowp = SB + ((size_t)(b * 16 + u.p0) * 1024 + u.p1 * 256 + wc * 32 + 4 * fq);
#pragma unroll
            for (int bj = 0; bj < 2; ++bj)
#pragma unroll
                for (int n = 0; n < 2; ++n) *(f32x4*)(rowp + bj * 128 + n * 16) = acc[0][bj][m][n]; }
    }
};

DEV void p4_phase(Frame& F) {
    const int gt = F.bx * 512 + F.tid, NT = F.G * 512;
    {
        const float* E = WSP(float, WS_E); const f32x2* APOW = WSP(f32x2, WS_APOW); bf16_t* UG = WSP(bf16_t, WS_UG);
        for (int idx = gt; idx < NB * NG * 128; idx += NT) {
            const int p = idx & 63, dir = (idx >> 6) & 1, g = (idx >> 7) & 15, b = idx >> 11;
            const f32x2 a = APOW[((dir * 16 + g) * 65 + 64) * 64 + p];
            const float* Eg = E + (size_t)g * NCH_PAD * 256 + dir * 128 + p;
            bf16_t* Ug = UG + (size_t)g * NCH_PAD * UGK + 1024 + dir * 128 + p;
            float sr = 0.f, si = 0.f;
            for (int c = 0; c < 4; ++c) { const int ch = NCH_LAT + b * 4 + (dir ? 3 - c : c); const float er = Eg[(size_t)ch * 256], ei = Eg[(size_t)ch * 256 + 64];
                const float nr = a.x * sr - a.y * si + er, ni = a.x * si + a.y * sr + ei; sr = nr; si = ni; }
            for (int c = 0; c < 32; ++c) { const int ch = b * 32 + (dir ? 31 - c : c);
                Ug[(size_t)ch * UGK] = (bf16_t)(cvt_pk_bf16(sr, 0.f) & 0xffffu); Ug[(size_t)ch * UGK + 64] = (bf16_t)(cvt_pk_bf16(si, 0.f) & 0xffffu);
                const float er = Eg[(size_t)ch * 256], ei = Eg[(size_t)ch * 256 + 64];
                const float nr = a.x * sr - a.y * si + er, ni = a.x * si + a.y * sr + ei; sr = nr; si = ni; }
        }
    }
    {
        const bf16_t* BG = WSP(bf16_t, WS_BG); const bf16_t* CV = WSP(bf16_t, WS_CV); bf16_t* YM = WSP(bf16_t, WS_YMIX); const float* cw = F.in[I_CONVW];
        for (int idx = gt; idx < TOK * 96; idx += NT) {
            const int j8 = idx % 96, m = idx / 96, j0 = j8 * 8;
            const bool rowp = j0 < 384; const int d = rowp ? 1 : 64;
            const bool hasl = rowp ? ((m & 63) > 0) : (((m >> 6) & 31) > 0), hasr = rowp ? ((m & 63) < 63) : (((m >> 6) & 31) < 31);
            const u32x4 z = (u32x4){0u, 0u, 0u, 0u};
            const u32x4 c0 = hasl ? *(const u32x4*)(CV + (size_t)(m - d) * CONVW + j0) : z;
            const u32x4 c1 = *(const u32x4*)(CV + (size_t)m * CONVW + j0);
            const u32x4 c2 = hasr ? *(const u32x4*)(CV + (size_t)(m + d) * CONVW + j0) : z;
            const u32x4 bb = *(const u32x4*)(BG + (size_t)m * CONVW + j0);
            float o[8];
#pragma unroll
            for (int q = 0; q < 4; ++q) {
                const float w0a = cw[j0 + 2 * q], w0b = cw[j0 + 2 * q + 1], w1a = cw[CONVW + j0 + 2 * q], w1b = cw[CONVW + j0 + 2 * q + 1], w2a = cw[2 * CONVW + j0 + 2 * q], w2b = cw[2 * CONVW + j0 + 2 * q + 1];
                o[2 * q] = bflo(bb[q]) * (bflo(c0[q]) * w0a + bflo(c1[q]) * w1a + bflo(c2[q]) * w2a);
                o[2 * q + 1] = bfhi(bb[q]) * (bfhi(c0[q]) * w0b + bfhi(c1[q]) * w1b + bfhi(c2[q]) * w2b);
            }
            u32x4 w; w.x = cvt_pk_bf16(o[0], o[1]); w.y = cvt_pk_bf16(o[2], o[3]); w.z = cvt_pk_bf16(o[4], o[5]); w.w = cvt_pk_bf16(o[6], o[7]);
            *(u32x4*)(YM + (size_t)m * DM + 256 + j0) = w;
        }
    }
}

struct SchedY {
    static constexpr bool GATHER = false;
    int nt; unsigned lda, ldb; int c; const char* UG; const char* TR;
    DEV bool next(int i, Unit& u) const {
        if (i > 0 || c >= 256) return false;
        const int g = c >> 4, pm = (c >> 2) & 3, pn = c & 3;
        u.A0 = UG + ((size_t)g * NCH_PAD + pm * 256) * UGK * 2; u.A1 = u.A0; u.B0 = TR + ((size_t)g * 1024 + pn * 256) * UGK * 2; u.B1 = u.B0; u.ksA = 1 << 20; u.ksB = 1 << 20;
        u.p0 = pm; u.p1 = pn; u.p2 = g; u.p3 = 0; return true;
    }
    DEV void rows(const Unit&, const int*, const int*, unsigned*) const {}
};
struct EpiY {
    static constexpr bool PERM = true;
    bf16_t* Gb;
    DEV void operator()(const f32x4 (&acc)[2][2][4][2], const Unit& u, int wr, int wc, int fr, int fq) const {
#pragma unroll
        for (int ai = 0; ai < 2; ++ai)
#pragma unroll
            for (int m = 0; m < 4; ++m) { const int chunk = u.p0 * 256 + ai * 128 + wr * 64 + m * 16 + fr;
#pragma unroll
                for (int bj = 0; bj < 2; ++bj) { const int n = u.p1 * 256 + bj * 128 + wc * 32 + 8 * fq, t = n >> 4, h0 = n & 15;
                    const f32x4 v0 = acc[ai][bj][m][0], v1 = acc[ai][bj][m][1];
                    u32x4 w; w.x = cvt_pk_bf16(gelu_tanh(v0[0]), gelu_tanh(v0[1])); w.y = cvt_pk_bf16(gelu_tanh(v0[2]), gelu_tanh(v0[3]));
                    w.z = cvt_pk_bf16(gelu_tanh(v1[0]), gelu_tanh(v1[1])); w.w = cvt_pk_bf16(gelu_tanh(v1[2]), gelu_tanh(v1[3]));
                    *(u32x4*)(Gb + ((size_t)(chunk * 64 + t) * 256 + u.p2 * 16 + h0)) = w; } }
    }
};

struct SchedGlu {
    static constexpr bool GATHER = false;
    int nt; unsigned lda, ldb; int G, c; const char* Gb; const char* W;
    DEV bool next(int i, Unit& u) const {
        const int L = i * G + c; if (L >= 256) return false;
        u.A0 = Gb + (size_t)L * 256 * 512; u.A1 = u.A0; u.B0 = W; u.B1 = u.B0; u.ksA = 1 << 20; u.ksB = 1 << 20; u.p0 = L; u.p1 = 0; u.p2 = 0; u.p3 = 0; return true;
    }
    DEV void rows(const Unit&, const int*, const int*, unsigned*) const {}
};
struct EpiGlu {
    static constexpr bool PERM = true;
    const bf16_t* Gb; bf16_t* YM; const float* bglu;
    DEV void operator()(const f32x4 (&acc)[2][2][4][2], const Unit& u, int wr, int wc, int fr, int fq) const {
#pragma unroll
        for (int ai = 0; ai < 2; ++ai)
#pragma unroll
            for (int m = 0; m < 4; ++m) { const int row = u.p0 * 256 + ai * 128 + wr * 64 + m * 16 + fr;
#pragma unroll
                for (int bj = 0; bj < 2; ++bj) { const int c = bj * 128 + wc * 32 + 8 * fq;
                    const u32x4 gv = *(const u32x4*)(Gb + (size_t)row * 256 + c); const f32x4 b0 = *(const f32x4*)(bglu + c), b1 = *(const f32x4*)(bglu + c + 4);
                    const f32x4 z0 = acc[ai][bj][m][0] + b0, z1 = acc[ai][bj][m][1] + b1;
                    u32x4 w; w.x = cvt_pk_bf16(bflo(gv.x) * sigmoidf_(z0[0]), bfhi(gv.x) * sigmoidf_(z0[1])); w.y = cvt_pk_bf16(bflo(gv.y) * sigmoidf_(z0[2]), bfhi(gv.y) * sigmoidf_(z0[3]));
                    w.z = cvt_pk_bf16(bflo(gv.z) * sigmoidf_(z1[0]), bfhi(gv.z) * sigmoidf_(z1[1])); w.w = cvt_pk_bf16(bflo(gv.w) * sigmoidf_(z1[2]), bfhi(gv.w) * sigmoidf_(z1[3]));
                    *(u32x4*)(YM + (size_t)row * DM + c) = w; } }
    }
};

struct SchedOut {
    static constexpr bool GATHER = false;
    int nt; unsigned lda, ldb; int G, c; const char* A; const char* W;
    DEV bool next(int i, Unit& u) const {
        const int L = i * G + c; if (L >= 1024) return false;
        int pm, pn; pg8::static_tile(L, 256, 4, pm, pn);
        u.A0 = A + (size_t)pm * 256 * 2048; u.A1 = u.A0; u.B0 = W + (size_t)pn * 256 * 2048; u.B1 = u.B0; u.ksA = 1 << 20; u.ksB = 1 << 20; u.p0 = pm; u.p1 = pn; u.p2 = 0; u.p3 = 0; return true;
    }
    DEV void rows(const Unit&, const int*, const int*, unsigned*) const {}
};
struct EpiOut {
    static constexpr bool PERM = false;
    const float* x; float* x1; bf16_t* x1g; float* rsq; const float* mod; const float* n2g;
    DEV void operator()(const f32x4 (&acc)[2][2][4][2], const Unit& u, int wr, int wc, int fr, int fq) const {
        const int b = u.p0 >> 3, col0 = u.p1 * 256 + wc * 32 + 4 * fq;
        f32x4 gate[2][2], gs[2][2];
#pragma unroll
        for (int bj = 0; bj < 2; ++bj)
#pragma unroll
            for (int n = 0; n < 2; ++n) { const int c = col0 + bj * 128 + n * 16;
                gate[bj][n] = *(const f32x4*)(mod + b * NMOD + 2 * DM + c);
                gs[bj][n] = *(const f32x4*)(n2g + c) * (1.0f + *(const f32x4*)(mod + b * NMOD + 4 * DM + c)); }
#pragma unroll
        for (int ai = 0; ai < 2; ++ai)
#pragma unroll
            for (int m = 0; m < 4; ++m) { const int row = u.p0 * 256 + ai * 128 + wr * 64 + m * 16 + fr; const size_t off = (size_t)row * DM + col0; float sq = 0.f;
#pragma unroll
                for (int bj = 0; bj < 2; ++bj)
#pragma unroll
                    for (int n = 0; n < 2; ++n) { const f32x4 xv = *(const f32x4*)(x + off + bj * 128 + n * 16); const f32x4 v = xv + gate[bj][n] * acc[ai][bj][m][n];
                        *(f32x4*)(x1 + off + bj * 128 + n * 16) = v; sq += (v[0] * v[0] + v[1] * v[1]) + (v[2] * v[2] + v[3] * v[3]);
                        const f32x4 y = v * gs[bj][n]; u32x2 w; w.x = cvt_pk_bf16(y[0], y[1]); w.y = cvt_pk_bf16(y[2], y[3]); *(u32x2*)(x1g + off + bj * 128 + n * 16) = w; }
                sq += __shfl_xor(sq, 16); sq += __shfl_xor(sq, 32);
                if (fq == 0) rsq[(size_t)row * 16 + u.p1 * 4 + wc] = sq; }
    }
};

DEV void p8_phase(Frame& F) {
    const bf16_t* X1G = WSP(bf16_t, WS_X1G); const bf16_t* Wr = WSP(bf16_t, WS_WR); const float* rsq = WSP(float, WS_RSQ1); const float* rb = WSP(float, WS_RB);
    int* tokb = WSP(int, WS_TOKB); float* tokw = WSP(float, WS_TOKW); float* tokr = WSP(float, WS_TOKR); int* segc = WSP(int, WS_SEGC);
    LAS int* hist = (LAS int*)F.lds;
    const int l15 = F.lane & 15, q = F.lane >> 4;
    for (int seg = F.bx; seg < TOK / 256; seg += F.G) {
        if (F.tid < 32) hist[F.tid] = 0;
        __syncthreads();
        const int tok0 = seg * 256 + F.wave * 32, b = seg >> 3;
        f32x4 acc[2][2];
#pragma unroll
        for (int a = 0; a < 2; ++a)
#pragma unroll
            for (int t = 0; t < 2; ++t) acc[a][t] = (f32x4){0.f, 0.f, 0.f, 0.f};
        const bf16_t* x0 = X1G + (size_t)(tok0 + l15) * DM + 8 * q; const bf16_t* x1 = x0 + 16 * DM;
        const bf16_t* w0 = Wr + (size_t)l15 * DM + 8 * q; const bf16_t* w1 = w0 + 16 * DM;
#pragma unroll 4
        for (int ks = 0; ks < 32; ++ks) {
            const bf16x8 xa = *(const bf16x8*)(x0 + ks * 32), xb = *(const bf16x8*)(x1 + ks * 32), wa = *(const bf16x8*)(w0 + ks * 32), wb = *(const bf16x8*)(w1 + ks * 32);
            acc[0][0] = __builtin_amdgcn_mfma_f32_16x16x32_bf16(wa, xa, acc[0][0], 0, 0, 0); acc[0][1] = __builtin_amdgcn_mfma_f32_16x16x32_bf16(wb, xa, acc[0][1], 0, 0, 0);
            acc[1][0] = __builtin_amdgcn_mfma_f32_16x16x32_bf16(wa, xb, acc[1][0], 0, 0, 0); acc[1][1] = __builtin_amdgcn_mfma_f32_16x16x32_bf16(wb, xb, acc[1][1], 0, 0, 0);
        }
#pragma unroll
        for (int rg = 0; rg < 2; ++rg) {
            const int tok = tok0 + rg * 16 + l15;
            const f32x4* rp = (const f32x4*)(rsq + (size_t)tok * 16); const f32x4 r0 = rp[0], r1 = rp[1], r2 = rp[2], r3 = rp[3];
            const float ss = ((r0[0] + r0[1]) + (r0[2] + r0[3])) + ((r1[0] + r1[1]) + (r1[2] + r1[3])) + ((r2[0] + r2[1]) + (r2[2] + r2[3])) + ((r3[0] + r3[1]) + (r3[2] + r3[3]));
            const float rstd = 1.0f / sqrtf(ss * (1.f / DM) + RMS_EPS);
            float lg[4], l2[4], gl[4], t1[4], t2[4], v[4];
#pragma unroll
            for (int r = 0; r < 4; ++r) { lg[r] = rstd * acc[rg][0][r] + rb[b * 32 + 4 * q + r]; l2[r] = rstd * acc[rg][1][r] + rb[b * 32 + 16 + ((4 * q + r) & 15)]; }
#pragma unroll
            for (int r = 0; r < 4; ++r) gl[r] = __shfl(lg[r], l15);
            int gi = 0; float gm = gl[0];
#pragma unroll
            for (int r = 1; r < 4; ++r) if (gl[r] > gm) { gm = gl[r]; gi = r; }
            float den = 0.f;
#pragma unroll
            for (int r = 0; r < 4; ++r) den += __expf(gl[r] - gm);
            const float gp = 1.0f / den;
            const int src = l15 + 16 * ((gi + 1) & 3);
#pragma unroll
            for (int r = 0; r < 4; ++r) { t1[r] = __shfl(lg[r], src); t2[r] = __shfl(l2[r], l15); v[r] = (gi == 3) ? t2[r] : t1[r]; }
            int i1 = 0; float v1 = v[0];
#pragma unroll
            for (int r = 1; r < 4; ++r) if (v[r] > v1) { v1 = v[r]; i1 = r; }
            int i2 = -1; float v2 = 0.f;
#pragma unroll
            for (int r = 0; r < 4; ++r) if (r != i1 && (i2 < 0 || v[r] > v2)) { v2 = v[r]; i2 = r; }
            const float ex = __expf(v2 - v1), p1 = 1.0f / (1.0f + ex), p2 = ex * p1;
            const int lo = i1 < i2 ? i1 : i2, hi = i1 < i2 ? i2 : i1;
            const float wlo = (i1 < i2 ? p1 : p2) * gp, whi = (i1 < i2 ? p2 : p1) * gp;
            const int pidx = (lo == 0) ? (hi - 1) : (lo == 1) ? (hi + 1) : 5;
            const int bucket = gi * 6 + pidx;
            if (q == 0) { tokb[tok] = bucket; tokw[tok * 2] = wlo; tokw[tok * 2 + 1] = whi; tokr[tok] = rstd; atomicAdd((int*)hist + bucket, 1); }
        }
        __syncthreads();
        if (F.tid < 32) segc[seg * 32 + F.tid] = (F.tid < NBUCKET) ? hist[F.tid] : 0;
        __syncthreads();
    }
}

DEV void p9_phase(Frame& F) {
    const int* segc = WSP(int, WS_SEGC); const int* tokb = WSP(int, WS_TOKB); int* perm = WSP(int, WS_PERM); int* tiles = WSP(int, WS_TILES);
    LAS int* tot = (LAS int*)F.lds;
    LAS int* tst = tot + 32;
    LAS int* base = tst + 32;
    LAS int* wcnt = base + 32;
    for (int seg = F.bx; seg < TOK / 256; seg += F.G) {
        __syncthreads();
        if (F.tid < 32) { int t = 0, bs = 0; if (F.tid < NBUCKET) for (int s = 0; s < 256; ++s) { const int c = ld_agent_i(segc + s * 32 + F.tid); if (s < seg) bs += c; t += c; } tot[F.tid] = t; base[F.tid] = bs; }
        if (F.tid < 128) wcnt[F.tid] = 0;
        __syncthreads();
        if (F.tid == 0) { int ts = 0; for (int k = 0; k < NBUCKET; ++k) { tst[k] = ts; ts += (tot[k] + 255) >> 8; } tst[NBUCKET] = ts; }
        __syncthreads();
        int bk = -1, rank = 0;
        if (F.tid < 256) {
            bk = ld_agent_i(tokb + seg * 256 + F.tid);
            for (int k = 0; k < NBUCKET; ++k) { const unsigned long long msk = __ballot(bk == k); if (bk == k) rank = __popcll(msk & ((1ull << F.lane) - 1ull)); if (F.lane == 0) wcnt[F.wave * 32 + k] = __popcll(msk); }
        }
        __syncthreads();
        if (F.tid < 256) { int off = 0; for (int w = 0; w < F.wave; ++w) off += wcnt[w * 32 + bk]; perm[tst[bk] * 256 + base[bk] + off + rank] = seg * 256 + F.tid; }
        if (seg < NBUCKET) { const int k = seg, n = tot[k], np = ((n + 255) >> 8) << 8; for (int r = n + F.tid; r < np; r += 512) perm[tst[k] * 256 + r] = -1; }
        if (seg == 0) { if (F.tid == 0) tiles[0] = tst[NBUCKET];
            if (F.tid < NBUCKET) { const int k = F.tid, nt_ = (tot[k] + 255) >> 8; for (int t = 0; t < nt_; ++t) tiles[16 + tst[k] + t] = k; } }
    }
}
DEV void bucket_experts(int bk, int& e0, int& e1) { const int grp = bk / 6, pi = bk % 6; const int lo = pi < 3 ? 0 : (pi < 5 ? 1 : 2), hi = pi < 3 ? pi + 1 : (pi < 5 ? pi - 1 : 3); e0 = grp * 4 + lo; e1 = grp * 4 + hi; }

struct SchedUp {
    static constexpr bool GATHER = true;
    int nt; unsigned lda, ldb; int G, c, ntiles; const char* X1G; const char* W13; const int* perm; const int* tiles;
    DEV bool next(int i, Unit& u) const {
        const int L = i * G + c; if (L >= ntiles * 8) return false;
        const int tile = L >> 3, s = (L >> 2) & 1, ti = L & 3; int e0, e1; bucket_experts(ld_agent_i(tiles + 16 + tile), e0, e1); const int e = s ? e1 : e0;
        u.A0 = X1G; u.A1 = X1G; u.B0 = W13 + ((size_t)e * 1024 + ti * 256) * 2048; u.B1 = u.B0; u.ksA = 1 << 20; u.ksB = 1 << 20; u.p0 = tile; u.p1 = s; u.p2 = ti; u.p3 = e; return true;
    }
    DEV void rows(const Unit& u, const int* R, const int* C, unsigned* v) const {
#pragma unroll
        for (int h = 0; h < 2; ++h)
#pragma unroll
            for (int i = 0; i < 2; ++i) { int t = ld_agent_i(perm + u.p0 * 256 + h * 128 + R[i]); t = t < 0 ? 0 : t; v[h * 2 + i] = (unsigned)t * 2048u + (unsigned)C[i] * 2u; }
    }
};
struct EpiUp {
    static constexpr bool PERM = true;
    bf16_t* HID; const int* perm; const float* tokw; const float* tokr; const float* sb13;
    DEV void operator()(const f32x4 (&acc)[2][2][4][2], const Unit& u, int wr, int wc, int fr, int fq) const {
#pragma unroll
        for (int ai = 0; ai < 2; ++ai)
#pragma unroll
            for (int m = 0; m < 4; ++m) { const int slot = u.p0 * 256 + ai * 128 + wr * 64 + m * 16 + fr; const int tk0 = ld_agent_i(perm + slot); const bool valid = tk0 >= 0; const int tk = valid ? tk0 : 0;
                const float rstd = tokr[tk], w = valid ? tokw[tk * 2 + u.p1] : 0.f; const int b = tk >> 11;
                const float* bias = sb13 + ((size_t)(b * 16 + u.p3) * 1024 + u.p2 * 256 + wc * 32 + 8 * fq);
                const f32x4 b10 = *(const f32x4*)(bias), b11 = *(const f32x4*)(bias + 4), b30 = *(const f32x4*)(bias + 128), b31 = *(const f32x4*)(bias + 132);
                const f32x4 p10 = acc[ai][0][m][0] * rstd + b10, p11 = acc[ai][0][m][1] * rstd + b11, p30 = acc[ai][1][m][0] * rstd + b30, p31 = acc[ai][1][m][1] * rstd + b31;
                float o[8];
#pragma unroll
                for (int j = 0; j < 4; ++j) { o[j] = w * siluf_(p10[j]) * p30[j]; o[4 + j] = w * siluf_(p11[j]) * p31[j]; }
                u32x4 wv; wv.x = cvt_pk_bf16(o[0], o[1]); wv.y = cvt_pk_bf16(o[2], o[3]); wv.z = cvt_pk_bf16(o[4], o[5]); wv.w = cvt_pk_bf16(o[6], o[7]);
                *(u32x4*)(HID + ((size_t)slot * 1024 + u.p1 * 512 + u.p2 * 128 + wc * 32 + 8 * fq)) = wv; }
    }
};

struct SchedDown {
    static constexpr bool GATHER = false;
    int nt; unsigned lda, ldb; int G, c, ntiles; const char* HID; const char* W2; const int* tiles;
    DEV bool next(int i, Unit& u) const {
        const int L = i * G + c; if (L >= ntiles * 4) return false;
        const int tile = L >> 2, pn = L & 3; int e0, e1; bucket_experts(ld_agent_i(tiles + 16 + tile), e0, e1);
        u.A0 = HID + (size_t)tile * 256 * 2048; u.A1 = u.A0; u.ksA = 1 << 20;
        u.B0 = W2 + ((size_t)e0 * 1024 + pn * 256) * 1024; u.B1 = W2 + ((size_t)e1 * 1024 + pn * 256) * 1024; u.ksB = 8;
        u.p0 = tile; u.p1 = pn; u.p2 = 0; u.p3 = 0; return true;
    }
    DEV void rows(const Unit&, const int*, const int*, unsigned*) const {}
};
struct EpiDown {
    static constexpr bool PERM = false;
    float* x1; float* rsq; const int* perm; const float* mod;
    DEV void operator()(const f32x4 (&acc)[2][2][4][2], const Unit& u, int wr, int wc, int fr, int fq) const {
        const int col0 = u.p1 * 256 + wc * 32 + 4 * fq;
#pragma unroll
        for (int ai = 0; ai < 2; ++ai)
#pragma unroll
            for (int m = 0; m < 4; ++m) { const int slot = u.p0 * 256 + ai * 128 + wr * 64 + m * 16 + fr; const int tk0 = ld_agent_i(perm + slot); const bool valid = tk0 >= 0; const int tk = valid ? tk0 : 0;
                const int b = tk >> 11; const size_t off = (size_t)tk * DM + col0; float sq = 0.f;
#pragma unroll
                for (int bj = 0; bj < 2; ++bj)
#pragma unroll
                    for (int n = 0; n < 2; ++n) { const f32x4 gate = *(const f32x4*)(mod + b * NMOD + 5 * DM + col0 + bj * 128 + n * 16);
                        const f32x4 xv = *(const f32x4*)(x1 + off + bj * 128 + n * 16); const f32x4 v = xv + gate * acc[ai][bj][m][n];
                        if (valid) *(f32x4*)(x1 + off + bj * 128 + n * 16) = v;
                        sq += (v[0] * v[0] + v[1] * v[1]) + (v[2] * v[2] + v[3] * v[3]); }
                sq += __shfl_xor(sq, 16); sq += __shfl_xor(sq, 32);
                if (fq == 0 && valid) rsq[(size_t)tk * 16 + u.p1 * 4 + wc] = sq; }
    }
};

DEV void p12_phase(Frame& F) {
    const float* rsq = WSP(float, WS_RSQ2); const float* fg = F.in[I_FING];
    const int gw = F.vcu * 8 + F.wave, NGW = F.G * 8;
    for (int m = gw; m < TOK; m += NGW) {
        float pv = (F.lane < 16) ? rsq[(size_t)m * 16 + F.lane] : 0.f;
        const float rstd = 1.0f / sqrtf(wave_sum(pv) * (1.f / DM) + RMS_EPS);
        f32x4* xr = (f32x4*)(F.out + (size_t)m * DM) + F.lane;
#pragma unroll
        for (int j = 0; j < 4; ++j) { const f32x4 v = xr[64 * j]; xr[64 * j] = v * rstd * ((const f32x4*)fg)[F.lane + 64 * j]; }
    }
}

constexpr int LDS_BYTES = 147456;
constexpr int NPHASE = 13;

__global__ void __launch_bounds__(512, 2) mk_fwd(Args args) {
    extern __shared__ __attribute__((aligned(16))) unsigned char lds_raw[];
    Frame F;
    F.lds = (LAS unsigned char*)lds_raw;
    F.tid = threadIdx.x; F.lane = F.tid & 63; F.wave = __builtin_amdgcn_readfirstlane(F.tid >> 6);
    F.G = gridDim.x; F.bx = blockIdx.x; F.vcu = (F.G % 8 == 0) ? (F.bx % 8) * (F.G / 8) + F.bx / 8 : F.bx;
#pragma unroll
    for (int i = 0; i < 29; ++i) F.in[i] = args.in[i];
    F.out = args.out; F.ws = args.ws;
    const int lo = args.ph_lo, hi = args.ph_hi;
#if MK_ONE_LAUNCH
    cg::grid_group grid = cg::this_grid();
#define SEAM(k) do { if (lo <= (k) && (k) + 1 < hi) grid.sync(); } while (0)
#else
#define SEAM(k) do { } while (0)
#endif
#define IN(k) (lo <= (k) && (k) < hi)

    if (IN(0)) { p0_phase(F); }
    SEAM(0);
    if (IN(1)) { p1_phase(F); }
    SEAM(1);
    if (IN(2)) {
        p2_fill_tr(F);
        SchedIn S{16, 2048u, 2048u, F.G, F.bx, (const char*)WSP(bf16_t, WS_HX), (const char*)WSP(bf16_t, WS_WIN)};
        EpiIn E{WSP(bf16_t, WS_UG), WSP(bf16_t, WS_BG), WSP(bf16_t, WS_CV)};
        pg8::gemm_phase<EpiIn, SchedIn>(F.lds, S, E);
    }
    SEAM(2);
    if (IN(3)) {
        if (F.bx < 80) { SchedE S{16, (unsigned)(UGK * 2), 2048u, F.bx, (const char*)WSP(bf16_t, WS_UG), (const char*)WSP(bf16_t, WS_WE)}; EpiE E{WSP(float, WS_E)};
            pg8::gemm_phase<EpiE, SchedE>(F.lds, S, E); }
        else if (F.bx < 144) { SchedSB S{16, 2048u, 2048u, F.bx - 80, (const char*)WSP(bf16_t, WS_SH2), (const char*)WSP(bf16_t, WS_W13)}; EpiSB E{WSP(float, WS_SB13)};
            pg8::gemm_phase<EpiSB, SchedSB>(F.lds, S, E); }
    }
    SEAM(3);
    if (IN(4)) { p4_phase(F); }
    SEAM(4);
    if (IN(5)) {
        SchedY S{20, (unsigned)(UGK * 2), (unsigned)(UGK * 2), F.bx, (const char*)WSP(bf16_t, WS_UG), (const char*)WSP(bf16_t, WS_TR)}; EpiY E{WSP(bf16_t, WS_G)};
        pg8::gemm_phase<EpiY, SchedY>(F.lds, S, E);
    }
    SEAM(5);
    if (IN(6)) {
        SchedGlu S{4, 512u, 512u, F.G, F.bx, (const char*)WSP(bf16_t, WS_G), (const char*)WSP(bf16_t, WS_WGLU)}; EpiGlu E{WSP(bf16_t, WS_G), WSP(bf16_t, WS_YMIX), F.in[I_BGLU]};
        pg8::gemm_phase<EpiGlu, SchedGlu>(F.lds, S, E);
    }
    SEAM(6);
    if (IN(7)) {
        SchedOut S{16, 2048u, 2048u, F.G, F.bx, (const char*)WSP(bf16_t, WS_YMIX), (const char*)WSP(bf16_t, WS_WOUT)};
        EpiOut E{F.in[I_X], F.out, WSP(bf16_t, WS_X1G), WSP(float, WS_RSQ1), WSP(float, WS_MOD), F.in[I_N2G]};
        pg8::gemm_phase<EpiOut, SchedOut>(F.lds, S, E);
    }
    SEAM(7);
    if (IN(8)) { p8_phase(F); }
    SEAM(8);
    if (IN(9)) { p9_phase(F); }
    SEAM(9);
    if (IN(10)) {
        const int ntiles = ld_agent_i(WSP(int, WS_TILES));
        SchedUp S{16, 2048u, 2048u, F.G, F.vcu, ntiles, (const char*)WSP(bf16_t, WS_X1G), (const char*)WSP(bf16_t, WS_W13), WSP(int, WS_PERM), WSP(int, WS_TILES)};
        EpiUp E{WSP(bf16_t, WS_HID), WSP(int, WS_PERM), WSP(float, WS_TOKW), WSP(float, WS_TOKR), WSP(float, WS_SB13)};
        pg8::gemm_phase<EpiUp, SchedUp>(F.lds, S, E);
    }
    SEAM(10);
    if (IN(11)) {
        const int ntiles = ld_agent_i(WSP(int, WS_TILES));
        SchedDown S{16, 2048u, 1024u, F.G, F.vcu, ntiles, (const char*)WSP(bf16_t, WS_HID), (const char*)WSP(bf16_t, WS_W2), WSP(int, WS_TILES)};
        EpiDown E{F.out, WSP(float, WS_RSQ2), WSP(int, WS_PERM), WSP(float, WS_MOD)};
        pg8::gemm_phase<EpiDown, SchedDown>(F.lds, S, E);
    }
    SEAM(11);
    if (IN(12)) { p12_phase(F); }
#undef IN
#undef SEAM
}

extern "C" void kernel_launch(void* const* d_in, const int* in_sizes, int n_in, void* d_out, int out_size, void* d_ws, size_t ws_size, hipStream_t stream) {
    static int grid = 0;
    if (grid == 0) {
        if (n_in != 29 || out_size != TOK * DM || ws_size < WS_END) { fprintf(stderr, "kernel_launch: unexpected problem (n_in %d, out %d, ws %zu)\n", n_in, out_size, ws_size); grid = -1; return; }
        int dev = 0, cus = 0, per_cu = 0;
        if (hipGetDevice(&dev) != hipSuccess || hipDeviceGetAttribute(&cus, hipDeviceAttributeMultiprocessorCount, dev) != hipSuccess) { grid = -1; return; }
        if (hipFuncSetAttribute((const void*)mk_fwd, hipFuncAttributeMaxDynamicSharedMemorySize, LDS_BYTES) != hipSuccess) { fprintf(stderr, "kernel_launch: hipFuncSetAttribute failed\n"); grid = -1; return; }
        if (hipOccupancyMaxActiveBlocksPerMultiprocessor(&per_cu, (const void*)mk_fwd, 512, LDS_BYTES) != hipSuccess || per_cu < 1) { fprintf(stderr, "kernel_launch: occupancy query gives %d\n", per_cu); (void)hipGetLastError(); per_cu = 1; }
        grid = cus;
        if (grid > 256) grid = 256;
    }
    if (grid < 0) return;
    Args a{};
    for (int i = 0; i < 29; ++i) a.in[i] = (const float*)d_in[i];
    a.out = (float*)d_out; a.ws = (unsigned char*)d_ws;
#if MK_ONE_LAUNCH
    a.ph_lo = 0; a.ph_hi = NPHASE;
    void* kargs[] = {&a};
    hipError_t e = hipLaunchCooperativeKernel((const void*)mk_fwd, dim3(grid), dim3(512), kargs, LDS_BYTES, stream);
    if (e != hipSuccess) fprintf(stderr, "cooperative launch failed: %s (grid %d)\n", hipGetErrorString(e), grid);
#else
    for (int p = 0; p < NPHASE; ++p) { a.ph_lo = p; a.ph_hi = p + 1; hipLaunchKernelGGL(mk_fwd, dim3(grid), dim3(512), LDS_BYTES, stream, a); }
#endif
}
```

```cpp
#include <hip/hip_runtime.h>
#include <hip/hip_cooperative_groups.h>
#include <cstdio>
namespace cg = cooperative_groups;

#ifndef MK_ONE_LAUNCH
#define MK_ONE_LAUNCH 1
#endif

#define DEV __device__ __forceinline__
#define LAS __attribute__((address_space(3)))
typedef unsigned short bf16_t;
typedef short bf16x8 __attribute__((ext_vector_type(8)));
typedef float f32x4 __attribute__((ext_vector_type(4)));
typedef float f32x2 __attribute__((ext_vector_type(2)));
typedef unsigned u32x4 __attribute__((ext_vector_type(4)));
typedef unsigned u32x2 __attribute__((ext_vector_type(2)));

constexpr int NB = 32, SEQ = 2048, DM = 1024, TOK = NB * SEQ, CTXL = 256, CTOK = NB * CTXL;
constexpr int NG = 16, NP = 64, NH = 16, LC = 64;
constexpr int NCH_LAT = TOK / LC, NCH_CTX = CTOK / LC, NCH_PAD = 1280, UGK = 1280;
constexpr int CONVW = 768, NMOD = 6 * DM;
constexpr int NEXP = 16, DEXP = 512, NBUCKET = 24, MAXTILES = 280;
constexpr float RMS_EPS = 1e-6f;

constexpr size_t MiB = 1u << 20;
constexpr size_t WS_CTL = 0;
constexpr size_t WS_MOD = 1 * MiB;
constexpr size_t WS_APOW = 2 * MiB;
constexpr size_t WS_BBAR = 4 * MiB;
constexpr size_t WS_KTAB = 5 * MiB;
constexpr size_t WS_SB13 = 7 * MiB;
constexpr size_t WS_SH2 = 9 * MiB;
constexpr size_t WS_RB = 10 * MiB;
constexpr size_t WS_TOKB = 10 * MiB + 65536;
constexpr size_t WS_TOKW = 11 * MiB;
constexpr size_t WS_TOKR = 12 * MiB;
constexpr size_t WS_SEGC = 12 * MiB + 512 * 1024;
constexpr size_t WS_PERM = 13 * MiB;
constexpr size_t WS_TILES = 14 * MiB;
constexpr size_t WS_RSQ1 = 16 * MiB;
constexpr size_t WS_RSQ2 = 20 * MiB;
constexpr size_t WS_WR = 24 * MiB;
constexpr size_t WS_WGLU = 25 * MiB;
constexpr size_t WS_WIN = 26 * MiB;
constexpr size_t WS_WOUT = 32 * MiB;
constexpr size_t WS_WE = 34 * MiB;
constexpr size_t WS_W2 = 42 * MiB;
constexpr size_t WS_W13 = 58 * MiB;
constexpr size_t WS_TR = 90 * MiB;
constexpr size_t WS_E = 130 * MiB;
constexpr size_t WS_UG = 150 * MiB;
constexpr size_t WS_G = 200 * MiB;
constexpr size_t WS_BG = 232 * MiB;
constexpr size_t WS_CV = 328 * MiB;
constexpr size_t WS_HX = 424 * MiB;
constexpr size_t WS_HID = WS_HX;
constexpr size_t WS_YMIX = 568 * MiB;
constexpr size_t WS_X1G = 696 * MiB;
constexpr size_t WS_END = 824 * MiB;

DEV unsigned cvt_pk_bf16(float lo, float hi) { unsigned r; asm volatile("v_cvt_pk_bf16_f32 %0, %1, %2" : "=v"(r) : "v"(lo), "v"(hi)); return r; }
DEV float bf2f(unsigned short h) { return __uint_as_float(((unsigned)h) << 16); }
DEV float bflo(unsigned w) { return __uint_as_float(w << 16); }
DEV float bfhi(unsigned w) { return __uint_as_float(w & 0xffff0000u); }
DEV float wave_sum(float v) {
#pragma unroll
    for (int o = 1; o < 64; o <<= 1) v += __shfl_xor(v, o);
    return v;
}
DEV float sigmoidf_(float x) { return __builtin_amdgcn_rcpf(1.0f + __expf(-x)); }
DEV float siluf_(float x) { return x * sigmoidf_(x); }
DEV float gelu_tanh(float x) { const float u = 0.7978845608028654f * (x + 0.044715f * x * x * x); return x * sigmoidf_(2.0f * u); }
DEV int ld_agent_i(const int* p) { return __hip_atomic_load(p, __ATOMIC_RELAXED, __HIP_MEMORY_SCOPE_AGENT); }

namespace pg8 {
constexpr int BM = 256, BK = 64, HALF = 128, HTB = HALF * BK * 2, STAGE_BYTES = 8 * HTB;
__host__ __device__ __forceinline__ int lds_byte(int r, int c) { const int st = (r >> 4) * 2 + (c >> 5), rr = r & 15, cc = c & 31, ob = rr * 64 + cc * 2; return st * 1024 + (ob ^ (((ob >> 9) & 1) << 5)); }
__host__ __device__ __forceinline__ void stage_rc(int b, int& R, int& C) { const int st = b / 1024, sb = b % 1024, swz = sb ^ (((sb >> 9) & 1) << 5); R = (st >> 1) * 16 + swz / 64; C = (st & 1) * 32 + (swz % 64) / 2; }
__host__ __device__ __forceinline__ int perm32(int rho) { const int n = rho >> 4, i = rho & 15; return 8 * (i >> 2) + 4 * n + (i & 3); }

struct Unit {
    const char* A0; const char* A1; const char* B0; const char* B1;
    int ksA, ksB;
    int p0, p1, p2, p3;
};
DEV const char* pa(const Unit& u, int kt) { return kt < u.ksA ? u.A0 + (size_t)kt * 128 : u.A1 + (size_t)(kt - u.ksA) * 128; }
DEV const char* pb(const Unit& u, int kt) { return kt < u.ksB ? u.B0 + (size_t)kt * 128 : u.B1 + (size_t)(kt - u.ksB) * 128; }

template <class Epi, class Sched>
DEV void gemm_phase(LAS unsigned char* lds, const Sched& S, const Epi& E) {
    const int tid = threadIdx.x, wid = __builtin_amdgcn_readfirstlane(tid >> 6), lane = tid & 63, wr = wid >> 2, wc = wid & 3, fr = lane & 15, fq = lane >> 4;
    const int nt = S.nt;
    int Rr[2], Cc[2];
    unsigned voffB[2], vA[4], vA2[4];
#pragma unroll
    for (int i = 0; i < 2; ++i) { stage_rc(tid * 16 + i * 8192, Rr[i], Cc[i]); const int Rb = Epi::PERM ? ((Rr[i] & ~31) + perm32(Rr[i] & 31)) : Rr[i];
        voffB[i] = (unsigned)Rb * S.ldb + (unsigned)Cc[i] * 2u; }
    const size_t hstepB = (size_t)HALF * S.ldb;
    const unsigned ldsw = (unsigned)wid * 1024u;
    const int aoff = lds_byte(wr * 64 + fr, fq * 8), boff = lds_byte(wc * 32 + fr, fq * 8);
#define PG8_SA(b, h) (((b) * 2 + (h)) * HTB)
#define PG8_SB(b, h) ((4 + (b) * 2 + (h)) * HTB)
#define PG8_STAGE(bufoff, gbase, v0, v1) do { \
        __builtin_amdgcn_global_load_lds((const unsigned*)((const char*)(gbase) + (v0)), (LAS unsigned*)(lds + (bufoff) + ldsw), 16, 0, 0); \
        __builtin_amdgcn_global_load_lds((const unsigned*)((const char*)(gbase) + (v1)), (LAS unsigned*)(lds + (bufoff) + ldsw + 8192), 16, 0, 0); } while (0)
#define PG8_LDA(dst, b, h) do { _Pragma("unroll") for (int m = 0; m < 4; ++m) _Pragma("unroll") for (int k = 0; k < 2; ++k) dst[m][k] = *(const LAS bf16x8*)(lds + PG8_SA(b, h) + aoff + m * 2048 + k * 1024); } while (0)
#define PG8_LDB(dst, b, h) do { _Pragma("unroll") for (int n = 0; n < 2; ++n) _Pragma("unroll") for (int k = 0; k < 2; ++k) dst[n][k] = *(const LAS bf16x8*)(lds + PG8_SB(b, h) + boff + n * 2048 + k * 1024); } while (0)
#define PG8_MMA(ai, bj, At, Bt) do { __builtin_amdgcn_s_setprio(1); _Pragma("unroll") for (int m = 0; m < 4; ++m) _Pragma("unroll") for (int n = 0; n < 2; ++n) _Pragma("unroll") for (int k = 0; k < 2; ++k) \
        acc[ai][bj][m][n] = __builtin_amdgcn_mfma_f32_16x16x32_bf16(Bt[n][k], At[m][k], acc[ai][bj][m][n], 0, 0, 0); __builtin_amdgcn_s_setprio(0); } while (0)
#define PG8_WAIT_V(n) asm volatile("s_waitcnt vmcnt(" #n ")" ::: "memory")
#define PG8_WAIT_L(n) asm volatile("s_waitcnt lgkmcnt(" #n ")" ::: "memory")
#define PG8_BAR __builtin_amdgcn_s_barrier()
#define PG8_SCHED __builtin_amdgcn_sched_barrier(0)
    Unit cur, nxt; int ui = 0;
    if (!S.next(0, cur)) return;
    f32x4 acc[2][2][4][2];
#pragma unroll
    for (int a = 0; a < 2; ++a)
#pragma unroll
        for (int b = 0; b < 2; ++b)
#pragma unroll
            for (int m = 0; m < 4; ++m)
#pragma unroll
                for (int n = 0; n < 2; ++n) acc[a][b][m][n] = (f32x4){0.f, 0.f, 0.f, 0.f};
    bf16x8 At[4][2], B0[2][2], B1[2][2];
    if constexpr (Sched::GATHER) S.rows(cur, Rr, Cc, vA);
    else {
#pragma unroll
        for (int h = 0; h < 2; ++h)
#pragma unroll
            for (int i = 0; i < 2; ++i) vA[h * 2 + i] = (unsigned)(h * HALF + Rr[i]) * S.lda + (unsigned)Cc[i] * 2u;
    }
    {
        const char* a0 = pa(cur, 0); const char* b0 = pb(cur, 0); const char* a1 = pa(cur, 1); const char* b1 = pb(cur, 1);
        PG8_STAGE(PG8_SB(0, 0), b0, voffB[0], voffB[1]); PG8_STAGE(PG8_SA(0, 0), a0, vA[0], vA[1]); PG8_STAGE(PG8_SB(0, 1), b0 + hstepB, voffB[0], voffB[1]); PG8_STAGE(PG8_SA(0, 1), a0, vA[2], vA[3]);
        if (wr == 1) PG8_BAR;
        PG8_WAIT_V(4); PG8_BAR;
        PG8_STAGE(PG8_SB(1, 0), b1, voffB[0], voffB[1]); PG8_STAGE(PG8_SA(1, 0), a1, vA[0], vA[1]); PG8_STAGE(PG8_SB(1, 1), b1 + hstepB, voffB[0], voffB[1]);
        PG8_WAIT_V(6); PG8_BAR;
    }
    for (;;) {
        const bool has_next = S.next(ui + 1, nxt);
        if (!has_next) nxt = cur;
        for (int t = 0; t < nt; t += 2) {
            const bool last = (t == nt - 2);
            const char* a1 = pa(cur, t + 1);
            const char* a2; const char* b2;
            if (last) { a2 = pa(nxt, 0); b2 = pb(nxt, 0);
                if constexpr (Sched::GATHER) { if (has_next) S.rows(nxt, Rr, Cc, vA2); else {
#pragma unroll
                    for (int q = 0; q < 4; ++q) vA2[q] = vA[q]; } }
            } else { a2 = pa(cur, t + 2); b2 = pb(cur, t + 2);
                if constexpr (Sched::GATHER) {
#pragma unroll
                    for (int q = 0; q < 4; ++q) vA2[q] = vA[q]; }
            }
            if constexpr (!Sched::GATHER) {
#pragma unroll
                for (int q = 0; q < 4; ++q) vA2[q] = vA[q];
            }
            const char* a3 = a2 + 128; const char* b3 = b2 + 128;
            PG8_LDB(B0, 0, 0); PG8_SCHED; PG8_LDA(At, 0, 0); PG8_STAGE(PG8_SA(1, 1), a1, vA[2], vA[3]);
            PG8_WAIT_L(8); PG8_BAR; PG8_WAIT_L(0); PG8_MMA(0, 0, At, B0); PG8_BAR; PG8_SCHED;
            PG8_LDB(B1, 0, 1); PG8_STAGE(PG8_SB(0, 0), b2, voffB[0], voffB[1]);
            PG8_BAR; PG8_WAIT_L(0); PG8_MMA(0, 1, At, B1); PG8_BAR;
            PG8_LDA(At, 0, 1); PG8_STAGE(PG8_SA(0, 0), a2, vA2[0], vA2[1]);
            PG8_BAR; PG8_WAIT_L(0); PG8_MMA(1, 0, At, B0); PG8_BAR; PG8_SCHED;
            PG8_STAGE(PG8_SB(0, 1), b2 + hstepB, voffB[0], voffB[1]);
            PG8_WAIT_V(6); PG8_BAR; PG8_MMA(1, 1, At, B1); PG8_BAR;
            PG8_LDB(B0, 1, 0); PG8_SCHED; PG8_LDA(At, 1, 0); PG8_STAGE(PG8_SA(0, 1), a2, vA2[2], vA2[3]);
            PG8_WAIT_L(8); PG8_BAR; PG8_WAIT_L(0); PG8_MMA(0, 0, At, B0); PG8_BAR; PG8_SCHED;
            PG8_LDB(B1, 1, 1); PG8_STAGE(PG8_SB(1, 0), b3, voffB[0], voffB[1]);
            PG8_BAR; PG8_WAIT_L(0); PG8_MMA(0, 1, At, B1); PG8_BAR;
            PG8_LDA(At, 1, 1); PG8_STAGE(PG8_SA(1, 0), a3, vA2[0], vA2[1]);
            PG8_BAR; PG8_WAIT_L(0); PG8_MMA(1, 0, At, B0); PG8_BAR; PG8_SCHED;
            PG8_STAGE(PG8_SB(1, 1), b3 + hstepB, voffB[0], voffB[1]);
            PG8_WAIT_V(6); PG8_BAR; PG8_MMA(1, 1, At, B1); PG8_BAR;
        }
        E(acc, cur, wr, wc, fr, fq);
        if (!has_next) break;
#pragma unroll
        for (int a = 0; a < 2; ++a)
#pragma unroll
            for (int b = 0; b < 2; ++b)
#pragma unroll
                for (int m = 0; m < 4; ++m)
#pragma unroll
                    for (int n = 0; n < 2; ++n) acc[a][b][m][n] = (f32x4){0.f, 0.f, 0.f, 0.f};
        cur = nxt; ++ui;
        if constexpr (Sched::GATHER) {
#pragma unroll
            for (int q = 0; q < 4; ++q) vA[q] = vA2[q];
        }
    }
    PG8_WAIT_V(0);
    if (wr == 0) PG8_BAR;
    PG8_BAR;
#undef PG8_SA
#undef PG8_SB
#undef PG8_STAGE
#undef PG8_LDA
#undef PG8_LDB
#undef PG8_MMA
#undef PG8_WAIT_V
#undef PG8_WAIT_L
#undef PG8_BAR
#undef PG8_SCHED
}

DEV void static_tile(int L, int nM, int nN, int& pm, int& pn) {
    const int nwg = nM * nN; int wgid = L;
    { const int q = nwg / 8, r = nwg % 8, xcd = wgid % 8, off = wgid / 8; wgid = (xcd < r ? xcd * (q + 1) : r * (q + 1) + (xcd - r) * q) + off; }
    const int nig = 8 * nN, gid = wgid / nig, fm = gid * 8, gsz = (nM - fm) < 8 ? (nM - fm) : 8;
    pm = fm + ((wgid % nig) % gsz); pn = (wgid % nig) / gsz;
}
}
using pg8::Unit;

struct Args { const float* in[29]; float* out; unsigned char* ws; int ph_lo, ph_hi; };
static_assert(sizeof(Args) == 31 * 8 + 8, "Args has no padding");
enum { I_X = 0, I_C, I_CTX, I_CCTX, I_WMOD, I_BMOD, I_N1G, I_N2G, I_WIN, I_LRE, I_LIM, I_LOGDT, I_BRE, I_BIM, I_CRE, I_CIM, I_S5D, I_WGLU, I_BGLU, I_CONVW, I_WOUT,
       I_RGW, I_RGB, I_REW, I_REB, I_W1, I_W3, I_W2, I_FING };

struct Frame {
    LAS unsigned char* lds;
    int tid, lane, wave, G, bx, vcu;
    const float* in[29]; float* out; unsigned char* ws;
};
#define WSP(T, off) ((T*)(F.ws + (off)))

DEV void p0_mod_item(Frame& F, int item) {
    LAS float* st = (LAS float*)F.lds;
    LAS float* red = (LAS float*)(F.lds + 33 * 512 * 4);
    const float* c = F.in[I_C]; const float* cc = F.in[I_CCTX]; const float* wm = F.in[I_WMOD]; const float* bm = F.in[I_BMOD];
    float* mod = WSP(float, WS_MOD);
    const int col = F.tid & 31, kc = F.tid >> 5, j0 = item * 32;
    float acc[33];
#pragma unroll
    for (int n = 0; n < 33; ++n) acc[n] = 0.f;
    for (int half = 0; half < 2; ++half) {
        __syncthreads();
        for (int idx = F.tid; idx < 33 * 512; idx += 512) { const int n = idx >> 9, kk = idx & 511; const float v = (n < 32) ? c[n * DM + half * 512 + kk] : cc[half * 512 + kk]; st[idx] = siluf_(v); }
        __syncthreads();
        for (int kk = kc; kk < 512; kk += 16) {
            const float w = wm[(size_t)(half * 512 + kk) * NMOD + j0 + col];
#pragma unroll
            for (int n = 0; n < 33; ++n) acc[n] += st[n * 512 + kk] * w;
        }
    }
#pragma unroll
    for (int n = 0; n < 33; ++n) red[(kc * 33 + n) * 32 + col] = acc[n];
    __syncthreads();
    for (int idx = F.tid; idx < 33 * 32; idx += 512) { const int n = idx >> 5, cl = idx & 31; float s = bm[j0 + cl];
#pragma unroll
        for (int q = 0; q < 16; ++q) s += red[(q * 33 + n) * 32 + cl];
        mod[n * NMOD + j0 + cl] = s; }
    __syncthreads();
}
DEV void p0_transpose_item(const float* W, int N, int k0, int n0, bf16_t* dst, int ldk, LAS float* scr, int lane) {
#pragma unroll 8
    for (int i = 0; i < 32; ++i) { const int kk = 2 * i + (lane >> 5); scr[kk * 33 + (lane & 31)] = W[(size_t)(k0 + kk) * N + n0 + (lane & 31)]; }
    asm volatile("s_waitcnt lgkmcnt(0)" ::: "memory");
    const int cch = lane & 7;
#pragma unroll
    for (int j = 0; j < 4; ++j) { const int n = (lane >> 3) + 8 * j; const LAS float* s = scr + (8 * cch) * 33 + n;
        u32x4 o; o.x = cvt_pk_bf16(s[0 * 33], s[1 * 33]); o.y = cvt_pk_bf16(s[2 * 33], s[3 * 33]); o.z = cvt_pk_bf16(s[4 * 33], s[5 * 33]); o.w = cvt_pk_bf16(s[6 * 33], s[7 * 33]);
        *(u32x4*)(dst + (size_t)n * ldk + k0 + 8 * cch) = o; }
    asm volatile("s_waitcnt lgkmcnt(0)" ::: "memory");
}
DEV void sincos_rev(double rev, double& s, double& c) {
    const double fr = rev - __builtin_rint(rev);
    const double q = __builtin_rint(fr * 4.0);
    const double y = (fr - q * 0.25) * 6.283185307179586476925;
    const double y2 = y * y;
    const double sy = y * (1.0 + y2 * (-1.0 / 6 + y2 * (1.0 / 120 + y2 * (-1.0 / 5040 + y2 * (1.0 / 362880 + y2 * (-1.0 / 39916800 + y2 * (1.0 / 6227020800.0)))))));
    const double cy = 1.0 + y2 * (-0.5 + y2 * (1.0 / 24 + y2 * (-1.0 / 720 + y2 * (1.0 / 40320 + y2 * (-1.0 / 3628800 + y2 * (1.0 / 479001600.0 + y2 * (-1.0 / 87178291200.0)))))));
    const int qi = ((int)q) & 3;
    s = (qi == 0) ? sy : (qi == 1) ? cy : (qi == 2) ? -sy : -cy;
    c = (qi == 0) ? cy : (qi == 1) ? -sy : (qi == 2) ? -cy : sy;
}
DEV double exp_d(double x) {
    const double k = __builtin_rint(x * 1.4426950408889634074);
    const double r = x - k * 0.69314718055994530942;
    double p = 1.0 / 6227020800.0;
    p = p * r + 1.0 / 479001600.0; p = p * r + 1.0 / 39916800.0; p = p * r + 1.0 / 3628800.0; p = p * r + 1.0 / 362880.0; p = p * r + 1.0 / 40320.0; p = p * r + 1.0 / 5040.0;
    p = p * r + 1.0 / 720.0; p = p * r + 1.0 / 120.0; p = p * r + 1.0 / 24.0; p = p * r + 1.0 / 6.0; p = p * r + 0.5; p = p * r + 1.0; p = p * r + 1.0;
    const long long e = (long long)k + 1023;
    return p * __builtin_bit_cast(double, (unsigned long long)e << 52);
}
DEV void p0_phase(Frame& F) {
    for (int it = F.bx; it < NMOD / 32; it += F.G) p0_mod_item(F, it);
    __syncthreads();
    {
        LAS float* scr = (LAS float*)(F.lds + F.wave * 8448);
        bf16_t* Win = WSP(bf16_t, WS_WIN); bf16_t* Wout = WSP(bf16_t, WS_WOUT); bf16_t* Wglu = WSP(bf16_t, WS_WGLU); bf16_t* W13 = WSP(bf16_t, WS_W13); bf16_t* W2 = WSP(bf16_t, WS_W2);
        const int gw = F.vcu * 8 + F.wave, NGW = F.G * 8;
        constexpr int I_IN = 16 * 80, I_OUT = 16 * 32, I_GLU = 4 * 8, I_E = 16 * 256;
        for (int it = gw; it < I_IN + I_OUT + I_GLU + 3 * I_E; it += NGW) {
            int r = it;
            if (r < I_IN) { const int kb = r / 80, nb = r % 80, n0 = nb * 32; int drow;
                if (n0 < 1024) drow = n0;
                else if (n0 < 1792) { const int j = n0 - 1024; drow = 1024 + (j >> 7) * 256 + (j & 127); }
                else { const int j = n0 - 1792; drow = 1024 + (j >> 7) * 256 + 128 + (j & 127); }
                p0_transpose_item(F.in[I_WIN], 2560, kb * 64, n0, Win + (size_t)drow * 1024, 1024, scr, F.lane); continue; }
            r -= I_IN;
            if (r < I_OUT) { const int kb = r / 32, nb = r % 32; p0_transpose_item(F.in[I_WOUT], 1024, kb * 64, nb * 32, Wout + (size_t)(nb * 32) * 1024, 1024, scr, F.lane); continue; }
            r -= I_OUT;
            if (r < I_GLU) { const int kb = r / 8, nb = r % 8; p0_transpose_item(F.in[I_WGLU], 256, kb * 64, nb * 32, Wglu + (size_t)(nb * 32) * 256, 256, scr, F.lane); continue; }
            r -= I_GLU;
            if (r < 2 * I_E) { const int which = r / I_E; const int rr = r % I_E; const int e = rr >> 8, rem = rr & 255, kb = rem >> 4, nb = rem & 15, n0 = nb * 32;
                const int drow = (n0 >> 7) * 256 + which * 128 + (n0 & 127);
                p0_transpose_item(F.in[which ? I_W3 : I_W1] + (size_t)e * 1024 * 512, 512, kb * 64, n0, W13 + ((size_t)e * 1024 + drow) * 1024, 1024, scr, F.lane); continue; }
            r -= 2 * I_E;
            { const int e = r >> 8, rem = r & 255, kb = rem >> 5, nb = rem & 31;
                p0_transpose_item(F.in[I_W2] + (size_t)e * 512 * 1024, 1024, kb * 64, nb * 32, W2 + ((size_t)e * 1024 + nb * 32) * 512, 512, scr, F.lane); }
        }
    }
    if (F.bx == F.G - 1) {
        bf16_t* Wr = WSP(bf16_t, WS_WR);
        for (int idx = F.tid; idx < 32 * 1024; idx += 512) { const int l = idx >> 10, k = idx & 1023;
            const float v = (l < 4) ? F.in[I_RGW][k * 4 + l] : (l < 20) ? F.in[I_REW][k * 16 + (l - 4)] : 0.f;
            Wr[idx] = (bf16_t)(cvt_pk_bf16(v, 0.f) & 0xffffu); }
    }
    {
        f32x2* APOW = WSP(f32x2, WS_APOW); f32x2* BBAR = WSP(f32x2, WS_BBAR);
        const int gt = F.bx * 512 + F.tid, NT = F.G * 512;
        for (int idx = gt; idx < 2 * 16 * 65 * 64; idx += NT) {
            const int p = idx & 63, j = (idx >> 6) % 65, dg = idx / (64 * 65);
            const double lre = F.in[I_LRE][dg * 64 + p], lim = F.in[I_LIM][dg * 64 + p], dt = exp_d((double)F.in[I_LOGDT][dg]);
            const double mag = exp_d(lre * dt * j); double s, c; sincos_rev(lim * dt * j * 0.15915494309189533577, s, c);
            APOW[idx] = (f32x2){(float)(mag * c), (float)(mag * s)};
        }
        for (int idx = gt; idx < 2 * 16 * 64 * 16; idx += NT) {
            const int dgp = idx >> 4, dg = dgp >> 6;
            const double lre = F.in[I_LRE][dgp], lim = F.in[I_LIM][dgp], dt = exp_d((double)F.in[I_LOGDT][dg]);
            const double mag = exp_d(lre * dt); double s, c; sincos_rev(lim * dt * 0.15915494309189533577, s, c);
            const double nr = mag * c - 1.0, ni = mag * s, d2 = lre * lre + lim * lim;
            const double qr = (nr * lre + ni * lim) / d2, qi = (ni * lre - nr * lim) / d2;
            const double br = F.in[I_BRE][idx], bi = F.in[I_BIM][idx];
            BBAR[idx] = (f32x2){(float)(qr * br - qi * bi), (float)(qr * bi + qi * br)};
        }
    }
}

DEV void p1_norm_row(Frame& F, const float* xrow, const float* g, const float* shift, const float* scale, bf16_t* orow) {
    const f32x4* xr = (const f32x4*)xrow + F.lane;
    f32x4 v[4]; float s = 0.f;
#pragma unroll
    for (int j = 0; j < 4; ++j) { v[j] = xr[64 * j]; s += (v[j].x * v[j].x + v[j].y * v[j].y) + (v[j].z * v[j].z + v[j].w * v[j].w); }
    const float rstd = 1.0f / sqrtf(wave_sum(s) * (1.f / DM) + RMS_EPS);
    u32x2* o8 = (u32x2*)orow + F.lane;
#pragma unroll
    for (int j = 0; j < 4; ++j) {
        const f32x4 gg = ((const f32x4*)g)[F.lane + 64 * j], sh = ((const f32x4*)shift)[F.lane + 64 * j], sc = ((const f32x4*)scale)[F.lane + 64 * j];
        const f32x4 y = (v[j] * rstd * gg) * (1.0f + sc) + sh;
        u32x2 w; w.x = cvt_pk_bf16(y.x, y.y); w.y = cvt_pk_bf16(y.z, y.w); o8[64 * j] = w;
    }
}
DEV void p1_phase(Frame& F) {
    const float* mod = WSP(float, WS_MOD);
    bf16_t* HX = WSP(bf16_t, WS_HX);
    const int gw = F.vcu * 8 + F.wave, NGW = F.G * 8;
    for (int m = gw; m < TOK + CTOK; m += NGW) {
        const bool isl = m < TOK; const int n = isl ? (m >> 11) : 32;
        const float* xr = isl ? F.in[I_X] + (size_t)m * DM : F.in[I_CTX] + (size_t)(m - TOK) * DM;
        p1_norm_row(F, xr, F.in[I_N1G], mod + n * NMOD, mod + n * NMOD + DM, HX + (size_t)m * DM);
    }
    const int gt = F.bx * 512 + F.tid, NT = F.G * 512;
    const f32x2* APOW = WSP(f32x2, WS_APOW); const f32x2* BBAR = WSP(f32x2, WS_BBAR);
    {
        float* KT = WSP(float, WS_KTAB);
        for (int idx = gt; idx < 2 * 16 * 64 * 256; idx += NT) {
            const int hp = idx & 15, h = (idx >> 4) & 15, j = (idx >> 8) & 63, dg = idx >> 14;
            float s = 0.f;
            for (int p = 0; p < 64; ++p) {
                const float cr = F.in[I_CRE][(dg * 16 + h) * 64 + p], ci = F.in[I_CIM][(dg * 16 + h) * 64 + p];
                const f32x2 a = APOW[(dg * 65 + j) * 64 + p], b = BBAR[(dg * 64 + p) * 16 + hp];
                const float ur = cr * a.x - ci * a.y, ui = cr * a.y + ci * a.x;
                s += ur * b.x - ui * b.y;
            }
            KT[idx] = s;
        }
    }
    {
        bf16_t* WE = WSP(bf16_t, WS_WE);
        for (int idx = gt; idx < 16 * 256 * 128; idx += NT) {
            const int k8 = idx & 127, n = (idx >> 7) & 255, g = idx >> 15;
            const int part = n >> 6, p = n & 63, dir = part >> 1, k = k8 >> 1, h0 = (k8 & 1) * 8;
            const int dg = dir * 16 + g; const f32x2 a = APOW[(dg * 65 + (dir ? k : 63 - k)) * 64 + p];
            float v[8];
#pragma unroll
            for (int q = 0; q < 8; ++q) { const f32x2 b = BBAR[(dg * 64 + p) * 16 + h0 + q]; v[q] = (part & 1) ? (a.x * b.y + a.y * b.x) : (a.x * b.x - a.y * b.y); }
            u32x4 o; o.x = cvt_pk_bf16(v[0], v[1]); o.y = cvt_pk_bf16(v[2], v[3]); o.z = cvt_pk_bf16(v[4], v[5]); o.w = cvt_pk_bf16(v[6], v[7]);
            *(u32x4*)(WE + ((size_t)(g * 256 + n) * 1024 + k8 * 8)) = o;
        }
    }
    {
        bf16_t* SH2 = WSP(bf16_t, WS_SH2);
        for (int idx = gt; idx < 256 * 1024; idx += NT) { const int r = idx >> 10, k = idx & 1023; const float v = (r < 32) ? mod[r * NMOD + 3 * DM + k] : 0.f; SH2[idx] = (bf16_t)(cvt_pk_bf16(v, 0.f) & 0xffffu); }
    }
    if (F.bx == F.G - 1) {
        float* rb = WSP(float, WS_RB);
        for (int idx = F.tid; idx < 32 * 32; idx += 512) { const int b = idx >> 5, l = idx & 31; float s = 0.f;
            if (l < 4) { for (int k = 0; k < DM; ++k) s += mod[b * NMOD + 3 * DM + k] * F.in[I_RGW][k * 4 + l]; s += F.in[I_RGB][l]; }
            else if (l < 20) { for (int k = 0; k < DM; ++k) s += mod[b * NMOD + 3 * DM + k] * F.in[I_REW][k * 16 + (l - 4)]; s += F.in[I_REB][l - 4]; }
            rb[idx] = s; }
    }
}

DEV void p2_fill_tr(Frame& F) {
    const float* KT = WSP(float, WS_KTAB); const f32x2* APOW = WSP(f32x2, WS_APOW); bf16_t* TR = WSP(bf16_t, WS_TR);
    const int gt = F.bx * 512 + F.tid, NT = F.G * 512;
    for (int idx = gt; idx < 16 * 1024 * 160; idx += NT) {
        const int k8 = idx % 160, n = (idx / 160) & 1023, g = idx / (160 * 1024);
        const int t = n >> 4, h = n & 15;
        float v[8];
        if (k8 < 128) { const int k = k8 >> 1, h0 = (k8 & 1) * 8;
            if (t > k) { const float* s = KT + (((0 * 16 + g) * 64 + (t - k)) * 256 + h * 16 + h0);
#pragma unroll
                for (int q = 0; q < 8; ++q) v[q] = s[q]; }
            else if (k > t) { const float* s = KT + (((1 * 16 + g) * 64 + (k - t)) * 256 + h * 16 + h0);
#pragma unroll
                for (int q = 0; q < 8; ++q) v[q] = s[q]; }
            else { const float* s0 = KT + (((0 * 16 + g) * 64) * 256 + h * 16 + h0); const float* s1 = KT + (((1 * 16 + g) * 64) * 256 + h * 16 + h0); const float dd = F.in[I_S5D][g * 16 + h];
#pragma unroll
                for (int q = 0; q < 8; ++q) v[q] = s0[q] + s1[q] + ((h0 + q == h) ? dd : 0.f); }
        } else { const int s0 = (k8 - 128) * 8, part = s0 >> 6, p0 = s0 & 63, dir = part >> 1, dg = dir * 16 + g, j = dir ? (64 - t) : (t + 1);
#pragma unroll
            for (int q = 0; q < 8; ++q) { const int p = p0 + q; const float cr = F.in[I_CRE][(dg * 16 + h) * 64 + p], ci = F.in[I_CIM][(dg * 16 + h) * 64 + p]; const f32x2 a = APOW[(dg * 65 + j) * 64 + p];
                v[q] = (part & 1) ? -(cr * a.y + ci * a.x) : (cr * a.x - ci * a.y); }
        }
        u32x4 o; o.x = cvt_pk_bf16(v[0], v[1]); o.y = cvt_pk_bf16(v[2], v[3]); o.z = cvt_pk_bf16(v[4], v[5]); o.w = cvt_pk_bf16(v[6], v[7]);
        *(u32x4*)(TR + ((size_t)(g * 1024 + n) * UGK + k8 * 8)) = o;
    }
}
struct SchedIn {
    static constexpr bool GATHER = false;
    int nt; unsigned lda, ldb; int G, c; const char* HX; const char* W;
    DEV bool next(int i, Unit& u) const {
        const int L = i * G + c; if (L >= 2560 + 32) return false;
        int pm, pn, ctx = 0;
        if (L < 2560) pg8::static_tile(L, 256, 10, pm, pn); else { pm = 256 + (L - 2560); pn = 0; ctx = 1; }
        u.A0 = HX + (size_t)pm * 256 * 2048; u.A1 = u.A0; u.B0 = W + (size_t)pn * 256 * 2048; u.B1 = u.B0; u.ksA = 1 << 20; u.ksB = 1 << 20;
        u.p0 = pm; u.p1 = pn; u.p2 = ctx; u.p3 = 0; return true;
    }
    DEV void rows(const Unit&, const int*, const int*, unsigned*) const {}
};
struct EpiIn {
    static constexpr bool PERM = true;
    bf16_t* UG; bf16_t* BG; bf16_t* CV;
    DEV void operator()(const f32x4 (&acc)[2][2][4][2], const Unit& u, int wr, int wc, int fr, int fq) const {
        const int pm = u.p0, pn = u.p1;
#pragma unroll
        for (int ai = 0; ai < 2; ++ai)
#pragma unroll
            for (int m = 0; m < 4; ++m) {
                const int r = ai * 128 + wr * 64 + m * 16 + fr;
                if (pn == 0) {
                    const int mm = pm * 256 + r;
                    const int chunk = mm >> 6, k = mm & 63;
#pragma unroll
                    for (int bj = 0; bj < 2; ++bj) { const int c = bj * 128 + wc * 32 + 8 * fq, g = c >> 4, h0 = c & 15;
                        const f32x4 v0 = acc[ai][bj][m][0], v1 = acc[ai][bj][m][1];
                        u32x4 w; w.x = cvt_pk_bf16(v0[0], v0[1]); w.y = cvt_pk_bf16(v0[2], v0[3]); w.z = cvt_pk_bf16(v1[0], v1[1]); w.w = cvt_pk_bf16(v1[2], v1[3]);
                        *(u32x4*)(UG + ((size_t)(g * NCH_PAD + chunk) * UGK + k * 16 + h0)) = w; }
                } else if (pn < 4) {
                    bf16_t* rowp = BG + (size_t)(pm * 256 + r) * CONVW + (pn - 1) * 256 + wc * 32 + 8 * fq;
#pragma unroll
                    for (int bj = 0; bj < 2; ++bj) { const f32x4 v0 = acc[ai][bj][m][0], v1 = acc[ai][bj][m][1];
                        u32x4 w; w.x = cvt_pk_bf16(v0[0], v0[1]); w.y = cvt_pk_bf16(v0[2], v0[3]); w.z = cvt_pk_bf16(v1[0], v1[1]); w.w = cvt_pk_bf16(v1[2], v1[3]);
                        *(u32x4*)(rowp + bj * 128) = w; }
                } else {
                    const f32x4 v0 = acc[ai][0][m][0] * acc[ai][1][m][0], v1 = acc[ai][0][m][1] * acc[ai][1][m][1];
                    u32x4 w; w.x = cvt_pk_bf16(v0[0], v0[1]); w.y = cvt_pk_bf16(v0[2], v0[3]); w.z = cvt_pk_bf16(v1[0], v1[1]); w.w = cvt_pk_bf16(v1[2], v1[3]);
                    *(u32x4*)(CV + (size_t)(pm * 256 + r) * CONVW + (pn - 4) * 128 + wc * 32 + 8 * fq) = w;
                }
            }
    }
};

struct SchedE {
    static constexpr bool GATHER = false;
    int nt; unsigned lda, ldb; int c; const char* UG; const char* WE;
    DEV bool next(int i, Unit& u) const {
        if (i > 0 || c >= 80) return false;
        const int g = c / 5, pm = c % 5;
        u.A0 = UG + ((size_t)g * NCH_PAD + pm * 256) * UGK * 2; u.A1 = u.A0; u.B0 = WE + (size_t)g * 256 * 2048; u.B1 = u.B0; u.ksA = 1 << 20; u.ksB = 1 << 20;
        u.p0 = pm; u.p1 = g; u.p2 = 0; u.p3 = 0; return true;
    }
    DEV void rows(const Unit&, const int*, const int*, unsigned*) const {}
};
struct EpiE {
    static constexpr bool PERM = false;
    float* E;
    DEV void operator()(const f32x4 (&acc)[2][2][4][2], const Unit& u, int wr, int wc, int fr, int fq) const {
        float* base = E + ((size_t)u.p1 * NCH_PAD + u.p0 * 256) * 256;
#pragma unroll
        for (int ai = 0; ai < 2; ++ai)
#pragma unroll
            for (int m = 0; m < 4; ++m) { float* rowp = base + (size_t)(ai * 128 + wr * 64 + m * 16 + fr) * 256 + wc * 32 + 4 * fq;
#pragma unroll
                for (int bj = 0; bj < 2; ++bj)
#pragma unroll
                    for (int n = 0; n < 2; ++n) *(f32x4*)(rowp + bj * 128 + n * 16) = acc[ai][bj][m][n]; }
    }
};
struct SchedSB {
    static constexpr bool GATHER = false;
    int nt; unsigned lda, ldb; int c; const char* SH2; const char* W13;
    DEV bool next(int i, Unit& u) const {
        if (i > 0 || c < 0 || c >= 64) return false;
        const int e = c >> 2, ti = c & 3;
        u.A0 = SH2; u.A1 = u.A0; u.B0 = W13 + ((size_t)e * 1024 + ti * 256) * 2048; u.B1 = u.B0; u.ksA = 1 << 20; u.ksB = 1 << 20;
        u.p0 = e; u.p1 = ti; u.p2 = 0; u.p3 = 0; return true;
    }
    DEV void rows(const Unit&, const int*, const int*, unsigned*) const {}
};
struct EpiSB {
    static constexpr bool PERM = false;
    float* SB;
    DEV void operator()(const f32x4 (&acc)[2][2][4][2], const Unit& u, int wr, int wc, int fr, int fq) const {
        if (wr != 0) return;
#pragma unroll
        for (int m = 0; m < 2; ++m) { const int b = m * 16 + fr; float* rowp = SB + ((size_t)(b * 16 + u.p0) * 1024 + u.p1 * 256 + wc * 32 + 4 * fq);
#pragma unroll
            for (int bj = 0; bj < 2; ++bj)
#pragma unroll
                for (int n = 0; n < 2; ++n) *(f32x4*)(rowp + bj * 128 + n * 16) = acc[0][bj][m][n]; }
    }
};

DEV void p4_phase(Frame& F) {
    const int gt = F.bx * 512 + F.tid, NT = F.G * 512;
    {
        const float* E = WSP(float, WS_E); const f32x2* APOW = WSP(f32x2, WS_APOW); bf16_t* UG = WSP(bf16_t, WS_UG);
        for (int idx = gt; idx < NB * NG * 128; idx += NT) {
            const int p = idx & 63, dir = (idx >> 6) & 1, g = (idx >> 7) & 15, b = idx >> 11;
            const f32x2 a = APOW[((dir * 16 + g) * 65 + 64) * 64 + p];
            const float* Eg = E + (size_t)g * NCH_PAD * 256 + dir * 128 + p;
            bf16_t* Ug = UG + (size_t)g * NCH_PAD * UGK + 1024 + dir * 128 + p;
            float sr = 0.f, si = 0.f;
            for (int c = 0; c < 4; ++c) { const int ch = NCH_LAT + b * 4 + (dir ? 3 - c : c); const float er = Eg[(size_t)ch * 256], ei = Eg[(size_t)ch * 256 + 64];
                const float nr = a.x * sr - a.y * si + er, ni = a.x * si + a.y * sr + ei; sr = nr; si = ni; }
            for (int c = 0; c < 32; ++c) { const int ch = b * 32 + (dir ? 31 - c : c);
                Ug[(size_t)ch * UGK] = (bf16_t)(cvt_pk_bf16(sr, 0.f) & 0xffffu); Ug[(size_t)ch * UGK + 64] = (bf16_t)(cvt_pk_bf16(si, 0.f) & 0xffffu);
                const float er = Eg[(size_t)ch * 256], ei = Eg[(size_t)ch * 256 + 64];
                const float nr = a.x * sr - a.y * si + er, ni = a.x * si + a.y * sr + ei; sr = nr; si = ni; }
        }
    }
    {
        const bf16_t* BG = WSP(bf16_t, WS_BG); const bf16_t* CV = WSP(bf16_t, WS_CV); bf16_t* YM = WSP(bf16_t, WS_YMIX); const float* cw = F.in[I_CONVW];
        for (int idx = gt; idx < TOK * 96; idx += NT) {
            const int j8 = idx % 96, m = idx / 96, j0 = j8 * 8;
            const bool rowp = j0 < 384; const int d = rowp ? 1 : 64;
            const bool hasl = rowp ? ((m & 63) > 0) : (((m >> 6) & 31) > 0), hasr = rowp ? ((m & 63) < 63) : (((m >> 6) & 31) < 31);
            const u32x4 z = (u32x4){0u, 0u, 0u, 0u};
            const u32x4 c0 = hasl ? *(const u32x4*)(CV + (size_t)(m - d) * CONVW + j0) : z;
            const u32x4 c1 = *(const u32x4*)(CV + (size_t)m * CONVW + j0);
            const u32x4 c2 = hasr ? *(const u32x4*)(CV + (size_t)(m + d) * CONVW + j0) : z;
            const u32x4 bb = *(const u32x4*)(BG + (size_t)m * CONVW + j0);
            float o[8];
#pragma unroll
            for (int q = 0; q < 4; ++q) {
                const float w0a = cw[j0 + 2 * q], w0b = cw[j0 + 2 * q + 1], w1a = cw[CONVW + j0 + 2 * q], w1b = cw[CONVW + j0 + 2 * q + 1], w2a = cw[2 * CONVW + j0 + 2 * q], w2b = cw[2 * CONVW + j0 + 2 * q + 1];
                o[2 * q] = bflo(bb[q]) * (bflo(c0[q]) * w0a + bflo(c1[q]) * w1a + bflo(c2[q]) * w2a);
                o[2 * q + 1] = bfhi(bb[q]) * (bfhi(c0[q]) * w0b + bfhi(c1[q]) * w1b + bfhi(c2[q]) * w2b);
            }
            u32x4 w; w.x = cvt_pk_bf16(o[0], o[1]); w.y = cvt_pk_bf16(o[2], o[3]); w.z = cvt_pk_bf16(o[4], o[5]); w.w = cvt_pk_bf16(o[6], o[7]);
            *(u32x4*)(YM + (size_t)m * DM + 256 + j0) = w;
        }
    }
}

struct SchedY {
    static constexpr bool GATHER = false;
    int nt; unsigned lda, ldb; int c; const char* UG; const char* TR;
    DEV bool next(int i, Unit& u) const {
        if (i > 0 || c >= 256) return false;
        const int g = c >> 4, pm = (c >> 2) & 3, pn = c & 3;
        u.A0 = UG + ((size_t)g * NCH_PAD + pm * 256) * UGK * 2; u.A1 = u.A0; u.B0 = TR + ((size_t)g * 1024 + pn * 256) * UGK * 2; u.B1 = u.B0; u.ksA = 1 << 20; u.ksB = 1 << 20;
        u.p0 = pm; u.p1 = pn; u.p2 = g; u.p3 = 0; return true;
    }
    DEV void rows(const Unit&, const int*, const int*, unsigned*) const {}
};
struct EpiY {
    static constexpr bool PERM = true;
    bf16_t* Gb;
    DEV void operator()(const f32x4 (&acc)[2][2][4][2], const Unit& u, int wr, int wc, int fr, int fq) const {
#pragma unroll
        for (int ai = 0; ai < 2; ++ai)
#pragma unroll
            for (int m = 0; m < 4; ++m) { const int chunk = u.p0 * 256 + ai * 128 + wr * 64 + m * 16 + fr;
#pragma unroll
                for (int bj = 0; bj < 2; ++bj) { const int n = u.p1 * 256 + bj * 128 + wc * 32 + 8 * fq, t = n >> 4, h0 = n & 15;
                    const f32x4 v0 = acc[ai][bj][m][0], v1 = acc[ai][bj][m][1];
                    u32x4 w; w.x = cvt_pk_bf16(gelu_tanh(v0[0]), gelu_tanh(v0[1])); w.y = cvt_pk_bf16(gelu_tanh(v0[2]), gelu_tanh(v0[3]));
                    w.z = cvt_pk_bf16(gelu_tanh(v1[0]), gelu_tanh(v1[1])); w.w = cvt_pk_bf16(gelu_tanh(v1[2]), gelu_tanh(v1[3]));
                    *(u32x4*)(Gb + ((size_t)(chunk * 64 + t) * 256 + u.p2 * 16 + h0)) = w; } }
    }
};

struct SchedGlu {
    static constexpr bool GATHER = false;
    int nt; unsigned lda, ldb; int G, c; const char* Gb; const char* W;
    DEV bool next(int i, Unit& u) const {
        const int L = i * G + c; if (L >= 256) return false;
        u.A0 = Gb + (size_t)L * 256 * 512; u.A1 = u.A0; u.B0 = W; u.B1 = u.B0; u.ksA = 1 << 20; u.ksB = 1 << 20; u.p0 = L; u.p1 = 0; u.p2 = 0; u.p3 = 0; return true;
    }
    DEV void rows(const Unit&, const int*, const int*, unsigned*) const {}
};
struct EpiGlu {
    static constexpr bool PERM = true;
    const bf16_t* Gb; bf16_t* YM; const float* bglu;
    DEV void operator()(const f32x4 (&acc)[2][2][4][2], const Unit& u, int wr, int wc, int fr, int fq) const {
#pragma unroll
        for (int ai = 0; ai < 2; ++ai)
#pragma unroll
            for (int m = 0; m < 4; ++m) { const int row = u.p0 * 256 + ai * 128 + wr * 64 + m * 16 + fr;
#pragma unroll
                for (int bj = 0; bj < 2; ++bj) { const int c = bj * 128 + wc * 32 + 8 * fq;
                    const u32x4 gv = *(const u32x4*)(Gb + (size_t)row * 256 + c); const f32x4 b0 = *(const f32x4*)(bglu + c), b1 = *(const f32x4*)(bglu + c + 4);
                    const f32x4 z0 = acc[ai][bj][m][0] + b0, z1 = acc[ai][bj][m][1] + b1;
                    u32x4 w; w.x = cvt_pk_bf16(bflo(gv.x) * sigmoidf_(z0[0]), bfhi(gv.x) * sigmoidf_(z0[1])); w.y = cvt_pk_bf16(bflo(gv.y) * sigmoidf_(z0[2]), bfhi(gv.y) * sigmoidf_(z0[3]));
                    w.z = cvt_pk_bf16(bflo(gv.z) * sigmoidf_(z1[0]), bfhi(gv.z) * sigmoidf_(z1[1])); w.w = cvt_pk_bf16(bflo(gv.w) * sigmoidf_(z1[2]), bfhi(gv.w) * sigmoidf_(z1[3]));
                    *(u32x4*)(YM + (size_t)row * DM + c) = w; } }
    }
};

struct SchedOut {
    static constexpr bool GATHER = false;
    int nt; unsigned lda, ldb; int G, c; const char* A; const char* W;
    DEV bool next(int i, Unit& u) const {
        const int L = i * G + c; if (L >= 1024) return false;
        int pm, pn; pg8::static_tile(L, 256, 4, pm, pn);
        u.A0 = A + (size_t)pm * 256 * 2048; u.A1 = u.A0; u.B0 = W + (size_t)pn * 256 * 2048; u.B1 = u.B0; u.ksA = 1 << 20; u.ksB = 1 << 20; u.p0 = pm; u.p1 = pn; u.p2 = 0; u.p3 = 0; return true;
    }
    DEV void rows(const Unit&, const int*, const int*, unsigned*) const {}
};
struct EpiOut {
    static constexpr bool PERM = false;
    const float* x; float* x1; bf16_t* x1g; float* rsq; const float* mod; const float* n2g;
    DEV void operator()(const f32x4 (&acc)[2][2][4][2], const Unit& u, int wr, int wc, int fr, int fq) const {
        const int b = u.p0 >> 3, col0 = u.p1 * 256 + wc * 32 + 4 * fq;
        f32x4 gate[2][2], gs[2][2];
#pragma unroll
        for (int bj = 0; bj < 2; ++bj)
#pragma unroll
            for (int n = 0; n < 2; ++n) { const int c = col0 + bj * 128 + n * 16;
                gate[bj][n] = *(const f32x4*)(mod + b * NMOD + 2 * DM + c);
                gs[bj][n] = *(const f32x4*)(n2g + c) * (1.0f + *(const f32x4*)(mod + b * NMOD + 4 * DM + c)); }
#pragma unroll
        for (int ai = 0; ai < 2; ++ai)
#pragma unroll
            for (int m = 0; m < 4; ++m) { const int row = u.p0 * 256 + ai * 128 + wr * 64 + m * 16 + fr; const size_t off = (size_t)row * DM + col0; float sq = 0.f;
#pragma unroll
                for (int bj = 0; bj < 2; ++bj)
#pragma unroll
                    for (int n = 0; n < 2; ++n) { const f32x4 xv = *(const f32x4*)(x + off + bj * 128 + n * 16); const f32x4 v = xv + gate[bj][n] * acc[ai][bj][m][n];
                        *(f32x4*)(x1 + off + bj * 128 + n * 16) = v; sq += (v[0] * v[0] + v[1] * v[1]) + (v[2] * v[2] + v[3] * v[3]);
                        const f32x4 y = v * gs[bj][n]; u32x2 w; w.x = cvt_pk_bf16(y[0], y[1]); w.y = cvt_pk_bf16(y[2], y[3]); *(u32x2*)(x1g + off + bj * 128 + n * 16) = w; }
                sq += __shfl_xor(sq, 16); sq += __shfl_xor(sq, 32);
                if (fq == 0) rsq[(size_t)row * 16 + u.p1 * 4 + wc] = sq; }
    }
};

DEV void p8_phase(Frame& F) {
    const bf16_t* X1G = WSP(bf16_t, WS_X1G); const bf16_t* Wr = WSP(bf16_t, WS_WR); const float* rsq = WSP(float, WS_RSQ1); const float* rb = WSP(float, WS_RB);
    int* tokb = WSP(int, WS_TOKB); float* tokw = WSP(float, WS_TOKW); float* tokr = WSP(float, WS_TOKR); int* segc = WSP(int, WS_SEGC);
    LAS int* hist = (LAS int*)F.lds;
    const int l15 = F.lane & 15, q = F.lane >> 4;
    for (int seg = F.bx; seg < TOK / 256; seg += F.G) {
        if (F.tid < 32) hist[F.tid] = 0;
        __syncthreads();
        const int tok0 = seg * 256 + F.wave * 32, b = seg >> 3;
        f32x4 acc[2][2];
#pragma unroll
        for (int a = 0; a < 2; ++a)
#pragma unroll
            for (int t = 0; t < 2; ++t) acc[a][t] = (f32x4){0.f, 0.f, 0.f, 0.f};
        const bf16_t* x0 = X1G + (size_t)(tok0 + l15) * DM + 8 * q; const bf16_t* x1 = x0 + 16 * DM;
        const bf16_t* w0 = Wr + (size_t)l15 * DM + 8 * q; const bf16_t* w1 = w0 + 16 * DM;
#pragma unroll 4
        for (int ks = 0; ks < 32; ++ks) {
            const bf16x8 xa = *(const bf16x8*)(x0 + ks * 32), xb = *(const bf16x8*)(x1 + ks * 32), wa = *(const bf16x8*)(w0 + ks * 32), wb = *(const bf16x8*)(w1 + ks * 32);
            acc[0][0] = __builtin_amdgcn_mfma_f32_16x16x32_bf16(wa, xa, acc[0][0], 0, 0, 0); acc[0][1] = __builtin_amdgcn_mfma_f32_16x16x32_bf16(wb, xa, acc[0][1], 0, 0, 0);
            acc[1][0] = __builtin_amdgcn_mfma_f32_16x16x32_bf16(wa, xb, acc[1][0], 0, 0, 0); acc[1][1] = __builtin_amdgcn_mfma_f32_16x16x32_bf16(wb, xb, acc[1][1], 0, 0, 0);
        }
#pragma unroll
        for (int rg = 0; rg < 2; ++rg) {
            const int tok = tok0 + rg * 16 + l15;
            const f32x4* rp = (const f32x4*)(rsq + (size_t)tok * 16); const f32x4 r0 = rp[0], r1 = rp[1], r2 = rp[2], r3 = rp[3];
            const float ss = ((r0[0] + r0[1]) + (r0[2] + r0[3])) + ((r1[0] + r1[1]) + (r1[2] + r1[3])) + ((r2[0] + r2[1]) + (r2[2] + r2[3])) + ((r3[0] + r3[1]) + (r3[2] + r3[3]));
            const float rstd = 1.0f / sqrtf(ss * (1.f / DM) + RMS_EPS);
            float lg[4], l2[4], gl[4], t1[4], t2[4], v[4];
#pragma unroll
            for (int r = 0; r < 4; ++r) { lg[r] = rstd * acc[rg][0][r] + rb[b * 32 + 4 * q + r]; l2[r] = rstd * acc[rg][1][r] + rb[b * 32 + 16 + ((4 * q + r) & 15)]; }
#pragma unroll
            for (int r = 0; r < 4; ++r) gl[r] = __shfl(lg[r], l15);
            int gi = 0; float gm = gl[0];
#pragma unroll
            for (int r = 1; r < 4; ++r) if (gl[r] > gm) { gm = gl[r]; gi = r; }
            float den = 0.f;
#pragma unroll
            for (int r = 0; r < 4; ++r) den += __expf(gl[r] - gm);
            const float gp = 1.0f / den;
            const int src = l15 + 16 * ((gi + 1) & 3);
#pragma unroll
            for (int r = 0; r < 4; ++r) { t1[r] = __shfl(lg[r], src); t2[r] = __shfl(l2[r], l15); v[r] = (gi == 3) ? t2[r] : t1[r]; }
            int i1 = 0; float v1 = v[0];
#pragma unroll
            for (int r = 1; r < 4; ++r) if (v[r] > v1) { v1 = v[r]; i1 = r; }
            int i2 = -1; float v2 = 0.f;
#pragma unroll
            for (int r = 0; r < 4; ++r) if (r != i1 && (i2 < 0 || v[r] > v2)) { v2 = v[r]; i2 = r; }
            const float ex = __expf(v2 - v1), p1 = 1.0f / (1.0f + ex), p2 = ex * p1;
            const int lo = i1 < i2 ? i1 : i2, hi = i1 < i2 ? i2 : i1;
            const float wlo = (i1 < i2 ? p1 : p2) * gp, whi = (i1 < i2 ? p2 : p1) * gp;
            const int pidx = (lo == 0) ? (hi - 1) : (lo == 1) ? (hi + 1) : 5;
            const int bucket = gi * 6 + pidx;
            if (q == 0) { tokb[tok] = bucket; tokw[tok * 2] = wlo; tokw[tok * 2 + 1] = whi; tokr[tok] = rstd; atomicAdd((int*)hist + bucket, 1); }
        }
        __syncthreads();
        if (F.tid < 32) segc[seg * 32 + F.tid] = (F.tid < NBUCKET) ? hist[F.tid] : 0;
        __syncthreads();
    }
}

DEV void p9_phase(Frame& F) {
    const int* segc = WSP(int, WS_SEGC); const int* tokb = WSP(int, WS_TOKB); int* perm = WSP(int, WS_PERM); int* tiles = WSP(int, WS_TILES);
    LAS int* tot = (LAS int*)F.lds;
    LAS int* tst = tot + 32;
    LAS int* base = tst + 32;
    LAS int* wcnt = base + 32;
    for (int seg = F.bx; seg < TOK / 256; seg += F.G) {
        __syncthreads();
        if (F.tid < 32) { int t = 0, bs = 0; if (F.tid < NBUCKET) for (int s = 0; s < 256; ++s) { const int c = ld_agent_i(segc + s * 32 + F.tid); if (s < seg) bs += c; t += c; } tot[F.tid] = t; base[F.tid] = bs; }
        if (F.tid < 128) wcnt[F.tid] = 0;
        __syncthreads();
        if (F.tid == 0) { int ts = 0; for (int k = 0; k < NBUCKET; ++k) { tst[k] = ts; ts += (tot[k] + 255) >> 8; } tst[NBUCKET] = ts; }
        __syncthreads();
        int bk = -1, rank = 0;
        if (F.tid < 256) {
            bk = ld_agent_i(tokb + seg * 256 + F.tid);
            for (int k = 0; k < NBUCKET; ++k) { const unsigned long long msk = __ballot(bk == k); if (bk == k) rank = __popcll(msk & ((1ull << F.lane) - 1ull)); if (F.lane == 0) wcnt[F.wave * 32 + k] = __popcll(msk); }
        }
        __syncthreads();
        if (F.tid < 256) { int off = 0; for (int w = 0; w < F.wave; ++w) off += wcnt[w * 32 + bk]; perm[tst[bk] * 256 + base[bk] + off + rank] = seg * 256 + F.tid; }
        if (seg < NBUCKET) { const int k = seg, n = tot[k], np = ((n + 255) >> 8) << 8; for (int r = n + F.tid; r < np; r += 512) perm[tst[k] * 256 + r] = -1; }
        if (seg == 0) { if (F.tid == 0) tiles[0] = tst[NBUCKET];
            if (F.tid < NBUCKET) { const int k = F.tid, nt_ = (tot[k] + 255) >> 8; for (int t = 0; t < nt_; ++t) tiles[16 + tst[k] + t] = k; } }
    }
}
DEV void bucket_experts(int bk, int& e0, int& e1) { const int grp = bk / 6, pi = bk % 6; const int lo = pi < 3 ? 0 : (pi < 5 ? 1 : 2), hi = pi < 3 ? pi + 1 : (pi < 5 ? pi - 1 : 3); e0 = grp * 4 + lo; e1 = grp * 4 + hi; }

struct SchedUp {
    static constexpr bool GATHER = true;
    int nt; unsigned lda, ldb; int G, c, ntiles; const char* X1G; const char* W13; const int* perm; const int* tiles;
    DEV bool next(int i, Unit& u) const {
        const int L = i * G + c; if (L >= ntiles * 8) return false;
        const int tile = L >> 3, s = (L >> 2) & 1, ti = L & 3; int e0, e1; bucket_experts(ld_agent_i(tiles + 16 + tile), e0, e1); const int e = s ? e1 : e0;
        u.A0 = X1G; u.A1 = X1G; u.B0 = W13 + ((size_t)e * 1024 + ti * 256) * 2048; u.B1 = u.B0; u.ksA = 1 << 20; u.ksB = 1 << 20; u.p0 = tile; u.p1 = s; u.p2 = ti; u.p3 = e; return true;
    }
    DEV void rows(const Unit& u, const int* R, const int* C, unsigned* v) const {
#pragma unroll
        for (int h = 0; h < 2; ++h)
#pragma unroll
            for (int i = 0; i < 2; ++i) { int t = ld_agent_i(perm + u.p0 * 256 + h * 128 + R[i]); t = t < 0 ? 0 : t; v[h * 2 + i] = (unsigned)t * 2048u + (unsigned)C[i] * 2u; }
    }
};
struct EpiUp {
    static constexpr bool PERM = true;
    bf16_t* HID; const int* perm; const float* tokw; const float* tokr; const float* sb13;
    DEV void operator()(const f32x4 (&acc)[2][2][4][2], const Unit& u, int wr, int wc, int fr, int fq) const {
#pragma unroll
        for (int ai = 0; ai < 2; ++ai)
#pragma unroll
            for (int m = 0; m < 4; ++m) { const int slot = u.p0 * 256 + ai * 128 + wr * 64 + m * 16 + fr; const int tk0 = ld_agent_i(perm + slot); const bool valid = tk0 >= 0; const int tk = valid ? tk0 : 0;
                const float rstd = tokr[tk], w = valid ? tokw[tk * 2 + u.p1] : 0.f; const int b = tk >> 11;
                const float* bias = sb13 + ((size_t)(b * 16 + u.p3) * 1024 + u.p2 * 256 + wc * 32 + 8 * fq);
                const f32x4 b10 = *(const f32x4*)(bias), b11 = *(const f32x4*)(bias + 4), b30 = *(const f32x4*)(bias + 128), b31 = *(const f32x4*)(bias + 132);
                const f32x4 p10 = acc[ai][0][m][0] * rstd + b10, p11 = acc[ai][0][m][1] * rstd + b11, p30 = acc[ai][1][m][0] * rstd + b30, p31 = acc[ai][1][m][1] * rstd + b31;
                float o[8];
#pragma unroll
                for (int j = 0; j < 4; ++j) { o[j] = w * siluf_(p10[j]) * p30[j]; o[4 + j] = w * siluf_(p11[j]) * p31[j]; }
                u32x4 wv; wv.x = cvt_pk_bf16(o[0], o[1]); wv.y = cvt_pk_bf16(o[2], o[3]); wv.z = cvt_pk_bf16(o[4], o[5]); wv.w = cvt_pk_bf16(o[6], o[7]);
                *(u32x4*)(HID + ((size_t)slot * 1024 + u.p1 * 512 + u.p2 * 128 + wc * 32 + 8 * fq)) = wv; }
    }
};

struct SchedDown {
    static constexpr bool GATHER = false;
    int nt; unsigned lda, ldb; int G, c, ntiles; const char* HID; const char* W2; const int* tiles;
    DEV bool next(int i, Unit& u) const {
        const int L = i * G + c; if (L >= ntiles * 4) return false;
        const int tile = L >> 2, pn = L & 3; int e0, e1; bucket_experts(ld_agent_i(tiles + 16 + tile), e0, e1);
        u.A0 = HID + (size_t)tile * 256 * 2048; u.A1 = u.A0; u.ksA = 1 << 20;
        u.B0 = W2 + ((size_t)e0 * 1024 + pn * 256) * 1024; u.B1 = W2 + ((size_t)e1 * 1024 + pn * 256) * 1024; u.ksB = 8;
        u.p0 = tile; u.p1 = pn; u.p2 = 0; u.p3 = 0; return true;
    }
    DEV void rows(const Unit&, const int*, const int*, unsigned*) const {}
};
struct EpiDown {
    static constexpr bool PERM = false;
    float* x1; float* rsq; const int* perm; const float* mod;
    DEV void operator()(const f32x4 (&acc)[2][2][4][2], const Unit& u, int wr, int wc, int fr, int fq) const {
        const int col0 = u.p1 * 256 + wc * 32 + 4 * fq;
#pragma unroll
        for (int ai = 0; ai < 2; ++ai)
#pragma unroll
            for (int m = 0; m < 4; ++m) { const int slot = u.p0 * 256 + ai * 128 + wr * 64 + m * 16 + fr; const int tk0 = ld_agent_i(perm + slot); const bool valid = tk0 >= 0; const int tk = valid ? tk0 : 0;
                const int b = tk >> 11; const size_t off = (size_t)tk * DM + col0; float sq = 0.f;
#pragma unroll
                for (int bj = 0; bj < 2; ++bj)
#pragma unroll
                    for (int n = 0; n < 2; ++n) { const f32x4 gate = *(const f32x4*)(mod + b * NMOD + 5 * DM + col0 + bj * 128 + n * 16);
                        const f32x4 xv = *(const f32x4*)(x1 + off + bj * 128 + n * 16); const f32x4 v = xv + gate * acc[ai][bj][m][n];
                        if (valid) *(f32x4*)(x1 + off + bj * 128 + n * 16) = v;
                        sq += (v[0] * v[0] + v[1] * v[1]) + (v[2] * v[2] + v[3] * v[3]); }
                sq += __shfl_xor(sq, 16); sq += __shfl_xor(sq, 32);
                if (fq == 0 && valid) rsq[(size_t)tk * 16 + u.p1 * 4 + wc] = sq; }
    }
};

DEV void p12_phase(Frame& F) {
    const float* rsq = WSP(float, WS_RSQ2); const float* fg = F.in[I_FING];
    const int gw = F.vcu * 8 + F.wave, NGW = F.G * 8;
    for (int m = gw; m < TOK; m += NGW) {
        float pv = (F.lane < 16) ? rsq[(size_t)m * 16 + F.lane] : 0.f;
        const float rstd = 1.0f / sqrtf(wave_sum(pv) * (1.f / DM) + RMS_EPS);
        f32x4* xr = (f32x4*)(F.out + (size_t)m * DM) + F.lane;
#pragma unroll
        for (int j = 0; j < 4; ++j) { const f32x4 v = xr[64 * j]; xr[64 * j] = v * rstd * ((const f32x4*)fg)[F.lane + 64 * j]; }
    }
}

constexpr int LDS_BYTES = 147456;
constexpr int NPHASE = 13;

__global__ void __launch_bounds__(512, 2) mk_fwd(Args args) {
    extern __shared__ __attribute__((aligned(16))) unsigned char lds_raw[];
    Frame F;
    F.lds = (LAS unsigned char*)lds_raw;
    F.tid = threadIdx.x; F.lane = F.tid & 63; F.wave = __builtin_amdgcn_readfirstlane(F.tid >> 6);
    F.G = gridDim.x; F.bx = blockIdx.x; F.vcu = (F.G % 8 == 0) ? (F.bx % 8) * (F.G / 8) + F.bx / 8 : F.bx;
#pragma unroll
    for (int i = 0; i < 29; ++i) F.in[i] = args.in[i];
    F.out = args.out; F.ws = args.ws;
    const int lo = args.ph_lo, hi = args.ph_hi;
#if MK_ONE_LAUNCH
    cg::grid_group grid = cg::this_grid();
#define SEAM(k) do { if (lo <= (k) && (k) + 1 < hi) grid.sync(); } while (0)
#else
#define SEAM(k) do { } while (0)
#endif
#define IN(k) (lo <= (k) && (k) < hi)

    if (IN(0)) { p0_phase(F); }
    SEAM(0);
    if (IN(1)) { p1_phase(F); }
    SEAM(1);
    if (IN(2)) {
        p2_fill_tr(F);
        SchedIn S{16, 2048u, 2048u, F.G, F.bx, (const char*)WSP(bf16_t, WS_HX), (const char*)WSP(bf16_t, WS_WIN)};
        EpiIn E{WSP(bf16_t, WS_UG), WSP(bf16_t, WS_BG), WSP(bf16_t, WS_CV)};
        pg8::gemm_phase<EpiIn, SchedIn>(F.lds, S, E);
    }
    SEAM(2);
    if (IN(3)) {
        if (F.bx < 80) { SchedE S{16, (unsigned)(UGK * 2), 2048u, F.bx, (const char*)WSP(bf16_t, WS_UG), (const char*)WSP(bf16_t, WS_WE)}; EpiE E{WSP(float, WS_E)};
            pg8::gemm_phase<EpiE, SchedE>(F.lds, S, E); }
        else if (F.bx < 144) { SchedSB S{16, 2048u, 2048u, F.bx - 80, (const char*)WSP(bf16_t, WS_SH2), (const char*)WSP(bf16_t, WS_W13)}; EpiSB E{WSP(float, WS_SB13)};
            pg8::gemm_phase<EpiSB, SchedSB>(F.lds, S, E); }
    }
    SEAM(3);
    if (IN(4)) { p4_phase(F); }
    SEAM(4);
    if (IN(5)) {
        SchedY S{20, (unsigned)(UGK * 2), (unsigned)(UGK * 2), F.bx, (const char*)WSP(bf16_t, WS_UG), (const char*)WSP(bf16_t, WS_TR)}; EpiY E{WSP(bf16_t, WS_G)};
        pg8::gemm_phase<EpiY, SchedY>(F.lds, S, E);
    }
    SEAM(5);
    if (IN(6)) {
        SchedGlu S{4, 512u, 512u, F.G, F.bx, (const char*)WSP(bf16_t, WS_G), (const char*)WSP(bf16_t, WS_WGLU)}; EpiGlu E{WSP(bf16_t, WS_G), WSP(bf16_t, WS_YMIX), F.in[I_BGLU]};
        pg8::gemm_phase<EpiGlu, SchedGlu>(F.lds, S, E);
    }
    SEAM(6);
    if (IN(7)) {
        SchedOut S{16, 2048u, 2048u, F.G, F.bx, (const char*)WSP(bf16_t, WS_YMIX), (const char*)WSP(bf16_t, WS_WOUT)};
        EpiOut E{F.in[I_X], F.out, WSP(bf16_t, WS_X1G), WSP(float, WS_RSQ1), WSP(float, WS_MOD), F.in[I_N2G]};
        pg8::gemm_phase<EpiOut, SchedOut>(F.lds, S, E);
    }
    SEAM(7);
    if (IN(8)) { p8_phase(F); }
    SEAM(8);
    if (IN(9)) { p9_phase(F); }
    SEAM(9);
    if (IN(10)) {
        const int ntiles = ld_agent_i(WSP(int, WS_TILES));
        SchedUp S{16, 2048u, 2048u, F.G, F.vcu, ntiles, (const char*)WSP(bf16_t, WS_X1G), (const char*)WSP(bf16_t, WS_W13), WSP(int, WS_PERM), WSP(int, WS_TILES)};
        EpiUp E{WSP(bf16_t, WS_HID), WSP(int, WS_PERM), WSP(float, WS_TOKW), WSP(float, WS_TOKR), WSP(float, WS_SB13)};
        pg8::gemm_phase<EpiUp, SchedUp>(F.lds, S, E);
    }
    SEAM(10);
    if (IN(11)) {
        const int ntiles = ld_agent_i(WSP(int, WS_TILES));
        SchedDown S{16, 2048u, 1024u, F.G, F.vcu, ntiles, (const char*)WSP(bf16_t, WS_HID), (const char*)WSP(bf16_t, WS_W2), WSP(int, WS_TILES)};
        EpiDown E{F.out, WSP(float, WS_RSQ2), WSP(int, WS_PERM), WSP(float, WS_MOD)};
        pg8::gemm_phase<EpiDown, SchedDown>(F.lds, S, E);
    }
    SEAM(11);
    if (IN(12)) { p12_phase(F); }
#undef IN
#undef SEAM
}

extern "C" void kernel_launch(void* const* d_in, const int* in_sizes, int n_in, void* d_out, int out_size, void* d_ws, size_t ws_size, hipStream_t stream) {
    static int grid = 0;
    if (grid == 0) {
        if (n_in != 29 || out_size != TOK * DM || ws_size < WS_END) { fprintf(stderr, "kernel_launch: unexpected problem (n_in %d, out %d, ws %zu)\n", n_in, out_size, ws_size); grid = -1; return; }
        int dev = 0, cus = 0, per_cu = 0;
        if (hipGetDevice(&dev) != hipSuccess || hipDeviceGetAttribute(&cus, hipDeviceAttributeMultiprocessorCount, dev) != hipSuccess) { grid = -1; return; }
        if (hipFuncSetAttribute((const void*)mk_fwd, hipFuncAttributeMaxDynamicSharedMemorySize, LDS_BYTES) != hipSuccess) { fprintf(stderr, "kernel_launch: hipFuncSetAttribute failed\n"); grid = -1; return; }
        if (hipOccupancyMaxActiveBlocksPerMultiprocessor(&per_cu, (const void*)mk_fwd, 512, LDS_BYTES) != hipSuccess || per_cu < 1) { fprintf(stderr, "kernel_launch: occupancy query gives %d\n", per_cu); (void)hipGetLastError(); per_cu = 1; }
        grid = cus;
        if (grid > 256) grid = 256;
    }
    if (grid < 0) return;
    Args a{};
    for (int i = 0; i < 29; ++i) a.in[i] = (const float*)d_in[i];
    a.out = (float*)d_out; a.ws = (unsigned char*)d_ws;
#if MK_ONE_LAUNCH
    a.ph_lo = 0; a.ph_hi = NPHASE;
    void* kargs[] = {&a};
    hipError_t e = hipLaunchCooperativeKernel((const void*)mk_fwd, dim3(grid), dim3(512), kargs, LDS_BYTES, stream);
    if (e != hipSuccess) fprintf(stderr, "cooperative launch failed: %s (grid %d)\n", hipGetErrorString(e), grid);
#else
    for (int p = 0; p < NPHASE; ++p) { a.ph_lo = p; a.ph_hi = p + 1; hipLaunchKernelGGL(mk_fwd, dim3(grid), dim3(512), LDS_BYTES, stream, a); }
#endif
}
```

```cpp
#include <hip/hip_runtime.h>
#include <hip/hip_cooperative_groups.h>
#include <cstdio>
namespace cg = cooperative_groups;

#ifndef MK_REP
#define MK_REP 0
#endif
#ifndef MK_ONE_LAUNCH
#define MK_ONE_LAUNCH 2
#endif

#define DEV __device__ __forceinline__
#define LAS __attribute__((address_space(3)))
typedef unsigned short bf16_t;
typedef short bf16x8 __attribute__((ext_vector_type(8)));
typedef float f32x4 __attribute__((ext_vector_type(4)));
typedef float f32x2 __attribute__((ext_vector_type(2)));
typedef unsigned u32x4 __attribute__((ext_vector_type(4)));
typedef unsigned u32x2 __attribute__((ext_vector_type(2)));

constexpr int NB = 32, SEQ = 2048, DM = 1024, TOK = NB * SEQ, CTXL = 256, CTOK = NB * CTXL;
constexpr int NG = 16, NP = 64, NH = 16, LC = 64;
constexpr int NCH_LAT = TOK / LC, NCH_CTX = CTOK / LC, NCH_PAD = 1280, UGK = 1280;
constexpr int CONVW = 768, NMOD = 6 * DM;
constexpr int NEXP = 16, DEXP = 512, NBUCKET = 24, MAXTILES = 280;
constexpr float RMS_EPS = 1e-6f;

constexpr size_t MiB = 1u << 20;
constexpr size_t WS_CTL = 0;
constexpr size_t WS_MOD = 1 * MiB;
constexpr size_t WS_APOW = 2 * MiB;
constexpr size_t WS_BBAR = 4 * MiB;
constexpr size_t WS_KTAB = 5 * MiB;
constexpr size_t WS_SB13 = 7 * MiB;
constexpr size_t WS_SH2 = 9 * MiB;
constexpr size_t WS_RB = 10 * MiB;
constexpr size_t WS_TOKB = 10 * MiB + 65536;
constexpr size_t WS_TOKW = 11 * MiB;
constexpr size_t WS_TOKR = 12 * MiB;
constexpr size_t WS_SEGC = 12 * MiB + 512 * 1024;
constexpr size_t WS_PERM = 13 * MiB;
constexpr size_t WS_TILES = 14 * MiB;
constexpr size_t WS_SLOT = 16 * MiB;
constexpr size_t WS_WR = 24 * MiB;
constexpr size_t WS_WGLU = 25 * MiB;
constexpr size_t WS_WIN = 26 * MiB;
constexpr size_t WS_WOUT = 32 * MiB;
constexpr size_t WS_WE = 34 * MiB;
constexpr size_t WS_W2 = 42 * MiB;
constexpr size_t WS_W13 = 58 * MiB;
constexpr size_t WS_TR = 90 * MiB;
constexpr size_t WS_E = 130 * MiB;
constexpr size_t WS_UG = 150 * MiB;
constexpr size_t WS_G = 200 * MiB;
constexpr size_t WS_BG = 232 * MiB;
constexpr size_t WS_CV = 328 * MiB;
constexpr size_t WS_HX = 424 * MiB;
constexpr size_t WS_HID = WS_HX;
constexpr size_t WS_YX = WS_BG;
constexpr size_t WS_YMIX = 568 * MiB;
constexpr size_t WS_X1G = 696 * MiB;
constexpr size_t WS_MOE = WS_YMIX;
constexpr size_t WS_X1B = 824 * MiB;
constexpr size_t WS_END = 952 * MiB;

DEV unsigned cvt_pk_bf16(float lo, float hi) { unsigned r; asm volatile("v_cvt_pk_bf16_f32 %0, %1, %2" : "=v"(r) : "v"(lo), "v"(hi)); return r; }
DEV float bf2f(unsigned short h) { return __uint_as_float(((unsigned)h) << 16); }
DEV float bflo(unsigned w) { return __uint_as_float(w << 16); }
DEV float bfhi(unsigned w) { return __uint_as_float(w & 0xffff0000u); }
DEV float wave_sum(float v) {
#pragma unroll
    for (int o = 1; o < 64; o <<= 1) v += __shfl_xor(v, o);
    return v;
}
DEV float sigmoidf_(float x) { return __builtin_amdgcn_rcpf(1.0f + __expf(-x)); }
DEV float siluf_(float x) { return x * sigmoidf_(x); }
DEV float gelu_tanh(float x) { const float u = 0.7978845608028654f * (x + 0.044715f * x * x * x); return x * sigmoidf_(2.0f * u); }
DEV int ld_agent_i(const int* p) { return __hip_atomic_load(p, __ATOMIC_RELAXED, __HIP_MEMORY_SCOPE_AGENT); }

namespace pg8 {
constexpr int BM = 256, BK = 64, HALF = 128, HTB = HALF * BK * 2, STAGE_BYTES = 8 * HTB;
__host__ __device__ __forceinline__ int lds_byte(int r, int c) { const int st = (r >> 4) * 2 + (c >> 5), rr = r & 15, cc = c & 31, ob = rr * 64 + cc * 2; return st * 1024 + (ob ^ (((ob >> 9) & 1) << 5)); }
__host__ __device__ __forceinline__ void stage_rc(int b, int& R, int& C) { const int st = b / 1024, sb = b % 1024, swz = sb ^ (((sb >> 9) & 1) << 5); R = (st >> 1) * 16 + swz / 64; C = (st & 1) * 32 + (swz % 64) / 2; }
__host__ __device__ __forceinline__ int perm32(int rho) { const int n = rho >> 4, i = rho & 15; return 8 * (i >> 2) + 4 * n + (i & 3); }

struct Unit {
    const char* A0; const char* A1; const char* B0; const char* B1;
    int ksA, ksB;
    int p0, p1, p2, p3;
};
DEV const char* pa(const Unit& u, int kt) { return kt < u.ksA ? u.A0 + (size_t)kt * 128 : u.A1 + (size_t)(kt - u.ksA) * 128; }
DEV const char* pb(const Unit& u, int kt) { return kt < u.ksB ? u.B0 + (size_t)kt * 128 : u.B1 + (size_t)(kt - u.ksB) * 128; }

template <class Epi, class Sched>
DEV void gemm_phase(LAS unsigned char* lds, const Sched& S, const Epi& E) {
    const int tid = threadIdx.x, wid = __builtin_amdgcn_readfirstlane(tid >> 6), lane = tid & 63, wr = wid >> 2, wc = wid & 3, fr = lane & 15, fq = lane >> 4;
    const int nt = S.nt;
    int Rr[2], Cc[2];
    unsigned voffB[2], vA[4], vA2[4];
#pragma unroll
    for (int i = 0; i < 2; ++i) { stage_rc(tid * 16 + i * 8192, Rr[i], Cc[i]); const int Rb = Epi::PERM ? ((Rr[i] & ~31) + perm32(Rr[i] & 31)) : Rr[i];
        voffB[i] = (unsigned)Rb * S.ldb + (unsigned)Cc[i] * 2u; }
    const size_t hstepB = (size_t)HALF * S.ldb;
    const unsigned ldsw = (unsigned)wid * 1024u;
    const int aoff = lds_byte(wr * 64 + fr, fq * 8), boff = lds_byte(wc * 32 + fr, fq * 8);
#define PG8_SA(b, h) (((b) * 2 + (h)) * HTB)
#define PG8_SB(b, h) ((4 + (b) * 2 + (h)) * HTB)
#define PG8_STAGE(bufoff, gbase, v0, v1) do { \
        __builtin_amdgcn_global_load_lds((const unsigned*)((const char*)(gbase) + (v0)), (LAS unsigned*)(lds + (bufoff) + ldsw), 16, 0, 0); \
        __builtin_amdgcn_global_load_lds((const unsigned*)((const char*)(gbase) + (v1)), (LAS unsigned*)(lds + (bufoff) + ldsw + 8192), 16, 0, 0); } while (0)
#define PG8_LDA(dst, b, h) do { _Pragma("unroll") for (int m = 0; m < 4; ++m) _Pragma("unroll") for (int k = 0; k < 2; ++k) dst[m][k] = *(const LAS bf16x8*)(lds + PG8_SA(b, h) + aoff + m * 2048 + k * 1024); } while (0)
#define PG8_LDB(dst, b, h) do { _Pragma("unroll") for (int n = 0; n < 2; ++n) _Pragma("unroll") for (int k = 0; k < 2; ++k) dst[n][k] = *(const LAS bf16x8*)(lds + PG8_SB(b, h) + boff + n * 2048 + k * 1024); } while (0)
#define PG8_MMA(ai, bj, At, Bt) do { __builtin_amdgcn_s_setprio(1); _Pragma("unroll") for (int m = 0; m < 4; ++m) _Pragma("unroll") for (int n = 0; n < 2; ++n) _Pragma("unroll") for (int k = 0; k < 2; ++k) \
        acc[ai][bj][m][n] = __builtin_amdgcn_mfma_f32_16x16x32_bf16(Bt[n][k], At[m][k], acc[ai][bj][m][n], 0, 0, 0); __builtin_amdgcn_s_setprio(0); } while (0)
#define PG8_WAIT_V(n) asm volatile("s_waitcnt vmcnt(" #n ")" ::: "memory")
#define PG8_WAIT_L(n) asm volatile("s_waitcnt lgkmcnt(" #n ")" ::: "memory")
#define PG8_BAR __builtin_amdgcn_s_barrier()
#define PG8_SCHED __builtin_amdgcn_sched_barrier(0)
    Unit cur, nxt; int ui = 0;
    int aux_t = 0; asm volatile("" : "+s"(aux_t));
    if (!S.next(0, cur)) return;
    f32x4 acc[2][2][4][2];
#pragma unroll
    for (int a = 0; a < 2; ++a)
#pragma unroll
        for (int b = 0; b < 2; ++b)
#pragma unroll
            for (int m = 0; m < 4; ++m)
#pragma unroll
                for (int n = 0; n < 2; ++n) acc[a][b][m][n] = (f32x4){0.f, 0.f, 0.f, 0.f};
    bf16x8 At[4][2], B0[2][2], B1[2][2];
    if constexpr (Sched::GATHER) S.rows(cur, Rr, Cc, vA);
    else {
#pragma unroll
        for (int h = 0; h < 2; ++h)
#pragma unroll
            for (int i = 0; i < 2; ++i) vA[h * 2 + i] = (unsigned)(h * HALF + Rr[i]) * S.lda + (unsigned)Cc[i] * 2u;
    }
    {
        const char* a0 = pa(cur, 0); const char* b0 = pb(cur, 0); const char* a1 = pa(cur, 1); const char* b1 = pb(cur, 1);
        PG8_STAGE(PG8_SB(0, 0), b0, voffB[0], voffB[1]); PG8_STAGE(PG8_SA(0, 0), a0, vA[0], vA[1]); PG8_STAGE(PG8_SB(0, 1), b0 + hstepB, voffB[0], voffB[1]); PG8_STAGE(PG8_SA(0, 1), a0, vA[2], vA[3]);
        if (wr == 1) PG8_BAR;
        PG8_WAIT_V(4); PG8_BAR;
        PG8_STAGE(PG8_SB(1, 0), b1, voffB[0], voffB[1]); PG8_STAGE(PG8_SA(1, 0), a1, vA[0], vA[1]); PG8_STAGE(PG8_SB(1, 1), b1 + hstepB, voffB[0], voffB[1]);
        PG8_WAIT_V(6); PG8_BAR;
    }
    for (;;) {
        const bool has_next = S.next(ui + 1, nxt);
        if (!has_next) nxt = cur;
        for (int t = 0; t < nt; t += 2) {
            const bool last = (t == nt - 2);
            const char* a1 = pa(cur, t + 1);
            const char* a2; const char* b2;
            if (last) { a2 = pa(nxt, 0); b2 = pb(nxt, 0);
                if constexpr (Sched::GATHER) { if (has_next) S.rows(nxt, Rr, Cc, vA2); else {
#pragma unroll
                    for (int q = 0; q < 4; ++q) vA2[q] = vA[q]; } }
            } else { a2 = pa(cur, t + 2); b2 = pb(cur, t + 2);
                if constexpr (Sched::GATHER) {
#pragma unroll
                    for (int q = 0; q < 4; ++q) vA2[q] = vA[q]; }
            }
            if constexpr (!Sched::GATHER) {
#pragma unroll
                for (int q = 0; q < 4; ++q) vA2[q] = vA[q];
            }
            const char* a3 = a2 + 128; const char* b3 = b2 + 128;
            PG8_LDB(B0, 0, 0); PG8_SCHED; PG8_LDA(At, 0, 0); PG8_STAGE(PG8_SA(1, 1), a1, vA[2], vA[3]);
            PG8_WAIT_L(8); PG8_BAR; PG8_WAIT_L(0); PG8_MMA(0, 0, At, B0); PG8_BAR; PG8_SCHED;
            PG8_LDB(B1, 0, 1); PG8_STAGE(PG8_SB(0, 0), b2, voffB[0], voffB[1]);
            PG8_BAR; PG8_WAIT_L(0); PG8_MMA(0, 1, At, B1); PG8_BAR;
            PG8_LDA(At, 0, 1); PG8_STAGE(PG8_SA(0, 0), a2, vA2[0], vA2[1]);
            if constexpr (Sched::AUX) { if (t == aux_t) S.aux(cur, lds, wid, lane); }
            PG8_BAR; PG8_WAIT_L(0); PG8_MMA(1, 0, At, B0); PG8_BAR; PG8_SCHED;
            PG8_STAGE(PG8_SB(0, 1), b2 + hstepB, voffB[0], voffB[1]);
            PG8_WAIT_V(6); PG8_BAR; PG8_MMA(1, 1, At, B1); PG8_BAR;
            PG8_LDB(B0, 1, 0); PG8_SCHED; PG8_LDA(At, 1, 0); PG8_STAGE(PG8_SA(0, 1), a2, vA2[2], vA2[3]);
            PG8_WAIT_L(8); PG8_BAR; PG8_WAIT_L(0); PG8_MMA(0, 0, At, B0); PG8_BAR; PG8_SCHED;
            PG8_LDB(B1, 1, 1); PG8_STAGE(PG8_SB(1, 0), b3, voffB[0], voffB[1]);
            PG8_BAR; PG8_WAIT_L(0); PG8_MMA(0, 1, At, B1); PG8_BAR;
            PG8_LDA(At, 1, 1); PG8_STAGE(PG8_SA(1, 0), a3, vA2[0], vA2[1]);
            PG8_BAR; PG8_WAIT_L(0); PG8_MMA(1, 0, At, B0); PG8_BAR; PG8_SCHED;
            PG8_STAGE(PG8_SB(1, 1), b3 + hstepB, voffB[0], voffB[1]);
            PG8_WAIT_V(6); PG8_BAR; PG8_MMA(1, 1, At, B1); PG8_BAR;
        }
        E(acc, cur, wr, wc, fr, fq);
        if (!has_next) break;
#pragma unroll
        for (int a = 0; a < 2; ++a)
#pragma unroll
            for (int b = 0; b < 2; ++b)
#pragma unroll
                for (int m = 0; m < 4; ++m)
#pragma unroll
                    for (int n = 0; n < 2; ++n) acc[a][b][m][n] = (f32x4){0.f, 0.f, 0.f, 0.f};
        cur = nxt; ++ui;
        if constexpr (Sched::GATHER) {
#pragma unroll
            for (int q = 0; q < 4; ++q) vA[q] = vA2[q];
        }
    }
    PG8_WAIT_V(0);
    if (wr == 0) PG8_BAR;
    PG8_BAR;
#undef PG8_SA
#undef PG8_SB
#undef PG8_STAGE
#undef PG8_LDA
#undef PG8_LDB
#undef PG8_MMA
#undef PG8_WAIT_V
#undef PG8_WAIT_L
#undef PG8_BAR
#undef PG8_SCHED
}

DEV void static_tile(int L, int nM, int nN, int& pm, int& pn) {
    const int nwg = nM * nN; int wgid = L;
    { const int q = nwg / 8, r = nwg % 8, xcd = wgid % 8, off = wgid / 8; wgid = (xcd < r ? xcd * (q + 1) : r * (q + 1) + (xcd - r) * q) + off; }
    const int nig = 8 * nN, gid = wgid / nig, fm = gid * 8, gsz = (nM - fm) < 8 ? (nM - fm) : 8;
    pm = fm + ((wgid % nig) % gsz); pn = (wgid % nig) / gsz;
}
}
using pg8::Unit;

struct Args { const float* in[29]; float* out; unsigned char* ws; int ph_lo, ph_hi; };
static_assert(sizeof(Args) == 31 * 8 + 8, "Args has no padding");
enum { I_X = 0, I_C, I_CTX, I_CCTX, I_WMOD, I_BMOD, I_N1G, I_N2G, I_WIN, I_LRE, I_LIM, I_LOGDT, I_BRE, I_BIM, I_CRE, I_CIM, I_S5D, I_WGLU, I_BGLU, I_CONVW, I_WOUT,
       I_RGW, I_RGB, I_REW, I_REB, I_W1, I_W3, I_W2, I_FING };

struct Frame {
    LAS unsigned char* lds;
    int tid, lane, wave, G, bx, vcu;
    const float* in[29]; float* out; unsigned char* ws;
};
#define WSP(T, off) ((T*)(F.ws + (off)))

DEV void p0_mod_item(Frame& F, int item) {
    LAS float* st = (LAS float*)F.lds;
    LAS float* red = (LAS float*)(F.lds + 33 * 512 * 4);
    const float* c = F.in[I_C]; const float* cc = F.in[I_CCTX]; const float* wm = F.in[I_WMOD]; const float* bm = F.in[I_BMOD];
    float* mod = WSP(float, WS_MOD);
    const int col = F.tid & 31, kc = F.tid >> 5, j0 = item * 32;
    float acc[33];
#pragma unroll
    for (int n = 0; n < 33; ++n) acc[n] = 0.f;
    for (int half = 0; half < 2; ++half) {
        __syncthreads();
        for (int idx = F.tid; idx < 33 * 512; idx += 512) { const int n = idx >> 9, kk = idx & 511; const float v = (n < 32) ? c[n * DM + half * 512 + kk] : cc[half * 512 + kk]; st[idx] = siluf_(v); }
        __syncthreads();
        for (int kk = kc; kk < 512; kk += 16) {
            const float w = wm[(size_t)(half * 512 + kk) * NMOD + j0 + col];
#pragma unroll
            for (int n = 0; n < 33; ++n) acc[n] += st[n * 512 + kk] * w;
        }
    }
#pragma unroll
    for (int n = 0; n < 33; ++n) red[(kc * 33 + n) * 32 + col] = acc[n];
    __syncthreads();
    for (int idx = F.tid; idx < 33 * 32; idx += 512) { const int n = idx >> 5, cl = idx & 31; float s = bm[j0 + cl];
#pragma unroll
        for (int q = 0; q < 16; ++q) s += red[(q * 33 + n) * 32 + cl];
        mod[n * NMOD + j0 + cl] = s; }
    __syncthreads();
}
DEV void p0_transpose_item(const float* W, int N, int k0, int n0, bf16_t* dst, int ldk, LAS float* scr, int lane) {
#pragma unroll 8
    for (int i = 0; i < 32; ++i) { const int kk = 2 * i + (lane >> 5); scr[kk * 33 + (lane & 31)] = W[(size_t)(k0 + kk) * N + n0 + (lane & 31)]; }
    asm volatile("s_waitcnt lgkmcnt(0)" ::: "memory");
    const int cch = lane & 7;
#pragma unroll
    for (int j = 0; j < 4; ++j) { const int n = (lane >> 3) + 8 * j; const LAS float* s = scr + (8 * cch) * 33 + n;
        u32x4 o; o.x = cvt_pk_bf16(s[0 * 33], s[1 * 33]); o.y = cvt_pk_bf16(s[2 * 33], s[3 * 33]); o.z = cvt_pk_bf16(s[4 * 33], s[5 * 33]); o.w = cvt_pk_bf16(s[6 * 33], s[7 * 33]);
        *(u32x4*)(dst + (size_t)n * ldk + k0 + 8 * cch) = o; }
    asm volatile("s_waitcnt lgkmcnt(0)" ::: "memory");
}
DEV void sincos_rev(double rev, double& s, double& c) {
    const double fr = rev - __builtin_rint(rev);
    const double q = __builtin_rint(fr * 4.0);
    const double y = (fr - q * 0.25) * 6.283185307179586476925;
    const double y2 = y * y;
    const double sy = y * (1.0 + y2 * (-1.0 / 6 + y2 * (1.0 / 120 + y2 * (-1.0 / 5040 + y2 * (1.0 / 362880 + y2 * (-1.0 / 39916800 + y2 * (1.0 / 6227020800.0)))))));
    const double cy = 1.0 + y2 * (-0.5 + y2 * (1.0 / 24 + y2 * (-1.0 / 720 + y2 * (1.0 / 40320 + y2 * (-1.0 / 3628800 + y2 * (1.0 / 479001600.0 + y2 * (-1.0 / 87178291200.0)))))));
    const int qi = ((int)q) & 3;
    s = (qi == 0) ? sy : (qi == 1) ? cy : (qi == 2) ? -sy : -cy;
    c = (qi == 0) ? cy : (qi == 1) ? -sy : (qi == 2) ? -cy : sy;
}
DEV double exp_d(double x) {
    const double k = __builtin_rint(x * 1.4426950408889634074);
    const double r = x - k * 0.69314718055994530942;
    double p = 1.0 / 6227020800.0;
    p = p * r + 1.0 / 479001600.0; p = p * r + 1.0 / 39916800.0; p = p * r + 1.0 / 3628800.0; p = p * r + 1.0 / 362880.0; p = p * r + 1.0 / 40320.0; p = p * r + 1.0 / 5040.0;
    p = p * r + 1.0 / 720.0; p = p * r + 1.0 / 120.0; p = p * r + 1.0 / 24.0; p = p * r + 1.0 / 6.0; p = p * r + 0.5; p = p * r + 1.0; p = p * r + 1.0;
    const long long e = (long long)k + 1023;
    return p * __builtin_bit_cast(double, (unsigned long long)e << 52);
}
DEV void p0_phase(Frame& F) {
    for (int it = F.bx; it < NMOD / 32; it += F.G) p0_mod_item(F, it);
    __syncthreads();
    {
        LAS float* scr = (LAS float*)(F.lds + F.wave * 8448);
        bf16_t* Win = WSP(bf16_t, WS_WIN); bf16_t* Wout = WSP(bf16_t, WS_WOUT); bf16_t* Wglu = WSP(bf16_t, WS_WGLU); bf16_t* W13 = WSP(bf16_t, WS_W13); bf16_t* W2 = WSP(bf16_t, WS_W2);
        const int gw = F.vcu * 8 + F.wave, NGW = F.G * 8;
        constexpr int I_IN = 16 * 80, I_OUT = 16 * 32, I_GLU = 4 * 8, I_E = 16 * 256;
        for (int it = gw; it < I_IN + I_OUT + I_GLU + 3 * I_E; it += NGW) {
            int r = it;
            if (r < I_IN) { const int kb = r / 80, nb = r % 80, n0 = nb * 32; int drow;
                if (n0 < 1024) drow = n0;
                else if (n0 < 1792) { const int j = n0 - 1024; drow = 1024 + (j >> 7) * 256 + (j & 127); }
                else { const int j = n0 - 1792; drow = 1024 + (j >> 7) * 256 + 128 + (j & 127); }
                p0_transpose_item(F.in[I_WIN], 2560, kb * 64, n0, Win + (size_t)drow * 1024, 1024, scr, F.lane); continue; }
            r -= I_IN;
            if (r < I_OUT) { const int kb = r / 32, nb = r % 32; p0_transpose_item(F.in[I_WOUT], 1024, kb * 64, nb * 32, Wout + (size_t)(nb * 32) * 1024, 1024, scr, F.lane); continue; }
            r -= I_OUT;
            if (r < I_GLU) { const int kb = r / 8, nb = r % 8; p0_transpose_item(F.in[I_WGLU], 256, kb * 64, nb * 32, Wglu + (size_t)(nb * 32) * 256, 256, scr, F.lane); continue; }
            r -= I_GLU;
            if (r < 2 * I_E) { const int which = r / I_E; const int rr = r % I_E; const int e = rr >> 8, rem = rr & 255, kb = rem >> 4, nb = rem & 15, n0 = nb * 32;
                const int drow = (n0 >> 7) * 256 + which * 128 + (n0 & 127);
                p0_transpose_item(F.in[which ? I_W3 : I_W1] + (size_t)e * 1024 * 512, 512, kb * 64, n0, W13 + ((size_t)e * 1024 + drow) * 1024, 1024, scr, F.lane); continue; }
            r -= 2 * I_E;
            { const int e = r >> 8, rem = r & 255, kb = rem >> 5, nb = rem & 31;
                p0_transpose_item(F.in[I_W2] + (size_t)e * 512 * 1024, 1024, kb * 64, nb * 32, W2 + ((size_t)e * 1024 + nb * 32) * 512, 512, scr, F.lane); }
        }
    }
    {
        bf16_t* Wr = WSP(bf16_t, WS_WR);
        for (int idx = F.bx * 512 + F.tid; idx < 32 * 1024; idx += F.G * 512) { const int l = idx >> 10, k = idx & 1023;
            const float v = (l < 4) ? F.in[I_RGW][k * 4 + l] : (l < 20) ? F.in[I_REW][k * 16 + (l - 4)] : 0.f;
            Wr[idx] = (bf16_t)(cvt_pk_bf16(v, 0.f) & 0xffffu); }
    }
    {
        f32x2* APOW = WSP(f32x2, WS_APOW); f32x2* BBAR = WSP(f32x2, WS_BBAR);
        const int gt = F.bx * 512 + F.tid, NT = F.G * 512;
        for (int idx = gt; idx < 2 * 16 * 65 * 64; idx += NT) {
            const int p = idx & 63, j = (idx >> 6) % 65, dg = idx / (64 * 65);
            const double lre = F.in[I_LRE][dg * 64 + p], lim = F.in[I_LIM][dg * 64 + p], dt = exp_d((double)F.in[I_LOGDT][dg]);
            const double mag = exp_d(lre * dt * j); double s, c; sincos_rev(lim * dt * j * 0.15915494309189533577, s, c);
            APOW[idx] = (f32x2){(float)(mag * c), (float)(mag * s)};
        }
        for (int idx = gt; idx < 2 * 16 * 64 * 16; idx += NT) {
            const int dgp = idx >> 4, dg = dgp >> 6;
            const double lre = F.in[I_LRE][dgp], lim = F.in[I_LIM][dgp], dt = exp_d((double)F.in[I_LOGDT][dg]);
            const double mag = exp_d(lre * dt); double s, c; sincos_rev(lim * dt * 0.15915494309189533577, s, c);
            const double nr = mag * c - 1.0, ni = mag * s, d2 = lre * lre + lim * lim;
            const double qr = (nr * lre + ni * lim) / d2, qi = (ni * lre - nr * lim) / d2;
            const double br = F.in[I_BRE][idx], bi = F.in[I_BIM][idx];
            BBAR[idx] = (f32x2){(float)(qr * br - qi * bi), (float)(qr * bi + qi * br)};
        }
    }
}

DEV void p1_norm_row(Frame& F, const float* xrow, const float* g, const float* shift, const float* scale, bf16_t* orow) {
    const f32x4* xr = (const f32x4*)xrow + F.lane;
    f32x4 v[4]; float s = 0.f;
#pragma unroll
    for (int j = 0; j < 4; ++j) { v[j] = xr[64 * j]; s += (v[j].x * v[j].x + v[j].y * v[j].y) + (v[j].z * v[j].z + v[j].w * v[j].w); }
    const float rstd = 1.0f / sqrtf(wave_sum(s) * (1.f / DM) + RMS_EPS);
    u32x2* o8 = (u32x2*)orow + F.lane;
#pragma unroll
    for (int j = 0; j < 4; ++j) {
        const f32x4 gg = ((const f32x4*)g)[F.lane + 64 * j], sh = ((const f32x4*)shift)[F.lane + 64 * j], sc = ((const f32x4*)scale)[F.lane + 64 * j];
        const f32x4 y = (v[j] * rstd * gg) * (1.0f + sc) + sh;
        u32x2 w; w.x = cvt_pk_bf16(y.x, y.y); w.y = cvt_pk_bf16(y.z, y.w); o8[64 * j] = w;
    }
}
DEV void p1_phase(Frame& F) {
    const float* mod = WSP(float, WS_MOD);
    bf16_t* HX = WSP(bf16_t, WS_HX);
    const int gw = F.vcu * 8 + F.wave, NGW = F.G * 8;
    for (int m = gw; m < TOK + CTOK; m += NGW) {
        const bool isl = m < TOK; const int n = isl ? (m >> 11) : 32;
        const float* xr = isl ? F.in[I_X] + (size_t)m * DM : F.in[I_CTX] + (size_t)(m - TOK) * DM;
        p1_norm_row(F, xr, F.in[I_N1G], mod + n * NMOD, mod + n * NMOD + DM, HX + (size_t)m * DM);
    }
    const int gt = F.bx * 512 + F.tid, NT = F.G * 512;
    const f32x2* APOW = WSP(f32x2, WS_APOW); const f32x2* BBAR = WSP(f32x2, WS_BBAR);
    {
        float* KT = WSP(float, WS_KTAB);
        for (int idx = gt; idx < 2 * 16 * 64 * 256; idx += NT) {
            const int hp = idx & 15, h = (idx >> 4) & 15, j = (idx >> 8) & 63, dg = idx >> 14;
            float s = 0.f;
            for (int p = 0; p < 64; ++p) {
                const float cr = F.in[I_CRE][(dg * 16 + h) * 64 + p], ci = F.in[I_CIM][(dg * 16 + h) * 64 + p];
                const f32x2 a = APOW[(dg * 65 + j) * 64 + p], b = BBAR[(dg * 64 + p) * 16 + hp];
                const float ur = cr * a.x - ci * a.y, ui = cr * a.y + ci * a.x;
                s += ur * b.x - ui * b.y;
            }
            KT[idx] = s;
        }
    }
    {
        bf16_t* WE = WSP(bf16_t, WS_WE);
        for (int idx = gt; idx < 16 * 256 * 128; idx += NT) {
            const int k8 = idx & 127, n = (idx >> 7) & 255, g = idx >> 15;
            const int part = n >> 6, p = n & 63, dir = part >> 1, k = k8 >> 1, h0 = (k8 & 1) * 8;
            const int dg = dir * 16 + g; const f32x2 a = APOW[(dg * 65 + (dir ? k : 63 - k)) * 64 + p];
            float v[8];
#pragma unroll
            for (int q = 0; q < 8; ++q) { const f32x2 b = BBAR[(dg * 64 + p) * 16 + h0 + q]; v[q] = (part & 1) ? (a.x * b.y + a.y * b.x) : (a.x * b.x - a.y * b.y); }
            u32x4 o; o.x = cvt_pk_bf16(v[0], v[1]); o.y = cvt_pk_bf16(v[2], v[3]); o.z = cvt_pk_bf16(v[4], v[5]); o.w = cvt_pk_bf16(v[6], v[7]);
            *(u32x4*)(WE + ((size_t)(g * 256 + n) * 1024 + k8 * 8)) = o;
        }
    }
    {
        bf16_t* SH2 = WSP(bf16_t, WS_SH2);
        for (int idx = gt; idx < 256 * 1024; idx += NT) { const int r = idx >> 10, k = idx & 1023; const float v = (r < 32) ? mod[r * NMOD + 3 * DM + k] : 0.f; SH2[idx] = (bf16_t)(cvt_pk_bf16(v, 0.f) & 0xffffu); }
    }
    {
        float* rb = WSP(float, WS_RB);
        for (int idx = gw; idx < 32 * 32; idx += NGW) { const int b = idx >> 5, l = idx & 31; float s = 0.f;
            if (l < 20) {
#pragma unroll 4
                for (int k = F.lane; k < DM; k += 64) s += mod[b * NMOD + 3 * DM + k] * ((l < 4) ? F.in[I_RGW][k * 4 + l] : F.in[I_REW][k * 16 + (l - 4)]);
                s = wave_sum(s) + ((l < 4) ? F.in[I_RGB][l] : F.in[I_REB][l - 4]); }
            if (F.lane == 0) rb[idx] = s; }
    }
}

DEV void p2_fill_tr(Frame& F) {
    const float* KT = WSP(float, WS_KTAB); const f32x2* APOW = WSP(f32x2, WS_APOW); bf16_t* TR = WSP(bf16_t, WS_TR);
    const int gt = F.bx * 512 + F.tid, NT = F.G * 512;
    for (int idx = gt; idx < 16 * 1024 * 160; idx += NT) {
        const int k8 = idx % 160, n = (idx / 160) & 1023, g = idx / (160 * 1024);
        const int t = n >> 4, h = n & 15;
        float v[8];
        if (k8 < 128) { const int k = k8 >> 1, h0 = (k8 & 1) * 8;
            if (t > k) { const float* s = KT + (((0 * 16 + g) * 64 + (t - k)) * 256 + h * 16 + h0);
#pragma unroll
                for (int q = 0; q < 8; ++q) v[q] = s[q]; }
            else if (k > t) { const float* s = KT + (((1 * 16 + g) * 64 + (k - t)) * 256 + h * 16 + h0);
#pragma unroll
                for (int q = 0; q < 8; ++q) v[q] = s[q]; }
            else { const float* s0 = KT + (((0 * 16 + g) * 64) * 256 + h * 16 + h0); const float* s1 = KT + (((1 * 16 + g) * 64) * 256 + h * 16 + h0); const float dd = F.in[I_S5D][g * 16 + h];
#pragma unroll
                for (int q = 0; q < 8; ++q) v[q] = s0[q] + s1[q] + ((h0 + q == h) ? dd : 0.f); }
        } else { const int s0 = (k8 - 128) * 8, part = s0 >> 6, p0 = s0 & 63, dir = part >> 1, dg = dir * 16 + g, j = dir ? (64 - t) : (t + 1);
#pragma unroll
            for (int q = 0; q < 8; ++q) { const int p = p0 + q; const float cr = F.in[I_CRE][(dg * 16 + h) * 64 + p], ci = F.in[I_CIM][(dg * 16 + h) * 64 + p]; const f32x2 a = APOW[(dg * 65 + j) * 64 + p];
                v[q] = (part & 1) ? -(cr * a.y + ci * a.x) : (cr * a.x - ci * a.y); }
        }
        u32x4 o; o.x = cvt_pk_bf16(v[0], v[1]); o.y = cvt_pk_bf16(v[2], v[3]); o.z = cvt_pk_bf16(v[4], v[5]); o.w = cvt_pk_bf16(v[6], v[7]);
        *(u32x4*)(TR + ((size_t)(g * 1024 + n) * UGK + k8 * 8)) = o;
    }
}
struct SchedIn {
    static constexpr bool GATHER = false, AUX = false;
    int nt; unsigned lda, ldb; int G, c; const char* HX; const char* W;
    DEV bool next(int i, Unit& u) const {
        const int L = i * G + c; if (L >= 2560 + 32) return false;
        int pm, pn, ctx = 0;
        if (L < 2560) pg8::static_tile(L, 256, 10, pm, pn); else { pm = 256 + (L - 2560); pn = 0; ctx = 1; }
        u.A0 = HX + (size_t)pm * 256 * 2048; u.A1 = u.A0; u.B0 = W + (size_t)pn * 256 * 2048; u.B1 = u.B0; u.ksA = 1 << 20; u.ksB = 1 << 20;
        u.p0 = pm; u.p1 = pn; u.p2 = ctx; u.p3 = 0; return true;
    }
    DEV void rows(const Unit&, const int*, const int*, unsigned*) const {}
    DEV void aux(const Unit&, LAS unsigned char*, int, int) const {}
};
struct EpiIn {
    static constexpr bool PERM = true;
    bf16_t* UG; bf16_t* BG; bf16_t* CV;
    DEV void operator()(const f32x4 (&acc)[2][2][4][2], const Unit& u, int wr, int wc, int fr, int fq) const {
        const int pm = u.p0, pn = u.p1;
#pragma unroll
        for (int ai = 0; ai < 2; ++ai)
#pragma unroll
            for (int m = 0; m < 4; ++m) {
                const int r = ai * 128 + wr * 64 + m * 16 + fr;
                if (pn == 0) {
                    const int mm = pm * 256 + r;
                    const int chunk = mm >> 6, k = mm & 63;
#pragma unroll
                    for (int bj = 0; bj < 2; ++bj) { const int c = bj * 128 + wc * 32 + 8 * fq, g = c >> 4, h0 = c & 15;
                        const f32x4 v0 = acc[ai][bj][m][0], v1 = acc[ai][bj][m][1];
                        u32x4 w; w.x = cvt_pk_bf16(v0[0], v0[1]); w.y = cvt_pk_bf16(v0[2], v0[3]); w.z = cvt_pk_bf16(v1[0], v1[1]); w.w = cvt_pk_bf16(v1[2], v1[3]);
                        *(u32x4*)(UG + ((size_t)(g * NCH_PAD + chunk) * UGK + k * 16 + h0)) = w; }
                } else if (pn < 4) {
                    bf16_t* rowp = BG + (size_t)(pm * 256 + r) * CONVW + (pn - 1) * 256 + wc * 32 + 8 * fq;
#pragma unroll
                    for (int bj = 0; bj < 2; ++bj) { const f32x4 v0 = acc[ai][bj][m][0], v1 = acc[ai][bj][m][1];
                        u32x4 w; w.x = cvt_pk_bf16(v0[0], v0[1]); w.y = cvt_pk_bf16(v0[2], v0[3]); w.z = cvt_pk_bf16(v1[0], v1[1]); w.w = cvt_pk_bf16(v1[2], v1[3]);
                        *(u32x4*)(rowp + bj * 128) = w; }
                } else {
                    const f32x4 v0 = acc[ai][0][m][0] * acc[ai][1][m][0], v1 = acc[ai][0][m][1] * acc[ai][1][m][1];
                    u32x4 w; w.x = cvt_pk_bf16(v0[0], v0[1]); w.y = cvt_pk_bf16(v0[2], v0[3]); w.z = cvt_pk_bf16(v1[0], v1[1]); w.w = cvt_pk_bf16(v1[2], v1[3]);
                    *(u32x4*)(CV + (size_t)(pm * 256 + r) * CONVW + (pn - 4) * 128 + wc * 32 + 8 * fq) = w;
                }
            }
    }
};

struct SchedE {
    static constexpr bool GATHER = false, AUX = false;
    int nt; unsigned lda, ldb; int c; const char* UG; const char* WE;
    DEV bool next(int i, Unit& u) const {
        if (i > 0 || c >= 80) return false;
        const int g = c / 5, pm = c % 5;
        u.A0 = UG + ((size_t)g * NCH_PAD + pm * 256) * UGK * 2; u.A1 = u.A0; u.B0 = WE + (size_t)g * 256 * 2048; u.B1 = u.B0; u.ksA = 1 << 20; u.ksB = 1 << 20;
        u.p0 = pm; u.p1 = g; u.p2 = 0; u.p3 = 0; return true;
    }
    DEV void rows(const Unit&, const int*, const int*, unsigned*) const {}
    DEV void aux(const Unit&, LAS unsigned char*, int, int) const {}
};
struct EpiE {
    static constexpr bool PERM = false;
    float* E;
    DEV void operator()(const f32x4 (&acc)[2][2][4][2], const Unit& u, int wr, int wc, int fr, int fq) const {
        float* base = E + ((size_t)u.p1 * NCH_PAD + u.p0 * 256) * 256;
#pragma unroll
        for (int ai = 0; ai < 2; ++ai)
#pragma unroll
            for (int m = 0; m < 4; ++m) { float* rowp = base + (size_t)(ai * 128 + wr * 64 + m * 16 + fr) * 256 + wc * 32 + 4 * fq;
#pragma unroll
                for (int bj = 0; bj < 2; ++bj)
#pragma unroll
                    for (int n = 0; n < 2; ++n) *(f32x4*)(rowp + bj * 128 + n * 16) = acc[ai][bj][m][n]; }
    }
};
struct SchedSB {
    static constexpr bool GATHER = false, AUX = false;
    int nt; unsigned lda, ldb; int c; const char* SH2; const char* W13;
    DEV bool next(int i, Unit& u) const {
        if (i > 0 || c < 0 || c >= 64) return false;
        const int e = c >> 2, ti = c & 3;
        u.A0 = SH2; u.A1 = u.A0; u.B0 = W13 + ((size_t)e * 1024 + ti * 256) * 2048; u.B1 = u.B0; u.ksA = 1 << 20; u.ksB = 1 << 20;
        u.p0 = e; u.p1 = ti; u.p2 = 0; u.p3 = 0; return true;
    }
    DEV void rows(const Unit&, const int*, const int*, unsigned*) const {}
    DEV void aux(const Unit&, LAS unsigned char*, int, int) const {}
};
struct EpiSB {
    static constexpr bool PERM = true;
    bf16_t* SB;
    DEV void operator()(const f32x4 (&acc)[2][2][4][2], const Unit& u, int wr, int wc, int fr, int fq) const {
        if (wr != 0) return;
#pragma unroll
        for (int m = 0; m < 2; ++m) { const int b = m * 16 + fr; bf16_t* rowp = SB + ((size_t)(b * 16 + u.p0) * 1024 + u.p1 * 256 + wc * 32 + 8 * fq);
#pragma unroll
            for (int bj = 0; bj < 2; ++bj) { const f32x4 v0 = acc[0][bj][m][0], v1 = acc[0][bj][m][1];
                u32x4 w; w.x = cvt_pk_bf16(v0[0], v0[1]); w.y = cvt_pk_bf16(v0[2], v0[3]); w.z = cvt_pk_bf16(v1[0], v1[1]); w.w = cvt_pk_bf16(v1[2], v1[3]);
                *(u32x4*)(rowp + bj * 128) = w; } }
    }
};

DEV void p4_phase(Frame& F) {
    const int gt = F.bx * 512 + F.tid, NT = F.G * 512;
    {
        const float* E = WSP(float, WS_E); const f32x2* APOW = WSP(f32x2, WS_APOW); bf16_t* UG = WSP(bf16_t, WS_UG);
        for (int idx = gt; idx < NB * NG * 128; idx += NT) {
            const int p = idx & 63, dir = (idx >> 6) & 1, g = (idx >> 7) & 15, b = idx >> 11;
            const f32x2 a = APOW[((dir * 16 + g) * 65 + 64) * 64 + p];
            const float* Eg = E + (size_t)g * NCH_PAD * 256 + dir * 128 + p;
            bf16_t* Ug = UG + (size_t)g * NCH_PAD * UGK + 1024 + dir * 128 + p;
            float sr = 0.f, si = 0.f;
            for (int c = 0; c < 4; ++c) { const int ch = NCH_LAT + b * 4 + (dir ? 3 - c : c); const float er = Eg[(size_t)ch * 256], ei = Eg[(size_t)ch * 256 + 64];
                const float nr = a.x * sr - a.y * si + er, ni = a.x * si + a.y * sr + ei; sr = nr; si = ni; }
            for (int c = 0; c < 32; ++c) { const int ch = b * 32 + (dir ? 31 - c : c);
                Ug[(size_t)ch * UGK] = (bf16_t)(cvt_pk_bf16(sr, 0.f) & 0xffffu); Ug[(size_t)ch * UGK + 64] = (bf16_t)(cvt_pk_bf16(si, 0.f) & 0xffffu);
                const float er = Eg[(size_t)ch * 256], ei = Eg[(size_t)ch * 256 + 64];
                const float nr = a.x * sr - a.y * si + er, ni = a.x * si + a.y * sr + ei; sr = nr; si = ni; }
        }
    }
    {
        const bf16_t* BG = WSP(bf16_t, WS_BG); const bf16_t* CV = WSP(bf16_t, WS_CV); bf16_t* YM = WSP(bf16_t, WS_YMIX); const float* cw = F.in[I_CONVW];
        for (int idx = gt; idx < TOK * 96; idx += NT) {
            const int j8 = idx % 96, m = idx / 96, j0 = j8 * 8;
            const bool rowp = j0 < 384; const int d = rowp ? 1 : 64;
            const bool hasl = rowp ? ((m & 63) > 0) : (((m >> 6) & 31) > 0), hasr = rowp ? ((m & 63) < 63) : (((m >> 6) & 31) < 31);
            const u32x4 z = (u32x4){0u, 0u, 0u, 0u};
            const u32x4 c0 = hasl ? *(const u32x4*)(CV + (size_t)(m - d) * CONVW + j0) : z;
            const u32x4 c1 = *(const u32x4*)(CV + (size_t)m * CONVW + j0);
            const u32x4 c2 = hasr ? *(const u32x4*)(CV + (size_t)(m + d) * CONVW + j0) : z;
            const u32x4 bb = *(const u32x4*)(BG + (size_t)m * CONVW + j0);
            float o[8];
#pragma unroll
            for (int q = 0; q < 4; ++q) {
                const float w0a = cw[j0 + 2 * q], w0b = cw[j0 + 2 * q + 1], w1a = cw[CONVW + j0 + 2 * q], w1b = cw[CONVW + j0 + 2 * q + 1], w2a = cw[2 * CONVW + j0 + 2 * q], w2b = cw[2 * CONVW + j0 + 2 * q + 1];
                o[2 * q] = bflo(bb[q]) * (bflo(c0[q]) * w0a + bflo(c1[q]) * w1a + bflo(c2[q]) * w2a);
                o[2 * q + 1] = bfhi(bb[q]) * (bfhi(c0[q]) * w0b + bfhi(c1[q]) * w1b + bfhi(c2[q]) * w2b);
            }
            u32x4 w; w.x = cvt_pk_bf16(o[0], o[1]); w.y = cvt_pk_bf16(o[2], o[3]); w.z = cvt_pk_bf16(o[4], o[5]); w.w = cvt_pk_bf16(o[6], o[7]);
            *(u32x4*)(YM + (size_t)m * DM + 256 + j0) = w;
        }
    }
}

struct SchedY {
    static constexpr bool GATHER = false, AUX = false;
    int nt; unsigned lda, ldb; int c; const char* UG; const char* TR;
    DEV bool next(int i, Unit& u) const {
        if (i > 0 || c >= 256) return false;
        const int g = c >> 4, pm = (c >> 2) & 3, pn = c & 3;
        u.A0 = UG + ((size_t)g * NCH_PAD + pm * 256) * UGK * 2; u.A1 = u.A0; u.B0 = TR + ((size_t)g * 1024 + pn * 256) * UGK * 2; u.B1 = u.B0; u.ksA = 1 << 20; u.ksB = 1 << 20;
        u.p0 = pm; u.p1 = pn; u.p2 = g; u.p3 = 0; return true;
    }
    DEV void rows(const Unit&, const int*, const int*, unsigned*) const {}
    DEV void aux(const Unit&, LAS unsigned char*, int, int) const {}
};
struct EpiY {
    static constexpr bool PERM = true;
    bf16_t* Gb;
    DEV void operator()(const f32x4 (&acc)[2][2][4][2], const Unit& u, int wr, int wc, int fr, int fq) const {
#pragma unroll
        for (int ai = 0; ai < 2; ++ai)
#pragma unroll
            for (int m = 0; m < 4; ++m) { const int chunk = u.p0 * 256 + ai * 128 + wr * 64 + m * 16 + fr;
#pragma unroll
                for (int bj = 0; bj < 2; ++bj) { const int n = u.p1 * 256 + bj * 128 + wc * 32 + 8 * fq, t = n >> 4, h0 = n & 15;
                    const f32x4 v0 = acc[ai][bj][m][0], v1 = acc[ai][bj][m][1];
                    u32x4 w; w.x = cvt_pk_bf16(gelu_tanh(v0[0]), gelu_tanh(v0[1])); w.y = cvt_pk_bf16(gelu_tanh(v0[2]), gelu_tanh(v0[3]));
                    w.z = cvt_pk_bf16(gelu_tanh(v1[0]), gelu_tanh(v1[1])); w.w = cvt_pk_bf16(gelu_tanh(v1[2]), gelu_tanh(v1[3]));
                    *(u32x4*)(Gb + ((size_t)(chunk * 64 + t) * 256 + u.p2 * 16 + h0)) = w; } }
    }
};

struct SchedGlu {
    static constexpr bool GATHER = false, AUX = false;
    int nt; unsigned lda, ldb; int G, c; const char* Gb; const char* W;
    DEV bool next(int i, Unit& u) const {
        const int L = i * G + c; if (L >= 256) return false;
        u.A0 = Gb + (size_t)L * 256 * 512; u.A1 = u.A0; u.B0 = W; u.B1 = u.B0; u.ksA = 1 << 20; u.ksB = 1 << 20; u.p0 = L; u.p1 = 0; u.p2 = 0; u.p3 = 0; return true;
    }
    DEV void rows(const Unit&, const int*, const int*, unsigned*) const {}
    DEV void aux(const Unit&, LAS unsigned char*, int, int) const {}
};
struct EpiGlu {
    static constexpr bool PERM = true;
    const bf16_t* Gb; bf16_t* YM; const float* bglu;
    DEV void operator()(const f32x4 (&acc)[2][2][4][2], const Unit& u, int wr, int wc, int fr, int fq) const {
        u32x4 gq[2][4][2];
#pragma unroll
        for (int ai = 0; ai < 2; ++ai)
#pragma unroll
            for (int m = 0; m < 4; ++m)
#pragma unroll
                for (int bj = 0; bj < 2; ++bj) gq[ai][m][bj] = *(const u32x4*)(Gb + (size_t)(u.p0 * 256 + ai * 128 + wr * 64 + m * 16 + fr) * 256 + bj * 128 + wc * 32 + 8 * fq);
        f32x4 bq[2][2];
#pragma unroll
        for (int bj = 0; bj < 2; ++bj) { bq[bj][0] = *(const f32x4*)(bglu + bj * 128 + wc * 32 + 8 * fq); bq[bj][1] = *(const f32x4*)(bglu + bj * 128 + wc * 32 + 8 * fq + 4); }
        asm volatile("" ::: "memory");
#pragma unroll
        for (int ai = 0; ai < 2; ++ai)
#pragma unroll
            for (int m = 0; m < 4; ++m) { const int row = u.p0 * 256 + ai * 128 + wr * 64 + m * 16 + fr;
#pragma unroll
                for (int bj = 0; bj < 2; ++bj) { const int c = bj * 128 + wc * 32 + 8 * fq;
                    const u32x4 gv = gq[ai][m][bj];
                    const f32x4 z0 = acc[ai][bj][m][0] + bq[bj][0], z1 = acc[ai][bj][m][1] + bq[bj][1];
                    u32x4 w; w.x = cvt_pk_bf16(bflo(gv.x) * sigmoidf_(z0[0]), bfhi(gv.x) * sigmoidf_(z0[1])); w.y = cvt_pk_bf16(bflo(gv.y) * sigmoidf_(z0[2]), bfhi(gv.y) * sigmoidf_(z0[3]));
                    w.z = cvt_pk_bf16(bflo(gv.z) * sigmoidf_(z1[0]), bfhi(gv.z) * sigmoidf_(z1[1])); w.w = cvt_pk_bf16(bflo(gv.w) * sigmoidf_(z1[2]), bfhi(gv.w) * sigmoidf_(z1[3]));
                    *(u32x4*)(YM + (size_t)row * DM + c) = w; } }
    }
};

struct SchedOut {
    static constexpr bool GATHER = false, AUX = false;
    int nt; unsigned lda, ldb; int G, c; const char* A; const char* W;
    DEV bool next(int i, Unit& u) const {
        const int L = i * G + c; if (L >= 1024) return false;
        int pm, pn; pg8::static_tile(L, 256, 4, pm, pn);
        u.A0 = A + (size_t)pm * 256 * 2048; u.A1 = u.A0; u.B0 = W + (size_t)pn * 256 * 2048; u.B1 = u.B0; u.ksA = 1 << 20; u.ksB = 1 << 20; u.p0 = pm; u.p1 = pn; u.p2 = 0; u.p3 = 0; return true;
    }
    DEV void rows(const Unit&, const int*, const int*, unsigned*) const {}
    DEV void aux(const Unit&, LAS unsigned char*, int, int) const {}
};
struct EpiYX {
    static constexpr bool PERM = true;
    bf16_t* YX;
    DEV void operator()(const f32x4 (&acc)[2][2][4][2], const Unit& u, int wr, int wc, int fr, int fq) const {
#pragma unroll
        for (int ai = 0; ai < 2; ++ai)
#pragma unroll
            for (int m = 0; m < 4; ++m) { bf16_t* rowp = YX + (size_t)(u.p0 * 256 + ai * 128 + wr * 64 + m * 16 + fr) * DM + u.p1 * 256 + wc * 32 + 8 * fq;
#pragma unroll
                for (int bj = 0; bj < 2; ++bj) { const f32x4 v0 = acc[ai][bj][m][0], v1 = acc[ai][bj][m][1];
                    u32x4 w; w.x = cvt_pk_bf16(v0[0], v0[1]); w.y = cvt_pk_bf16(v0[2], v0[3]); w.z = cvt_pk_bf16(v1[0], v1[1]); w.w = cvt_pk_bf16(v1[2], v1[3]);
                    *(u32x4*)(rowp + bj * 128) = w; } }
    }
};

constexpr int P8_WR_STRIDE = 2064;
constexpr int P8_GT_OFF = 32 * P8_WR_STRIDE, P8_GS_OFF = P8_GT_OFF + 4096, P8_HIST_OFF = P8_GS_OFF + 4096;
DEV void p8_phase(Frame& F) {
    const float* X = F.in[I_X]; const bf16_t* YX = WSP(bf16_t, WS_YX); bf16_t* X1B = WSP(bf16_t, WS_X1B); bf16_t* X1G = WSP(bf16_t, WS_X1G);
    const bf16_t* Wr = WSP(bf16_t, WS_WR); const float* rb = WSP(float, WS_RB); const float* mod = WSP(float, WS_MOD); const float* n2g = F.in[I_N2G];
    int* tokb = WSP(int, WS_TOKB); float* tokw = WSP(float, WS_TOKW); float* tokr = WSP(float, WS_TOKR); int* segc = WSP(int, WS_SEGC);
    LAS int* hist = (LAS int*)(F.lds + P8_HIST_OFF);
    LAS float* gt = (LAS float*)(F.lds + P8_GT_OFF); LAS float* gsl = (LAS float*)(F.lds + P8_GS_OFF);
    const int l15 = F.lane & 15, q = F.lane >> 4;
    for (int idx = F.tid; idx < 32 * 128; idx += 512) { const int r = idx >> 7, c16 = idx & 127; *(LAS u32x4*)(F.lds + r * P8_WR_STRIDE + c16 * 16) = *(const u32x4*)(Wr + (size_t)r * DM + c16 * 8); }
    for (int seg = F.bx; seg < TOK / 256; seg += F.G) {
        const int b = seg >> 3;
        __syncthreads();
        if (F.tid < 32) hist[F.tid] = 0;
        for (int k = F.tid; k < DM; k += 512) { gt[k] = mod[b * NMOD + 2 * DM + k]; gsl[k] = n2g[k] * (1.0f + mod[b * NMOD + 4 * DM + k]); }
        __syncthreads();
        const int tok0 = seg * 256 + F.wave * 32;
#pragma unroll 1
        for (int rg = 0; rg < 2; ++rg) {
            const int tok = tok0 + rg * 16 + l15;
            const float* xp = X + (size_t)tok * DM + 8 * q; const bf16_t* yp = YX + (size_t)tok * DM + 8 * q;
            bf16_t* o1 = X1B + (size_t)tok * DM + 8 * q; bf16_t* og = X1G + (size_t)tok * DM + 8 * q;
            const LAS unsigned char* wl = F.lds + l15 * P8_WR_STRIDE + q * 16;
            f32x4 acc0 = (f32x4){0.f, 0.f, 0.f, 0.f}, acc1 = acc0; float sq = 0.f;
#pragma unroll 4
            for (int ks = 0; ks < 32; ++ks) {
                const f32x4 xa = *(const f32x4*)(xp + ks * 32), xb = *(const f32x4*)(xp + ks * 32 + 4); const u32x4 yv = *(const u32x4*)(yp + ks * 32);
                const f32x4 g0 = *(const LAS f32x4*)(gt + ks * 32 + 8 * q), g1 = *(const LAS f32x4*)(gt + ks * 32 + 8 * q + 4);
                const f32x4 s0 = *(const LAS f32x4*)(gsl + ks * 32 + 8 * q), s1 = *(const LAS f32x4*)(gsl + ks * 32 + 8 * q + 4);
                f32x4 va, vb;
                va[0] = xa[0] + g0[0] * bflo(yv.x); va[1] = xa[1] + g0[1] * bfhi(yv.x); va[2] = xa[2] + g0[2] * bflo(yv.y); va[3] = xa[3] + g0[3] * bfhi(yv.y);
                vb[0] = xb[0] + g1[0] * bflo(yv.z); vb[1] = xb[1] + g1[1] * bfhi(yv.z); vb[2] = xb[2] + g1[2] * bflo(yv.w); vb[3] = xb[3] + g1[3] * bfhi(yv.w);
                sq += ((va[0] * va[0] + va[1] * va[1]) + (va[2] * va[2] + va[3] * va[3])) + ((vb[0] * vb[0] + vb[1] * vb[1]) + (vb[2] * vb[2] + vb[3] * vb[3]));
                u32x4 w1; w1.x = cvt_pk_bf16(va[0], va[1]); w1.y = cvt_pk_bf16(va[2], va[3]); w1.z = cvt_pk_bf16(vb[0], vb[1]); w1.w = cvt_pk_bf16(vb[2], vb[3]);
                *(u32x4*)(o1 + ks * 32) = w1;
                const f32x4 ga = va * s0, gb = vb * s1;
                u32x4 wg; wg.x = cvt_pk_bf16(ga[0], ga[1]); wg.y = cvt_pk_bf16(ga[2], ga[3]); wg.z = cvt_pk_bf16(gb[0], gb[1]); wg.w = cvt_pk_bf16(gb[2], gb[3]);
                *(u32x4*)(og + ks * 32) = wg;
                const bf16x8 xf = __builtin_bit_cast(bf16x8, wg);
                const bf16x8 wa = *(const LAS bf16x8*)(wl + ks * 64), wb = *(const LAS bf16x8*)(wl + 16 * P8_WR_STRIDE + ks * 64);
                acc0 = __builtin_amdgcn_mfma_f32_16x16x32_bf16(wa, xf, acc0, 0, 0, 0); acc1 = __builtin_amdgcn_mfma_f32_16x16x32_bf16(wb, xf, acc1, 0, 0, 0);
            }
            sq += __shfl_xor(sq, 16); sq += __shfl_xor(sq, 32);
            const float rstd = 1.0f / sqrtf(sq * (1.f / DM) + RMS_EPS);
            float lg[4], l2[4], gl[4], t1[4], t2[4], v[4];
#pragma unroll
            for (int r = 0; r < 4; ++r) { lg[r] = rstd * acc0[r] + rb[b * 32 + 4 * q + r]; l2[r] = rstd * acc1[r] + rb[b * 32 + 16 + ((4 * q + r) & 15)]; }
#pragma unroll
            for (int r = 0; r < 4; ++r) gl[r] = __shfl(lg[r], l15);
            int gi = 0; float gm = gl[0];
#pragma unroll
            for (int r = 1; r < 4; ++r) if (gl[r] > gm) { gm = gl[r]; gi = r; }
            float den = 0.f;
#pragma unroll
            for (int r = 0; r < 4; ++r) den += __expf(gl[r] - gm);
            const float gp = 1.0f / den;
            const int src = l15 + 16 * ((gi + 1) & 3);
#pragma unroll
            for (int r = 0; r < 4; ++r) { t1[r] = __shfl(lg[r], src); t2[r] = __shfl(l2[r], l15); v[r] = (gi == 3) ? t2[r] : t1[r]; }
            int i1 = 0; float v1 = v[0];
#pragma unroll
            for (int r = 1; r < 4; ++r) if (v[r] > v1) { v1 = v[r]; i1 = r; }
            int i2 = -1; float v2 = 0.f;
#pragma unroll
            for (int r = 0; r < 4; ++r) if (r != i1 && (i2 < 0 || v[r] > v2)) { v2 = v[r]; i2 = r; }
            const float ex = __expf(v2 - v1), p1 = 1.0f / (1.0f + ex), p2 = ex * p1;
            const int lo = i1 < i2 ? i1 : i2, hi = i1 < i2 ? i2 : i1;
            const float wlo = (i1 < i2 ? p1 : p2) * gp, whi = (i1 < i2 ? p2 : p1) * gp;
            const int pidx = (lo == 0) ? (hi - 1) : (lo == 1) ? (hi + 1) : 5;
            const int bucket = gi * 6 + pidx;
            if (q == 0) { tokb[tok] = bucket; tokw[tok * 2] = wlo; tokw[tok * 2 + 1] = whi; tokr[tok] = rstd; atomicAdd((int*)hist + bucket, 1); }
        }
        __syncthreads();
        if (F.tid < 32) segc[seg * 32 + F.tid] = (F.tid < NBUCKET) ? hist[F.tid] : 0;
    }
    __syncthreads();
}

DEV void p9_phase(Frame& F) {
    const int* segc = WSP(int, WS_SEGC); const int* tokb = WSP(int, WS_TOKB); int* perm = WSP(int, WS_PERM); int* tiles = WSP(int, WS_TILES);
    const float* tokw = WSP(float, WS_TOKW); const float* tokr = WSP(float, WS_TOKR); u32x4* slotrec = WSP(u32x4, WS_SLOT);
    LAS int* tot = (LAS int*)F.lds;
    LAS int* tst = tot + 32;
    LAS int* base = tst + 32;
    LAS int* wcnt = base + 32;
    for (int seg = F.bx; seg < TOK / 256; seg += F.G) {
        __syncthreads();
        if (F.tid < 32) { int t = 0, bs = 0; if (F.tid < NBUCKET) for (int s = 0; s < 256; ++s) { const int c = ld_agent_i(segc + s * 32 + F.tid); if (s < seg) bs += c; t += c; } tot[F.tid] = t; base[F.tid] = bs; }
        if (F.tid < 128) wcnt[F.tid] = 0;
        __syncthreads();
        if (F.tid == 0) { int ts = 0; for (int k = 0; k < NBUCKET; ++k) { tst[k] = ts; ts += (tot[k] + 255) >> 8; } tst[NBUCKET] = ts; }
        __syncthreads();
        int bk = -1, rank = 0;
        if (F.tid < 256) {
            bk = tokb[seg * 256 + F.tid];
            for (int k = 0; k < NBUCKET; ++k) { const unsigned long long msk = __ballot(bk == k); if (bk == k) rank = __popcll(msk & ((1ull << F.lane) - 1ull)); if (F.lane == 0) wcnt[F.wave * 32 + k] = __popcll(msk); }
        }
        __syncthreads();
        if (F.tid < 256) { int off = 0; for (int w = 0; w < F.wave; ++w) off += wcnt[w * 32 + bk]; const int tok = seg * 256 + F.tid, slot = tst[bk] * 256 + base[bk] + off + rank;
            perm[slot] = tok; slotrec[slot] = (u32x4){(unsigned)tok, __float_as_uint(tokr[tok]), __float_as_uint(tokw[tok * 2]), __float_as_uint(tokw[tok * 2 + 1])}; }
        if (seg < NBUCKET) { const int k = seg, n = tot[k], np = ((n + 255) >> 8) << 8; for (int r = n + F.tid; r < np; r += 512) { perm[tst[k] * 256 + r] = -1; slotrec[tst[k] * 256 + r] = (u32x4){0xffffffffu, 0u, 0u, 0u}; } }
        if (seg == 0) { if (F.tid == 0) tiles[0] = tst[NBUCKET];
            if (F.tid < NBUCKET) { const int k = F.tid, nt_ = (tot[k] + 255) >> 8; for (int t = 0; t < nt_; ++t) tiles[16 + tst[k] + t] = k; } }
    }
}
DEV void bucket_experts(int bk, int& e0, int& e1) { const int grp = bk / 6, pi = bk % 6; const int lo = pi < 3 ? 0 : (pi < 5 ? 1 : 2), hi = pi < 3 ? pi + 1 : (pi < 5 ? pi - 1 : 3); e0 = grp * 4 + lo; e1 = grp * 4 + hi; }

constexpr int AUX_SLOT_OFF = 131072, AUX_BIAS_OFF = 131072 + 4096;
DEV void glds16(const void* g, LAS unsigned char* l) { __builtin_amdgcn_global_load_lds((const unsigned*)g, (LAS unsigned*)l, 16, 0, 0); }

struct SchedUp {
    static constexpr bool GATHER = true, AUX = true;
    int nt; unsigned lda, ldb; int G, c, ntiles; const char* X1G; const char* W13; const int* perm; const int* tiles; const char* slotrec; const char* sb13;
    DEV bool next(int i, Unit& u) const {
        const int L = i * G + c; if (L >= ntiles * 8) return false;
        const int tile = L >> 3, s = (L >> 2) & 1, ti = L & 3; int e0, e1; bucket_experts(ld_agent_i(tiles + 16 + tile), e0, e1); const int e = s ? e1 : e0;
        u.A0 = X1G; u.A1 = X1G; u.B0 = W13 + ((size_t)e * 1024 + ti * 256) * 2048; u.B1 = u.B0; u.ksA = 1 << 20; u.ksB = 1 << 20; u.p0 = tile; u.p1 = s; u.p2 = ti; u.p3 = e; return true;
    }
    DEV void rows(const Unit& u, const int* R, const int* C, unsigned* v) const {
#pragma unroll
        for (int h = 0; h < 2; ++h)
#pragma unroll
            for (int i = 0; i < 2; ++i) { int t = perm[u.p0 * 256 + h * 128 + R[i]]; t = t < 0 ? 0 : t; v[h * 2 + i] = (unsigned)t * 2048u + (unsigned)C[i] * 2u; }
    }
    DEV void aux(const Unit& u, LAS unsigned char* lds, int wid, int lane) const {
        if (wid < 4) glds16(slotrec + (size_t)u.p0 * 4096 + wid * 1024 + lane * 16, lds + AUX_SLOT_OFF + wid * 1024);
#pragma unroll
        for (int i = 0; i < 2; ++i) { const int p = wid * 2 + i, b = 2 * p + (lane >> 5);
            glds16(sb13 + ((size_t)(b * 16 + u.p3) * 1024 + u.p2 * 256) * 2 + (lane & 31) * 16, lds + AUX_BIAS_OFF + p * 1024); }
    }
};
struct EpiUp {
    static constexpr bool PERM = true;
    bf16_t* HID; LAS unsigned char* lds;
    DEV void operator()(const f32x4 (&acc)[2][2][4][2], const Unit& u, int wr, int wc, int fr, int fq) const {
#pragma unroll
        for (int ai = 0; ai < 2; ++ai)
#pragma unroll
            for (int m = 0; m < 4; ++m) { const int r = ai * 128 + wr * 64 + m * 16 + fr, slot = u.p0 * 256 + r;
                const u32x4 rec = *(const LAS u32x4*)(lds + AUX_SLOT_OFF + r * 16);
                const bool valid = (int)rec.x >= 0; const int tk = valid ? (int)rec.x : 0; const float rstd = __uint_as_float(rec.y), w = u.p1 ? __uint_as_float(rec.w) : __uint_as_float(rec.z);
                const LAS unsigned char* bp = lds + AUX_BIAS_OFF + (tk >> 11) * 512 + (wc * 32 + 8 * fq) * 2;
                const u32x4 b1 = *(const LAS u32x4*)bp, b3 = *(const LAS u32x4*)(bp + 256);
                const f32x4 a10 = acc[ai][0][m][0] * rstd, a11 = acc[ai][0][m][1] * rstd, a30 = acc[ai][1][m][0] * rstd, a31 = acc[ai][1][m][1] * rstd;
                float o[8];
                o[0] = w * siluf_(a10[0] + bflo(b1.x)) * (a30[0] + bflo(b3.x)); o[1] = w * siluf_(a10[1] + bfhi(b1.x)) * (a30[1] + bfhi(b3.x));
                o[2] = w * siluf_(a10[2] + bflo(b1.y)) * (a30[2] + bflo(b3.y)); o[3] = w * siluf_(a10[3] + bfhi(b1.y)) * (a30[3] + bfhi(b3.y));
                o[4] = w * siluf_(a11[0] + bflo(b1.z)) * (a31[0] + bflo(b3.z)); o[5] = w * siluf_(a11[1] + bfhi(b1.z)) * (a31[1] + bfhi(b3.z));
                o[6] = w * siluf_(a11[2] + bflo(b1.w)) * (a31[2] + bflo(b3.w)); o[7] = w * siluf_(a11[3] + bfhi(b1.w)) * (a31[3] + bfhi(b3.w));
                u32x4 wv; wv.x = cvt_pk_bf16(o[0], o[1]); wv.y = cvt_pk_bf16(o[2], o[3]); wv.z = cvt_pk_bf16(o[4], o[5]); wv.w = cvt_pk_bf16(o[6], o[7]);
                *(u32x4*)(HID + ((size_t)slot * 1024 + u.p1 * 512 + u.p2 * 128 + wc * 32 + 8 * fq)) = wv; }
    }
};

struct SchedDown {
    static constexpr bool GATHER = false, AUX = true;
    int nt; unsigned lda, ldb; int G, c, ntiles; const char* HID; const char* W2; const int* tiles; const char* slotrec;
    DEV bool next(int i, Unit& u) const {
        const int L = i * G + c; if (L >= ntiles * 4) return false;
        const int tile = L >> 2, pn = L & 3; int e0, e1; bucket_experts(ld_agent_i(tiles + 16 + tile), e0, e1);
        u.A0 = HID + (size_t)tile * 256 * 2048; u.A1 = u.A0; u.ksA = 1 << 20;
        u.B0 = W2 + ((size_t)e0 * 1024 + pn * 256) * 1024; u.B1 = W2 + ((size_t)e1 * 1024 + pn * 256) * 1024; u.ksB = 8;
        u.p0 = tile; u.p1 = pn; u.p2 = 0; u.p3 = 0; return true;
    }
    DEV void rows(const Unit&, const int*, const int*, unsigned*) const {}
    DEV void aux(const Unit& u, LAS unsigned char* lds, int wid, int lane) const {
        if (wid < 4) glds16(slotrec + (size_t)u.p0 * 4096 + wid * 1024 + lane * 16, lds + AUX_SLOT_OFF + wid * 1024);
    }
};
struct EpiDown {
    static constexpr bool PERM = true;
    bf16_t* MOE; LAS unsigned char* lds;
    DEV void operator()(const f32x4 (&acc)[2][2][4][2], const Unit& u, int wr, int wc, int fr, int fq) const {
#pragma unroll
        for (int ai = 0; ai < 2; ++ai)
#pragma unroll
            for (int m = 0; m < 4; ++m) { const int r = ai * 128 + wr * 64 + m * 16 + fr; const int tk = *(const LAS int*)(lds + AUX_SLOT_OFF + r * 16);
                if (tk >= 0) { bf16_t* rowp = MOE + (size_t)tk * DM + u.p1 * 256 + wc * 32 + 8 * fq;
#pragma unroll
                    for (int bj = 0; bj < 2; ++bj) { const f32x4 v0 = acc[ai][bj][m][0], v1 = acc[ai][bj][m][1];
                        u32x4 w; w.x = cvt_pk_bf16(v0[0], v0[1]); w.y = cvt_pk_bf16(v0[2], v0[3]); w.z = cvt_pk_bf16(v1[0], v1[1]); w.w = cvt_pk_bf16(v1[2], v1[3]);
                        *(u32x4*)(rowp + bj * 128) = w; } } }
    }
};

DEV void p12_phase(Frame& F) {
    const bf16_t* X1B = WSP(bf16_t, WS_X1B); const bf16_t* MOE = WSP(bf16_t, WS_MOE); const float* mod = WSP(float, WS_MOD); const float* fg = F.in[I_FING];
    const int gw = F.vcu * 8 + F.wave, NGW = F.G * 8;
    for (int m = gw; m < TOK; m += NGW) {
        const int b = m >> 11; const float* gate = mod + b * NMOD + 5 * DM;
        float v[16];
#pragma unroll
        for (int h = 0; h < 2; ++h) { const int c0 = h * 512 + 8 * F.lane;
            const u32x4 xv = *(const u32x4*)(X1B + (size_t)m * DM + c0), mv = *(const u32x4*)(MOE + (size_t)m * DM + c0);
            const f32x4 g0 = *(const f32x4*)(gate + c0), g1 = *(const f32x4*)(gate + c0 + 4);
            v[h * 8 + 0] = bflo(xv.x) + g0[0] * bflo(mv.x); v[h * 8 + 1] = bfhi(xv.x) + g0[1] * bfhi(mv.x); v[h * 8 + 2] = bflo(xv.y) + g0[2] * bflo(mv.y); v[h * 8 + 3] = bfhi(xv.y) + g0[3] * bfhi(mv.y);
            v[h * 8 + 4] = bflo(xv.z) + g1[0] * bflo(mv.z); v[h * 8 + 5] = bfhi(xv.z) + g1[1] * bfhi(mv.z); v[h * 8 + 6] = bflo(xv.w) + g1[2] * bflo(mv.w); v[h * 8 + 7] = bfhi(xv.w) + g1[3] * bfhi(mv.w); }
        float s = 0.f;
#pragma unroll
        for (int j = 0; j < 16; ++j) s += v[j] * v[j];
        const float rstd = 1.0f / sqrtf(wave_sum(s) * (1.f / DM) + RMS_EPS);
#pragma unroll
        for (int h = 0; h < 2; ++h) { const int c0 = h * 512 + 8 * F.lane; const f32x4 f0 = *(const f32x4*)(fg + c0), f1 = *(const f32x4*)(fg + c0 + 4);
            f32x4 o0, o1;
#pragma unroll
            for (int j = 0; j < 4; ++j) { o0[j] = v[h * 8 + j] * rstd * f0[j]; o1[j] = v[h * 8 + 4 + j] * rstd * f1[j]; }
            *(f32x4*)(F.out + (size_t)m * DM + c0) = o0; *(f32x4*)(F.out + (size_t)m * DM + c0 + 4) = o1; }
    }
}

#define XB_TMO      128
#define XB_XCNT(j)  (256  + 64 * (j))
#define XB_XSUB(j)  (1280 + 64 * (j))
#define XB_XGEN(j)  (2304 + 64 * (j))
#define XB_TOP      3328
#define XB_TOPGEN   3392
#define XCD_BAR_WORDS 3456
#define XB_SPIN_CAP (1u << 22)
DEV unsigned xb_ld(unsigned* p)              { return __hip_atomic_load(p, __ATOMIC_RELAXED, __HIP_MEMORY_SCOPE_AGENT); }
DEV unsigned xb_add(unsigned* p, unsigned v) { return __hip_atomic_fetch_add(p, v, __ATOMIC_RELAXED, __HIP_MEMORY_SCOPE_AGENT); }
DEV unsigned xb_xcc_id() { return (unsigned)__builtin_amdgcn_s_getreg((3 << 11) | 20) & 0xFu; }
#define XB_SPIN(cond, bar) do { unsigned _sp = 0; while (cond) { __builtin_amdgcn_s_sleep(1); \
    if ((++_sp & 255u) == 0u) { if (xb_ld(&(bar)[XB_TMO])) break; if (_sp > XB_SPIN_CAP) { atomicAdd(&(bar)[XB_TMO], 1u); break; } } } } while (0)
struct XcdBarrier { unsigned* bar; unsigned x; volatile LAS unsigned* st; };
DEV XcdBarrier xcd_barrier_post(unsigned* bar, volatile LAS unsigned* st) {
    XcdBarrier b; b.bar = bar; b.x = xb_xcc_id(); b.st = st;
    if (threadIdx.x == 0) (void)xb_add(&bar[XB_XCNT(b.x)], 1u);
    return b;
}
DEV void xcd_barrier_complete(unsigned* bar, unsigned x, unsigned& nloc, unsigned& nx) {
    const unsigned G = gridDim.x * gridDim.y * gridDim.z;
    unsigned sum, cnt, mine, sp = 0u;
    for (;;) {
        sum = 0u; cnt = 0u; mine = 0u;
#pragma unroll
        for (unsigned j = 0; j < 16; ++j) { const unsigned c = xb_ld(&bar[XB_XCNT(j)]); sum += c; cnt += (c > 0u) ? 1u : 0u; mine = (j == x) ? c : mine; }
        if (sum == G) break;
        __builtin_amdgcn_s_sleep(1);
        if ((++sp & 255u) == 0u) { if (xb_ld(&bar[XB_TMO])) break; if (sp > XB_SPIN_CAP) { atomicAdd(&bar[XB_TMO], 1u); break; } }
    }
    nloc = mine > 0u ? mine : 1u; nx = cnt > 0u ? cnt : 1u;
}
DEV void xcd_barrier(const XcdBarrier& b) {
    asm volatile("s_waitcnt vmcnt(0)" ::: "memory");
    __syncthreads();
    if (threadIdx.x == 0) {
        unsigned* bar = b.bar;
        __builtin_amdgcn_s_waitcnt(0);
        unsigned nloc = b.st[0], nx = b.st[1];
        if (nloc == 0u) { xcd_barrier_complete(bar, b.x, nloc, nx); b.st[0] = nloc; b.st[1] = nx; }
        const unsigned old = xb_add(&bar[XB_XSUB(b.x)], 1u);
        const unsigned gen = old / nloc;
        if (old + 1u == (gen + 1u) * nloc) {
            __builtin_amdgcn_fence(__ATOMIC_RELEASE, "agent");
            asm volatile("s_waitcnt vmcnt(0)" ::: "memory");
            const unsigned og = xb_add(&bar[XB_TOP], 1u);
            const unsigned tg = og / nx;
            if (og + 1u == (tg + 1u) * nx) xb_add(&bar[XB_TOPGEN], 1u);
            else XB_SPIN(xb_ld(&bar[XB_TOPGEN]) == tg, bar);
            __builtin_amdgcn_fence(__ATOMIC_ACQUIRE, "agent");
            xb_add(&bar[XB_XGEN(b.x)], 1u);
            asm volatile("s_waitcnt vmcnt(0)" ::: "memory");
        } else {
            XB_SPIN(xb_ld(&bar[XB_XGEN(b.x)]) == gen, bar);
            __builtin_amdgcn_fence(__ATOMIC_ACQUIRE, "agent");
            asm volatile("s_waitcnt vmcnt(0)" ::: "memory");
        }
    }
    __syncthreads();
}

constexpr int LDS_BYTES = 155648;
constexpr int NPHASE = 13;
constexpr int MISC_OFF = LDS_BYTES - 256;
constexpr int CW_BAR = 4096;
constexpr size_t CTL_ZERO_BYTES = 65536;

__global__ void __launch_bounds__(512, 2) mk_fwd(Args args) {
    extern __shared__ __attribute__((aligned(16))) unsigned char lds_raw[];
    Frame F;
    F.lds = (LAS unsigned char*)lds_raw;
    F.tid = threadIdx.x; F.lane = F.tid & 63; F.wave = __builtin_amdgcn_readfirstlane(F.tid >> 6);
    F.G = gridDim.x; F.bx = blockIdx.x; F.vcu = (F.G % 8 == 0) ? (F.bx % 8) * (F.G / 8) + F.bx / 8 : F.bx;
#pragma unroll
    for (int i = 0; i < 29; ++i) F.in[i] = args.in[i];
    F.out = args.out; F.ws = args.ws;
    const int lo = args.ph_lo, hi = args.ph_hi;
#if MK_ONE_LAUNCH == 1
    cg::grid_group grid = cg::this_grid();
#define SEAM(k) do { if (lo <= (k) && (k) + 1 < hi) grid.sync(); } while (0)
#elif MK_ONE_LAUNCH == 2
    {
        volatile LAS unsigned* misc = (volatile LAS unsigned*)(F.lds + MISC_OFF);
        if (F.tid < 16) misc[F.tid] = 0u;
        __syncthreads();
    }
    const XcdBarrier xbar = xcd_barrier_post((unsigned*)(F.ws + WS_CTL) + CW_BAR, (volatile LAS unsigned*)(F.lds + MISC_OFF));
#define SEAM(k) do { if (lo <= (k) && (k) + 1 < hi) xcd_barrier(xbar); } while (0)
#else
#define SEAM(k) do { } while (0)
#endif
#define IN(k) (lo <= (k) && (k) < hi)
#define REPS(k) for (int rep_ = 0; rep_ < 1 + ((MK_REP >> (k)) & 1); ++rep_)

    if (IN(0)) REPS(0) { p0_phase(F); }
    SEAM(0);
    if (IN(1)) REPS(1) { p1_phase(F); }
    SEAM(1);
    if (IN(2)) REPS(2) {
        p2_fill_tr(F);
        SchedIn S{16, 2048u, 2048u, F.G, F.bx, (const char*)WSP(bf16_t, WS_HX), (const char*)WSP(bf16_t, WS_WIN)};
        EpiIn E{WSP(bf16_t, WS_UG), WSP(bf16_t, WS_BG), WSP(bf16_t, WS_CV)};
        pg8::gemm_phase<EpiIn, SchedIn>(F.lds, S, E);
    }
    SEAM(2);
    if (IN(3)) REPS(3) {
        if (F.bx < 80) { SchedE S{16, (unsigned)(UGK * 2), 2048u, F.bx, (const char*)WSP(bf16_t, WS_UG), (const char*)WSP(bf16_t, WS_WE)}; EpiE E{WSP(float, WS_E)};
            pg8::gemm_phase<EpiE, SchedE>(F.lds, S, E); }
        else if (F.bx < 144) { SchedSB S{16, 2048u, 2048u, F.bx - 80, (const char*)WSP(bf16_t, WS_SH2), (const char*)WSP(bf16_t, WS_W13)}; EpiSB E{WSP(bf16_t, WS_SB13)};
            pg8::gemm_phase<EpiSB, SchedSB>(F.lds, S, E); }
    }
    SEAM(3);
    if (IN(4)) REPS(4) { p4_phase(F); }
    SEAM(4);
    if (IN(5)) REPS(5) {
        SchedY S{20, (unsigned)(UGK * 2), (unsigned)(UGK * 2), F.bx, (const char*)WSP(bf16_t, WS_UG), (const char*)WSP(bf16_t, WS_TR)}; EpiY E{WSP(bf16_t, WS_G)};
        pg8::gemm_phase<EpiY, SchedY>(F.lds, S, E);
    }
    SEAM(5);
    if (IN(6)) REPS(6) {
        SchedGlu S{4, 512u, 512u, F.G, F.bx, (const char*)WSP(bf16_t, WS_G), (const char*)WSP(bf16_t, WS_WGLU)}; EpiGlu E{WSP(bf16_t, WS_G), WSP(bf16_t, WS_YMIX), F.in[I_BGLU]};
        pg8::gemm_phase<EpiGlu, SchedGlu>(F.lds, S, E);
    }
    SEAM(6);
    if (IN(7)) REPS(7) {
        SchedOut S{16, 2048u, 2048u, F.G, F.bx, (const char*)WSP(bf16_t, WS_YMIX), (const char*)WSP(bf16_t, WS_WOUT)};
        EpiYX E{WSP(bf16_t, WS_YX)};
        pg8::gemm_phase<EpiYX, SchedOut>(F.lds, S, E);
    }
    SEAM(7);
    if (IN(8)) REPS(8) { p8_phase(F); }
    SEAM(8);
    if (IN(9)) REPS(9) { p9_phase(F); }
    SEAM(9);
    if (IN(10)) REPS(10) {
        const int ntiles = ld_agent_i(WSP(int, WS_TILES));
        SchedUp S{16, 2048u, 2048u, F.G, F.vcu, ntiles, (const char*)WSP(bf16_t, WS_X1G), (const char*)WSP(bf16_t, WS_W13), WSP(int, WS_PERM), WSP(int, WS_TILES), (const char*)WSP(u32x4, WS_SLOT), (const char*)WSP(bf16_t, WS_SB13)};
        EpiUp E{WSP(bf16_t, WS_HID), F.lds};
        pg8::gemm_phase<EpiUp, SchedUp>(F.lds, S, E);
    }
    SEAM(10);
    if (IN(11)) {
        const int ntiles = ld_agent_i(WSP(int, WS_TILES));
        SchedDown S{16, 2048u, 1024u, F.G, F.vcu, ntiles, (const char*)WSP(bf16_t, WS_HID), (const char*)WSP(bf16_t, WS_W2), WSP(int, WS_TILES), (const char*)WSP(u32x4, WS_SLOT)};
        EpiDown E{WSP(bf16_t, WS_MOE), F.lds};
        pg8::gemm_phase<EpiDown, SchedDown>(F.lds, S, E);
    }
    SEAM(11);
    if (IN(12)) { p12_phase(F); }
#undef IN
#undef SEAM
}

extern "C" void kernel_launch(void* const* d_in, const int* in_sizes, int n_in, void* d_out, int out_size, void* d_ws, size_t ws_size, hipStream_t stream) {
    static int grid = 0;
    if (grid == 0) {
        if (n_in != 29 || out_size != TOK * DM || ws_size < WS_END) { fprintf(stderr, "kernel_launch: unexpected problem (n_in %d, out %d, ws %zu)\n", n_in, out_size, ws_size); grid = -1; return; }
        int dev = 0, cus = 0, per_cu = 0;
        if (hipGetDevice(&dev) != hipSuccess || hipDeviceGetAttribute(&cus, hipDeviceAttributeMultiprocessorCount, dev) != hipSuccess) { grid = -1; return; }
        if (hipFuncSetAttribute((const void*)mk_fwd, hipFuncAttributeMaxDynamicSharedMemorySize, LDS_BYTES) != hipSuccess) { fprintf(stderr, "kernel_launch: hipFuncSetAttribute failed\n"); grid = -1; return; }
        if (hipOccupancyMaxActiveBlocksPerMultiprocessor(&per_cu, (const void*)mk_fwd, 512, LDS_BYTES) != hipSuccess || per_cu < 1) { fprintf(stderr, "kernel_launch: occupancy query gives %d\n", per_cu); (void)hipGetLastError(); per_cu = 1; }
        grid = cus;
        if (grid > 256) grid = 256;
    }
    if (grid < 0) return;
    Args a{};
    for (int i = 0; i < 29; ++i) a.in[i] = (const float*)d_in[i];
    a.out = (float*)d_out; a.ws = (unsigned char*)d_ws;
#if MK_ONE_LAUNCH == 1
    a.ph_lo = 0; a.ph_hi = NPHASE;
    void* kargs[] = {&a};
    hipError_t e = hipLaunchCooperativeKernel((const void*)mk_fwd, dim3(grid), dim3(512), kargs, LDS_BYTES, stream);
    if (e != hipSuccess) fprintf(stderr, "cooperative launch failed: %s (grid %d)\n", hipGetErrorString(e), grid);
#elif MK_ONE_LAUNCH == 2
    if (hipMemsetAsync((char*)d_ws + WS_CTL, 0, CTL_ZERO_BYTES, stream) != hipSuccess) { fprintf(stderr, "kernel_launch: memset failed\n"); return; }
    a.ph_lo = 0; a.ph_hi = NPHASE;
    hipLaunchKernelGGL(mk_fwd, dim3(grid), dim3(512), LDS_BYTES, stream, a);
#else
    for (int p = 0; p < NPHASE; ++p) { a.ph_lo = p; a.ph_hi = p + 1; hipLaunchKernelGGL(mk_fwd, dim3(grid), dim3(512), LDS_BYTES, stream, a); }
#endif
}
```

```cpp
#include <hip/hip_runtime.h>
#include <hip/hip_cooperative_groups.h>
#include <cstdio>
namespace cg = cooperative_groups;

#ifndef MK_PROBE_PHASE
#define MK_PROBE_PHASE -1
#endif
#ifndef MK_REP
#define MK_REP 0
#endif
#ifndef MK_ONE_LAUNCH
#define MK_ONE_LAUNCH 2
#endif

#define DEV __device__ __forceinline__
#define LAS __attribute__((address_space(3)))
typedef unsigned short bf16_t;
typedef short bf16x8 __attribute__((ext_vector_type(8)));
typedef float f32x4 __attribute__((ext_vector_type(4)));
typedef float f32x2 __attribute__((ext_vector_type(2)));
typedef unsigned u32x4 __attribute__((ext_vector_type(4)));
typedef unsigned u32x2 __attribute__((ext_vector_type(2)));

constexpr int NB = 32, SEQ = 2048, DM = 1024, TOK = NB * SEQ, CTXL = 256, CTOK = NB * CTXL;
constexpr int NG = 16, NP = 64, NH = 16, LC = 64;
constexpr int NCH_LAT = TOK / LC, NCH_CTX = CTOK / LC, NCH_PAD = 1280, UGK = 1280;
constexpr int CONVW = 768, NMOD = 6 * DM;
constexpr int NEXP = 16, DEXP = 512, NBUCKET = 24, MAXTILES = 280;
constexpr float RMS_EPS = 1e-6f;

constexpr size_t MiB = 1u << 20;
constexpr size_t WS_CTL = 0;
constexpr size_t WS_MOD = 1 * MiB;
constexpr size_t WS_APOW = 2 * MiB;
constexpr size_t WS_BBAR = 4 * MiB;
constexpr size_t WS_KTAB = 5 * MiB;
constexpr size_t WS_SB13 = 7 * MiB;
constexpr size_t WS_SH2 = 9 * MiB;
constexpr size_t WS_RB = 10 * MiB;
constexpr size_t WS_TOKB = 10 * MiB + 65536;
constexpr size_t WS_TOKW = 11 * MiB;
constexpr size_t WS_TOKR = 12 * MiB;
constexpr size_t WS_SEGC = 12 * MiB + 512 * 1024;
constexpr size_t WS_PERM = 13 * MiB;
constexpr size_t WS_TILES = 14 * MiB;
constexpr size_t WS_SLOT = 16 * MiB;
constexpr size_t WS_WR = 24 * MiB;
constexpr size_t WS_WGLU = 25 * MiB;
constexpr size_t WS_WIN = 26 * MiB;
constexpr size_t WS_WOUT = 32 * MiB;
constexpr size_t WS_WE = 34 * MiB;
constexpr size_t WS_W2 = 42 * MiB;
constexpr size_t WS_W13 = 58 * MiB;
constexpr size_t WS_TR = 90 * MiB;
constexpr size_t WS_E = 130 * MiB;
constexpr size_t WS_UG = 150 * MiB;
constexpr size_t WS_G = 200 * MiB;
constexpr size_t WS_BG = 232 * MiB;
constexpr size_t WS_CV = 328 * MiB;
constexpr size_t WS_HX = 424 * MiB;
constexpr size_t WS_HID = WS_HX;
constexpr size_t WS_YX = WS_BG;
constexpr size_t WS_YMIX = 568 * MiB;
constexpr size_t WS_X1G = 696 * MiB;
constexpr size_t WS_MOE = WS_YMIX;
constexpr size_t WS_X1B = 824 * MiB;
constexpr size_t WS_END = 952 * MiB;

DEV unsigned cvt_pk_bf16(float lo, float hi) { unsigned r; asm volatile("v_cvt_pk_bf16_f32 %0, %1, %2" : "=v"(r) : "v"(lo), "v"(hi)); return r; }
DEV float bf2f(unsigned short h) { return __uint_as_float(((unsigned)h) << 16); }
DEV float bflo(unsigned w) { return __uint_as_float(w << 16); }
DEV float bfhi(unsigned w) { return __uint_as_float(w & 0xffff0000u); }
DEV float wave_sum(float v) {
#pragma unroll
    for (int o = 1; o < 64; o <<= 1) v += __shfl_xor(v, o);
    return v;
}
DEV float sigmoidf_(float x) { return __builtin_amdgcn_rcpf(1.0f + __expf(-x)); }
DEV float siluf_(float x) { return x * sigmoidf_(x); }
DEV float gelu_tanh(float x) { const float u = 0.7978845608028654f * (x + 0.044715f * x * x * x); return x * sigmoidf_(2.0f * u); }
DEV int ld_agent_i(const int* p) { return __hip_atomic_load(p, __ATOMIC_RELAXED, __HIP_MEMORY_SCOPE_AGENT); }

namespace pg8 {
constexpr int BM = 256, BK = 64, HALF = 128, HTB = HALF * BK * 2, STAGE_BYTES = 8 * HTB;
__host__ __device__ __forceinline__ int lds_byte(int r, int c) { const int st = (r >> 4) * 2 + (c >> 5), rr = r & 15, cc = c & 31, ob = rr * 64 + cc * 2; return st * 1024 + (ob ^ (((ob >> 9) & 1) << 5)); }
__host__ __device__ __forceinline__ void stage_rc(int b, int& R, int& C) { const int st = b / 1024, sb = b % 1024, swz = sb ^ (((sb >> 9) & 1) << 5); R = (st >> 1) * 16 + swz / 64; C = (st & 1) * 32 + (swz % 64) / 2; }
__host__ __device__ __forceinline__ int perm32(int rho) { const int n = rho >> 4, i = rho & 15; return 8 * (i >> 2) + 4 * n + (i & 3); }

struct Unit {
    const char* A0; const char* A1; const char* B0; const char* B1;
    int ksA, ksB;
    int p0, p1, p2, p3;
};
DEV const char* pa(const Unit& u, int kt) { return kt < u.ksA ? u.A0 + (size_t)kt * 128 : u.A1 + (size_t)(kt - u.ksA) * 128; }
DEV const char* pb(const Unit& u, int kt) { return kt < u.ksB ? u.B0 + (size_t)kt * 128 : u.B1 + (size_t)(kt - u.ksB) * 128; }

template <class Epi, class Sched>
DEV void gemm_phase(LAS unsigned char* lds, const Sched& S, const Epi& E) {
    const int tid = threadIdx.x, wid = __builtin_amdgcn_readfirstlane(tid >> 6), lane = tid & 63, wr = wid >> 2, wc = wid & 3, fr = lane & 15, fq = lane >> 4;
    const int nt = S.nt;
    int Rr[2], Cc[2];
    unsigned voffB[2], vA[4], vA2[4];
#pragma unroll
    for (int i = 0; i < 2; ++i) { stage_rc(tid * 16 + i * 8192, Rr[i], Cc[i]); const int Rb = Epi::PERM ? ((Rr[i] & ~31) + perm32(Rr[i] & 31)) : Rr[i];
        voffB[i] = (unsigned)Rb * S.ldb + (unsigned)Cc[i] * 2u; }
    const size_t hstepB = (size_t)HALF * S.ldb;
    const unsigned ldsw = (unsigned)wid * 1024u;
    const int aoff = lds_byte(wr * 64 + fr, fq * 8), boff = lds_byte(wc * 32 + fr, fq * 8);
#define PG8_SA(b, h) (((b) * 2 + (h)) * HTB)
#define PG8_SB(b, h) ((4 + (b) * 2 + (h)) * HTB)
#define PG8_STAGE(bufoff, gbase, v0, v1) do { \
        __builtin_amdgcn_global_load_lds((const unsigned*)((const char*)(gbase) + (v0)), (LAS unsigned*)(lds + (bufoff) + ldsw), 16, 0, 0); \
        __builtin_amdgcn_global_load_lds((const unsigned*)((const char*)(gbase) + (v1)), (LAS unsigned*)(lds + (bufoff) + ldsw + 8192), 16, 0, 0); } while (0)
#define PG8_LDA(dst, b, h) do { _Pragma("unroll") for (int m = 0; m < 4; ++m) _Pragma("unroll") for (int k = 0; k < 2; ++k) dst[m][k] = *(const LAS bf16x8*)(lds + PG8_SA(b, h) + aoff + m * 2048 + k * 1024); } while (0)
#define PG8_LDB(dst, b, h) do { _Pragma("unroll") for (int n = 0; n < 2; ++n) _Pragma("unroll") for (int k = 0; k < 2; ++k) dst[n][k] = *(const LAS bf16x8*)(lds + PG8_SB(b, h) + boff + n * 2048 + k * 1024); } while (0)
#define PG8_MMA(ai, bj, At, Bt) do { __builtin_amdgcn_s_setprio(1); _Pragma("unroll") for (int m = 0; m < 4; ++m) _Pragma("unroll") for (int n = 0; n < 2; ++n) _Pragma("unroll") for (int k = 0; k < 2; ++k) \
        acc[ai][bj][m][n] = __builtin_amdgcn_mfma_f32_16x16x32_bf16(Bt[n][k], At[m][k], acc[ai][bj][m][n], 0, 0, 0); __builtin_amdgcn_s_setprio(0); } while (0)
#define PG8_WAIT_V(n) asm volatile("s_waitcnt vmcnt(" #n ")" ::: "memory")
#define PG8_WAIT_L(n) asm volatile("s_waitcnt lgkmcnt(" #n ")" ::: "memory")
#define PG8_BAR __builtin_amdgcn_s_barrier()
#define PG8_SCHED __builtin_amdgcn_sched_barrier(0)
    Unit cur, nxt; int ui = 0;
    int aux_t = 0; asm volatile("" : "+s"(aux_t));
    if (!S.next(0, cur)) return;
    f32x4 acc[2][2][4][2];
#pragma unroll
    for (int a = 0; a < 2; ++a)
#pragma unroll
        for (int b = 0; b < 2; ++b)
#pragma unroll
            for (int m = 0; m < 4; ++m)
#pragma unroll
                for (int n = 0; n < 2; ++n) acc[a][b][m][n] = (f32x4){0.f, 0.f, 0.f, 0.f};
    bf16x8 At[4][2], B0[2][2], B1[2][2];
    if constexpr (Sched::GATHER) S.rows(cur, Rr, Cc, vA);
    else {
#pragma unroll
        for (int h = 0; h < 2; ++h)
#pragma unroll
            for (int i = 0; i < 2; ++i) vA[h * 2 + i] = (unsigned)(h * HALF + Rr[i]) * S.lda + (unsigned)Cc[i] * 2u;
    }
    {
        const char* a0 = pa(cur, 0); const char* b0 = pb(cur, 0); const char* a1 = pa(cur, 1); const char* b1 = pb(cur, 1);
        PG8_STAGE(PG8_SB(0, 0), b0, voffB[0], voffB[1]); PG8_STAGE(PG8_SA(0, 0), a0, vA[0], vA[1]); PG8_STAGE(PG8_SB(0, 1), b0 + hstepB, voffB[0], voffB[1]); PG8_STAGE(PG8_SA(0, 1), a0, vA[2], vA[3]);
        if (wr == 1) PG8_BAR;
        PG8_WAIT_V(4); PG8_BAR;
        PG8_STAGE(PG8_SB(1, 0), b1, voffB[0], voffB[1]); PG8_STAGE(PG8_SA(1, 0), a1, vA[0], vA[1]); PG8_STAGE(PG8_SB(1, 1), b1 + hstepB, voffB[0], voffB[1]);
        PG8_WAIT_V(6); PG8_BAR;
    }
    for (;;) {
        const bool has_next = S.next(ui + 1, nxt);
        if (!has_next) nxt = cur;
        for (int t = 0; t < nt; t += 2) {
            const bool last = (t == nt - 2);
            const char* a1 = pa(cur, t + 1);
            const char* a2; const char* b2;
            if (last) { a2 = pa(nxt, 0); b2 = pb(nxt, 0);
                if constexpr (Sched::GATHER) { if (has_next) S.rows(nxt, Rr, Cc, vA2); else {
#pragma unroll
                    for (int q = 0; q < 4; ++q) vA2[q] = vA[q]; } }
            } else { a2 = pa(cur, t + 2); b2 = pb(cur, t + 2);
                if constexpr (Sched::GATHER) {
#pragma unroll
                    for (int q = 0; q < 4; ++q) vA2[q] = vA[q]; }
            }
            if constexpr (!Sched::GATHER) {
#pragma unroll
                for (int q = 0; q < 4; ++q) vA2[q] = vA[q];
            }
            const char* a3 = a2 + 128; const char* b3 = b2 + 128;
            PG8_LDB(B0, 0, 0); PG8_SCHED; PG8_LDA(At, 0, 0); PG8_STAGE(PG8_SA(1, 1), a1, vA[2], vA[3]);
            PG8_WAIT_L(8); PG8_BAR; PG8_WAIT_L(0); PG8_MMA(0, 0, At, B0); PG8_BAR; PG8_SCHED;
            PG8_LDB(B1, 0, 1); PG8_STAGE(PG8_SB(0, 0), b2, voffB[0], voffB[1]);
            PG8_BAR; PG8_WAIT_L(0); PG8_MMA(0, 1, At, B1); PG8_BAR;
            PG8_LDA(At, 0, 1); PG8_STAGE(PG8_SA(0, 0), a2, vA2[0], vA2[1]);
            if constexpr (Sched::AUX) { if (t == aux_t) S.aux(cur, lds, wid, lane); }
            PG8_BAR; PG8_WAIT_L(0); PG8_MMA(1, 0, At, B0); PG8_BAR; PG8_SCHED;
            PG8_STAGE(PG8_SB(0, 1), b2 + hstepB, voffB[0], voffB[1]);
            PG8_WAIT_V(6); PG8_BAR; PG8_MMA(1, 1, At, B1); PG8_BAR;
            PG8_LDB(B0, 1, 0); PG8_SCHED; PG8_LDA(At, 1, 0); PG8_STAGE(PG8_SA(0, 1), a2, vA2[2], vA2[3]);
            PG8_WAIT_L(8); PG8_BAR; PG8_WAIT_L(0); PG8_MMA(0, 0, At, B0); PG8_BAR; PG8_SCHED;
            PG8_LDB(B1, 1, 1); PG8_STAGE(PG8_SB(1, 0), b3, voffB[0], voffB[1]);
            PG8_BAR; PG8_WAIT_L(0); PG8_MMA(0, 1, At, B1); PG8_BAR;
            PG8_LDA(At, 1, 1); PG8_STAGE(PG8_SA(1, 0), a3, vA2[0], vA2[1]);
            PG8_BAR; PG8_WAIT_L(0); PG8_MMA(1, 0, At, B0); PG8_BAR; PG8_SCHED;
            PG8_STAGE(PG8_SB(1, 1), b3 + hstepB, voffB[0], voffB[1]);
            PG8_WAIT_V(6); PG8_BAR; PG8_MMA(1, 1, At, B1); PG8_BAR;
        }
        if (wr == 0) PG8_BAR;
        E(acc, cur, wr, wc, fr, fq);
        if (!has_next) break;
#pragma unroll
        for (int a = 0; a < 2; ++a)
#pragma unroll
            for (int b = 0; b < 2; ++b)
#pragma unroll
                for (int m = 0; m < 4; ++m)
#pragma unroll
                    for (int n = 0; n < 2; ++n) acc[a][b][m][n] = (f32x4){0.f, 0.f, 0.f, 0.f};
        cur = nxt; ++ui;
        if constexpr (Sched::GATHER) {
#pragma unroll
            for (int q = 0; q < 4; ++q) vA[q] = vA2[q];
        }
        if (wr == 1) PG8_BAR;
    }
    PG8_WAIT_V(0);
    PG8_BAR;
#undef PG8_SA
#undef PG8_SB
#undef PG8_STAGE
#undef PG8_LDA
#undef PG8_LDB
#undef PG8_MMA
#undef PG8_WAIT_V
#undef PG8_WAIT_L
#undef PG8_BAR
#undef PG8_SCHED
}

DEV void static_tile(int L, int nM, int nN, int& pm, int& pn) {
    const int nwg = nM * nN; int wgid = L;
    { const int q = nwg / 8, r = nwg % 8, xcd = wgid % 8, off = wgid / 8; wgid = (xcd < r ? xcd * (q + 1) : r * (q + 1) + (xcd - r) * q) + off; }
    const int nig = 8 * nN, gid = wgid / nig, fm = gid * 8, gsz = (nM - fm) < 8 ? (nM - fm) : 8;
    pm = fm + ((wgid % nig) % gsz); pn = (wgid % nig) / gsz;
}
}
using pg8::Unit;

struct Args { const float* in[29]; float* out; unsigned char* ws; int ph_lo, ph_hi; };
static_assert(sizeof(Args) == 31 * 8 + 8, "Args has no padding");
enum { I_X = 0, I_C, I_CTX, I_CCTX, I_WMOD, I_BMOD, I_N1G, I_N2G, I_WIN, I_LRE, I_LIM, I_LOGDT, I_BRE, I_BIM, I_CRE, I_CIM, I_S5D, I_WGLU, I_BGLU, I_CONVW, I_WOUT,
       I_RGW, I_RGB, I_REW, I_REB, I_W1, I_W3, I_W2, I_FING };

struct Frame {
    LAS unsigned char* lds;
    int tid, lane, wave, G, bx, vcu;
    const float* in[29]; float* out; unsigned char* ws;
};
#define WSP(T, off) ((T*)(F.ws + (off)))

DEV void p0_mod_item(Frame& F, int item) {
    LAS float* st = (LAS float*)F.lds;
    LAS float* red = (LAS float*)(F.lds + 33 * 512 * 4);
    const float* c = F.in[I_C]; const float* cc = F.in[I_CCTX]; const float* wm = F.in[I_WMOD]; const float* bm = F.in[I_BMOD];
    float* mod = WSP(float, WS_MOD);
    const int col = F.tid & 31, kc = F.tid >> 5, j0 = item * 32;
    float acc[33];
#pragma unroll
    for (int n = 0; n < 33; ++n) acc[n] = 0.f;
    for (int half = 0; half < 2; ++half) {
        __syncthreads();
        for (int idx = F.tid; idx < 33 * 512; idx += 512) { const int n = idx >> 9, kk = idx & 511; const float v = (n < 32) ? c[n * DM + half * 512 + kk] : cc[half * 512 + kk]; st[idx] = siluf_(v); }
        __syncthreads();
        for (int kk = kc; kk < 512; kk += 16) {
            const float w = wm[(size_t)(half * 512 + kk) * NMOD + j0 + col];
#pragma unroll
            for (int n = 0; n < 33; ++n) acc[n] += st[n * 512 + kk] * w;
        }
    }
#pragma unroll
    for (int n = 0; n < 33; ++n) red[(kc * 33 + n) * 32 + col] = acc[n];
    __syncthreads();
    for (int idx = F.tid; idx < 33 * 32; idx += 512) { const int n = idx >> 5, cl = idx & 31; float s = bm[j0 + cl];
#pragma unroll
        for (int q = 0; q < 16; ++q) s += red[(q * 33 + n) * 32 + cl];
        mod[n * NMOD + j0 + cl] = s; }
    __syncthreads();
}
DEV void p0_transpose_item(const float* W, int N, int k0, int n0, bf16_t* dst, int ldk, LAS float* scr, int lane) {
#pragma unroll 8
    for (int i = 0; i < 32; ++i) { const int kk = 2 * i + (lane >> 5); scr[kk * 33 + (lane & 31)] = W[(size_t)(k0 + kk) * N + n0 + (lane & 31)]; }
    asm volatile("s_waitcnt lgkmcnt(0)" ::: "memory");
    const int cch = lane & 7;
#pragma unroll
    for (int j = 0; j < 4; ++j) { const int n = (lane >> 3) + 8 * j; const LAS float* s = scr + (8 * cch) * 33 + n;
        u32x4 o; o.x = cvt_pk_bf16(s[0 * 33], s[1 * 33]); o.y = cvt_pk_bf16(s[2 * 33], s[3 * 33]); o.z = cvt_pk_bf16(s[4 * 33], s[5 * 33]); o.w = cvt_pk_bf16(s[6 * 33], s[7 * 33]);
        *(u32x4*)(dst + (size_t)n * ldk + k0 + 8 * cch) = o; }
    asm volatile("s_waitcnt lgkmcnt(0)" ::: "memory");
}
DEV void sincos_rev(double rev, double& s, double& c) {
    const double fr = rev - __builtin_rint(rev);
    const double q = __builtin_rint(fr * 4.0);
    const double y = (fr - q * 0.25) * 6.283185307179586476925;
    const double y2 = y * y;
    const double sy = y * (1.0 + y2 * (-1.0 / 6 + y2 * (1.0 / 120 + y2 * (-1.0 / 5040 + y2 * (1.0 / 362880 + y2 * (-1.0 / 39916800 + y2 * (1.0 / 6227020800.0)))))));
    const double cy = 1.0 + y2 * (-0.5 + y2 * (1.0 / 24 + y2 * (-1.0 / 720 + y2 * (1.0 / 40320 + y2 * (-1.0 / 3628800 + y2 * (1.0 / 479001600.0 + y2 * (-1.0 / 87178291200.0)))))));
    const int qi = ((int)q) & 3;
    s = (qi == 0) ? sy : (qi == 1) ? cy : (qi == 2) ? -sy : -cy;
    c = (qi == 0) ? cy : (qi == 1) ? -sy : (qi == 2) ? -cy : sy;
}
DEV double exp_d(double x) {
    const double k = __builtin_rint(x * 1.4426950408889634074);
    const double r = x - k * 0.69314718055994530942;
    double p = 1.0 / 6227020800.0;
    p = p * r + 1.0 / 479001600.0; p = p * r + 1.0 / 39916800.0; p = p * r + 1.0 / 3628800.0; p = p * r + 1.0 / 362880.0; p = p * r + 1.0 / 40320.0; p = p * r + 1.0 / 5040.0;
    p = p * r + 1.0 / 720.0; p = p * r + 1.0 / 120.0; p = p * r + 1.0 / 24.0; p = p * r + 1.0 / 6.0; p = p * r + 0.5; p = p * r + 1.0; p = p * r + 1.0;
    const long long e = (long long)k + 1023;
    return p * __builtin_bit_cast(double, (unsigned long long)e << 52);
}
DEV void p0_phase(Frame& F) {
    for (int it = F.bx; it < NMOD / 32; it += F.G) p0_mod_item(F, it);
    __syncthreads();
    {
        LAS float* scr = (LAS float*)(F.lds + F.wave * 8448);
        bf16_t* Win = WSP(bf16_t, WS_WIN); bf16_t* Wout = WSP(bf16_t, WS_WOUT); bf16_t* Wglu = WSP(bf16_t, WS_WGLU); bf16_t* W13 = WSP(bf16_t, WS_W13); bf16_t* W2 = WSP(bf16_t, WS_W2);
        const int gw = F.vcu * 8 + F.wave, NGW = F.G * 8;
        constexpr int I_IN = 16 * 80, I_OUT = 16 * 32, I_GLU = 4 * 8, I_E = 16 * 256;
        for (int it = gw; it < I_IN + I_OUT + I_GLU + 3 * I_E; it += NGW) {
            int r = it;
            if (r < I_IN) { const int kb = r / 80, nb = r % 80, n0 = nb * 32; int drow;
                if (n0 < 1024) drow = n0;
                else if (n0 < 1792) { const int j = n0 - 1024; drow = 1024 + (j >> 7) * 256 + (j & 127); }
                else { const int j = n0 - 1792; drow = 1024 + (j >> 7) * 256 + 128 + (j & 127); }
                p0_transpose_item(F.in[I_WIN], 2560, kb * 64, n0, Win + (size_t)drow * 1024, 1024, scr, F.lane); continue; }
            r -= I_IN;
            if (r < I_OUT) { const int kb = r / 32, nb = r % 32; p0_transpose_item(F.in[I_WOUT], 1024, kb * 64, nb * 32, Wout + (size_t)(nb * 32) * 1024, 1024, scr, F.lane); continue; }
            r -= I_OUT;
            if (r < I_GLU) { const int kb = r / 8, nb = r % 8; p0_transpose_item(F.in[I_WGLU], 256, kb * 64, nb * 32, Wglu + (size_t)(nb * 32) * 256, 256, scr, F.lane); continue; }
            r -= I_GLU;
            if (r < 2 * I_E) { const int which = r / I_E; const int rr = r % I_E; const int e = rr >> 8, rem = rr & 255, kb = rem >> 4, nb = rem & 15, n0 = nb * 32;
                const int drow = (n0 >> 7) * 256 + which * 128 + (n0 & 127);
                p0_transpose_item(F.in[which ? I_W3 : I_W1] + (size_t)e * 1024 * 512, 512, kb * 64, n0, W13 + ((size_t)e * 1024 + drow) * 1024, 1024, scr, F.lane); continue; }
            r -= 2 * I_E;
            { const int e = r >> 8, rem = r & 255, kb = rem >> 5, nb = rem & 31;
                p0_transpose_item(F.in[I_W2] + (size_t)e * 512 * 1024, 1024, kb * 64, nb * 32, W2 + ((size_t)e * 1024 + nb * 32) * 512, 512, scr, F.lane); }
        }
    }
    {
        bf16_t* Wr = WSP(bf16_t, WS_WR);
        for (int idx = F.bx * 512 + F.tid; idx < 32 * 1024; idx += F.G * 512) { const int l = idx >> 10, k = idx & 1023;
            const float v = (l < 4) ? F.in[I_RGW][k * 4 + l] : (l < 20) ? F.in[I_REW][k * 16 + (l - 4)] : 0.f;
            Wr[idx] = (bf16_t)(cvt_pk_bf16(v, 0.f) & 0xffffu); }
    }
    {
        f32x2* APOW = WSP(f32x2, WS_APOW); f32x2* BBAR = WSP(f32x2, WS_BBAR);
        const int gt = F.bx * 512 + F.tid, NT = F.G * 512;
        for (int idx = gt; idx < 2 * 16 * 65 * 64; idx += NT) {
            const int p = idx & 63, j = (idx >> 6) % 65, dg = idx / (64 * 65);
            const double lre = F.in[I_LRE][dg * 64 + p], lim = F.in[I_LIM][dg * 64 + p], dt = exp_d((double)F.in[I_LOGDT][dg]);
            const double mag = exp_d(lre * dt * j); double s, c; sincos_rev(lim * dt * j * 0.15915494309189533577, s, c);
            APOW[idx] = (f32x2){(float)(mag * c), (float)(mag * s)};
        }
        for (int idx = gt; idx < 2 * 16 * 64 * 16; idx += NT) {
            const int dgp = idx >> 4, dg = dgp >> 6;
            const double lre = F.in[I_LRE][dgp], lim = F.in[I_LIM][dgp], dt = exp_d((double)F.in[I_LOGDT][dg]);
            const double mag = exp_d(lre * dt); double s, c; sincos_rev(lim * dt * 0.15915494309189533577, s, c);
            const double nr = mag * c - 1.0, ni = mag * s, d2 = lre * lre + lim * lim;
            const double qr = (nr * lre + ni * lim) / d2, qi = (ni * lre - nr * lim) / d2;
            const double br = F.in[I_BRE][idx], bi = F.in[I_BIM][idx];
            BBAR[idx] = (f32x2){(float)(qr * br - qi * bi), (float)(qr * bi + qi * br)};
        }
    }
}

DEV void p1_norm_rows(Frame& F) {
    const float* mod = WSP(float, WS_MOD); bf16_t* HX = WSP(bf16_t, WS_HX); const float* g = F.in[I_N1G];
    const int gw = F.vcu * 8 + F.wave, NGW = F.G * 8;
    constexpr int RPW = 36, RT = 4;
    for (int ch = gw; ch < (TOK + CTOK) / RPW; ch += NGW) {
        int ncur = -1; f32x4 gs[4], sh[4];
        f32x4 cur[RT][4], nxt[RT][4];
#define P1_LOAD(dst, i0) do { _Pragma("unroll") for (int r = 0; r < RT; ++r) { const int m_ = ch * RPW + (i0) + r; \
            const f32x4* xp_ = (const f32x4*)((m_ < TOK) ? F.in[I_X] + (size_t)m_ * DM : F.in[I_CTX] + (size_t)(m_ - TOK) * DM) + F.lane; \
            _Pragma("unroll") for (int j = 0; j < 4; ++j) dst[r][j] = xp_[64 * j]; } } while (0)
        P1_LOAD(cur, 0);
#pragma unroll 1
        for (int i = 0; i < RPW; i += RT) {
            if (i + RT < RPW) P1_LOAD(nxt, i + RT);
            float ss[RT];
#pragma unroll
            for (int r = 0; r < RT; ++r) { float a = 0.f;
#pragma unroll
                for (int j = 0; j < 4; ++j) a += (cur[r][j].x * cur[r][j].x + cur[r][j].y * cur[r][j].y) + (cur[r][j].z * cur[r][j].z + cur[r][j].w * cur[r][j].w);
                ss[r] = a; }
#pragma unroll
            for (int o = 1; o < 64; o <<= 1) {
#pragma unroll
                for (int r = 0; r < RT; ++r) ss[r] += __shfl_xor(ss[r], o); }
#pragma unroll
            for (int r = 0; r < RT; ++r) {
                const int m = ch * RPW + i + r; const int n = (m < TOK) ? (m >> 11) : 32;
                if (n != ncur) { ncur = n;
#pragma unroll
                    for (int j = 0; j < 4; ++j) { gs[j] = ((const f32x4*)g)[F.lane + 64 * j] * (1.0f + ((const f32x4*)(mod + n * NMOD + DM))[F.lane + 64 * j]); sh[j] = ((const f32x4*)(mod + n * NMOD))[F.lane + 64 * j]; } }
                u32x2* o8 = (u32x2*)(HX + (size_t)m * DM) + F.lane; const float rs = 1.0f / sqrtf(ss[r] * (1.f / DM) + RMS_EPS);
#pragma unroll
                for (int j = 0; j < 4; ++j) { const f32x4 y = (cur[r][j] * rs) * gs[j] + sh[j]; u32x2 w; w.x = cvt_pk_bf16(y.x, y.y); w.y = cvt_pk_bf16(y.z, y.w); o8[64 * j] = w; }
            }
#pragma unroll
            for (int r = 0; r < RT; ++r)
#pragma unroll
                for (int j = 0; j < 4; ++j) cur[r][j] = nxt[r][j];
        }
#undef P1_LOAD
    }
}
DEV void p1_phase(Frame& F) {
    const float* mod = WSP(float, WS_MOD);
    const int gw = F.vcu * 8 + F.wave, NGW = F.G * 8;
    p1_norm_rows(F);
    const int gt = F.bx * 512 + F.tid, NT = F.G * 512;
    const f32x2* APOW = WSP(f32x2, WS_APOW); const f32x2* BBAR = WSP(f32x2, WS_BBAR);
    {
        float* KT = WSP(float, WS_KTAB);
        for (int idx = gt; idx < 2 * 16 * 64 * 256; idx += NT) {
            const int hp = idx & 15, h = (idx >> 4) & 15, j = (idx >> 8) & 63, dg = idx >> 14;
            float s = 0.f;
            for (int p = 0; p < 64; ++p) {
                const float cr = F.in[I_CRE][(dg * 16 + h) * 64 + p], ci = F.in[I_CIM][(dg * 16 + h) * 64 + p];
                const f32x2 a = APOW[(dg * 65 + j) * 64 + p], b = BBAR[(dg * 64 + p) * 16 + hp];
                const float ur = cr * a.x - ci * a.y, ui = cr * a.y + ci * a.x;
                s += ur * b.x - ui * b.y;
            }
            KT[idx] = s;
        }
    }
    {
        bf16_t* WE = WSP(bf16_t, WS_WE);
        for (int idx = gt; idx < 16 * 256 * 128; idx += NT) {
            const int k8 = idx & 127, n = (idx >> 7) & 255, g = idx >> 15;
            const int part = n >> 6, p = n & 63, dir = part >> 1, k = k8 >> 1, h0 = (k8 & 1) * 8;
            const int dg = dir * 16 + g; const f32x2 a = APOW[(dg * 65 + (dir ? k : 63 - k)) * 64 + p];
            float v[8];
#pragma unroll
            for (int q = 0; q < 8; ++q) { const f32x2 b = BBAR[(dg * 64 + p) * 16 + h0 + q]; v[q] = (part & 1) ? (a.x * b.y + a.y * b.x) : (a.x * b.x - a.y * b.y); }
            u32x4 o; o.x = cvt_pk_bf16(v[0], v[1]); o.y = cvt_pk_bf16(v[2], v[3]); o.z = cvt_pk_bf16(v[4], v[5]); o.w = cvt_pk_bf16(v[6], v[7]);
            *(u32x4*)(WE + ((size_t)(g * 256 + n) * 1024 + k8 * 8)) = o;
        }
    }
    {
        bf16_t* SH2 = WSP(bf16_t, WS_SH2);
        for (int idx = gt; idx < 256 * 1024; idx += NT) { const int r = idx >> 10, k = idx & 1023; const float v = (r < 32) ? mod[r * NMOD + 3 * DM + k] : 0.f; SH2[idx] = (bf16_t)(cvt_pk_bf16(v, 0.f) & 0xffffu); }
    }
    {
        float* rb = WSP(float, WS_RB);
        for (int idx = gw; idx < 32 * 32; idx += NGW) { const int b = idx >> 5, l = idx & 31; float s = 0.f;
            if (l < 20) {
#pragma unroll 4
                for (int k = F.lane; k < DM; k += 64) s += mod[b * NMOD + 3 * DM + k] * ((l < 4) ? F.in[I_RGW][k * 4 + l] : F.in[I_REW][k * 16 + (l - 4)]);
                s = wave_sum(s) + ((l < 4) ? F.in[I_RGB][l] : F.in[I_REB][l - 4]); }
            if (F.lane == 0) rb[idx] = s; }
    }
}

DEV void p2_fill_tr(Frame& F) {
    const float* KT = WSP(float, WS_KTAB); const f32x2* APOW = WSP(f32x2, WS_APOW); bf16_t* TR = WSP(bf16_t, WS_TR);
    const int gt = F.bx * 512 + F.tid, NT = F.G * 512;
    for (int idx = gt; idx < 16 * 1024 * 160; idx += NT) {
        const int k8 = idx % 160, n = (idx / 160) & 1023, g = idx / (160 * 1024);
        const int t = n >> 4, h = n & 15;
        float v[8];
        if (k8 < 128) { const int k = k8 >> 1, h0 = (k8 & 1) * 8;
            if (t > k) { const float* s = KT + (((0 * 16 + g) * 64 + (t - k)) * 256 + h * 16 + h0);
#pragma unroll
                for (int q = 0; q < 8; ++q) v[q] = s[q]; }
            else if (k > t) { const float* s = KT + (((1 * 16 + g) * 64 + (k - t)) * 256 + h * 16 + h0);
#pragma unroll
                for (int q = 0; q < 8; ++q) v[q] = s[q]; }
            else { const float* s0 = KT + (((0 * 16 + g) * 64) * 256 + h * 16 + h0); const float* s1 = KT + (((1 * 16 + g) * 64) * 256 + h * 16 + h0); const float dd = F.in[I_S5D][g * 16 + h];
#pragma unroll
                for (int q = 0; q < 8; ++q) v[q] = s0[q] + s1[q] + ((h0 + q == h) ? dd : 0.f); }
        } else { const int s0 = (k8 - 128) * 8, part = s0 >> 6, p0 = s0 & 63, dir = part >> 1, dg = dir * 16 + g, j = dir ? (64 - t) : (t + 1);
#pragma unroll
            for (int q = 0; q < 8; ++q) { const int p = p0 + q; const float cr = F.in[I_CRE][(dg * 16 + h) * 64 + p], ci = F.in[I_CIM][(dg * 16 + h) * 64 + p]; const f32x2 a = APOW[(dg * 65 + j) * 64 + p];
                v[q] = (part & 1) ? -(cr * a.y + ci * a.x) : (cr * a.x - ci * a.y); }
        }
        u32x4 o; o.x = cvt_pk_bf16(v[0], v[1]); o.y = cvt_pk_bf16(v[2], v[3]); o.z = cvt_pk_bf16(v[4], v[5]); o.w = cvt_pk_bf16(v[6], v[7]);
        *(u32x4*)(TR + ((size_t)(g * 1024 + n) * UGK + k8 * 8)) = o;
    }
}
struct SchedIn {
    static constexpr bool GATHER = false, AUX = false;
    int nt; unsigned lda, ldb; int G, c; const char* HX; const char* W;
    DEV bool next(int i, Unit& u) const {
        const int L = i * G + c; if (L >= 2560 + 32) return false;
        int pm, pn, ctx = 0;
        if (L < 2560) pg8::static_tile(L, 256, 10, pm, pn); else { pm = 256 + (L - 2560); pn = 0; ctx = 1; }
        u.A0 = HX + (size_t)pm * 256 * 2048; u.A1 = u.A0; u.B0 = W + (size_t)pn * 256 * 2048; u.B1 = u.B0; u.ksA = 1 << 20; u.ksB = 1 << 20;
        u.p0 = pm; u.p1 = pn; u.p2 = ctx; u.p3 = 0; return true;
    }
    DEV void rows(const Unit&, const int*, const int*, unsigned*) const {}
    DEV void aux(const Unit&, LAS unsigned char*, int, int) const {}
};
struct EpiIn {
    static constexpr bool PERM = true;
    bf16_t* UG; bf16_t* BG; bf16_t* CV;
    DEV void operator()(const f32x4 (&acc)[2][2][4][2], const Unit& u, int wr, int wc, int fr, int fq) const {
        const int pm = u.p0, pn = u.p1;
#pragma unroll
        for (int ai = 0; ai < 2; ++ai)
#pragma unroll
            for (int m = 0; m < 4; ++m) {
                const int r = ai * 128 + wr * 64 + m * 16 + fr;
                if (pn == 0) {
                    const int mm = pm * 256 + r;
                    const int chunk = mm >> 6, k = mm & 63;
#pragma unroll
                    for (int bj = 0; bj < 2; ++bj) { const int c = bj * 128 + wc * 32 + 8 * fq, g = c >> 4, h0 = c & 15;
                        const f32x4 v0 = acc[ai][bj][m][0], v1 = acc[ai][bj][m][1];
                        u32x4 w; w.x = cvt_pk_bf16(v0[0], v0[1]); w.y = cvt_pk_bf16(v0[2], v0[3]); w.z = cvt_pk_bf16(v1[0], v1[1]); w.w = cvt_pk_bf16(v1[2], v1[3]);
                        *(u32x4*)(UG + ((size_t)(g * NCH_PAD + chunk) * UGK + k * 16 + h0)) = w; }
                } else if (pn < 4) {
                    bf16_t* rowp = BG + (size_t)(pm * 256 + r) * CONVW + (pn - 1) * 256 + wc * 32 + 8 * fq;
#pragma unroll
                    for (int bj = 0; bj < 2; ++bj) { const f32x4 v0 = acc[ai][bj][m][0], v1 = acc[ai][bj][m][1];
                        u32x4 w; w.x = cvt_pk_bf16(v0[0], v0[1]); w.y = cvt_pk_bf16(v0[2], v0[3]); w.z = cvt_pk_bf16(v1[0], v1[1]); w.w = cvt_pk_bf16(v1[2], v1[3]);
                        *(u32x4*)(rowp + bj * 128) = w; }
                } else {
                    const f32x4 v0 = acc[ai][0][m][0] * acc[ai][1][m][0], v1 = acc[ai][0][m][1] * acc[ai][1][m][1];
                    u32x4 w; w.x = cvt_pk_bf16(v0[0], v0[1]); w.y = cvt_pk_bf16(v0[2], v0[3]); w.z = cvt_pk_bf16(v1[0], v1[1]); w.w = cvt_pk_bf16(v1[2], v1[3]);
                    *(u32x4*)(CV + (size_t)(pm * 256 + r) * CONVW + (pn - 4) * 128 + wc * 32 + 8 * fq) = w;
                }
            }
    }
};

struct SchedE {
    static constexpr bool GATHER = false, AUX = false;
    int nt; unsigned lda, ldb; int c; const char* UG; const char* WE;
    DEV bool next(int i, Unit& u) const {
        if (i > 0 || c >= 80) return false;
        const int g = c / 5, pm = c % 5;
        u.A0 = UG + ((size_t)g * NCH_PAD + pm * 256) * UGK * 2; u.A1 = u.A0; u.B0 = WE + (size_t)g * 256 * 2048; u.B1 = u.B0; u.ksA = 1 << 20; u.ksB = 1 << 20;
        u.p0 = pm; u.p1 = g; u.p2 = 0; u.p3 = 0; return true;
    }
    DEV void rows(const Unit&, const int*, const int*, unsigned*) const {}
    DEV void aux(const Unit&, LAS unsigned char*, int, int) const {}
};
struct EpiE {
    static constexpr bool PERM = false;
    float* E;
    DEV void operator()(const f32x4 (&acc)[2][2][4][2], const Unit& u, int wr, int wc, int fr, int fq) const {
        float* base = E + ((size_t)u.p1 * NCH_PAD + u.p0 * 256) * 256;
#pragma unroll
        for (int ai = 0; ai < 2; ++ai)
#pragma unroll
            for (int m = 0; m < 4; ++m) { float* rowp = base + (size_t)(ai * 128 + wr * 64 + m * 16 + fr) * 256 + wc * 32 + 4 * fq;
#pragma unroll
                for (int bj = 0; bj < 2; ++bj)
#pragma unroll
                    for (int n = 0; n < 2; ++n) *(f32x4*)(rowp + bj * 128 + n * 16) = acc[ai][bj][m][n]; }
    }
};
struct SchedSB {
    static constexpr bool GATHER = false, AUX = false;
    int nt; unsigned lda, ldb; int c; const char* SH2; const char* W13;
    DEV bool next(int i, Unit& u) const {
        if (i > 0 || c < 0 || c >= 64) return false;
        const int e = c >> 2, ti = c & 3;
        u.A0 = SH2; u.A1 = u.A0; u.B0 = W13 + ((size_t)e * 1024 + ti * 256) * 2048; u.B1 = u.B0; u.ksA = 1 << 20; u.ksB = 1 << 20;
        u.p0 = e; u.p1 = ti; u.p2 = 0; u.p3 = 0; return true;
    }
    DEV void rows(const Unit&, const int*, const int*, unsigned*) const {}
    DEV void aux(const Unit&, LAS unsigned char*, int, int) const {}
};
struct EpiSB {
    static constexpr bool PERM = true;
    bf16_t* SB;
    DEV void operator()(const f32x4 (&acc)[2][2][4][2], const Unit& u, int wr, int wc, int fr, int fq) const {
        if (wr != 0) return;
#pragma unroll
        for (int m = 0; m < 2; ++m) { const int b = m * 16 + fr; bf16_t* rowp = SB + ((size_t)(b * 16 + u.p0) * 1024 + u.p1 * 256 + wc * 32 + 8 * fq);
#pragma unroll
            for (int bj = 0; bj < 2; ++bj) { const f32x4 v0 = acc[0][bj][m][0], v1 = acc[0][bj][m][1];
                u32x4 w; w.x = cvt_pk_bf16(v0[0], v0[1]); w.y = cvt_pk_bf16(v0[2], v0[3]); w.z = cvt_pk_bf16(v1[0], v1[1]); w.w = cvt_pk_bf16(v1[2], v1[3]);
                *(u32x4*)(rowp + bj * 128) = w; } }
    }
};

DEV void p4_phase(Frame& F) {
    const int gt = F.bx * 512 + F.tid, NT = F.G * 512;
    const float* E = WSP(float, WS_E); const f32x2* APOW = WSP(f32x2, WS_APOW); bf16_t* UG = WSP(bf16_t, WS_UG);
    for (int idx = gt; idx < NB * NG * 128; idx += NT) {
        const int p = idx & 63, dir = (idx >> 6) & 1, g = (idx >> 7) & 15, b = idx >> 11;
        const f32x2 a = APOW[((dir * 16 + g) * 65 + 64) * 64 + p];
        const float* Eg = E + (size_t)g * NCH_PAD * 256 + dir * 128 + p;
        bf16_t* Ug = UG + (size_t)g * NCH_PAD * UGK + 1024 + dir * 128 + p;
        float er[36], ei[36];
#pragma unroll
        for (int c = 0; c < 4; ++c) { const int ch = NCH_LAT + b * 4 + (dir ? 3 - c : c); er[c] = Eg[(size_t)ch * 256]; ei[c] = Eg[(size_t)ch * 256 + 64]; }
#pragma unroll
        for (int c = 0; c < 32; ++c) { const int ch = b * 32 + (dir ? 31 - c : c); er[4 + c] = Eg[(size_t)ch * 256]; ei[4 + c] = Eg[(size_t)ch * 256 + 64]; }
        float sr = 0.f, si = 0.f;
#pragma unroll
        for (int c = 0; c < 4; ++c) { const float nr = a.x * sr - a.y * si + er[c], ni = a.x * si + a.y * sr + ei[c]; sr = nr; si = ni; }
#pragma unroll
        for (int c = 0; c < 32; ++c) { const int ch = b * 32 + (dir ? 31 - c : c);
            Ug[(size_t)ch * UGK] = (bf16_t)(cvt_pk_bf16(sr, 0.f) & 0xffffu); Ug[(size_t)ch * UGK + 64] = (bf16_t)(cvt_pk_bf16(si, 0.f) & 0xffffu);
            const float nr = a.x * sr - a.y * si + er[4 + c], ni = a.x * si + a.y * sr + ei[4 + c]; sr = nr; si = ni; }
    }
}
DEV void conv_items(Frame& F, int vt, int NVT) {
    const bf16_t* BG = WSP(bf16_t, WS_BG); const bf16_t* CV = WSP(bf16_t, WS_CV); bf16_t* YM = WSP(bf16_t, WS_YMIX); const float* cw = F.in[I_CONVW];
    constexpr int NI = 4;
    for (int idx0 = vt; idx0 < TOK * 96; idx0 += NI * NVT) {
        u32x4 c0[NI], c1[NI], c2[NI], bb[NI];
#pragma unroll
        for (int q = 0; q < NI; ++q) { const int idx = idx0 + q * NVT; const bool ok = idx < TOK * 96; const int j8 = idx % 96, m = ok ? idx / 96 : 0, j0 = j8 * 8;
            const bool rowp = j0 < 384; const int d = rowp ? 1 : 64;
            const bool hasl = ok && (rowp ? ((m & 63) > 0) : (((m >> 6) & 31) > 0)), hasr = ok && (rowp ? ((m & 63) < 63) : (((m >> 6) & 31) < 31));
            const u32x4 z = (u32x4){0u, 0u, 0u, 0u};
            c0[q] = hasl ? *(const u32x4*)(CV + (size_t)(m - d) * CONVW + j0) : z;
            c1[q] = *(const u32x4*)(CV + (size_t)m * CONVW + j0);
            c2[q] = hasr ? *(const u32x4*)(CV + (size_t)(m + d) * CONVW + j0) : z;
            bb[q] = *(const u32x4*)(BG + (size_t)m * CONVW + j0); }
#pragma unroll
        for (int q = 0; q < NI; ++q) { const int idx = idx0 + q * NVT; if (idx < TOK * 96) { const int j8 = idx % 96, m = idx / 96, j0 = j8 * 8;
            const f32x4 w0a = *(const f32x4*)(cw + j0), w0b = *(const f32x4*)(cw + j0 + 4), w1a = *(const f32x4*)(cw + CONVW + j0), w1b = *(const f32x4*)(cw + CONVW + j0 + 4), w2a = *(const f32x4*)(cw + 2 * CONVW + j0), w2b = *(const f32x4*)(cw + 2 * CONVW + j0 + 4);
            float o[8];
            o[0] = bflo(bb[q].x) * (bflo(c0[q].x) * w0a[0] + bflo(c1[q].x) * w1a[0] + bflo(c2[q].x) * w2a[0]); o[1] = bfhi(bb[q].x) * (bfhi(c0[q].x) * w0a[1] + bfhi(c1[q].x) * w1a[1] + bfhi(c2[q].x) * w2a[1]);
            o[2] = bflo(bb[q].y) * (bflo(c0[q].y) * w0a[2] + bflo(c1[q].y) * w1a[2] + bflo(c2[q].y) * w2a[2]); o[3] = bfhi(bb[q].y) * (bfhi(c0[q].y) * w0a[3] + bfhi(c1[q].y) * w1a[3] + bfhi(c2[q].y) * w2a[3]);
            o[4] = bflo(bb[q].z) * (bflo(c0[q].z) * w0b[0] + bflo(c1[q].z) * w1b[0] + bflo(c2[q].z) * w2b[0]); o[5] = bfhi(bb[q].z) * (bfhi(c0[q].z) * w0b[1] + bfhi(c1[q].z) * w1b[1] + bfhi(c2[q].z) * w2b[1]);
            o[6] = bflo(bb[q].w) * (bflo(c0[q].w) * w0b[2] + bflo(c1[q].w) * w1b[2] + bflo(c2[q].w) * w2b[2]); o[7] = bfhi(bb[q].w) * (bfhi(c0[q].w) * w0b[3] + bfhi(c1[q].w) * w1b[3] + bfhi(c2[q].w) * w2b[3]);
            u32x4 w; w.x = cvt_pk_bf16(o[0], o[1]); w.y = cvt_pk_bf16(o[2], o[3]); w.z = cvt_pk_bf16(o[4], o[5]); w.w = cvt_pk_bf16(o[6], o[7]);
            *(u32x4*)(YM + (size_t)m * DM + 256 + j0) = w; } }
    }
}

struct SchedY {
    static constexpr bool GATHER = false, AUX = false;
    int nt; unsigned lda, ldb; int c; const char* UG; const char* TR;
    DEV bool next(int i, Unit& u) const {
        if (i > 0 || c >= 256) return false;
        const int g = c >> 4, pm = (c >> 2) & 3, pn = c & 3;
        u.A0 = UG + ((size_t)g * NCH_PAD + pm * 256) * UGK * 2; u.A1 = u.A0; u.B0 = TR + ((size_t)g * 1024 + pn * 256) * UGK * 2; u.B1 = u.B0; u.ksA = 1 << 20; u.ksB = 1 << 20;
        u.p0 = pm; u.p1 = pn; u.p2 = g; u.p3 = 0; return true;
    }
    DEV void rows(const Unit&, const int*, const int*, unsigned*) const {}
    DEV void aux(const Unit&, LAS unsigned char*, int, int) const {}
};
struct EpiY {
    static constexpr bool PERM = true;
    bf16_t* Gb;
    DEV void operator()(const f32x4 (&acc)[2][2][4][2], const Unit& u, int wr, int wc, int fr, int fq) const {
#pragma unroll
        for (int ai = 0; ai < 2; ++ai)
#pragma unroll
            for (int m = 0; m < 4; ++m) { const int chunk = u.p0 * 256 + ai * 128 + wr * 64 + m * 16 + fr;
#pragma unroll
                for (int bj = 0; bj < 2; ++bj) { const int n = u.p1 * 256 + bj * 128 + wc * 32 + 8 * fq, t = n >> 4, h0 = n & 15;
                    const f32x4 v0 = acc[ai][bj][m][0], v1 = acc[ai][bj][m][1];
                    u32x4 w; w.x = cvt_pk_bf16(gelu_tanh(v0[0]), gelu_tanh(v0[1])); w.y = cvt_pk_bf16(gelu_tanh(v0[2]), gelu_tanh(v0[3]));
                    w.z = cvt_pk_bf16(gelu_tanh(v1[0]), gelu_tanh(v1[1])); w.w = cvt_pk_bf16(gelu_tanh(v1[2]), gelu_tanh(v1[3]));
                    *(u32x4*)(Gb + ((size_t)(chunk * 64 + t) * 256 + u.p2 * 16 + h0)) = w; } }
    }
};

struct SchedGlu {
    static constexpr bool GATHER = false, AUX = false;
    int nt; unsigned lda, ldb; int G, c; const char* Gb; const char* W;
    DEV bool next(int i, Unit& u) const {
        const int L = i * G + c; if (L >= 256) return false;
        u.A0 = Gb + (size_t)L * 256 * 512; u.A1 = u.A0; u.B0 = W; u.B1 = u.B0; u.ksA = 1 << 20; u.ksB = 1 << 20; u.p0 = L; u.p1 = 0; u.p2 = 0; u.p3 = 0; return true;
    }
    DEV void rows(const Unit&, const int*, const int*, unsigned*) const {}
    DEV void aux(const Unit&, LAS unsigned char*, int, int) const {}
};
struct EpiGlu {
    static constexpr bool PERM = true;
    const bf16_t* Gb; bf16_t* YM; const float* bglu;
    DEV void operator()(const f32x4 (&acc)[2][2][4][2], const Unit& u, int wr, int wc, int fr, int fq) const {
        u32x4 gq[2][4][2];
#pragma unroll
        for (int ai = 0; ai < 2; ++ai)
#pragma unroll
            for (int m = 0; m < 4; ++m)
#pragma unroll
                for (int bj = 0; bj < 2; ++bj) gq[ai][m][bj] = *(const u32x4*)(Gb + (size_t)(u.p0 * 256 + ai * 128 + wr * 64 + m * 16 + fr) * 256 + bj * 128 + wc * 32 + 8 * fq);
        f32x4 bq[2][2];
#pragma unroll
        for (int bj = 0; bj < 2; ++bj) { bq[bj][0] = *(const f32x4*)(bglu + bj * 128 + wc * 32 + 8 * fq); bq[bj][1] = *(const f32x4*)(bglu + bj * 128 + wc * 32 + 8 * fq + 4); }
        asm volatile("" ::: "memory");
#pragma unroll
        for (int ai = 0; ai < 2; ++ai)
#pragma unroll
            for (int m = 0; m < 4; ++m) { const int row = u.p0 * 256 + ai * 128 + wr * 64 + m * 16 + fr;
#pragma unroll
                for (int bj = 0; bj < 2; ++bj) { const int c = bj * 128 + wc * 32 + 8 * fq;
                    const u32x4 gv = gq[ai][m][bj];
                    const f32x4 z0 = acc[ai][bj][m][0] + bq[bj][0], z1 = acc[ai][bj][m][1] + bq[bj][1];
                    u32x4 w; w.x = cvt_pk_bf16(bflo(gv.x) * sigmoidf_(z0[0]), bfhi(gv.x) * sigmoidf_(z0[1])); w.y = cvt_pk_bf16(bflo(gv.y) * sigmoidf_(z0[2]), bfhi(gv.y) * sigmoidf_(z0[3]));
                    w.z = cvt_pk_bf16(bflo(gv.z) * sigmoidf_(z1[0]), bfhi(gv.z) * sigmoidf_(z1[1])); w.w = cvt_pk_bf16(bflo(gv.w) * sigmoidf_(z1[2]), bfhi(gv.w) * sigmoidf_(z1[3]));
                    *(u32x4*)(YM + (size_t)row * DM + c) = w; } }
    }
};

struct SchedOut {
    static constexpr bool GATHER = false, AUX = false;
    int nt; unsigned lda, ldb; int G, c; const char* A; const char* W;
    DEV bool next(int i, Unit& u) const {
        const int L = i * G + c; if (L >= 1024) return false;
        int pm, pn; pg8::static_tile(L, 256, 4, pm, pn);
        u.A0 = A + (size_t)pm * 256 * 2048; u.A1 = u.A0; u.B0 = W + (size_t)pn * 256 * 2048; u.B1 = u.B0; u.ksA = 1 << 20; u.ksB = 1 << 20; u.p0 = pm; u.p1 = pn; u.p2 = 0; u.p3 = 0; return true;
    }
    DEV void rows(const Unit&, const int*, const int*, unsigned*) const {}
    DEV void aux(const Unit&, LAS unsigned char*, int, int) const {}
};
struct EpiYX {
    static constexpr bool PERM = true;
    bf16_t* YX;
    DEV void operator()(const f32x4 (&acc)[2][2][4][2], const Unit& u, int wr, int wc, int fr, int fq) const {
#pragma unroll
        for (int ai = 0; ai < 2; ++ai)
#pragma unroll
            for (int m = 0; m < 4; ++m) { bf16_t* rowp = YX + (size_t)(u.p0 * 256 + ai * 128 + wr * 64 + m * 16 + fr) * DM + u.p1 * 256 + wc * 32 + 8 * fq;
#pragma unroll
                for (int bj = 0; bj < 2; ++bj) { const f32x4 v0 = acc[ai][bj][m][0], v1 = acc[ai][bj][m][1];
                    u32x4 w; w.x = cvt_pk_bf16(v0[0], v0[1]); w.y = cvt_pk_bf16(v0[2], v0[3]); w.z = cvt_pk_bf16(v1[0], v1[1]); w.w = cvt_pk_bf16(v1[2], v1[3]);
                    *(u32x4*)(rowp + bj * 128) = w; } }
    }
};

constexpr int P8_WR_STRIDE = 2064;
constexpr int P8_GT_OFF = 32 * P8_WR_STRIDE, P8_GS_OFF = P8_GT_OFF + 4096, P8_HIST_OFF = P8_GS_OFF + 4096;
DEV void p8_phase(Frame& F) {
    const float* X = F.in[I_X]; const bf16_t* YX = WSP(bf16_t, WS_YX); bf16_t* X1B = WSP(bf16_t, WS_X1B); bf16_t* X1G = WSP(bf16_t, WS_X1G);
    const bf16_t* Wr = WSP(bf16_t, WS_WR); const float* rb = WSP(float, WS_RB); const float* mod = WSP(float, WS_MOD); const float* n2g = F.in[I_N2G];
    int* tokb = WSP(int, WS_TOKB); float* tokw = WSP(float, WS_TOKW); float* tokr = WSP(float, WS_TOKR); int* segc = WSP(int, WS_SEGC);
    LAS int* hist = (LAS int*)(F.lds + P8_HIST_OFF);
    LAS float* gt = (LAS float*)(F.lds + P8_GT_OFF); LAS float* gsl = (LAS float*)(F.lds + P8_GS_OFF);
    const int l15 = F.lane & 15, q = F.lane >> 4;
    for (int idx = F.tid; idx < 32 * 128; idx += 512) { const int r = idx >> 7, c16 = idx & 127; *(LAS u32x4*)(F.lds + r * P8_WR_STRIDE + c16 * 16) = *(const u32x4*)(Wr + (size_t)r * DM + c16 * 8); }
    for (int seg = F.bx; seg < TOK / 256; seg += F.G) {
        const int b = seg >> 3;
        __syncthreads();
        if (F.tid < 32) hist[F.tid] = 0;
        for (int k = F.tid; k < DM; k += 512) { gt[k] = mod[b * NMOD + 2 * DM + k]; gsl[k] = n2g[k] * (1.0f + mod[b * NMOD + 4 * DM + k]); }
        __syncthreads();
        const int tok0 = seg * 256 + F.wave * 32;
#pragma unroll 1
        for (int rg = 0; rg < 2; ++rg) {
            const int tok = tok0 + rg * 16 + l15;
            const float* xp = X + (size_t)tok * DM + 8 * q; const bf16_t* yp = YX + (size_t)tok * DM + 8 * q;
            bf16_t* o1 = X1B + (size_t)tok * DM + 8 * q; bf16_t* og = X1G + (size_t)tok * DM + 8 * q;
            const LAS unsigned char* wl = F.lds + l15 * P8_WR_STRIDE + q * 16;
            f32x4 acc0 = (f32x4){0.f, 0.f, 0.f, 0.f}, acc1 = acc0; float sq = 0.f;
            f32x4 xc[4][2], xn[4][2]; u32x4 yc[4], yn[4];
#define P8_LOAD(xd, yd, k0) do { _Pragma("unroll") for (int u_ = 0; u_ < 4; ++u_) { xd[u_][0] = *(const f32x4*)(xp + ((k0) + u_) * 32); xd[u_][1] = *(const f32x4*)(xp + ((k0) + u_) * 32 + 4); yd[u_] = *(const u32x4*)(yp + ((k0) + u_) * 32); } } while (0)
            P8_LOAD(xc, yc, 0);
#pragma unroll 1
            for (int k4 = 0; k4 < 32; k4 += 4) {
                if (k4 + 4 < 32) P8_LOAD(xn, yn, k4 + 4);
#pragma unroll
                for (int u_ = 0; u_ < 4; ++u_) { const int ks = k4 + u_;
                    const f32x4 xa = xc[u_][0], xb = xc[u_][1]; const u32x4 yv = yc[u_];
                    const f32x4 g0 = *(const LAS f32x4*)(gt + ks * 32 + 8 * q), g1 = *(const LAS f32x4*)(gt + ks * 32 + 8 * q + 4);
                    const f32x4 s0 = *(const LAS f32x4*)(gsl + ks * 32 + 8 * q), s1 = *(const LAS f32x4*)(gsl + ks * 32 + 8 * q + 4);
                    f32x4 va, vb;
                    va[0] = xa[0] + g0[0] * bflo(yv.x); va[1] = xa[1] + g0[1] * bfhi(yv.x); va[2] = xa[2] + g0[2] * bflo(yv.y); va[3] = xa[3] + g0[3] * bfhi(yv.y);
                    vb[0] = xb[0] + g1[0] * bflo(yv.z); vb[1] = xb[1] + g1[1] * bfhi(yv.z); vb[2] = xb[2] + g1[2] * bflo(yv.w); vb[3] = xb[3] + g1[3] * bfhi(yv.w);
                    sq += ((va[0] * va[0] + va[1] * va[1]) + (va[2] * va[2] + va[3] * va[3])) + ((vb[0] * vb[0] + vb[1] * vb[1]) + (vb[2] * vb[2] + vb[3] * vb[3]));
                    u32x4 w1; w1.x = cvt_pk_bf16(va[0], va[1]); w1.y = cvt_pk_bf16(va[2], va[3]); w1.z = cvt_pk_bf16(vb[0], vb[1]); w1.w = cvt_pk_bf16(vb[2], vb[3]);
                    *(u32x4*)(o1 + ks * 32) = w1;
                    const f32x4 ga = va * s0, gb = vb * s1;
                    u32x4 wg; wg.x = cvt_pk_bf16(ga[0], ga[1]); wg.y = cvt_pk_bf16(ga[2], ga[3]); wg.z = cvt_pk_bf16(gb[0], gb[1]); wg.w = cvt_pk_bf16(gb[2], gb[3]);
                    *(u32x4*)(og + ks * 32) = wg;
                    const bf16x8 xf = __builtin_bit_cast(bf16x8, wg);
                    const bf16x8 wa = *(const LAS bf16x8*)(wl + ks * 64), wb = *(const LAS bf16x8*)(wl + 16 * P8_WR_STRIDE + ks * 64);
                    acc0 = __builtin_amdgcn_mfma_f32_16x16x32_bf16(wa, xf, acc0, 0, 0, 0); acc1 = __builtin_amdgcn_mfma_f32_16x16x32_bf16(wb, xf, acc1, 0, 0, 0);
                }
#pragma unroll
                for (int u_ = 0; u_ < 4; ++u_) { xc[u_][0] = xn[u_][0]; xc[u_][1] = xn[u_][1]; yc[u_] = yn[u_]; }
            }
#undef P8_LOAD
            sq += __shfl_xor(sq, 16); sq += __shfl_xor(sq, 32);
            const float rstd = 1.0f / sqrtf(sq * (1.f / DM) + RMS_EPS);
            float lg[4], l2[4], gl[4], t1[4], t2[4], v[4];
#pragma unroll
            for (int r = 0; r < 4; ++r) { lg[r] = rstd * acc0[r] + rb[b * 32 + 4 * q + r]; l2[r] = rstd * acc1[r] + rb[b * 32 + 16 + ((4 * q + r) & 15)]; }
#pragma unroll
            for (int r = 0; r < 4; ++r) gl[r] = __shfl(lg[r], l15);
            int gi = 0; float gm = gl[0];
#pragma unroll
            for (int r = 1; r < 4; ++r) if (gl[r] > gm) { gm = gl[r]; gi = r; }
            float den = 0.f;
#pragma unroll
            for (int r = 0; r < 4; ++r) den += __expf(gl[r] - gm);
            const float gp = 1.0f / den;
            const int src = l15 + 16 * ((gi + 1) & 3);
#pragma unroll
            for (int r = 0; r < 4; ++r) { t1[r] = __shfl(lg[r], src); t2[r] = __shfl(l2[r], l15); v[r] = (gi == 3) ? t2[r] : t1[r]; }
            int i1 = 0; float v1 = v[0];
#pragma unroll
            for (int r = 1; r < 4; ++r) if (v[r] > v1) { v1 = v[r]; i1 = r; }
            int i2 = -1; float v2 = 0.f;
#pragma unroll
            for (int r = 0; r < 4; ++r) if (r != i1 && (i2 < 0 || v[r] > v2)) { v2 = v[r]; i2 = r; }
            const float ex = __expf(v2 - v1), p1 = 1.0f / (1.0f + ex), p2 = ex * p1;
            const int lo = i1 < i2 ? i1 : i2, hi = i1 < i2 ? i2 : i1;
            const float wlo = (i1 < i2 ? p1 : p2) * gp, whi = (i1 < i2 ? p2 : p1) * gp;
            const int pidx = (lo == 0) ? (hi - 1) : (lo == 1) ? (hi + 1) : 5;
            const int bucket = gi * 6 + pidx;
            if (q == 0) { tokb[tok] = bucket; tokw[tok * 2] = wlo; tokw[tok * 2 + 1] = whi; tokr[tok] = rstd; atomicAdd((int*)hist + bucket, 1); }
        }
        __syncthreads();
        if (F.tid < 32) segc[seg * 32 + F.tid] = (F.tid < NBUCKET) ? hist[F.tid] : 0;
    }
    __syncthreads();
}

DEV void p9_phase(Frame& F) {
    const int* segc = WSP(int, WS_SEGC); const int* tokb = WSP(int, WS_TOKB); int* perm = WSP(int, WS_PERM); int* tiles = WSP(int, WS_TILES);
    const float* tokw = WSP(float, WS_TOKW); const float* tokr = WSP(float, WS_TOKR); u32x4* slotrec = WSP(u32x4, WS_SLOT);
    LAS int* tot = (LAS int*)F.lds;
    LAS int* tst = tot + 32;
    LAS int* base = tst + 32;
    LAS int* wcnt = base + 32;
    for (int seg = F.bx; seg < TOK / 256; seg += F.G) {
        __syncthreads();
        if (F.tid < 32) { int t = 0, bs = 0; if (F.tid < NBUCKET) for (int s = 0; s < 256; ++s) { const int c = ld_agent_i(segc + s * 32 + F.tid); if (s < seg) bs += c; t += c; } tot[F.tid] = t; base[F.tid] = bs; }
        if (F.tid < 128) wcnt[F.tid] = 0;
        __syncthreads();
        if (F.tid == 0) { int ts = 0; for (int k = 0; k < NBUCKET; ++k) { tst[k] = ts; ts += (tot[k] + 255) >> 8; } tst[NBUCKET] = ts; }
        __syncthreads();
        int bk = -1, rank = 0;
        if (F.tid < 256) {
            bk = tokb[seg * 256 + F.tid];
            for (int k = 0; k < NBUCKET; ++k) { const unsigned long long msk = __ballot(bk == k); if (bk == k) rank = __popcll(msk & ((1ull << F.lane) - 1ull)); if (F.lane == 0) wcnt[F.wave * 32 + k] = __popcll(msk); }
        }
        __syncthreads();
        if (F.tid < 256) { int off = 0; for (int w = 0; w < F.wave; ++w) off += wcnt[w * 32 + bk]; const int tok = seg * 256 + F.tid, slot = tst[bk] * 256 + base[bk] + off + rank;
            perm[slot] = tok; slotrec[slot] = (u32x4){(unsigned)tok, __float_as_uint(tokr[tok]), __float_as_uint(tokw[tok * 2]), __float_as_uint(tokw[tok * 2 + 1])}; }
        if (seg < NBUCKET) { const int k = seg, n = tot[k], np = ((n + 255) >> 8) << 8; for (int r = n + F.tid; r < np; r += 512) { perm[tst[k] * 256 + r] = -1; slotrec[tst[k] * 256 + r] = (u32x4){0xffffffffu, 0u, 0u, 0u}; } }
        if (seg == 0) { if (F.tid == 0) tiles[0] = tst[NBUCKET];
            if (F.tid < NBUCKET) { const int k = F.tid, nt_ = (tot[k] + 255) >> 8; for (int t = 0; t < nt_; ++t) tiles[16 + tst[k] + t] = k; } }
    }
}
DEV void bucket_experts(int bk, int& e0, int& e1) { const int grp = bk / 6, pi = bk % 6; const int lo = pi < 3 ? 0 : (pi < 5 ? 1 : 2), hi = pi < 3 ? pi + 1 : (pi < 5 ? pi - 1 : 3); e0 = grp * 4 + lo; e1 = grp * 4 + hi; }

constexpr int AUX_SLOT_OFF = 131072, AUX_BIAS_OFF = 131072 + 4096;
DEV void glds16(const void* g, LAS unsigned char* l) { __builtin_amdgcn_global_load_lds((const unsigned*)g, (LAS unsigned*)l, 16, 0, 0); }

struct SchedUp {
    static constexpr bool GATHER = true, AUX = true;
    int nt; unsigned lda, ldb; int G, c, ntiles; const char* X1G; const char* W13; const int* perm; const int* tiles; const char* slotrec; const char* sb13;
    DEV bool next(int i, Unit& u) const {
        const int L = i * G + c; if (L >= ntiles * 8) return false;
        const int tile = L >> 3, s = (L >> 2) & 1, ti = L & 3; int e0, e1; bucket_experts(ld_agent_i(tiles + 16 + tile), e0, e1); const int e = s ? e1 : e0;
        u.A0 = X1G; u.A1 = X1G; u.B0 = W13 + ((size_t)e * 1024 + ti * 256) * 2048; u.B1 = u.B0; u.ksA = 1 << 20; u.ksB = 1 << 20; u.p0 = tile; u.p1 = s; u.p2 = ti; u.p3 = e; return true;
    }
    DEV void rows(const Unit& u, const int* R, const int* C, unsigned* v) const {
#pragma unroll
        for (int h = 0; h < 2; ++h)
#pragma unroll
            for (int i = 0; i < 2; ++i) { int t = perm[u.p0 * 256 + h * 128 + R[i]]; t = t < 0 ? 0 : t; v[h * 2 + i] = (unsigned)t * 2048u + (unsigned)C[i] * 2u; }
    }
    DEV void aux(const Unit& u, LAS unsigned char* lds, int wid, int lane) const {
        if (wid < 4) glds16(slotrec + (size_t)u.p0 * 4096 + wid * 1024 + lane * 16, lds + AUX_SLOT_OFF + wid * 1024);
#pragma unroll
        for (int i = 0; i < 2; ++i) { const int p = wid * 2 + i, b = 2 * p + (lane >> 5);
            glds16(sb13 + ((size_t)(b * 16 + u.p3) * 1024 + u.p2 * 256) * 2 + (lane & 31) * 16, lds + AUX_BIAS_OFF + p * 1024); }
    }
};
struct EpiUp {
    static constexpr bool PERM = true;
    bf16_t* HID; LAS unsigned char* lds;
    DEV void operator()(const f32x4 (&acc)[2][2][4][2], const Unit& u, int wr, int wc, int fr, int fq) const {
#pragma unroll
        for (int ai = 0; ai < 2; ++ai)
#pragma unroll
            for (int m = 0; m < 4; ++m) { const int r = ai * 128 + wr * 64 + m * 16 + fr, slot = u.p0 * 256 + r;
                const u32x4 rec = *(const LAS u32x4*)(lds + AUX_SLOT_OFF + r * 16);
                const bool valid = (int)rec.x >= 0; const int tk = valid ? (int)rec.x : 0; const float rstd = __uint_as_float(rec.y), w = u.p1 ? __uint_as_float(rec.w) : __uint_as_float(rec.z);
                const LAS unsigned char* bp = lds + AUX_BIAS_OFF + (tk >> 11) * 512 + (wc * 32 + 8 * fq) * 2;
                const u32x4 b1 = *(const LAS u32x4*)bp, b3 = *(const LAS u32x4*)(bp + 256);
                const f32x4 a10 = acc[ai][0][m][0] * rstd, a11 = acc[ai][0][m][1] * rstd, a30 = acc[ai][1][m][0] * rstd, a31 = acc[ai][1][m][1] * rstd;
                float o[8];
                o[0] = w * siluf_(a10[0] + bflo(b1.x)) * (a30[0] + bflo(b3.x)); o[1] = w * siluf_(a10[1] + bfhi(b1.x)) * (a30[1] + bfhi(b3.x));
                o[2] = w * siluf_(a10[2] + bflo(b1.y)) * (a30[2] + bflo(b3.y)); o[3] = w * siluf_(a10[3] + bfhi(b1.y)) * (a30[3] + bfhi(b3.y));
                o[4] = w * siluf_(a11[0] + bflo(b1.z)) * (a31[0] + bflo(b3.z)); o[5] = w * siluf_(a11[1] + bfhi(b1.z)) * (a31[1] + bfhi(b3.z));
                o[6] = w * siluf_(a11[2] + bflo(b1.w)) * (a31[2] + bflo(b3.w)); o[7] = w * siluf_(a11[3] + bfhi(b1.w)) * (a31[3] + bfhi(b3.w));
                u32x4 wv; wv.x = cvt_pk_bf16(o[0], o[1]); wv.y = cvt_pk_bf16(o[2], o[3]); wv.z = cvt_pk_bf16(o[4], o[5]); wv.w = cvt_pk_bf16(o[6], o[7]);
                *(u32x4*)(HID + ((size_t)slot * 1024 + u.p1 * 512 + u.p2 * 128 + wc * 32 + 8 * fq)) = wv; }
    }
};

struct SchedDown {
    static constexpr bool GATHER = false, AUX = true;
    int nt; unsigned lda, ldb; int G, c, ntiles; const char* HID; const char* W2; const int* tiles; const char* slotrec;
    DEV bool next(int i, Unit& u) const {
        const int L = i * G + c; if (L >= ntiles * 4) return false;
        const int tile = L >> 2, pn = L & 3; int e0, e1; bucket_experts(ld_agent_i(tiles + 16 + tile), e0, e1);
        u.A0 = HID + (size_t)tile * 256 * 2048; u.A1 = u.A0; u.ksA = 1 << 20;
        u.B0 = W2 + ((size_t)e0 * 1024 + pn * 256) * 1024; u.B1 = W2 + ((size_t)e1 * 1024 + pn * 256) * 1024; u.ksB = 8;
        u.p0 = tile; u.p1 = pn; u.p2 = 0; u.p3 = 0; return true;
    }
    DEV void rows(const Unit&, const int*, const int*, unsigned*) const {}
    DEV void aux(const Unit& u, LAS unsigned char* lds, int wid, int lane) const {
        if (wid < 4) glds16(slotrec + (size_t)u.p0 * 4096 + wid * 1024 + lane * 16, lds + AUX_SLOT_OFF + wid * 1024);
    }
};
struct EpiDown {
    static constexpr bool PERM = true;
    bf16_t* MOE; LAS unsigned char* lds;
    DEV void operator()(const f32x4 (&acc)[2][2][4][2], const Unit& u, int wr, int wc, int fr, int fq) const {
#pragma unroll
        for (int ai = 0; ai < 2; ++ai)
#pragma unroll
            for (int m = 0; m < 4; ++m) { const int r = ai * 128 + wr * 64 + m * 16 + fr; const int tk = *(const LAS int*)(lds + AUX_SLOT_OFF + r * 16);
                if (tk >= 0) { bf16_t* rowp = MOE + (size_t)tk * DM + u.p1 * 256 + wc * 32 + 8 * fq;
#pragma unroll
                    for (int bj = 0; bj < 2; ++bj) { const f32x4 v0 = acc[ai][bj][m][0], v1 = acc[ai][bj][m][1];
                        u32x4 w; w.x = cvt_pk_bf16(v0[0], v0[1]); w.y = cvt_pk_bf16(v0[2], v0[3]); w.z = cvt_pk_bf16(v1[0], v1[1]); w.w = cvt_pk_bf16(v1[2], v1[3]);
                        *(u32x4*)(rowp + bj * 128) = w; } } }
    }
};

DEV void p12_phase(Frame& F) {
    const bf16_t* X1B = WSP(bf16_t, WS_X1B); const bf16_t* MOE = WSP(bf16_t, WS_MOE); const float* mod = WSP(float, WS_MOD); const float* fg = F.in[I_FING];
    const int gw = F.vcu * 8 + F.wave, NGW = F.G * 8;
    constexpr int RT = 4;
    for (int ch = gw; ch < TOK / 32; ch += NGW) {
        const int b = ch >> 6; const float* gate = mod + b * NMOD + 5 * DM;
        float gq[16], fq_[16];
#pragma unroll
        for (int h = 0; h < 2; ++h) { const int c0 = h * 512 + 8 * F.lane; const f32x4 g0 = *(const f32x4*)(gate + c0), g1 = *(const f32x4*)(gate + c0 + 4), f0 = *(const f32x4*)(fg + c0), f1 = *(const f32x4*)(fg + c0 + 4);
#pragma unroll
            for (int j = 0; j < 4; ++j) { gq[h * 8 + j] = g0[j]; gq[h * 8 + 4 + j] = g1[j]; fq_[h * 8 + j] = f0[j]; fq_[h * 8 + 4 + j] = f1[j]; } }
        u32x4 xc[RT][2], mc[RT][2], xn[RT][2], mn[RT][2];
#define P12_LOAD(xd, md, i0) do { _Pragma("unroll") for (int r = 0; r < RT; ++r) _Pragma("unroll") for (int h = 0; h < 2; ++h) { \
            const size_t off_ = (size_t)(ch * 32 + (i0) + r) * DM + h * 512 + 8 * F.lane; xd[r][h] = *(const u32x4*)(X1B + off_); md[r][h] = *(const u32x4*)(MOE + off_); } } while (0)
        P12_LOAD(xc, mc, 0);
#pragma unroll 1
        for (int i = 0; i < 32; i += RT) {
            if (i + RT < 32) P12_LOAD(xn, mn, i + RT);
            float v[RT][16], ss[RT];
#pragma unroll
            for (int r = 0; r < RT; ++r) { float s_ = 0.f;
#pragma unroll
                for (int h = 0; h < 2; ++h)
#pragma unroll
                    for (int j = 0; j < 4; ++j) { const unsigned xw = xc[r][h][j], mw = mc[r][h][j];
                        const float lo = bflo(xw) + gq[h * 8 + 2 * j] * bflo(mw), hi = bfhi(xw) + gq[h * 8 + 2 * j + 1] * bfhi(mw);
                        v[r][h * 8 + 2 * j] = lo; v[r][h * 8 + 2 * j + 1] = hi; s_ += lo * lo + hi * hi; }
                ss[r] = s_; }
#pragma unroll
            for (int o = 1; o < 64; o <<= 1) {
#pragma unroll
                for (int r = 0; r < RT; ++r) ss[r] += __shfl_xor(ss[r], o); }
#pragma unroll
            for (int r = 0; r < RT; ++r) { const float rstd = 1.0f / sqrtf(ss[r] * (1.f / DM) + RMS_EPS); float* op = F.out + (size_t)(ch * 32 + i + r) * DM + 8 * F.lane;
#pragma unroll
                for (int h = 0; h < 2; ++h) { f32x4 o0, o1;
#pragma unroll
                    for (int j = 0; j < 4; ++j) { o0[j] = v[r][h * 8 + j] * rstd * fq_[h * 8 + j]; o1[j] = v[r][h * 8 + 4 + j] * rstd * fq_[h * 8 + 4 + j]; }
                    *(f32x4*)(op + h * 512) = o0; *(f32x4*)(op + h * 512 + 4) = o1; } }
#pragma unroll
            for (int r = 0; r < RT; ++r)
#pragma unroll
                for (int h = 0; h < 2; ++h) { xc[r][h] = xn[r][h]; mc[r][h] = mn[r][h]; }
        }
#undef P12_LOAD
    }
}

#define XB_TMO      128
#define XB_XCNT(j)  (256  + 64 * (j))
#define XB_XSUB(j)  (1280 + 64 * (j))
#define XB_XGEN(j)  (2304 + 64 * (j))
#define XB_TOP      3328
#define XB_TOPGEN   3392
#define XCD_BAR_WORDS 3456
#define XB_SPIN_CAP (1u << 22)
DEV unsigned xb_ld(unsigned* p)              { return __hip_atomic_load(p, __ATOMIC_RELAXED, __HIP_MEMORY_SCOPE_AGENT); }
DEV unsigned xb_add(unsigned* p, unsigned v) { return __hip_atomic_fetch_add(p, v, __ATOMIC_RELAXED, __HIP_MEMORY_SCOPE_AGENT); }
DEV unsigned xb_xcc_id() { return (unsigned)__builtin_amdgcn_s_getreg((3 << 11) | 20) & 0xFu; }
#define XB_SPIN(cond, bar) do { unsigned _sp = 0; while (cond) { __builtin_amdgcn_s_sleep(1); \
    if ((++_sp & 255u) == 0u) { if (xb_ld(&(bar)[XB_TMO])) break; if (_sp > XB_SPIN_CAP) { atomicAdd(&(bar)[XB_TMO], 1u); break; } } } } while (0)
struct XcdBarrier { unsigned* bar; unsigned x; volatile LAS unsigned* st; };
DEV XcdBarrier xcd_barrier_post(unsigned* bar, volatile LAS unsigned* st) {
    XcdBarrier b; b.bar = bar; b.x = xb_xcc_id(); b.st = st;
    if (threadIdx.x == 0) (void)xb_add(&bar[XB_XCNT(b.x)], 1u);
    return b;
}
DEV void xcd_barrier_complete(unsigned* bar, unsigned x, unsigned& nloc, unsigned& nx) {
    const unsigned G = gridDim.x * gridDim.y * gridDim.z;
    unsigned sum, cnt, mine, sp = 0u;
    for (;;) {
        sum = 0u; cnt = 0u; mine = 0u;
#pragma unroll
        for (unsigned j = 0; j < 16; ++j) { const unsigned c = xb_ld(&bar[XB_XCNT(j)]); sum += c; cnt += (c > 0u) ? 1u : 0u; mine = (j == x) ? c : mine; }
        if (sum == G) break;
        __builtin_amdgcn_s_sleep(1);
        if ((++sp & 255u) == 0u) { if (xb_ld(&bar[XB_TMO])) break; if (sp > XB_SPIN_CAP) { atomicAdd(&bar[XB_TMO], 1u); break; } }
    }
    nloc = mine > 0u ? mine : 1u; nx = cnt > 0u ? cnt : 1u;
}
DEV void xcd_barrier(const XcdBarrier& b) {
    asm volatile("s_waitcnt vmcnt(0)" ::: "memory");
    __syncthreads();
    if (threadIdx.x == 0) {
        unsigned* bar = b.bar;
        __builtin_amdgcn_s_waitcnt(0);
        unsigned nloc = b.st[0], nx = b.st[1];
        if (nloc == 0u) { xcd_barrier_complete(bar, b.x, nloc, nx); b.st[0] = nloc; b.st[1] = nx; }
        const unsigned old = xb_add(&bar[XB_XSUB(b.x)], 1u);
        const unsigned gen = old / nloc;
        if (old + 1u == (gen + 1u) * nloc) {
            __builtin_amdgcn_fence(__ATOMIC_RELEASE, "agent");
            asm volatile("s_waitcnt vmcnt(0)" ::: "memory");
            const unsigned og = xb_add(&bar[XB_TOP], 1u);
            const unsigned tg = og / nx;
            if (og + 1u == (tg + 1u) * nx) xb_add(&bar[XB_TOPGEN], 1u);
            else XB_SPIN(xb_ld(&bar[XB_TOPGEN]) == tg, bar);
            __builtin_amdgcn_fence(__ATOMIC_ACQUIRE, "agent");
            xb_add(&bar[XB_XGEN(b.x)], 1u);
            asm volatile("s_waitcnt vmcnt(0)" ::: "memory");
        } else {
            XB_SPIN(xb_ld(&bar[XB_XGEN(b.x)]) == gen, bar);
            __builtin_amdgcn_fence(__ATOMIC_ACQUIRE, "agent");
            asm volatile("s_waitcnt vmcnt(0)" ::: "memory");
        }
    }
    __syncthreads();
}

constexpr int LDS_BYTES = 155648;
constexpr int NPHASE = 13;
constexpr int MISC_OFF = LDS_BYTES - 256;
constexpr int CW_BAR = 4096;
constexpr size_t CTL_ZERO_BYTES = 65536;

__global__ void __launch_bounds__(512, 2) mk_fwd(Args args) {
    extern __shared__ __attribute__((aligned(16))) unsigned char lds_raw[];
    Frame F;
    F.lds = (LAS unsigned char*)lds_raw;
    F.tid = threadIdx.x; F.lane = F.tid & 63; F.wave = __builtin_amdgcn_readfirstlane(F.tid >> 6);
    F.G = gridDim.x; F.bx = blockIdx.x; F.vcu = (F.G % 8 == 0) ? (F.bx % 8) * (F.G / 8) + F.bx / 8 : F.bx;
#pragma unroll
    for (int i = 0; i < 29; ++i) F.in[i] = args.in[i];
    F.out = args.out; F.ws = args.ws;
    const int lo = args.ph_lo, hi = args.ph_hi;
#if MK_ONE_LAUNCH == 1
    cg::grid_group grid = cg::this_grid();
#define SEAM(k) do { if (lo <= (k) && (k) + 1 < hi) grid.sync(); } while (0)
#elif MK_ONE_LAUNCH == 2
    {
        volatile LAS unsigned* misc = (volatile LAS unsigned*)(F.lds + MISC_OFF);
        if (F.tid < 16) misc[F.tid] = 0u;
        __syncthreads();
    }
    const XcdBarrier xbar = xcd_barrier_post((unsigned*)(F.ws + WS_CTL) + CW_BAR, (volatile LAS unsigned*)(F.lds + MISC_OFF));
#define SEAM(k) do { if (lo <= (k) && (k) + 1 < hi) xcd_barrier(xbar); } while (0)
#else
#define SEAM(k) do { } while (0)
#endif
#define IN(k) (lo <= (k) && (k) < hi)
#define REPS(k) for (int rep_ = 0; rep_ < 1 + ((MK_REP >> (k)) & 1); ++rep_)

    if (IN(0)) REPS(0) { p0_phase(F); }
    SEAM(0);
    if (IN(1)) REPS(1) { p1_phase(F); }
    SEAM(1);
    if (IN(2)) REPS(2) {
        p2_fill_tr(F);
        SchedIn S{16, 2048u, 2048u, F.G, F.bx, (const char*)WSP(bf16_t, WS_HX), (const char*)WSP(bf16_t, WS_WIN)};
        EpiIn E{WSP(bf16_t, WS_UG), WSP(bf16_t, WS_BG), WSP(bf16_t, WS_CV)};
        pg8::gemm_phase<EpiIn, SchedIn>(F.lds, S, E);
        if (F.bx >= 32 && F.bx < 96) {
            SchedSB S2{16, 2048u, 2048u, F.bx - 32, (const char*)WSP(bf16_t, WS_SH2), (const char*)WSP(bf16_t, WS_W13)}; EpiSB E2{WSP(bf16_t, WS_SB13)};
            pg8::gemm_phase<EpiSB, SchedSB>(F.lds, S2, E2); }
    }
    SEAM(2);
    if (IN(3)) REPS(3) {
        if (F.bx < 80) { SchedE S{16, (unsigned)(UGK * 2), 2048u, F.bx, (const char*)WSP(bf16_t, WS_UG), (const char*)WSP(bf16_t, WS_WE)}; EpiE E{WSP(float, WS_E)};
            pg8::gemm_phase<EpiE, SchedE>(F.lds, S, E);
            conv_items(F, F.bx * 512 + F.tid, 432 * 512); }
        else { conv_items(F, (80 + (F.bx - 80) * 2) * 512 + F.tid, 432 * 512); conv_items(F, (81 + (F.bx - 80) * 2) * 512 + F.tid, 432 * 512); }
    }
    SEAM(3);
    if (IN(4)) REPS(4) { p4_phase(F); }
    SEAM(4);
    if (IN(5)) REPS(5) {
        SchedY S{20, (unsigned)(UGK * 2), (unsigned)(UGK * 2), F.bx, (const char*)WSP(bf16_t, WS_UG), (const char*)WSP(bf16_t, WS_TR)}; EpiY E{WSP(bf16_t, WS_G)};
        pg8::gemm_phase<EpiY, SchedY>(F.lds, S, E);
    }
    SEAM(5);
    if (IN(6)) REPS(6) {
        SchedGlu S{4, 512u, 512u, F.G, F.bx, (const char*)WSP(bf16_t, WS_G), (const char*)WSP(bf16_t, WS_WGLU)}; EpiGlu E{WSP(bf16_t, WS_G), WSP(bf16_t, WS_YMIX), F.in[I_BGLU]};
        pg8::gemm_phase<EpiGlu, SchedGlu>(F.lds, S, E);
    }
    SEAM(6);
    if (IN(7)) REPS(7) {
        SchedOut S{16, 2048u, 2048u, F.G, F.bx, (const char*)WSP(bf16_t, WS_YMIX), (const char*)WSP(bf16_t, WS_WOUT)};
        EpiYX E{WSP(bf16_t, WS_YX)};
        pg8::gemm_phase<EpiYX, SchedOut>(F.lds, S, E);
    }
    SEAM(7);
    if (IN(8)) REPS(8) { p8_phase(F); }
    SEAM(8);
    if (IN(9)) REPS(9) { p9_phase(F); }
    SEAM(9);
    if (IN(10)) REPS(10) {
        const int ntiles = ld_agent_i(WSP(int, WS_TILES));
        SchedUp S{16, 2048u, 2048u, F.G, F.vcu, ntiles, (const char*)WSP(bf16_t, WS_X1G), (const char*)WSP(bf16_t, WS_W13), WSP(int, WS_PERM), WSP(int, WS_TILES), (const char*)WSP(u32x4, WS_SLOT), (const char*)WSP(bf16_t, WS_SB13)};
        EpiUp E{WSP(bf16_t, WS_HID), F.lds};
        pg8::gemm_phase<EpiUp, SchedUp>(F.lds, S, E);
    }
    SEAM(10);
    if (IN(11)) REPS(11) {
        const int ntiles = ld_agent_i(WSP(int, WS_TILES));
        SchedDown S{16, 2048u, 1024u, F.G, F.vcu, ntiles, (const char*)WSP(bf16_t, WS_HID), (const char*)WSP(bf16_t, WS_W2), WSP(int, WS_TILES), (const char*)WSP(u32x4, WS_SLOT)};
        EpiDown E{WSP(bf16_t, WS_MOE), F.lds};
        pg8::gemm_phase<EpiDown, SchedDown>(F.lds, S, E);
    }
    SEAM(11);
    if (IN(12)) REPS(12) { p12_phase(F); }
#undef IN
#undef SEAM
}

extern "C" void kernel_launch(void* const* d_in, const int* in_sizes, int n_in, void* d_out, int out_size, void* d_ws, size_t ws_size, hipStream_t stream) {
    static int grid = 0;
    if (grid == 0) {
        if (n_in != 29 || out_size != TOK * DM || ws_size < WS_END) { fprintf(stderr, "kernel_launch: unexpected problem (n_in %d, out %d, ws %zu)\n", n_in, out_size, ws_size); grid = -1; return; }
        int dev = 0, cus = 0, per_cu = 0;
        if (hipGetDevice(&dev) != hipSuccess || hipDeviceGetAttribute(&cus, hipDeviceAttributeMultiprocessorCount, dev) != hipSuccess) { grid = -1; return; }
        if (hipFuncSetAttribute((const void*)mk_fwd, hipFuncAttributeMaxDynamicSharedMemorySize, LDS_BYTES) != hipSuccess) { fprintf(stderr, "kernel_launch: hipFuncSetAttribute failed\n"); grid = -1; return; }
        if (hipOccupancyMaxActiveBlocksPerMultiprocessor(&per_cu, (const void*)mk_fwd, 512, LDS_BYTES) != hipSuccess || per_cu < 1) { fprintf(stderr, "kernel_launch: occupancy query gives %d\n", per_cu); (void)hipGetLastError(); per_cu = 1; }
        grid = cus;
        if (grid > 256) grid = 256;
    }
    if (grid < 0) return;
    Args a{};
    for (int i = 0; i < 29; ++i) a.in[i] = (const float*)d_in[i];
    a.out = (float*)d_out; a.ws = (unsigned char*)d_ws;
#if MK_ONE_LAUNCH == 1
    a.ph_lo = 0; a.ph_hi = NPHASE;
    void* kargs[] = {&a};
    hipError_t e = hipLaunchCooperativeKernel((const void*)mk_fwd, dim3(grid), dim3(512), kargs, LDS_BYTES, stream);
    if (e != hipSuccess) fprintf(stderr, "cooperative launch failed: %s (grid %d)\n", hipGetErrorString(e), grid);
#elif MK_ONE_LAUNCH == 2
    if (hipMemsetAsync((char*)d_ws + WS_CTL, 0, CTL_ZERO_BYTES, stream) != hipSuccess) { fprintf(stderr, "kernel_launch: memset failed\n"); return; }
    a.ph_lo = 0; a.ph_hi = NPHASE;
    hipLaunchKernelGGL(mk_fwd, dim3(grid), dim3(512), LDS_BYTES, stream, a);
#if MK_PROBE_PHASE >= 0
    a.ph_lo = MK_PROBE_PHASE; a.ph_hi = MK_PROBE_PHASE + 1;
    hipLaunchKernelGGL(mk_fwd, dim3(grid), dim3(512), LDS_BYTES, stream, a);
#endif
#else
    for (int p = 0; p < NPHASE; ++p) { a.ph_lo = p; a.ph_hi = p + 1; hipLaunchKernelGGL(mk_fwd, dim3(grid), dim3(512), LDS_BYTES, stream, a); }
#endif
}
```

```cpp
#include <hip/hip_runtime.h>
#include <hip/hip_cooperative_groups.h>
#include <cstdio>
namespace cg = cooperative_groups;

#ifndef MK_PROBE_FLAGS
#define MK_PROBE_FLAGS 0
#endif
#ifndef MK_PROBE_PHASE
#define MK_PROBE_PHASE -1
#endif
#ifndef MK_REP
#define MK_REP 0
#endif
#ifndef MK_ONE_LAUNCH
#define MK_ONE_LAUNCH 2
#endif

#define DEV __device__ __forceinline__
#define LAS __attribute__((address_space(3)))
typedef unsigned short bf16_t;
typedef short bf16x8 __attribute__((ext_vector_type(8)));
typedef float f32x4 __attribute__((ext_vector_type(4)));
typedef float f32x2 __attribute__((ext_vector_type(2)));
typedef unsigned u32x4 __attribute__((ext_vector_type(4)));
typedef unsigned u32x2 __attribute__((ext_vector_type(2)));

constexpr int NB = 32, SEQ = 2048, DM = 1024, TOK = NB * SEQ, CTXL = 256, CTOK = NB * CTXL;
constexpr int NG = 16, NP = 64, NH = 16, LC = 64;
constexpr int NCH_LAT = TOK / LC, NCH_CTX = CTOK / LC, NCH_PAD = 1280, UGK = 1280;
constexpr int CONVW = 768, NMOD = 6 * DM;
constexpr int NEXP = 16, DEXP = 512, NBUCKET = 24, MAXTILES = 280;
constexpr float RMS_EPS = 1e-6f;

constexpr size_t MiB = 1u << 20;
constexpr size_t WS_CTL = 0;
constexpr size_t WS_MOD = 1 * MiB;
constexpr size_t WS_APOW = 2 * MiB;
constexpr size_t WS_BBAR = 4 * MiB;
constexpr size_t WS_KTAB = 5 * MiB;
constexpr size_t WS_SB13 = 7 * MiB;
constexpr size_t WS_SH2 = 9 * MiB;
constexpr size_t WS_RB = 10 * MiB;
constexpr size_t WS_TOKB = 10 * MiB + 65536;
constexpr size_t WS_TOKW = 11 * MiB;
constexpr size_t WS_TOKR = 12 * MiB;
constexpr size_t WS_SEGC = 12 * MiB + 512 * 1024;
constexpr size_t WS_PERM = 13 * MiB;
constexpr size_t WS_TILES = 14 * MiB;
constexpr size_t WS_SLOT = 16 * MiB;
constexpr size_t WS_WR = 24 * MiB;
constexpr size_t WS_WGLU = 25 * MiB;
constexpr size_t WS_WIN = 26 * MiB;
constexpr size_t WS_WOUT = 32 * MiB;
constexpr size_t WS_WE = 34 * MiB;
constexpr size_t WS_W2 = 42 * MiB;
constexpr size_t WS_W13 = 58 * MiB;
constexpr size_t WS_TR = 90 * MiB;
constexpr size_t WS_E = 130 * MiB;
constexpr size_t WS_UG = 150 * MiB;
constexpr size_t WS_G = 200 * MiB;
constexpr size_t WS_BG = 232 * MiB;
constexpr size_t WS_CV = 328 * MiB;
constexpr size_t WS_HX = 424 * MiB;
constexpr size_t WS_HID = WS_HX;
constexpr size_t WS_YX = WS_BG;
constexpr size_t WS_YMIX = 568 * MiB;
constexpr size_t WS_X1G = 696 * MiB;
constexpr size_t WS_MOE = WS_YMIX;
constexpr size_t WS_X1B = 824 * MiB;
constexpr size_t WS_END = 952 * MiB;

DEV unsigned cvt_pk_bf16(float lo, float hi) { unsigned r; asm volatile("v_cvt_pk_bf16_f32 %0, %1, %2" : "=v"(r) : "v"(lo), "v"(hi)); return r; }
DEV float bf2f(unsigned short h) { return __uint_as_float(((unsigned)h) << 16); }
DEV float bflo(unsigned w) { return __uint_as_float(w << 16); }
DEV float bfhi(unsigned w) { return __uint_as_float(w & 0xffff0000u); }
DEV float wave_sum(float v) {
#pragma unroll
    for (int o = 1; o < 64; o <<= 1) v += __shfl_xor(v, o);
    return v;
}
DEV float sigmoidf_(float x) { return __builtin_amdgcn_rcpf(1.0f + __expf(-x)); }
DEV float siluf_(float x) { return x * sigmoidf_(x); }
DEV float gelu_tanh(float x) { const float u = 0.7978845608028654f * (x + 0.044715f * x * x * x); return x * sigmoidf_(2.0f * u); }
typedef int v8i_t __attribute__((ext_vector_type(8)));
typedef int v4i_t __attribute__((ext_vector_type(4)));
DEV unsigned pk4_fp8(float a, float b, float c, float d) { int w = 0; w = __builtin_amdgcn_cvt_pk_fp8_f32(a, b, w, false); w = __builtin_amdgcn_cvt_pk_fp8_f32(c, d, w, true); return (unsigned)w; }
constexpr float FP8_WSCALE = 16.0f;
DEV int ld_agent_i(const int* p) { return __hip_atomic_load(p, __ATOMIC_RELAXED, __HIP_MEMORY_SCOPE_AGENT); }

namespace pg8 {
constexpr int BM = 256, BK = 64, HALF = 128, HTB = HALF * BK * 2, STAGE_BYTES = 8 * HTB;
__host__ __device__ __forceinline__ int lds_byte(int r, int c) { const int st = (r >> 4) * 2 + (c >> 5), rr = r & 15, cc = c & 31, ob = rr * 64 + cc * 2; return st * 1024 + (ob ^ (((ob >> 9) & 1) << 5)); }
__host__ __device__ __forceinline__ void stage_rc(int b, int& R, int& C) { const int st = b / 1024, sb = b % 1024, swz = sb ^ (((sb >> 9) & 1) << 5); R = (st >> 1) * 16 + swz / 64; C = (st & 1) * 32 + (swz % 64) / 2; }
__host__ __device__ __forceinline__ int perm32(int rho) { const int n = rho >> 4, i = rho & 15; return 8 * (i >> 2) + 4 * n + (i & 3); }

struct Unit {
    const char* A0; const char* A1; const char* B0; const char* B1;
    int ksA, ksB;
    int p0, p1, p2, p3;
};
DEV const char* pa(const Unit& u, int kt) { return kt < u.ksA ? u.A0 + (size_t)kt * 128 : u.A1 + (size_t)(kt - u.ksA) * 128; }
DEV const char* pb(const Unit& u, int kt) { return kt < u.ksB ? u.B0 + (size_t)kt * 128 : u.B1 + (size_t)(kt - u.ksB) * 128; }

template <class Epi, class Sched>
DEV void gemm_phase(LAS unsigned char* lds, const Sched& S, const Epi& E) {
    const int tid = threadIdx.x, wid = __builtin_amdgcn_readfirstlane(tid >> 6), lane = tid & 63, wr = wid >> 2, wc = wid & 3, fr = lane & 15, fq = lane >> 4;
    const int nt = S.nt;
    unsigned voffB[2], vA[4];
#pragma unroll
    for (int i = 0; i < 2; ++i) { int R_, C_; stage_rc(tid * 16 + i * 8192, R_, C_); const int Rb = Epi::PERM ? ((R_ & ~31) + perm32(R_ & 31)) : R_;
        voffB[i] = (unsigned)Rb * S.ldb + (unsigned)C_ * 2u; }
    const size_t hstepB = (size_t)HALF * S.ldb;
    const unsigned ldsw = (unsigned)wid * 1024u;
    const int aoff = lds_byte(wr * 64 + fr, fq * 8), boff = lds_byte(wc * 32 + fr, fq * 8);
#define PG8_SA(b, h) (((b) * 2 + (h)) * HTB)
#define PG8_SB(b, h) ((4 + (b) * 2 + (h)) * HTB)
#define PG8_STAGE(bufoff, gbase, v0, v1) do { \
        __builtin_amdgcn_global_load_lds((const unsigned*)((const char*)(gbase) + (v0)), (LAS unsigned*)(lds + (bufoff) + ldsw), 16, 0, 0); \
        __builtin_amdgcn_global_load_lds((const unsigned*)((const char*)(gbase) + (v1)), (LAS unsigned*)(lds + (bufoff) + ldsw + 8192), 16, 0, 0); } while (0)
#define PG8_LDA(dst, b, h) do { if constexpr (Sched::FP8) { _Pragma("unroll") for (int m = 0; m < 4; ++m) { const v4i_t lo_ = *(const LAS v4i_t*)(lds + PG8_SA(b, h) + aoff + m * 2048), hi_ = *(const LAS v4i_t*)(lds + PG8_SA(b, h) + aoff + m * 2048 + 1024); \
            dst##8[m] = __builtin_shufflevector(lo_, hi_, 0, 1, 2, 3, 4, 5, 6, 7); } } \
        else { _Pragma("unroll") for (int m = 0; m < 4; ++m) _Pragma("unroll") for (int k = 0; k < 2; ++k) dst[m][k] = *(const LAS bf16x8*)(lds + PG8_SA(b, h) + aoff + m * 2048 + k * 1024); } } while (0)
#define PG8_LDB(dst, b, h) do { if constexpr (Sched::FP8) { _Pragma("unroll") for (int n = 0; n < 2; ++n) { const v4i_t lo_ = *(const LAS v4i_t*)(lds + PG8_SB(b, h) + boff + n * 2048), hi_ = *(const LAS v4i_t*)(lds + PG8_SB(b, h) + boff + n * 2048 + 1024); \
            dst##8[n] = __builtin_shufflevector(lo_, hi_, 0, 1, 2, 3, 4, 5, 6, 7); } } \
        else { _Pragma("unroll") for (int n = 0; n < 2; ++n) _Pragma("unroll") for (int k = 0; k < 2; ++k) dst[n][k] = *(const LAS bf16x8*)(lds + PG8_SB(b, h) + boff + n * 2048 + k * 1024); } } while (0)
#define PG8_MMA(ai, bj, At, Bt) do { __builtin_amdgcn_s_setprio(1); _Pragma("unroll") for (int m = 0; m < 4; ++m) _Pragma("unroll") for (int n = 0; n < 2; ++n) { \
        if constexpr (Sched::FP8)   \
            asm volatile("v_mfma_scale_f32_16x16x128_f8f6f4 %0, %1, %2, %0, %3, %3 op_sel_hi:[0,0,0]" : "+v"(acc[ai][bj][m][n]) : "v"(Bt##8[n]), "v"(At##8[m]), "v"(sc_one));   \
        else { _Pragma("unroll") for (int k = 0; k < 2; ++k) acc[ai][bj][m][n] = __builtin_amdgcn_mfma_f32_16x16x32_bf16(Bt[n][k], At[m][k], acc[ai][bj][m][n], 0, 0, 0); } } \
        __builtin_amdgcn_s_setprio(0); } while (0)
#define PG8_WAIT_V(n) asm volatile("s_waitcnt vmcnt(" #n ")" ::: "memory")
#define PG8_WAIT_L(n) asm volatile("s_waitcnt lgkmcnt(" #n ")" ::: "memory")
#define PG8_BAR __builtin_amdgcn_s_barrier()
#define PG8_SCHED __builtin_amdgcn_sched_barrier(0)
    Unit cur, nxt; int ui = 0;
    int aux_t = 0; asm volatile("" : "+s"(aux_t));
    if (!S.next(0, cur)) return;
    f32x4 acc[2][2][4][2];
#pragma unroll
    for (int a = 0; a < 2; ++a)
#pragma unroll
        for (int b = 0; b < 2; ++b)
#pragma unroll
            for (int m = 0; m < 4; ++m)
#pragma unroll
                for (int n = 0; n < 2; ++n) acc[a][b][m][n] = (f32x4){0.f, 0.f, 0.f, 0.f};
    bf16x8 At[4][2], B0[2][2], B1[2][2];
    v8i_t At8[4], B08[2], B18[2];
    int sc_one = 0x7f7f7f7f; asm volatile("" : "+v"(sc_one));
    if constexpr (Sched::GATHER) S.rows(cur, tid, vA);
    else {
#pragma unroll
        for (int h = 0; h < 2; ++h)
#pragma unroll
            for (int i = 0; i < 2; ++i) { int R_, C_; stage_rc(tid * 16 + i * 8192, R_, C_); vA[h * 2 + i] = (unsigned)(h * HALF + R_) * S.lda + (unsigned)C_ * 2u; }
    }
    {
        const char* a0 = pa(cur, 0); const char* b0 = pb(cur, 0); const char* a1 = pa(cur, 1); const char* b1 = pb(cur, 1);
        PG8_STAGE(PG8_SB(0, 0), b0, voffB[0], voffB[1]); PG8_STAGE(PG8_SA(0, 0), a0, vA[0], vA[1]); PG8_STAGE(PG8_SB(0, 1), b0 + hstepB, voffB[0], voffB[1]); PG8_STAGE(PG8_SA(0, 1), a0, vA[2], vA[3]);
        if (wr == 1) PG8_BAR;
        PG8_WAIT_V(4); PG8_BAR;
        PG8_STAGE(PG8_SB(1, 0), b1, voffB[0], voffB[1]); PG8_STAGE(PG8_SA(1, 0), a1, vA[0], vA[1]); PG8_STAGE(PG8_SB(1, 1), b1 + hstepB, voffB[0], voffB[1]);
        PG8_WAIT_V(6); PG8_BAR;
    }
    for (;;) {
        const bool has_next = S.next(ui + 1, nxt);
        if (!has_next) nxt = cur;
        for (int t = 0; t < nt; t += 2) {
            const bool last = (t == nt - 2);
            const char* a1 = pa(cur, t + 1);
            const char* a2; const char* b2;
            if (last) { a2 = pa(nxt, 0); b2 = pb(nxt, 0); } else { a2 = pa(cur, t + 2); b2 = pb(cur, t + 2); }
            const char* a3 = a2 + 128; const char* b3 = b2 + 128;
            PG8_LDB(B0, 0, 0); PG8_SCHED; PG8_LDA(At, 0, 0); PG8_STAGE(PG8_SA(1, 1), a1, vA[2], vA[3]);
            if constexpr (Sched::GATHER) { if (last && has_next) S.rows(nxt, tid, vA); }
            PG8_WAIT_L(8); PG8_BAR; PG8_WAIT_L(0); PG8_MMA(0, 0, At, B0); PG8_BAR; PG8_SCHED;
            PG8_LDB(B1, 0, 1); PG8_STAGE(PG8_SB(0, 0), b2, voffB[0], voffB[1]);
            PG8_BAR; PG8_WAIT_L(0); PG8_MMA(0, 1, At, B1); PG8_BAR;
            PG8_LDA(At, 0, 1); PG8_STAGE(PG8_SA(0, 0), a2, vA[0], vA[1]);
            if constexpr (Sched::AUX) { if (t == aux_t) S.aux(cur, lds, wid, lane); }
            PG8_BAR; PG8_WAIT_L(0); PG8_MMA(1, 0, At, B0); PG8_BAR; PG8_SCHED;
            PG8_STAGE(PG8_SB(0, 1), b2 + hstepB, voffB[0], voffB[1]);
            PG8_WAIT_V(6); PG8_BAR; PG8_MMA(1, 1, At, B1); PG8_BAR;
            PG8_LDB(B0, 1, 0); PG8_SCHED; PG8_LDA(At, 1, 0); PG8_STAGE(PG8_SA(0, 1), a2, vA[2], vA[3]);
            PG8_WAIT_L(8); PG8_BAR; PG8_WAIT_L(0); PG8_MMA(0, 0, At, B0); PG8_BAR; PG8_SCHED;
            PG8_LDB(B1, 1, 1); PG8_STAGE(PG8_SB(1, 0), b3, voffB[0], voffB[1]);
            PG8_BAR; PG8_WAIT_L(0); PG8_MMA(0, 1, At, B1); PG8_BAR;
            PG8_LDA(At, 1, 1); PG8_STAGE(PG8_SA(1, 0), a3, vA[0], vA[1]);
            PG8_BAR; PG8_WAIT_L(0); PG8_MMA(1, 0, At, B0); PG8_BAR; PG8_SCHED;
            PG8_STAGE(PG8_SB(1, 1), b3 + hstepB, voffB[0], voffB[1]);
            PG8_WAIT_V(6); PG8_BAR; PG8_MMA(1, 1, At, B1); PG8_BAR;
        }
        if (wr == 0) PG8_BAR;
        if constexpr (Sched::FP8) asm volatile("s_nop 15\n\ts_nop 15" ::: "memory");
        E(acc, cur, wr, wc, fr, fq);
        if (!has_next) break;
#pragma unroll
        for (int a = 0; a < 2; ++a)
#pragma unroll
            for (int b = 0; b < 2; ++b)
#pragma unroll
                for (int m = 0; m < 4; ++m)
#pragma unroll
                    for (int n = 0; n < 2; ++n) acc[a][b][m][n] = (f32x4){0.f, 0.f, 0.f, 0.f};
        cur = nxt; ++ui;
        if (wr == 1) PG8_BAR;
    }
    PG8_WAIT_V(0);
    PG8_BAR;
#undef PG8_SA
#undef PG8_SB
#undef PG8_STAGE
#undef PG8_LDA
#undef PG8_LDB
#undef PG8_MMA
#undef PG8_WAIT_V
#undef PG8_WAIT_L
#undef PG8_BAR
#undef PG8_SCHED
}

DEV void static_tile(int L, int nM, int nN, int& pm, int& pn) {
    const int nwg = nM * nN; int wgid = L;
    { const int q = nwg / 8, r = nwg % 8, xcd = wgid % 8, off = wgid / 8; wgid = (xcd < r ? xcd * (q + 1) : r * (q + 1) + (xcd - r) * q) + off; }
    const int nig = 8 * nN, gid = wgid / nig, fm = gid * 8, gsz = (nM - fm) < 8 ? (nM - fm) : 8;
    pm = fm + ((wgid % nig) % gsz); pn = (wgid % nig) / gsz;
}
}
using pg8::Unit;

struct Args { const float* in[29]; float* out; unsigned char* ws; int ph_lo, ph_hi, flags, pad; };
static_assert(sizeof(Args) == 31 * 8 + 16, "Args has no padding");
enum { I_X = 0, I_C, I_CTX, I_CCTX, I_WMOD, I_BMOD, I_N1G, I_N2G, I_WIN, I_LRE, I_LIM, I_LOGDT, I_BRE, I_BIM, I_CRE, I_CIM, I_S5D, I_WGLU, I_BGLU, I_CONVW, I_WOUT,
       I_RGW, I_RGB, I_REW, I_REB, I_W1, I_W3, I_W2, I_FING };

struct Frame {
    LAS unsigned char* lds;
    int G, bx, vcu;
    const float* in[29]; float* out; unsigned char* ws;
};
#define WSP(T, off) ((T*)(F.ws + (off)))
#define F_TID ((int)threadIdx.x)
#define F_LANE ((int)threadIdx.x & 63)
#define F_WAVE (__builtin_amdgcn_readfirstlane((int)threadIdx.x >> 6))

DEV void p0_mod_item(Frame& F, int item) {
    LAS float* st = (LAS float*)F.lds;
    LAS float* red = (LAS float*)(F.lds + 33 * 512 * 4);
    const float* c = F.in[I_C]; const float* cc = F.in[I_CCTX]; const float* wm = F.in[I_WMOD]; const float* bm = F.in[I_BMOD];
    float* mod = WSP(float, WS_MOD);
    const int col = F_TID & 31, kc = F_TID >> 5, j0 = item * 32;
    float acc[33];
#pragma unroll
    for (int n = 0; n < 33; ++n) acc[n] = 0.f;
    for (int half = 0; half < 2; ++half) {
        __syncthreads();
        for (int idx = F_TID; idx < 33 * 512; idx += 512) { const int n = idx >> 9, kk = idx & 511; const float v = (n < 32) ? c[n * DM + half * 512 + kk] : cc[half * 512 + kk]; st[idx] = siluf_(v); }
        __syncthreads();
        for (int kk = kc; kk < 512; kk += 16) {
            const float w = wm[(size_t)(half * 512 + kk) * NMOD + j0 + col];
#pragma unroll
            for (int n = 0; n < 33; ++n) acc[n] += st[n * 512 + kk] * w;
        }
    }
#pragma unroll
    for (int n = 0; n < 33; ++n) red[(kc * 33 + n) * 32 + col] = acc[n];
    __syncthreads();
    for (int idx = F_TID; idx < 33 * 32; idx += 512) { const int n = idx >> 5, cl = idx & 31; float s = bm[j0 + cl];
#pragma unroll
        for (int q = 0; q < 16; ++q) s += red[(q * 33 + n) * 32 + cl];
        mod[n * NMOD + j0 + cl] = s; }
    __syncthreads();
}
DEV void p0_transpose_item(const float* W, int N, int k0, int n0, bf16_t* dst, int ldk, LAS float* scr, int lane) {
#pragma unroll 8
    for (int i = 0; i < 32; ++i) { const int kk = 2 * i + (lane >> 5); scr[kk * 33 + (lane & 31)] = W[(size_t)(k0 + kk) * N + n0 + (lane & 31)]; }
    asm volatile("s_waitcnt lgkmcnt(0)" ::: "memory");
    const int cch = lane & 7;
#pragma unroll
    for (int j = 0; j < 4; ++j) { const int n = (lane >> 3) + 8 * j; const LAS float* s = scr + (8 * cch) * 33 + n;
        u32x4 o; o.x = cvt_pk_bf16(s[0 * 33], s[1 * 33]); o.y = cvt_pk_bf16(s[2 * 33], s[3 * 33]); o.z = cvt_pk_bf16(s[4 * 33], s[5 * 33]); o.w = cvt_pk_bf16(s[6 * 33], s[7 * 33]);
        *(u32x4*)(dst + (size_t)n * ldk + k0 + 8 * cch) = o; }
    asm volatile("s_waitcnt lgkmcnt(0)" ::: "memory");
}
DEV void p0_transpose_item_fp8(const float* W, int N, int k0, int n0, unsigned char* dst, int ldk, float scale, LAS float* scr, int lane) {
#pragma unroll 8
    for (int i = 0; i < 32; ++i) { const int kk = 2 * i + (lane >> 5); scr[kk * 33 + (lane & 31)] = W[(size_t)(k0 + kk) * N + n0 + (lane & 31)] * scale; }
    asm volatile("s_waitcnt lgkmcnt(0)" ::: "memory");
    const int cch = lane & 7;
#pragma unroll
    for (int j = 0; j < 4; ++j) { const int n = (lane >> 3) + 8 * j; const LAS float* s = scr + (8 * cch) * 33 + n;
        u32x2 o; o.x = pk4_fp8(s[0 * 33], s[1 * 33], s[2 * 33], s[3 * 33]); o.y = pk4_fp8(s[4 * 33], s[5 * 33], s[6 * 33], s[7 * 33]);
        *(u32x2*)(dst + (size_t)n * ldk + k0 + 8 * cch) = o; }
    asm volatile("s_waitcnt lgkmcnt(0)" ::: "memory");
}
DEV void sincos_rev(double rev, double& s, double& c) {
    const double fr = rev - __builtin_rint(rev);
    const double q = __builtin_rint(fr * 4.0);
    const double y = (fr - q * 0.25) * 6.283185307179586476925;
    const double y2 = y * y;
    const double sy = y * (1.0 + y2 * (-1.0 / 6 + y2 * (1.0 / 120 + y2 * (-1.0 / 5040 + y2 * (1.0 / 362880 + y2 * (-1.0 / 39916800 + y2 * (1.0 / 6227020800.0)))))));
    const double cy = 1.0 + y2 * (-0.5 + y2 * (1.0 / 24 + y2 * (-1.0 / 720 + y2 * (1.0 / 40320 + y2 * (-1.0 / 3628800 + y2 * (1.0 / 479001600.0 + y2 * (-1.0 / 87178291200.0)))))));
    const int qi = ((int)q) & 3;
    s = (qi == 0) ? sy : (qi == 1) ? cy : (qi == 2) ? -sy : -cy;
    c = (qi == 0) ? cy : (qi == 1) ? -sy : (qi == 2) ? -cy : sy;
}
DEV double exp_d(double x) {
    const double k = __builtin_rint(x * 1.4426950408889634074);
    const double r = x - k * 0.69314718055994530942;
    double p = 1.0 / 6227020800.0;
    p = p * r + 1.0 / 479001600.0; p = p * r + 1.0 / 39916800.0; p = p * r + 1.0 / 3628800.0; p = p * r + 1.0 / 362880.0; p = p * r + 1.0 / 40320.0; p = p * r + 1.0 / 5040.0;
    p = p * r + 1.0 / 720.0; p = p * r + 1.0 / 120.0; p = p * r + 1.0 / 24.0; p = p * r + 1.0 / 6.0; p = p * r + 0.5; p = p * r + 1.0; p = p * r + 1.0;
    const long long e = (long long)k + 1023;
    return p * __builtin_bit_cast(double, (unsigned long long)e << 52);
}
DEV void p0_phase(Frame& F) {
    for (int it = F.bx; it < NMOD / 32; it += F.G) p0_mod_item(F, it);
    __syncthreads();
    {
        LAS float* scr = (LAS float*)(F.lds + F_WAVE * 8448);
        bf16_t* Win = WSP(bf16_t, WS_WIN); bf16_t* Wout = WSP(bf16_t, WS_WOUT); bf16_t* Wglu = WSP(bf16_t, WS_WGLU); unsigned char* W13 = WSP(unsigned char, WS_W13); unsigned char* W2 = WSP(unsigned char, WS_W2);
        const int gw = F.vcu * 8 + F_WAVE, NGW = F.G * 8;
        constexpr int I_IN = 16 * 80, I_OUT = 16 * 32, I_GLU = 4 * 8, I_E = 16 * 256;
        for (int it = gw; it < I_IN + I_OUT + I_GLU + 3 * I_E; it += NGW) {
            int r = it;
            if (r < I_IN) { const int kb = r / 80, nb = r % 80, n0 = nb * 32; int drow;
                if (n0 < 1024) drow = n0;
                else if (n0 < 1792) { const int j = n0 - 1024; drow = 1024 + (j >> 7) * 256 + (j & 127); }
                else { const int j = n0 - 1792; drow = 1024 + (j >> 7) * 256 + 128 + (j & 127); }
                p0_transpose_item(F.in[I_WIN], 2560, kb * 64, n0, Win + (size_t)drow * 1024, 1024, scr, F_LANE); continue; }
            r -= I_IN;
            if (r < I_OUT) { const int kb = r / 32, nb = r % 32; p0_transpose_item(F.in[I_WOUT], 1024, kb * 64, nb * 32, Wout + (size_t)(nb * 32) * 1024, 1024, scr, F_LANE); continue; }
            r -= I_OUT;
            if (r < I_GLU) { const int kb = r / 8, nb = r % 8; p0_transpose_item(F.in[I_WGLU], 256, kb * 64, nb * 32, Wglu + (size_t)(nb * 32) * 256, 256, scr, F_LANE); continue; }
            r -= I_GLU;
            if (r < 2 * I_E) { const int which = r / I_E; const int rr = r % I_E; const int e = rr >> 8, rem = rr & 255, kb = rem >> 4, nb = rem & 15, n0 = nb * 32;
                const int drow = (n0 >> 7) * 256 + which * 128 + (n0 & 127);
                p0_transpose_item_fp8(F.in[which ? I_W3 : I_W1] + (size_t)e * 1024 * 512, 512, kb * 64, n0, W13 + ((size_t)e * 1024 + drow) * 1024, 1024, FP8_WSCALE, scr, F_LANE); continue; }
            r -= 2 * I_E;
            { const int e = r >> 8, rem = r & 255, kb = rem >> 5, nb = rem & 31;
                p0_transpose_item_fp8(F.in[I_W2] + (size_t)e * 512 * 1024, 1024, kb * 64, nb * 32, W2 + ((size_t)e * 1024 + nb * 32) * 512, 512, FP8_WSCALE, scr, F_LANE); }
        }
    }
    {
        bf16_t* Wr = WSP(bf16_t, WS_WR);
        for (int idx = F.bx * 512 + F_TID; idx < 32 * 1024; idx += F.G * 512) { const int l = idx >> 10, k = idx & 1023;
            const float v = (l < 4) ? F.in[I_RGW][k * 4 + l] : (l < 20) ? F.in[I_REW][k * 16 + (l - 4)] : 0.f;
            Wr[idx] = (bf16_t)(cvt_pk_bf16(v, 0.f) & 0xffffu); }
    }
    {
        f32x2* APOW = WSP(f32x2, WS_APOW); f32x2* BBAR = WSP(f32x2, WS_BBAR);
        const int gt = F.bx * 512 + F_TID, NT = F.G * 512;
        for (int idx = gt; idx < 2 * 16 * 65 * 64; idx += NT) {
            const int p = idx & 63, j = (idx >> 6) % 65, dg = idx / (64 * 65);
            const double lre = F.in[I_LRE][dg * 64 + p], lim = F.in[I_LIM][dg * 64 + p], dt = exp_d((double)F.in[I_LOGDT][dg]);
            const double mag = exp_d(lre * dt * j); double s, c; sincos_rev(lim * dt * j * 0.15915494309189533577, s, c);
            APOW[idx] = (f32x2){(float)(mag * c), (float)(mag * s)};
        }
        for (int idx = gt; idx < 2 * 16 * 64 * 16; idx += NT) {
            const int dgp = idx >> 4, dg = dgp >> 6;
            const double lre = F.in[I_LRE][dgp], lim = F.in[I_LIM][dgp], dt = exp_d((double)F.in[I_LOGDT][dg]);
            const double mag = exp_d(lre * dt); double s, c; sincos_rev(lim * dt * 0.15915494309189533577, s, c);
            const double nr = mag * c - 1.0, ni = mag * s, d2 = lre * lre + lim * lim;
            const double qr = (nr * lre + ni * lim) / d2, qi = (ni * lre - nr * lim) / d2;
            const double br = F.in[I_BRE][idx], bi = F.in[I_BIM][idx];
            BBAR[idx] = (f32x2){(float)(qr * br - qi * bi), (float)(qr * bi + qi * br)};
        }
    }
}

DEV void p1_norm_rows(Frame& F) {
    const float* mod = WSP(float, WS_MOD); bf16_t* HX = WSP(bf16_t, WS_HX); const float* g = F.in[I_N1G];
    const int gw = F.vcu * 8 + F_WAVE, NGW = F.G * 8;
    constexpr int RPW = 36, RT = 4;
    for (int ch = gw; ch < (TOK + CTOK) / RPW; ch += NGW) {
        int ncur = -1; f32x4 gs[4], sh[4];
        f32x4 cur[RT][4], nxt[RT][4];
#define P1_LOAD(dst, i0) do { _Pragma("unroll") for (int r = 0; r < RT; ++r) { const int m_ = ch * RPW + (i0) + r; \
            const f32x4* xp_ = (const f32x4*)((m_ < TOK) ? F.in[I_X] + (size_t)m_ * DM : F.in[I_CTX] + (size_t)(m_ - TOK) * DM) + F_LANE; \
            _Pragma("unroll") for (int j = 0; j < 4; ++j) dst[r][j] = xp_[64 * j]; } } while (0)
        P1_LOAD(cur, 0);
#pragma unroll 1
        for (int i = 0; i < RPW; i += RT) {
            if (i + RT < RPW) P1_LOAD(nxt, i + RT);
            float ss[RT];
#pragma unroll
            for (int r = 0; r < RT; ++r) { float a = 0.f;
#pragma unroll
                for (int j = 0; j < 4; ++j) a += (cur[r][j].x * cur[r][j].x + cur[r][j].y * cur[r][j].y) + (cur[r][j].z * cur[r][j].z + cur[r][j].w * cur[r][j].w);
                ss[r] = a; }
#pragma unroll
            for (int o = 1; o < 64; o <<= 1) {
#pragma unroll
                for (int r = 0; r < RT; ++r) ss[r] += __shfl_xor(ss[r], o); }
#pragma unroll
            for (int r = 0; r < RT; ++r) {
                const int m = ch * RPW + i + r; const int n = (m < TOK) ? (m >> 11) : 32;
                if (n != ncur) { ncur = n;
#pragma unroll
                    for (int j = 0; j < 4; ++j) { gs[j] = ((const f32x4*)g)[F_LANE + 64 * j] * (1.0f + ((const f32x4*)(mod + n * NMOD + DM))[F_LANE + 64 * j]); sh[j] = ((const f32x4*)(mod + n * NMOD))[F_LANE + 64 * j]; } }
                u32x2* o8 = (u32x2*)(HX + (size_t)m * DM) + F_LANE; const float rs = 1.0f / sqrtf(ss[r] * (1.f / DM) + RMS_EPS);
#pragma unroll
                for (int j = 0; j < 4; ++j) { const f32x4 y = (cur[r][j] * rs) * gs[j] + sh[j]; u32x2 w; w.x = cvt_pk_bf16(y.x, y.y); w.y = cvt_pk_bf16(y.z, y.w); o8[64 * j] = w; }
            }
#pragma unroll
            for (int r = 0; r < RT; ++r)
#pragma unroll
                for (int j = 0; j < 4; ++j) cur[r][j] = nxt[r][j];
        }
#undef P1_LOAD
    }
}
DEV void p1_phase(Frame& F) {
    const float* mod = WSP(float, WS_MOD);
    const int gw = F.vcu * 8 + F_WAVE, NGW = F.G * 8;
    p1_norm_rows(F);
    const int gt = F.bx * 512 + F_TID, NT = F.G * 512;
    const f32x2* APOW = WSP(f32x2, WS_APOW); const f32x2* BBAR = WSP(f32x2, WS_BBAR);
    {
        float* KT = WSP(float, WS_KTAB);
        for (int idx = gt; idx < 2 * 16 * 64 * 256; idx += NT) {
            const int hp = idx & 15, h = (idx >> 4) & 15, j = (idx >> 8) & 63, dg = idx >> 14;
            float s = 0.f;
            for (int p = 0; p < 64; ++p) {
                const float cr = F.in[I_CRE][(dg * 16 + h) * 64 + p], ci = F.in[I_CIM][(dg * 16 + h) * 64 + p];
                const f32x2 a = APOW[(dg * 65 + j) * 64 + p], b = BBAR[(dg * 64 + p) * 16 + hp];
                const float ur = cr * a.x - ci * a.y, ui = cr * a.y + ci * a.x;
                s += ur * b.x - ui * b.y;
            }
            KT[idx] = s;
        }
    }
    {
        bf16_t* WE = WSP(bf16_t, WS_WE);
        for (int idx = gt; idx < 16 * 256 * 128; idx += NT) {
            const int k8 = idx & 127, n = (idx >> 7) & 255, g = idx >> 15;
            const int part = n >> 6, p = n & 63, dir = part >> 1, k = k8 >> 1, h0 = (k8 & 1) * 8;
            const int dg = dir * 16 + g; const f32x2 a = APOW[(dg * 65 + (dir ? k : 63 - k)) * 64 + p];
            float v[8];
#pragma unroll
            for (int q = 0; q < 8; ++q) { const f32x2 b = BBAR[(dg * 64 + p) * 16 + h0 + q]; v[q] = (part & 1) ? (a.x * b.y + a.y * b.x) : (a.x * b.x - a.y * b.y); }
            u32x4 o; o.x = cvt_pk_bf16(v[0], v[1]); o.y = cvt_pk_bf16(v[2], v[3]); o.z = cvt_pk_bf16(v[4], v[5]); o.w = cvt_pk_bf16(v[6], v[7]);
            *(u32x4*)(WE + ((size_t)(g * 256 + n) * 1024 + k8 * 8)) = o;
        }
    }
    {
        unsigned* SH2 = WSP(unsigned, WS_SH2);
        for (int idx = gt; idx < 256 * 256; idx += NT) { const int r = idx >> 8, k = (idx & 255) * 4; const float* mp = mod + r * NMOD + 3 * DM + k;
            SH2[idx] = (r < 32) ? pk4_fp8(mp[0], mp[1], mp[2], mp[3]) : 0u; }
    }
    {
        float* rb = WSP(float, WS_RB);
        for (int idx = gw; idx < 32 * 32; idx += NGW) { const int b = idx >> 5, l = idx & 31; float s = 0.f;
            if (l < 20) {
#pragma unroll 4
                for (int k = F_LANE; k < DM; k += 64) s += mod[b * NMOD + 3 * DM + k] * ((l < 4) ? F.in[I_RGW][k * 4 + l] : F.in[I_REW][k * 16 + (l - 4)]);
                s = wave_sum(s) + ((l < 4) ? F.in[I_RGB][l] : F.in[I_REB][l - 4]); }
            if (F_LANE == 0) rb[idx] = s; }
    }
}

DEV void p2_fill_tr(Frame& F) {
    const float* KT = WSP(float, WS_KTAB); const f32x2* APOW = WSP(f32x2, WS_APOW); bf16_t* TR = WSP(bf16_t, WS_TR);
    const int gt = F.bx * 512 + F_TID, NT = F.G * 512;
    for (int idx = gt; idx < 16 * 1024 * 160; idx += NT) {
        const int k8 = idx % 160, n = (idx / 160) & 1023, g = idx / (160 * 1024);
        const int t = n >> 4, h = n & 15;
        float v[8];
        if (k8 < 128) { const int k = k8 >> 1, h0 = (k8 & 1) * 8;
            if (t > k) { const float* s = KT + (((0 * 16 + g) * 64 + (t - k)) * 256 + h * 16 + h0);
#pragma unroll
                for (int q = 0; q < 8; ++q) v[q] = s[q]; }
            else if (k > t) { const float* s = KT + (((1 * 16 + g) * 64 + (k - t)) * 256 + h * 16 + h0);
#pragma unroll
                for (int q = 0; q < 8; ++q) v[q] = s[q]; }
            else { const float* s0 = KT + (((0 * 16 + g) * 64) * 256 + h * 16 + h0); const float* s1 = KT + (((1 * 16 + g) * 64) * 256 + h * 16 + h0); const float dd = F.in[I_S5D][g * 16 + h];
#pragma unroll
                for (int q = 0; q < 8; ++q) v[q] = s0[q] + s1[q] + ((h0 + q == h) ? dd : 0.f); }
        } else { const int s0 = (k8 - 128) * 8, part = s0 >> 6, p0 = s0 & 63, dir = part >> 1, dg = dir * 16 + g, j = dir ? (64 - t) : (t + 1);
#pragma unroll
            for (int q = 0; q < 8; ++q) { const int p = p0 + q; const float cr = F.in[I_CRE][(dg * 16 + h) * 64 + p], ci = F.in[I_CIM][(dg * 16 + h) * 64 + p]; const f32x2 a = APOW[(dg * 65 + j) * 64 + p];
                v[q] = (part & 1) ? -(cr * a.y + ci * a.x) : (cr * a.x - ci * a.y); }
        }
        u32x4 o; o.x = cvt_pk_bf16(v[0], v[1]); o.y = cvt_pk_bf16(v[2], v[3]); o.z = cvt_pk_bf16(v[4], v[5]); o.w = cvt_pk_bf16(v[6], v[7]);
        *(u32x4*)(TR + ((size_t)(g * 1024 + n) * UGK + k8 * 8)) = o;
    }
}
struct SchedIn {
    static constexpr bool GATHER = false, AUX = false, FP8 = false;
    int nt; unsigned lda, ldb; int G, c; const char* HX; const char* W;
    DEV bool next(int i, Unit& u) const {
        const int L = i * G + c; if (L >= 2560 + 32) return false;
        int pm, pn, ctx = 0;
        if (L < 2560) pg8::static_tile(L, 256, 10, pm, pn); else { pm = 256 + (L - 2560); pn = 0; ctx = 1; }
        u.A0 = HX + (size_t)pm * 256 * 2048; u.A1 = u.A0; u.B0 = W + (size_t)pn * 256 * 2048; u.B1 = u.B0; u.ksA = 1 << 20; u.ksB = 1 << 20;
        u.p0 = pm; u.p1 = pn; u.p2 = ctx; u.p3 = 0; return true;
    }
    DEV void rows(const Unit&, int, unsigned*) const {}
    DEV void aux(const Unit&, LAS unsigned char*, int, int) const {}
};
struct EpiIn {
    static constexpr bool PERM = true;
    bf16_t* UG; bf16_t* BG; bf16_t* CV;
    DEV void operator()(const f32x4 (&acc)[2][2][4][2], const Unit& u, int wr, int wc, int fr, int fq) const {
        const int pm = u.p0, pn = u.p1;
#pragma unroll
        for (int ai = 0; ai < 2; ++ai)
#pragma unroll
            for (int m = 0; m < 4; ++m) {
                const int r = ai * 128 + wr * 64 + m * 16 + fr;
                if (pn == 0) {
                    const int mm = pm * 256 + r;
                    const int chunk = mm >> 6, k = mm & 63;
#pragma unroll
                    for (int bj = 0; bj < 2; ++bj) { const int c = bj * 128 + wc * 32 + 8 * fq, g = c >> 4, h0 = c & 15;
                        const f32x4 v0 = acc[ai][bj][m][0], v1 = acc[ai][bj][m][1];
                        u32x4 w; w.x = cvt_pk_bf16(v0[0], v0[1]); w.y = cvt_pk_bf16(v0[2], v0[3]); w.z = cvt_pk_bf16(v1[0], v1[1]); w.w = cvt_pk_bf16(v1[2], v1[3]);
                        *(u32x4*)(UG + ((size_t)(g * NCH_PAD + chunk) * UGK + k * 16 + h0)) = w; }
                } else if (pn < 4) {
                    bf16_t* rowp = BG + (size_t)(pm * 256 + r) * CONVW + (pn - 1) * 256 + wc * 32 + 8 * fq;
#pragma unroll
                    for (int bj = 0; bj < 2; ++bj) { const f32x4 v0 = acc[ai][bj][m][0], v1 = acc[ai][bj][m][1];
                        u32x4 w; w.x = cvt_pk_bf16(v0[0], v0[1]); w.y = cvt_pk_bf16(v0[2], v0[3]); w.z = cvt_pk_bf16(v1[0], v1[1]); w.w = cvt_pk_bf16(v1[2], v1[3]);
                        *(u32x4*)(rowp + bj * 128) = w; }
                } else {
                    const f32x4 v0 = acc[ai][0][m][0] * acc[ai][1][m][0], v1 = acc[ai][0][m][1] * acc[ai][1][m][1];
                    u32x4 w; w.x = cvt_pk_bf16(v0[0], v0[1]); w.y = cvt_pk_bf16(v0[2], v0[3]); w.z = cvt_pk_bf16(v1[0], v1[1]); w.w = cvt_pk_bf16(v1[2], v1[3]);
                    *(u32x4*)(CV + (size_t)(pm * 256 + r) * CONVW + (pn - 4) * 128 + wc * 32 + 8 * fq) = w;
                }
            }
    }
};

struct SchedE {
    static constexpr bool GATHER = false, AUX = false, FP8 = false;
    int nt; unsigned lda, ldb; int c; const char* UG; const char* WE;
    DEV bool next(int i, Unit& u) const {
        if (i > 0 || c >= 80) return false;
        const int g = c / 5, pm = c % 5;
        u.A0 = UG + ((size_t)g * NCH_PAD + pm * 256) * UGK * 2; u.A1 = u.A0; u.B0 = WE + (size_t)g * 256 * 2048; u.B1 = u.B0; u.ksA = 1 << 20; u.ksB = 1 << 20;
        u.p0 = pm; u.p1 = g; u.p2 = 0; u.p3 = 0; return true;
    }
    DEV void rows(const Unit&, int, unsigned*) const {}
    DEV void aux(const Unit&, LAS unsigned char*, int, int) const {}
};
struct EpiE {
    static constexpr bool PERM = false;
    float* E;
    DEV void operator()(const f32x4 (&acc)[2][2][4][2], const Unit& u, int wr, int wc, int fr, int fq) const {
        float* base = E + ((size_t)u.p1 * NCH_PAD + u.p0 * 256) * 256;
#pragma unroll
        for (int ai = 0; ai < 2; ++ai)
#pragma unroll
            for (int m = 0; m < 4; ++m) { float* rowp = base + (size_t)(ai * 128 + wr * 64 + m * 16 + fr) * 256 + wc * 32 + 4 * fq;
#pragma unroll
                for (int bj = 0; bj < 2; ++bj)
#pragma unroll
                    for (int n = 0; n < 2; ++n) *(f32x4*)(rowp + bj * 128 + n * 16) = acc[ai][bj][m][n]; }
    }
};
struct SchedSB {
    static constexpr bool GATHER = false, AUX = false, FP8 = true;
    int nt; unsigned lda, ldb; int c; const char* SH2; const char* W13;
    DEV bool next(int i, Unit& u) const {
        if (i > 0 || c < 0 || c >= 64) return false;
        const int e = c >> 2, ti = c & 3;
        u.A0 = SH2; u.A1 = u.A0; u.B0 = W13 + ((size_t)e * 1024 + ti * 256) * 1024; u.B1 = u.B0; u.ksA = 1 << 20; u.ksB = 1 << 20;
        u.p0 = e; u.p1 = ti; u.p2 = 0; u.p3 = 0; return true;
    }
    DEV void rows(const Unit&, int, unsigned*) const {}
    DEV void aux(const Unit&, LAS unsigned char*, int, int) const {}
};
struct EpiSB {
    static constexpr bool PERM = true;
    bf16_t* SB;
    DEV void operator()(const f32x4 (&acc)[2][2][4][2], const Unit& u, int wr, int wc, int fr, int fq) const {
        if (wr != 0) return;
#pragma unroll
        for (int m = 0; m < 2; ++m) { const int b = m * 16 + fr; bf16_t* rowp = SB + ((size_t)(b * 16 + u.p0) * 1024 + u.p1 * 256 + wc * 32 + 8 * fq);
#pragma unroll
            for (int bj = 0; bj < 2; ++bj) { const f32x4 v0 = acc[0][bj][m][0] * (1.0f / FP8_WSCALE), v1 = acc[0][bj][m][1] * (1.0f / FP8_WSCALE);
                u32x4 w; w.x = cvt_pk_bf16(v0[0], v0[1]); w.y = cvt_pk_bf16(v0[2], v0[3]); w.z = cvt_pk_bf16(v1[0], v1[1]); w.w = cvt_pk_bf16(v1[2], v1[3]);
                *(u32x4*)(rowp + bj * 128) = w; } }
    }
};

DEV void p4_phase(Frame& F) {
    const int gt = F.bx * 512 + F_TID, NT = F.G * 512;
    const float* E = WSP(float, WS_E); const f32x2* APOW = WSP(f32x2, WS_APOW); bf16_t* UG = WSP(bf16_t, WS_UG);
    for (int idx = gt; idx < NB * NG * 128; idx += NT) {
        const int p = idx & 63, dir = (idx >> 6) & 1, g = (idx >> 7) & 15, b = idx >> 11;
        const f32x2 a = APOW[((dir * 16 + g) * 65 + 64) * 64 + p];
        const float* Eg = E + (size_t)g * NCH_PAD * 256 + dir * 128 + p;
        bf16_t* Ug = UG + (size_t)g * NCH_PAD * UGK + 1024 + dir * 128 + p;
        float er[36], ei[36];
#pragma unroll
        for (int c = 0; c < 4; ++c) { const int ch = NCH_LAT + b * 4 + (dir ? 3 - c : c); er[c] = Eg[(size_t)ch * 256]; ei[c] = Eg[(size_t)ch * 256 + 64]; }
#pragma unroll
        for (int c = 0; c < 32; ++c) { const int ch = b * 32 + (dir ? 31 - c : c); er[4 + c] = Eg[(size_t)ch * 256]; ei[4 + c] = Eg[(size_t)ch * 256 + 64]; }
        float sr = 0.f, si = 0.f;
#pragma unroll
        for (int c = 0; c < 4; ++c) { const float nr = a.x * sr - a.y * si + er[c], ni = a.x * si + a.y * sr + ei[c]; sr = nr; si = ni; }
#pragma unroll
        for (int c = 0; c < 32; ++c) { const int ch = b * 32 + (dir ? 31 - c : c);
            Ug[(size_t)ch * UGK] = (bf16_t)(cvt_pk_bf16(sr, 0.f) & 0xffffu); Ug[(size_t)ch * UGK + 64] = (bf16_t)(cvt_pk_bf16(si, 0.f) & 0xffffu);
            const float nr = a.x * sr - a.y * si + er[4 + c], ni = a.x * si + a.y * sr + ei[4 + c]; sr = nr; si = ni; }
    }
}
DEV void conv_items(Frame& F, int vt, int NVT) {
    const bf16_t* BG = WSP(bf16_t, WS_BG); const bf16_t* CV = WSP(bf16_t, WS_CV); bf16_t* YM = WSP(bf16_t, WS_YMIX); const float* cw = F.in[I_CONVW];
    constexpr int NI = 4;
    for (int idx0 = vt; idx0 < TOK * 96; idx0 += NI * NVT) {
        u32x4 c0[NI], c1[NI], c2[NI], bb[NI];
#pragma unroll
        for (int q = 0; q < NI; ++q) { const int idx = idx0 + q * NVT; const bool ok = idx < TOK * 96; const int j8 = idx % 96, m = ok ? idx / 96 : 0, j0 = j8 * 8;
            const bool rowp = j0 < 384; const int d = rowp ? 1 : 64;
            const bool hasl = ok && (rowp ? ((m & 63) > 0) : (((m >> 6) & 31) > 0)), hasr = ok && (rowp ? ((m & 63) < 63) : (((m >> 6) & 31) < 31));
            const u32x4 z = (u32x4){0u, 0u, 0u, 0u};
            c0[q] = hasl ? *(const u32x4*)(CV + (size_t)(m - d) * CONVW + j0) : z;
            c1[q] = *(const u32x4*)(CV + (size_t)m * CONVW + j0);
            c2[q] = hasr ? *(const u32x4*)(CV + (size_t)(m + d) * CONVW + j0) : z;
            bb[q] = *(const u32x4*)(BG + (size_t)m * CONVW + j0); }
#pragma unroll
        for (int q = 0; q < NI; ++q) { const int idx = idx0 + q * NVT; if (idx < TOK * 96) { const int j8 = idx % 96, m = idx / 96, j0 = j8 * 8;
            const f32x4 w0a = *(const f32x4*)(cw + j0), w0b = *(const f32x4*)(cw + j0 + 4), w1a = *(const f32x4*)(cw + CONVW + j0), w1b = *(const f32x4*)(cw + CONVW + j0 + 4), w2a = *(const f32x4*)(cw + 2 * CONVW + j0), w2b = *(const f32x4*)(cw + 2 * CONVW + j0 + 4);
            float o[8];
            o[0] = bflo(bb[q].x) * (bflo(c0[q].x) * w0a[0] + bflo(c1[q].x) * w1a[0] + bflo(c2[q].x) * w2a[0]); o[1] = bfhi(bb[q].x) * (bfhi(c0[q].x) * w0a[1] + bfhi(c1[q].x) * w1a[1] + bfhi(c2[q].x) * w2a[1]);
            o[2] = bflo(bb[q].y) * (bflo(c0[q].y) * w0a[2] + bflo(c1[q].y) * w1a[2] + bflo(c2[q].y) * w2a[2]); o[3] = bfhi(bb[q].y) * (bfhi(c0[q].y) * w0a[3] + bfhi(c1[q].y) * w1a[3] + bfhi(c2[q].y) * w2a[3]);
            o[4] = bflo(bb[q].z) * (bflo(c0[q].z) * w0b[0] + bflo(c1[q].z) * w1b[0] + bflo(c2[q].z) * w2b[0]); o[5] = bfhi(bb[q].z) * (bfhi(c0[q].z) * w0b[1] + bfhi(c1[q].z) * w1b[1] + bfhi(c2[q].z) * w2b[1]);
            o[6] = bflo(bb[q].w) * (bflo(c0[q].w) * w0b[2] + bflo(c1[q].w) * w1b[2] + bflo(c2[q].w) * w2b[2]); o[7] = bfhi(bb[q].w) * (bfhi(c0[q].w) * w0b[3] + bfhi(c1[q].w) * w1b[3] + bfhi(c2[q].w) * w2b[3]);
            u32x4 w; w.x = cvt_pk_bf16(o[0], o[1]); w.y = cvt_pk_bf16(o[2], o[3]); w.z = cvt_pk_bf16(o[4], o[5]); w.w = cvt_pk_bf16(o[6], o[7]);
            *(u32x4*)(YM + (size_t)m * DM + 256 + j0) = w; } }
    }
}

struct SchedY {
    static constexpr bool GATHER = false, AUX = false, FP8 = false;
    int nt; unsigned lda, ldb; int c; const char* UG; const char* TR;
    DEV bool next(int i, Unit& u) const {
        if (i > 0 || c >= 256) return false;
        const int g = c >> 4, pm = (c >> 2) & 3, pn = c & 3;
        u.A0 = UG + ((size_t)g * NCH_PAD + pm * 256) * UGK * 2; u.A1 = u.A0; u.B0 = TR + ((size_t)g * 1024 + pn * 256) * UGK * 2; u.B1 = u.B0; u.ksA = 1 << 20; u.ksB = 1 << 20;
        u.p0 = pm; u.p1 = pn; u.p2 = g; u.p3 = 0; return true;
    }
    DEV void rows(const Unit&, int, unsigned*) const {}
    DEV void aux(const Unit&, LAS unsigned char*, int, int) const {}
};
struct EpiY {
    static constexpr bool PERM = true;
    bf16_t* Gb;
    DEV void operator()(const f32x4 (&acc)[2][2][4][2], const Unit& u, int wr, int wc, int fr, int fq) const {
#pragma unroll
        for (int ai = 0; ai < 2; ++ai)
#pragma unroll
            for (int m = 0; m < 4; ++m) { const int chunk = u.p0 * 256 + ai * 128 + wr * 64 + m * 16 + fr;
#pragma unroll
                for (int bj = 0; bj < 2; ++bj) { const int n = u.p1 * 256 + bj * 128 + wc * 32 + 8 * fq, t = n >> 4, h0 = n & 15;
                    const f32x4 v0 = acc[ai][bj][m][0], v1 = acc[ai][bj][m][1];
                    u32x4 w; w.x = cvt_pk_bf16(gelu_tanh(v0[0]), gelu_tanh(v0[1])); w.y = cvt_pk_bf16(gelu_tanh(v0[2]), gelu_tanh(v0[3]));
                    w.z = cvt_pk_bf16(gelu_tanh(v1[0]), gelu_tanh(v1[1])); w.w = cvt_pk_bf16(gelu_tanh(v1[2]), gelu_tanh(v1[3]));
                    *(u32x4*)(Gb + ((size_t)(chunk * 64 + t) * 256 + u.p2 * 16 + h0)) = w; } }
    }
};

struct SchedGlu {
    static constexpr bool GATHER = false, AUX = false, FP8 = false;
    int nt; unsigned lda, ldb; int G, c; const char* Gb; const char* W;
    DEV bool next(int i, Unit& u) const {
        const int L = i * G + c; if (L >= 256) return false;
        u.A0 = Gb + (size_t)L * 256 * 512; u.A1 = u.A0; u.B0 = W; u.B1 = u.B0; u.ksA = 1 << 20; u.ksB = 1 << 20; u.p0 = L; u.p1 = 0; u.p2 = 0; u.p3 = 0; return true;
    }
    DEV void rows(const Unit&, int, unsigned*) const {}
    DEV void aux(const Unit&, LAS unsigned char*, int, int) const {}
};
struct EpiGlu {
    static constexpr bool PERM = true;
    const bf16_t* Gb; bf16_t* YM; const float* bglu;
    DEV void operator()(const f32x4 (&acc)[2][2][4][2], const Unit& u, int wr, int wc, int fr, int fq) const {
        u32x4 gq[2][4][2];
#pragma unroll
        for (int ai = 0; ai < 2; ++ai)
#pragma unroll
            for (int m = 0; m < 4; ++m)
#pragma unroll
                for (int bj = 0; bj < 2; ++bj) gq[ai][m][bj] = *(const u32x4*)(Gb + (size_t)(u.p0 * 256 + ai * 128 + wr * 64 + m * 16 + fr) * 256 + bj * 128 + wc * 32 + 8 * fq);
        f32x4 bq[2][2];
#pragma unroll
        for (int bj = 0; bj < 2; ++bj) { bq[bj][0] = *(const f32x4*)(bglu + bj * 128 + wc * 32 + 8 * fq); bq[bj][1] = *(const f32x4*)(bglu + bj * 128 + wc * 32 + 8 * fq + 4); }
        asm volatile("" ::: "memory");
#pragma unroll
        for (int ai = 0; ai < 2; ++ai)
#pragma unroll
            for (int m = 0; m < 4; ++m) { const int row = u.p0 * 256 + ai * 128 + wr * 64 + m * 16 + fr;
#pragma unroll
                for (int bj = 0; bj < 2; ++bj) { const int c = bj * 128 + wc * 32 + 8 * fq;
                    const u32x4 gv = gq[ai][m][bj];
                    const f32x4 z0 = acc[ai][bj][m][0] + bq[bj][0], z1 = acc[ai][bj][m][1] + bq[bj][1];
                    u32x4 w; w.x = cvt_pk_bf16(bflo(gv.x) * sigmoidf_(z0[0]), bfhi(gv.x) * sigmoidf_(z0[1])); w.y = cvt_pk_bf16(bflo(gv.y) * sigmoidf_(z0[2]), bfhi(gv.y) * sigmoidf_(z0[3]));
                    w.z = cvt_pk_bf16(bflo(gv.z) * sigmoidf_(z1[0]), bfhi(gv.z) * sigmoidf_(z1[1])); w.w = cvt_pk_bf16(bflo(gv.w) * sigmoidf_(z1[2]), bfhi(gv.w) * sigmoidf_(z1[3]));
                    *(u32x4*)(YM + (size_t)row * DM + c) = w; } }
    }
};

struct SchedOut {
    static constexpr bool GATHER = false, AUX = false, FP8 = false;
    int nt; unsigned lda, ldb; int G, c; const char* A; const char* W;
    DEV bool next(int i, Unit& u) const {
        const int L = i * G + c; if (L >= 1024) return false;
        int pm, pn; pg8::static_tile(L, 256, 4, pm, pn);
        u.A0 = A + (size_t)pm * 256 * 2048; u.A1 = u.A0; u.B0 = W + (size_t)pn * 256 * 2048; u.B1 = u.B0; u.ksA = 1 << 20; u.ksB = 1 << 20; u.p0 = pm; u.p1 = pn; u.p2 = 0; u.p3 = 0; return true;
    }
    DEV void rows(const Unit&, int, unsigned*) const {}
    DEV void aux(const Unit&, LAS unsigned char*, int, int) const {}
};
struct EpiYX {
    static constexpr bool PERM = true;
    bf16_t* YX; int nostore;
    DEV void operator()(const f32x4 (&acc)[2][2][4][2], const Unit& u, int wr, int wc, int fr, int fq) const {
        if (nostore) { float t = 0.f;
#pragma unroll
            for (int ai = 0; ai < 2; ++ai)
#pragma unroll
                for (int m = 0; m < 4; ++m)
#pragma unroll
                    for (int bj = 0; bj < 2; ++bj) t += acc[ai][bj][m][0][0] + acc[ai][bj][m][1][3];
            if (t == 1.2345e38f) YX[0] = 0; return; }
#pragma unroll
        for (int ai = 0; ai < 2; ++ai)
#pragma unroll
            for (int m = 0; m < 4; ++m) { bf16_t* rowp = YX + (size_t)(u.p0 * 256 + ai * 128 + wr * 64 + m * 16 + fr) * DM + u.p1 * 256 + wc * 32 + 8 * fq;
#pragma unroll
                for (int bj = 0; bj < 2; ++bj) { const f32x4 v0 = acc[ai][bj][m][0], v1 = acc[ai][bj][m][1];
                    u32x4 w; w.x = cvt_pk_bf16(v0[0], v0[1]); w.y = cvt_pk_bf16(v0[2], v0[3]); w.z = cvt_pk_bf16(v1[0], v1[1]); w.w = cvt_pk_bf16(v1[2], v1[3]);
                    *(u32x4*)(rowp + bj * 128) = w; } }
    }
};

constexpr int P8_WR_STRIDE = 2064;
constexpr int P8_GT_OFF = 32 * P8_WR_STRIDE, P8_GS_OFF = P8_GT_OFF + 4096, P8_HIST_OFF = P8_GS_OFF + 4096;
DEV void p8_phase(Frame& F) {
    const float* X = F.in[I_X]; const bf16_t* YX = WSP(bf16_t, WS_YX); bf16_t* X1B = WSP(bf16_t, WS_X1B); unsigned char* X1G = WSP(unsigned char, WS_X1G);
    const bf16_t* Wr = WSP(bf16_t, WS_WR); const float* rb = WSP(float, WS_RB); const float* mod = WSP(float, WS_MOD); const float* n2g = F.in[I_N2G];
    int* tokb = WSP(int, WS_TOKB); float* tokw = WSP(float, WS_TOKW); float* tokr = WSP(float, WS_TOKR); int* segc = WSP(int, WS_SEGC);
    LAS int* hist = (LAS int*)(F.lds + P8_HIST_OFF);
    LAS float* gt = (LAS float*)(F.lds + P8_GT_OFF); LAS float* gsl = (LAS float*)(F.lds + P8_GS_OFF);
    const int l15 = F_LANE & 15, q = F_LANE >> 4;
    for (int idx = F_TID; idx < 32 * 128; idx += 512) { const int r = idx >> 7, c16 = idx & 127; *(LAS u32x4*)(F.lds + r * P8_WR_STRIDE + c16 * 16) = *(const u32x4*)(Wr + (size_t)r * DM + c16 * 8); }
    for (int seg = F.bx; seg < TOK / 256; seg += F.G) {
        const int b = seg >> 3;
        __syncthreads();
        if (F_TID < 32) hist[F_TID] = 0;
        for (int k = F_TID; k < DM; k += 512) { gt[k] = mod[b * NMOD + 2 * DM + k]; gsl[k] = n2g[k] * (1.0f + mod[b * NMOD + 4 * DM + k]); }
        __syncthreads();
        const int tok0 = seg * 256 + F_WAVE * 32;
#pragma unroll 1
        for (int rg = 0; rg < 2; ++rg) {
            const int tok = tok0 + rg * 16 + l15;
            const float* xp = X + (size_t)tok * DM + 8 * q; const bf16_t* yp = YX + (size_t)tok * DM + 8 * q;
            bf16_t* o1 = X1B + (size_t)tok * DM + 8 * q; unsigned char* og = X1G + (size_t)tok * DM + 8 * q;
            const LAS unsigned char* wl = F.lds + l15 * P8_WR_STRIDE + q * 16;
            f32x4 acc0 = (f32x4){0.f, 0.f, 0.f, 0.f}, acc1 = acc0; float sq = 0.f;
            f32x4 xc[4][2], xn[4][2]; u32x4 yc[4], yn[4];
#define P8_LOAD(xd, yd, k0) do { _Pragma("unroll") for (int u_ = 0; u_ < 4; ++u_) { xd[u_][0] = *(const f32x4*)(xp + ((k0) + u_) * 32); xd[u_][1] = *(const f32x4*)(xp + ((k0) + u_) * 32 + 4); yd[u_] = *(const u32x4*)(yp + ((k0) + u_) * 32); } } while (0)
            P8_LOAD(xc, yc, 0);
#pragma unroll 1
            for (int k4 = 0; k4 < 32; k4 += 4) {
                if (k4 + 4 < 32) P8_LOAD(xn, yn, k4 + 4);
#pragma unroll
                for (int u_ = 0; u_ < 4; ++u_) { const int ks = k4 + u_;
                    const f32x4 xa = xc[u_][0], xb = xc[u_][1]; const u32x4 yv = yc[u_];
                    const f32x4 g0 = *(const LAS f32x4*)(gt + ks * 32 + 8 * q), g1 = *(const LAS f32x4*)(gt + ks * 32 + 8 * q + 4);
                    const f32x4 s0 = *(const LAS f32x4*)(gsl + ks * 32 + 8 * q), s1 = *(const LAS f32x4*)(gsl + ks * 32 + 8 * q + 4);
                    f32x4 va, vb;
                    va[0] = xa[0] + g0[0] * bflo(yv.x); va[1] = xa[1] + g0[1] * bfhi(yv.x); va[2] = xa[2] + g0[2] * bflo(yv.y); va[3] = xa[3] + g0[3] * bfhi(yv.y);
                    vb[0] = xb[0] + g1[0] * bflo(yv.z); vb[1] = xb[1] + g1[1] * bfhi(yv.z); vb[2] = xb[2] + g1[2] * bflo(yv.w); vb[3] = xb[3] + g1[3] * bfhi(yv.w);
                    sq += ((va[0] * va[0] + va[1] * va[1]) + (va[2] * va[2] + va[3] * va[3])) + ((vb[0] * vb[0] + vb[1] * vb[1]) + (vb[2] * vb[2] + vb[3] * vb[3]));
                    u32x4 w1; w1.x = cvt_pk_bf16(va[0], va[1]); w1.y = cvt_pk_bf16(va[2], va[3]); w1.z = cvt_pk_bf16(vb[0], vb[1]); w1.w = cvt_pk_bf16(vb[2], vb[3]);
                    *(u32x4*)(o1 + ks * 32) = w1;
                    const f32x4 ga = va * s0, gb = vb * s1;
                    u32x4 wg; wg.x = cvt_pk_bf16(ga[0], ga[1]); wg.y = cvt_pk_bf16(ga[2], ga[3]); wg.z = cvt_pk_bf16(gb[0], gb[1]); wg.w = cvt_pk_bf16(gb[2], gb[3]);
                    { u32x2 w8; w8.x = pk4_fp8(ga[0], ga[1], ga[2], ga[3]); w8.y = pk4_fp8(gb[0], gb[1], gb[2], gb[3]); *(u32x2*)(og + ks * 32) = w8; }
                    const bf16x8 xf = __builtin_bit_cast(bf16x8, wg);
                    const bf16x8 wa = *(const LAS bf16x8*)(wl + ks * 64), wb = *(const LAS bf16x8*)(wl + 16 * P8_WR_STRIDE + ks * 64);
                    acc0 = __builtin_amdgcn_mfma_f32_16x16x32_bf16(wa, xf, acc0, 0, 0, 0); acc1 = __builtin_amdgcn_mfma_f32_16x16x32_bf16(wb, xf, acc1, 0, 0, 0);
                }
#pragma unroll
                for (int u_ = 0; u_ < 4; ++u_) { xc[u_][0] = xn[u_][0]; xc[u_][1] = xn[u_][1]; yc[u_] = yn[u_]; }
            }
#undef P8_LOAD
            sq += __shfl_xor(sq, 16); sq += __shfl_xor(sq, 32);
            const float rstd = 1.0f / sqrtf(sq * (1.f / DM) + RMS_EPS);
            float lg[4], l2[4], gl[4], t1[4], t2[4], v[4];
#pragma unroll
            for (int r = 0; r < 4; ++r) { lg[r] = rstd * acc0[r] + rb[b * 32 + 4 * q + r]; l2[r] = rstd * acc1[r] + rb[b * 32 + 16 + ((4 * q + r) & 15)]; }
#pragma unroll
            for (int r = 0; r < 4; ++r) gl[r] = __shfl(lg[r], l15);
            int gi = 0; float gm = gl[0];
#pragma unroll
            for (int r = 1; r < 4; ++r) if (gl[r] > gm) { gm = gl[r]; gi = r; }
            float den = 0.f;
#pragma unroll
            for (int r = 0; r < 4; ++r) den += __expf(gl[r] - gm);
            const float gp = 1.0f / den;
            const int src = l15 + 16 * ((gi + 1) & 3);
#pragma unroll
            for (int r = 0; r < 4; ++r) { t1[r] = __shfl(lg[r], src); t2[r] = __shfl(l2[r], l15); v[r] = (gi == 3) ? t2[r] : t1[r]; }
            int i1 = 0; float v1 = v[0];
#pragma unroll
            for (int r = 1; r < 4; ++r) if (v[r] > v1) { v1 = v[r]; i1 = r; }
            int i2 = -1; float v2 = 0.f;
#pragma unroll
            for (int r = 0; r < 4; ++r) if (r != i1 && (i2 < 0 || v[r] > v2)) { v2 = v[r]; i2 = r; }
            const float ex = __expf(v2 - v1), p1 = 1.0f / (1.0f + ex), p2 = ex * p1;
            const int lo = i1 < i2 ? i1 : i2, hi = i1 < i2 ? i2 : i1;
            const float wlo = (i1 < i2 ? p1 : p2) * gp, whi = (i1 < i2 ? p2 : p1) * gp;
            const int pidx = (lo == 0) ? (hi - 1) : (lo == 1) ? (hi + 1) : 5;
            const int bucket = gi * 6 + pidx;
            if (q == 0) { tokb[tok] = bucket; tokw[tok * 2] = wlo; tokw[tok * 2 + 1] = whi; tokr[tok] = rstd; atomicAdd((int*)hist + bucket, 1); }
        }
        __syncthreads();
        if (F_TID < 32) segc[seg * 32 + F_TID] = (F_TID < NBUCKET) ? hist[F_TID] : 0;
    }
    __syncthreads();
}

DEV void p9_phase(Frame& F) {
    const int* segc = WSP(int, WS_SEGC); const int* tokb = WSP(int, WS_TOKB); int* perm = WSP(int, WS_PERM); int* tiles = WSP(int, WS_TILES);
    const float* tokw = WSP(float, WS_TOKW); const float* tokr = WSP(float, WS_TOKR); u32x4* slotrec = WSP(u32x4, WS_SLOT);
    LAS int* tot = (LAS int*)F.lds;
    LAS int* tst = tot + 32;
    LAS int* base = tst + 32;
    LAS int* wcnt = base + 32;
    for (int seg = F.bx; seg < TOK / 256; seg += F.G) {
        __syncthreads();
        if (F_TID < 32) { int t = 0, bs = 0; if (F_TID < NBUCKET) for (int s = 0; s < 256; ++s) { const int c = ld_agent_i(segc + s * 32 + F_TID); if (s < seg) bs += c; t += c; } tot[F_TID] = t; base[F_TID] = bs; }
        if (F_TID < 128) wcnt[F_TID] = 0;
        __syncthreads();
        if (F_TID == 0) { int ts = 0; for (int k = 0; k < NBUCKET; ++k) { tst[k] = ts; ts += (tot[k] + 255) >> 8; } tst[NBUCKET] = ts; }
        __syncthreads();
        int bk = -1, rank = 0;
        if (F_TID < 256) {
            bk = tokb[seg * 256 + F_TID];
            for (int k = 0; k < NBUCKET; ++k) { const unsigned long long msk = __ballot(bk == k); if (bk == k) rank = __popcll(msk & ((1ull << F_LANE) - 1ull)); if (F_LANE == 0) wcnt[F_WAVE * 32 + k] = __popcll(msk); }
        }
        __syncthreads();
        if (F_TID < 256) { int off = 0; for (int w = 0; w < F_WAVE; ++w) off += wcnt[w * 32 + bk]; const int tok = seg * 256 + F_TID, slot = tst[bk] * 256 + base[bk] + off + rank;
            perm[slot] = tok; slotrec[slot] = (u32x4){(unsigned)tok, __float_as_uint(tokr[tok]), __float_as_uint(tokw[tok * 2]), __float_as_uint(tokw[tok * 2 + 1])}; }
        if (seg < NBUCKET) { const int k = seg, n = tot[k], np = ((n + 255) >> 8) << 8; for (int r = n + F_TID; r < np; r += 512) { perm[tst[k] * 256 + r] = -1; slotrec[tst[k] * 256 + r] = (u32x4){0xffffffffu, 0u, 0u, 0u}; } }
        if (seg == 0) { if (F_TID == 0) tiles[0] = tst[NBUCKET];
            if (F_TID < NBUCKET) { const int k = F_TID, nt_ = (tot[k] + 255) >> 8; for (int t = 0; t < nt_; ++t) tiles[16 + tst[k] + t] = k; } }
    }
}
DEV void bucket_experts(int bk, int& e0, int& e1) { const int grp = bk / 6, pi = bk % 6; const int lo = pi < 3 ? 0 : (pi < 5 ? 1 : 2), hi = pi < 3 ? pi + 1 : (pi < 5 ? pi - 1 : 3); e0 = grp * 4 + lo; e1 = grp * 4 + hi; }

constexpr int AUX_SLOT_OFF = 131072, AUX_BIAS_OFF = 131072 + 4096;
DEV void glds16(const void* g, LAS unsigned char* l) { __builtin_amdgcn_global_load_lds((const unsigned*)g, (LAS unsigned*)l, 16, 0, 0); }

struct SchedUp {
    static constexpr bool GATHER = true, AUX = true, FP8 = true;
    int nt; unsigned lda, ldb; int G, c, ntiles; const char* X1G; const char* W13; const int* perm; const int* tiles; const char* slotrec; const char* sb13;
    DEV bool next(int i, Unit& u) const {
        const int L = i * G + c; if (L >= ntiles * 8) return false;
        const int tile = L >> 3, s = (L >> 2) & 1, ti = L & 3; int e0, e1; bucket_experts(ld_agent_i(tiles + 16 + tile), e0, e1); const int e = s ? e1 : e0;
        u.A0 = X1G; u.A1 = X1G; u.B0 = W13 + ((size_t)e * 1024 + ti * 256) * 1024; u.B1 = u.B0; u.ksA = 1 << 20; u.ksB = 1 << 20; u.p0 = tile; u.p1 = s; u.p2 = ti; u.p3 = e; return true;
    }
    DEV void rows(const Unit& u, int tid, unsigned* v) const {
#pragma unroll
        for (int i = 0; i < 2; ++i) { int R_, C_; pg8::stage_rc(tid * 16 + i * 8192, R_, C_);
#pragma unroll
            for (int h = 0; h < 2; ++h) { int t = perm[u.p0 * 256 + h * 128 + R_]; t = t < 0 ? 0 : t; v[h * 2 + i] = (unsigned)t * 1024u + (unsigned)C_ * 2u; } }
    }
    DEV void aux(const Unit& u, LAS unsigned char* lds, int wid, int lane) const {
        if (wid < 4) glds16(slotrec + (size_t)u.p0 * 4096 + wid * 1024 + lane * 16, lds + AUX_SLOT_OFF + wid * 1024);
#pragma unroll
        for (int i = 0; i < 2; ++i) { const int p = wid * 2 + i, b = 2 * p + (lane >> 5);
            glds16(sb13 + ((size_t)(b * 16 + u.p3) * 1024 + u.p2 * 256) * 2 + (lane & 31) * 16, lds + AUX_BIAS_OFF + p * 1024); }
    }
};
struct EpiUp {
    static constexpr bool PERM = true;
    unsigned char* HID; LAS unsigned char* lds;
    DEV void operator()(const f32x4 (&acc)[2][2][4][2], const Unit& u, int wr, int wc, int fr, int fq) const {
#pragma unroll
        for (int ai = 0; ai < 2; ++ai)
#pragma unroll
            for (int m = 0; m < 4; ++m) { const int r = ai * 128 + wr * 64 + m * 16 + fr, slot = u.p0 * 256 + r;
                const u32x4 rec = *(const LAS u32x4*)(lds + AUX_SLOT_OFF + r * 16);
                const bool valid = (int)rec.x >= 0; const int tk = valid ? (int)rec.x : 0; const float rstd = __uint_as_float(rec.y) * (1.0f / FP8_WSCALE), w = (u.p1 ? __uint_as_float(rec.w) : __uint_as_float(rec.z)) * FP8_WSCALE;
                const LAS unsigned char* bp = lds + AUX_BIAS_OFF + (tk >> 11) * 512 + (wc * 32 + 8 * fq) * 2;
                const u32x4 b1 = *(const LAS u32x4*)bp, b3 = *(const LAS u32x4*)(bp + 256);
                const f32x4 a10 = acc[ai][0][m][0] * rstd, a11 = acc[ai][0][m][1] * rstd, a30 = acc[ai][1][m][0] * rstd, a31 = acc[ai][1][m][1] * rstd;
                float o[8];
                o[0] = w * siluf_(a10[0] + bflo(b1.x)) * (a30[0] + bflo(b3.x)); o[1] = w * siluf_(a10[1] + bfhi(b1.x)) * (a30[1] + bfhi(b3.x));
                o[2] = w * siluf_(a10[2] + bflo(b1.y)) * (a30[2] + bflo(b3.y)); o[3] = w * siluf_(a10[3] + bfhi(b1.y)) * (a30[3] + bfhi(b3.y));
                o[4] = w * siluf_(a11[0] + bflo(b1.z)) * (a31[0] + bflo(b3.z)); o[5] = w * siluf_(a11[1] + bfhi(b1.z)) * (a31[1] + bfhi(b3.z));
                o[6] = w * siluf_(a11[2] + bflo(b1.w)) * (a31[2] + bflo(b3.w)); o[7] = w * siluf_(a11[3] + bfhi(b1.w)) * (a31[3] + bfhi(b3.w));
                u32x2 wv; wv.x = pk4_fp8(o[0], o[1], o[2], o[3]); wv.y = pk4_fp8(o[4], o[5], o[6], o[7]);
                *(u32x2*)(HID + ((size_t)slot * 1024 + u.p1 * 512 + u.p2 * 128 + wc * 32 + 8 * fq)) = wv; }
    }
};

struct SchedDown {
    static constexpr bool GATHER = false, AUX = true, FP8 = true;
    int nt; unsigned lda, ldb; int G, c, ntiles; const char* HID; const char* W2; const int* tiles; const char* slotrec;
    DEV bool next(int i, Unit& u) const {
        const int L = i * G + c; if (L >= ntiles * 4) return false;
        const int tile = L >> 2, pn = L & 3; int e0, e1; bucket_experts(ld_agent_i(tiles + 16 + tile), e0, e1);
        u.A0 = HID + (size_t)tile * 256 * 1024; u.A1 = u.A0; u.ksA = 1 << 20;
        u.B0 = W2 + ((size_t)e0 * 1024 + pn * 256) * 512; u.B1 = W2 + ((size_t)e1 * 1024 + pn * 256) * 512; u.ksB = 4;
        u.p0 = tile; u.p1 = pn; u.p2 = 0; u.p3 = 0; return true;
    }
    DEV void rows(const Unit&, int, unsigned*) const {}
    DEV void aux(const Unit& u, LAS unsigned char* lds, int wid, int lane) const {
        if (wid < 4) glds16(slotrec + (size_t)u.p0 * 4096 + wid * 1024 + lane * 16, lds + AUX_SLOT_OFF + wid * 1024);
    }
};
struct EpiDown {
    static constexpr bool PERM = true;
    bf16_t* MOE; LAS unsigned char* lds;
    DEV void operator()(const f32x4 (&acc)[2][2][4][2], const Unit& u, int wr, int wc, int fr, int fq) const {
#pragma unroll
        for (int ai = 0; ai < 2; ++ai)
#pragma unroll
            for (int m = 0; m < 4; ++m) { const int r = ai * 128 + wr * 64 + m * 16 + fr; const int tk = *(const LAS int*)(lds + AUX_SLOT_OFF + r * 16);
                if (tk >= 0) { bf16_t* rowp = MOE + (size_t)tk * DM + u.p1 * 256 + wc * 32 + 8 * fq;
#pragma unroll
                    for (int bj = 0; bj < 2; ++bj) { const f32x4 v0 = acc[ai][bj][m][0] * (1.0f / (FP8_WSCALE * FP8_WSCALE)), v1 = acc[ai][bj][m][1] * (1.0f / (FP8_WSCALE * FP8_WSCALE));
                        u32x4 w; w.x = cvt_pk_bf16(v0[0], v0[1]); w.y = cvt_pk_bf16(v0[2], v0[3]); w.z = cvt_pk_bf16(v1[0], v1[1]); w.w = cvt_pk_bf16(v1[2], v1[3]);
                        *(u32x4*)(rowp + bj * 128) = w; } } }
    }
};

DEV void p12_phase(Frame& F) {
    const bf16_t* X1B = WSP(bf16_t, WS_X1B); const bf16_t* MOE = WSP(bf16_t, WS_MOE); const float* mod = WSP(float, WS_MOD); const float* fg = F.in[I_FING];
    const int gw = F.vcu * 8 + F_WAVE, NGW = F.G * 8;
    constexpr int RT = 4;
    for (int ch = gw; ch < TOK / 32; ch += NGW) {
        const int b = ch >> 6; const float* gate = mod + b * NMOD + 5 * DM;
        float gq[16], fq_[16];
#pragma unroll
        for (int h = 0; h < 2; ++h) { const int c0 = h * 512 + 8 * F_LANE; const f32x4 g0 = *(const f32x4*)(gate + c0), g1 = *(const f32x4*)(gate + c0 + 4), f0 = *(const f32x4*)(fg + c0), f1 = *(const f32x4*)(fg + c0 + 4);
#pragma unroll
            for (int j = 0; j < 4; ++j) { gq[h * 8 + j] = g0[j]; gq[h * 8 + 4 + j] = g1[j]; fq_[h * 8 + j] = f0[j]; fq_[h * 8 + 4 + j] = f1[j]; } }
        u32x4 xc[RT][2], mc[RT][2], xn[RT][2], mn[RT][2];
#define P12_LOAD(xd, md, i0) do { _Pragma("unroll") for (int r = 0; r < RT; ++r) _Pragma("unroll") for (int h = 0; h < 2; ++h) { \
            const size_t off_ = (size_t)(ch * 32 + (i0) + r) * DM + h * 512 + 8 * F_LANE; xd[r][h] = *(const u32x4*)(X1B + off_); md[r][h] = *(const u32x4*)(MOE + off_); } } while (0)
        P12_LOAD(xc, mc, 0);
#pragma unroll 1
        for (int i = 0; i < 32; i += RT) {
            if (i + RT < 32) P12_LOAD(xn, mn, i + RT);
            float v[RT][16], ss[RT];
#pragma unroll
            for (int r = 0; r < RT; ++r) { float s_ = 0.f;
#pragma unroll
                for (int h = 0; h < 2; ++h)
#pragma unroll
                    for (int j = 0; j < 4; ++j) { const unsigned xw = xc[r][h][j], mw = mc[r][h][j];
                        const float lo = bflo(xw) + gq[h * 8 + 2 * j] * bflo(mw), hi = bfhi(xw) + gq[h * 8 + 2 * j + 1] * bfhi(mw);
                        v[r][h * 8 + 2 * j] = lo; v[r][h * 8 + 2 * j + 1] = hi; s_ += lo * lo + hi * hi; }
                ss[r] = s_; }
#pragma unroll
            for (int o = 1; o < 64; o <<= 1) {
#pragma unroll
                for (int r = 0; r < RT; ++r) ss[r] += __shfl_xor(ss[r], o); }
#pragma unroll
            for (int r = 0; r < RT; ++r) { const float rstd = 1.0f / sqrtf(ss[r] * (1.f / DM) + RMS_EPS); float* op = F.out + (size_t)(ch * 32 + i + r) * DM + 8 * F_LANE;
#pragma unroll
                for (int h = 0; h < 2; ++h) { f32x4 o0, o1;
#pragma unroll
                    for (int j = 0; j < 4; ++j) { o0[j] = v[r][h * 8 + j] * rstd * fq_[h * 8 + j]; o1[j] = v[r][h * 8 + 4 + j] * rstd * fq_[h * 8 + 4 + j]; }
                    *(f32x4*)(op + h * 512) = o0; *(f32x4*)(op + h * 512 + 4) = o1; } }
#pragma unroll
            for (int r = 0; r < RT; ++r)
#pragma unroll
                for (int h = 0; h < 2; ++h) { xc[r][h] = xn[r][h]; mc[r][h] = mn[r][h]; }
        }
#undef P12_LOAD
    }
}

#define XB_TMO      128
#define XB_XCNT(j)  (256  + 64 * (j))
#define XB_XSUB(j)  (1280 + 64 * (j))
#define XB_XGEN(j)  (2304 + 64 * (j))
#define XB_TOP      3328
#define XB_TOPGEN   3392
#define XCD_BAR_WORDS 3456
#define XB_SPIN_CAP (1u << 22)
DEV unsigned xb_ld(unsigned* p)              { return __hip_atomic_load(p, __ATOMIC_RELAXED, __HIP_MEMORY_SCOPE_AGENT); }
DEV unsigned xb_add(unsigned* p, unsigned v) { return __hip_atomic_fetch_add(p, v, __ATOMIC_RELAXED, __HIP_MEMORY_SCOPE_AGENT); }
DEV unsigned xb_xcc_id() { return (unsigned)__builtin_amdgcn_s_getreg((3 << 11) | 20) & 0xFu; }
#define XB_SPIN(cond, bar) do { unsigned _sp = 0; while (cond) { __builtin_amdgcn_s_sleep(1); \
    if ((++_sp & 255u) == 0u) { if (xb_ld(&(bar)[XB_TMO])) break; if (_sp > XB_SPIN_CAP) { atomicAdd(&(bar)[XB_TMO], 1u); break; } } } } while (0)
struct XcdBarrier { unsigned* bar; unsigned x; volatile LAS unsigned* st; };
DEV XcdBarrier xcd_barrier_post(unsigned* bar, volatile LAS unsigned* st) {
    XcdBarrier b; b.bar = bar; b.x = xb_xcc_id(); b.st = st;
    if (threadIdx.x == 0) (void)xb_add(&bar[XB_XCNT(b.x)], 1u);
    return b;
}
DEV void xcd_barrier_complete(unsigned* bar, unsigned x, unsigned& nloc, unsigned& nx) {
    const unsigned G = gridDim.x * gridDim.y * gridDim.z;
    unsigned sum, cnt, mine, sp = 0u;
    for (;;) {
        sum = 0u; cnt = 0u; mine = 0u;
#pragma unroll
        for (unsigned j = 0; j < 16; ++j) { const unsigned c = xb_ld(&bar[XB_XCNT(j)]); sum += c; cnt += (c > 0u) ? 1u : 0u; mine = (j == x) ? c : mine; }
        if (sum == G) break;
        __builtin_amdgcn_s_sleep(1);
        if ((++sp & 255u) == 0u) { if (xb_ld(&bar[XB_TMO])) break; if (sp > XB_SPIN_CAP) { atomicAdd(&bar[XB_TMO], 1u); break; } }
    }
    nloc = mine > 0u ? mine : 1u; nx = cnt > 0u ? cnt : 1u;
}
DEV void xcd_barrier(const XcdBarrier& b) {
    asm volatile("s_waitcnt vmcnt(0)" ::: "memory");
    __syncthreads();
    if (threadIdx.x == 0) {
        unsigned* bar = b.bar;
        __builtin_amdgcn_s_waitcnt(0);
        unsigned nloc = b.st[0], nx = b.st[1];
        if (nloc == 0u) { xcd_barrier_complete(bar, b.x, nloc, nx); b.st[0] = nloc; b.st[1] = nx; }
        const unsigned old = xb_add(&bar[XB_XSUB(b.x)], 1u);
        const unsigned gen = old / nloc;
        if (old + 1u == (gen + 1u) * nloc) {
            __builtin_amdgcn_fence(__ATOMIC_RELEASE, "agent");
            asm volatile("s_waitcnt vmcnt(0)" ::: "memory");
            const unsigned og = xb_add(&bar[XB_TOP], 1u);
            const unsigned tg = og / nx;
            if (og + 1u == (tg + 1u) * nx) xb_add(&bar[XB_TOPGEN], 1u);
            else XB_SPIN(xb_ld(&bar[XB_TOPGEN]) == tg, bar);
            __builtin_amdgcn_fence(__ATOMIC_ACQUIRE, "agent");
            xb_add(&bar[XB_XGEN(b.x)], 1u);
            asm volatile("s_waitcnt vmcnt(0)" ::: "memory");
        } else {
            XB_SPIN(xb_ld(&bar[XB_XGEN(b.x)]) == gen, bar);
            __builtin_amdgcn_fence(__ATOMIC_ACQUIRE, "agent");
            asm volatile("s_waitcnt vmcnt(0)" ::: "memory");
        }
    }
    __syncthreads();
}

constexpr int LDS_BYTES = 155648;
constexpr int NPHASE = 13;
constexpr int MISC_OFF = LDS_BYTES - 256;
constexpr int CW_BAR = 4096;
constexpr size_t CTL_ZERO_BYTES = 65536;

__global__ void __launch_bounds__(512, 2) mk_fwd(Args args) {
    extern __shared__ __attribute__((aligned(16))) unsigned char lds_raw[];
    Frame F;
    F.lds = (LAS unsigned char*)lds_raw;
    F.G = gridDim.x; F.bx = blockIdx.x; F.vcu = (F.G % 8 == 0) ? (F.bx % 8) * (F.G / 8) + F.bx / 8 : F.bx;
#pragma unroll
    for (int i = 0; i < 29; ++i) F.in[i] = args.in[i];
    F.out = args.out; F.ws = args.ws;
    const int lo = args.ph_lo, hi = args.ph_hi;
#if MK_ONE_LAUNCH == 1
    cg::grid_group grid = cg::this_grid();
#define SEAM(k) do { if (lo <= (k) && (k) + 1 < hi) grid.sync(); } while (0)
#elif MK_ONE_LAUNCH == 2
    {
        volatile LAS unsigned* misc = (volatile LAS unsigned*)(F.lds + MISC_OFF);
        if (F_TID < 16) misc[F_TID] = 0u;
        __syncthreads();
    }
    const XcdBarrier xbar = xcd_barrier_post((unsigned*)(F.ws + WS_CTL) + CW_BAR, (volatile LAS unsigned*)(F.lds + MISC_OFF));
#define SEAM(k) do { if (lo <= (k) && (k) + 1 < hi) xcd_barrier(xbar); } while (0)
#else
#define SEAM(k) do { } while (0)
#endif
#define IN(k) (lo <= (k) && (k) < hi)
#define REPS(k) for (int rep_ = 0; rep_ < 1 + ((MK_REP >> (k)) & 1); ++rep_)

    if (IN(0)) REPS(0) { p0_phase(F); }
    SEAM(0);
    if (IN(1)) REPS(1) { p1_phase(F); }
    SEAM(1);
    if (IN(2)) REPS(2) {
        p2_fill_tr(F);
        SchedIn S{16, 2048u, 2048u, F.G, F.bx, (const char*)WSP(bf16_t, WS_HX), (const char*)WSP(bf16_t, WS_WIN)};
        EpiIn E{WSP(bf16_t, WS_UG), WSP(bf16_t, WS_BG), WSP(bf16_t, WS_CV)};
        pg8::gemm_phase<EpiIn, SchedIn>(F.lds, S, E);
        if (F.bx >= 32 && F.bx < 96) {
            SchedSB S2{8, 1024u, 1024u, F.bx - 32, (const char*)WSP(bf16_t, WS_SH2), (const char*)WSP(bf16_t, WS_W13)}; EpiSB E2{WSP(bf16_t, WS_SB13)};
            pg8::gemm_phase<EpiSB, SchedSB>(F.lds, S2, E2); }
    }
    SEAM(2);
    if (IN(3)) REPS(3) {
        if (F.bx < 80) { SchedE S{16, (unsigned)(UGK * 2), 2048u, F.bx, (const char*)WSP(bf16_t, WS_UG), (const char*)WSP(bf16_t, WS_WE)}; EpiE E{WSP(float, WS_E)};
            pg8::gemm_phase<EpiE, SchedE>(F.lds, S, E);
            conv_items(F, F.bx * 512 + F_TID, 432 * 512); }
        else { conv_items(F, (80 + (F.bx - 80) * 2) * 512 + F_TID, 432 * 512); conv_items(F, (81 + (F.bx - 80) * 2) * 512 + F_TID, 432 * 512); }
    }
    SEAM(3);
    if (IN(4)) REPS(4) { p4_phase(F); }
    SEAM(4);
    if (IN(5)) REPS(5) {
        SchedY S{20, (unsigned)(UGK * 2), (unsigned)(UGK * 2), F.bx, (const char*)WSP(bf16_t, WS_UG), (const char*)WSP(bf16_t, WS_TR)}; EpiY E{WSP(bf16_t, WS_G)};
        pg8::gemm_phase<EpiY, SchedY>(F.lds, S, E);
    }
    SEAM(5);
    if (IN(6)) REPS(6) {
        SchedGlu S{4, 512u, 512u, F.G, F.bx, (const char*)WSP(bf16_t, WS_G), (const char*)WSP(bf16_t, WS_WGLU)}; EpiGlu E{WSP(bf16_t, WS_G), WSP(bf16_t, WS_YMIX), F.in[I_BGLU]};
        pg8::gemm_phase<EpiGlu, SchedGlu>(F.lds, S, E);
    }
    SEAM(6);
    if (IN(7)) REPS(7) {
        SchedOut S{16, 2048u, 2048u, F.G, F.bx, (const char*)WSP(bf16_t, WS_YMIX), (const char*)WSP(bf16_t, WS_WOUT)};
        EpiYX E{WSP(bf16_t, WS_YX), args.flags & 1};
        pg8::gemm_phase<EpiYX, SchedOut>(F.lds, S, E);
    }
    SEAM(7);
    if (IN(8)) REPS(8) { p8_phase(F); }
    SEAM(8);
    if (IN(9)) REPS(9) { p9_phase(F); }
    SEAM(9);
    if (IN(10)) REPS(10) {
        const int ntiles = ld_agent_i(WSP(int, WS_TILES));
        SchedUp S{8, 1024u, 1024u, F.G, F.vcu, ntiles, (const char*)WSP(bf16_t, WS_X1G), (const char*)WSP(bf16_t, WS_W13), WSP(int, WS_PERM), WSP(int, WS_TILES), (const char*)WSP(u32x4, WS_SLOT), (const char*)WSP(bf16_t, WS_SB13)};
        EpiUp E{WSP(unsigned char, WS_HID), F.lds};
        pg8::gemm_phase<EpiUp, SchedUp>(F.lds, S, E);
    }
    SEAM(10);
    if (IN(11)) REPS(11) {
        const int ntiles = ld_agent_i(WSP(int, WS_TILES));
        SchedDown S{8, 1024u, 512u, F.G, F.vcu, ntiles, (const char*)WSP(bf16_t, WS_HID), (const char*)WSP(bf16_t, WS_W2), WSP(int, WS_TILES), (const char*)WSP(u32x4, WS_SLOT)};
        EpiDown E{WSP(bf16_t, WS_MOE), F.lds};
        pg8::gemm_phase<EpiDown, SchedDown>(F.lds, S, E);
    }
    SEAM(11);
    if (IN(12)) REPS(12) { p12_phase(F); }
#undef IN
#undef SEAM
}

extern "C" void kernel_launch(void* const* d_in, const int* in_sizes, int n_in, void* d_out, int out_size, void* d_ws, size_t ws_size, hipStream_t stream) {
    static int grid = 0;
    if (grid == 0) {
        if (n_in != 29 || out_size != TOK * DM || ws_size < WS_END) { fprintf(stderr, "kernel_launch: unexpected problem (n_in %d, out %d, ws %zu)\n", n_in, out_size, ws_size); grid = -1; return; }
        int dev = 0, cus = 0, per_cu = 0;
        if (hipGetDevice(&dev) != hipSuccess || hipDeviceGetAttribute(&cus, hipDeviceAttributeMultiprocessorCount, dev) != hipSuccess) { grid = -1; return; }
        if (hipFuncSetAttribute((const void*)mk_fwd, hipFuncAttributeMaxDynamicSharedMemorySize, LDS_BYTES) != hipSuccess) { fprintf(stderr, "kernel_launch: hipFuncSetAttribute failed\n"); grid = -1; return; }
        if (hipOccupancyMaxActiveBlocksPerMultiprocessor(&per_cu, (const void*)mk_fwd, 512, LDS_BYTES) != hipSuccess || per_cu < 1) { fprintf(stderr, "kernel_launch: occupancy query gives %d\n", per_cu); (void)hipGetLastError(); per_cu = 1; }
        grid = cus;
        if (grid > 256) grid = 256;
    }
    if (grid < 0) return;
    Args a{};
    for (int i = 0; i < 29; ++i) a.in[i] = (const float*)d_in[i];
    a.out = (float*)d_out; a.ws = (unsigned char*)d_ws;
#if MK_ONE_LAUNCH == 1
    a.ph_lo = 0; a.ph_hi = NPHASE;
    void* kargs[] = {&a};
    hipError_t e = hipLaunchCooperativeKernel((const void*)mk_fwd, dim3(grid), dim3(512), kargs, LDS_BYTES, stream);
    if (e != hipSuccess) fprintf(stderr, "cooperative launch failed: %s (grid %d)\n", hipGetErrorString(e), grid);
#elif MK_ONE_LAUNCH == 2
    if (hipMemsetAsync((char*)d_ws + WS_CTL, 0, CTL_ZERO_BYTES, stream) != hipSuccess) { fprintf(stderr, "kernel_launch: memset failed\n"); return; }
    a.ph_lo = 0; a.ph_hi = NPHASE;
    hipLaunchKernelGGL(mk_fwd, dim3(grid), dim3(512), LDS_BYTES, stream, a);
#if MK_PROBE_PHASE >= 0
    a.ph_lo = MK_PROBE_PHASE; a.ph_hi = MK_PROBE_PHASE + 1; a.flags = MK_PROBE_FLAGS;
    hipLaunchKernelGGL(mk_fwd, dim3(grid), dim3(512), LDS_BYTES, stream, a);
#endif
#else
    for (int p = 0; p < NPHASE; ++p) { a.ph_lo = p; a.ph_hi = p + 1; hipLaunchKernelGGL(mk_fwd, dim3(grid), dim3(512), LDS_BYTES, stream, a); }
#endif
}
```

```cpp
#include <hip/hip_runtime.h>
#include <hip/hip_cooperative_groups.h>
#include <cstdio>
namespace cg = cooperative_groups;

#ifndef MK_SPLIT_AT
#define MK_SPLIT_AT -1
#endif
#ifndef MK_SPLIT_DUP
#define MK_SPLIT_DUP 0
#endif
#ifndef MK_TIME_A
#define MK_TIME_A -1
#endif
#ifndef MK_TIME_B
#define MK_TIME_B -1
#endif
#ifndef MK_PROBE_FLAGS
#define MK_PROBE_FLAGS 0
#endif
#ifndef MK_PROBE_PHASE
#define MK_PROBE_PHASE -1
#endif
#ifndef MK_REP
#define MK_REP 0
#endif
#ifndef MK_ONE_LAUNCH
#define MK_ONE_LAUNCH 2
#endif

#define DEV __device__ __forceinline__
#define LAS __attribute__((address_space(3)))
typedef unsigned short bf16_t;
typedef short bf16x8 __attribute__((ext_vector_type(8)));
typedef float f32x4 __attribute__((ext_vector_type(4)));
typedef float f32x2 __attribute__((ext_vector_type(2)));
typedef unsigned u32x4 __attribute__((ext_vector_type(4)));
typedef unsigned u32x2 __attribute__((ext_vector_type(2)));

constexpr int NB = 32, SEQ = 2048, DM = 1024, TOK = NB * SEQ, CTXL = 256, CTOK = NB * CTXL;
constexpr int NG = 16, NP = 64, NH = 16, LC = 32;
constexpr int NCH_LAT = TOK / LC, NCH_CTX = CTOK / LC, NCH_PAD = 2304, UK = LC * NH, UGK = UK + 256, TRN = LC * NH;
static_assert(NCH_LAT + NCH_CTX == NCH_PAD && NCH_PAD % 256 == 0 && (UGK / 64) % 2 == 0 && (UK / 64) % 2 == 0, "S5 chunk geometry");
constexpr int CONVW = 768, NMOD = 6 * DM;
constexpr int NEXP = 16, DEXP = 512, NBUCKET = 24, MAXTILES = 280;
constexpr float RMS_EPS = 1e-6f;

constexpr size_t MiB = 1u << 20;
constexpr size_t WS_CTL = 0;
constexpr size_t WS_STAMP = 512 * 1024;
constexpr size_t WS_MOD = 1 * MiB;
constexpr size_t WS_APOW = 2 * MiB;
constexpr size_t WS_BBAR = 4 * MiB;
constexpr size_t WS_KTAB = 5 * MiB;
constexpr size_t WS_SB13 = 7 * MiB;
constexpr size_t WS_SH2 = 9 * MiB;
constexpr size_t WS_RB = 10 * MiB;
constexpr size_t WS_TOKB = 10 * MiB + 65536;
constexpr size_t WS_TOKW = 11 * MiB;
constexpr size_t WS_TOKR = 12 * MiB;
constexpr size_t WS_SEGC = 12 * MiB + 512 * 1024;
constexpr size_t WS_PERM = 13 * MiB;
constexpr size_t WS_TILES = 14 * MiB;
constexpr size_t WS_CSCALE = 15 * MiB;
constexpr size_t WS_RSCALE = 15 * MiB + 65536;
constexpr size_t WS_SLOT = 16 * MiB;
constexpr size_t WS_WR = 24 * MiB;
constexpr size_t WS_WGLU = 25 * MiB;
constexpr size_t WS_WIN = 26 * MiB;
constexpr size_t WS_WOUT = 32 * MiB;
constexpr size_t WS_WE = 34 * MiB;
constexpr size_t WS_W2 = 42 * MiB;
constexpr size_t WS_W13 = 58 * MiB;
constexpr size_t WS_TR = 186 * MiB;
constexpr size_t WS_E = 90 * MiB;
constexpr size_t WS_UG = 130 * MiB;
static_assert(WS_E + (size_t)16 * NCH_PAD * 256 * 4 <= WS_UG && WS_UG + (size_t)16 * NCH_PAD * UGK * 2 <= WS_TR && WS_TR + (size_t)16 * TRN * UGK * 2 <= 200 * MiB, "S5 workspace map");
constexpr size_t WS_G = 200 * MiB;
constexpr size_t WS_BG = 232 * MiB;
constexpr size_t WS_CV = 328 * MiB;
constexpr size_t WS_HX = 424 * MiB;
constexpr size_t WS_HID = WS_HX;
constexpr size_t WS_YX = WS_BG;
constexpr size_t WS_YMIX = 568 * MiB;
constexpr size_t WS_X1G = 696 * MiB;
constexpr size_t WS_MOE = WS_YMIX;
constexpr size_t WS_X1B = 824 * MiB;
constexpr size_t WS_END = 952 * MiB;

DEV unsigned cvt_pk_bf16(float lo, float hi) { unsigned r; asm volatile("v_cvt_pk_bf16_f32 %0, %1, %2" : "=v"(r) : "v"(lo), "v"(hi)); return r; }
DEV float bf2f(unsigned short h) { return __uint_as_float(((unsigned)h) << 16); }
DEV float bflo(unsigned w) { return __uint_as_float(w << 16); }
DEV float bfhi(unsigned w) { return __uint_as_float(w & 0xffff0000u); }
DEV float wave_sum(float v) {
#pragma unroll
    for (int o = 1; o < 64; o <<= 1) v += __shfl_xor(v, o);
    return v;
}
DEV float sigmoidf_(float x) { return __builtin_amdgcn_rcpf(1.0f + __expf(-x)); }
DEV float siluf_(float x) { return x * sigmoidf_(x); }
DEV float gelu_tanh(float x) { const float u = 0.7978845608028654f * (x + 0.044715f * x * x * x); return x * sigmoidf_(2.0f * u); }
typedef int v8i_t __attribute__((ext_vector_type(8)));
typedef int v4i_t __attribute__((ext_vector_type(4)));
DEV float clamp_e4m3(float v) { return __builtin_amdgcn_fmed3f(v, -448.0f, 448.0f); }
DEV unsigned pk4_fp8(float a, float b, float c, float d) { int w = 0; w = __builtin_amdgcn_cvt_pk_fp8_f32(clamp_e4m3(a), clamp_e4m3(b), w, false); w = __builtin_amdgcn_cvt_pk_fp8_f32(clamp_e4m3(c), clamp_e4m3(d), w, true); return (unsigned)w; }
constexpr float FP8_WSCALE = 16.0f;
DEV int ld_agent_i(const int* p) { return __hip_atomic_load(p, __ATOMIC_RELAXED, __HIP_MEMORY_SCOPE_AGENT); }

#ifndef PG8_SP2
#define PG8_SP2 true
#endif
namespace pg8 {
constexpr int BM = 256, BK = 64, HALF = 128, HTB = HALF * BK * 2, STAGE_BYTES = 8 * HTB;
__host__ __device__ __forceinline__ int lds_byte(int r, int c) { const int st = (r >> 4) * 2 + (c >> 5), rr = r & 15, cc = c & 31, ob = rr * 64 + cc * 2; return st * 1024 + (ob ^ (((ob >> 9) & 1) << 5)); }
__host__ __device__ __forceinline__ void stage_rc(int b, int& R, int& C) { const int st = b / 1024, sb = b % 1024, swz = sb ^ (((sb >> 9) & 1) << 5); R = (st >> 1) * 16 + swz / 64; C = (st & 1) * 32 + (swz % 64) / 2; }
__host__ __device__ __forceinline__ int perm32(int rho) { const int n = rho >> 4, i = rho & 15; return 8 * (i >> 2) + 4 * n + (i & 3); }

struct Unit {
    const char* A0; const char* A1; const char* B0; const char* B1;
    int ksA, ksB;
    int p0, p1, p2, p3, q;
};
DEV const char* pa(const Unit& u, int kt) { return kt < u.ksA ? u.A0 + (size_t)kt * 128 : u.A1 + (size_t)(kt - u.ksA) * 128; }
DEV const char* pb(const Unit& u, int kt) { return kt < u.ksB ? u.B0 + (size_t)kt * 128 : u.B1 + (size_t)(kt - u.ksB) * 128; }

template <class Epi, class Sched>
DEV void gemm_phase(LAS unsigned char* lds, const Sched& S, const Epi& E) {
    const int tid = threadIdx.x, wid = __builtin_amdgcn_readfirstlane(tid >> 6), lane = tid & 63, wr = wid >> 2, wc = wid & 3, fr = lane & 15, fq = lane >> 4;
    int nt = S.nt; asm volatile("" : "+s"(nt));
    unsigned voffB[2], vA[4];
#pragma unroll
    for (int i = 0; i < 2; ++i) { int R_, C_; stage_rc(tid * 16 + i * 8192, R_, C_); const int Rb = Epi::PERM ? ((R_ & ~31) + perm32(R_ & 31)) : R_;
        voffB[i] = (unsigned)Rb * S.ldb + (unsigned)C_ * 2u; }
    const size_t hstepB = (size_t)HALF * S.ldb;
    const unsigned ldsw = (unsigned)wid * 1024u;
    const int aoff = lds_byte(wr * 64 + fr, fq * 8), boff = lds_byte(wc * 32 + fr, fq * 8);
#define PG8_SA(b, h) (((b) * 2 + (h)) * HTB)
#define PG8_SB(b, h) ((4 + (b) * 2 + (h)) * HTB)
#define PG8_STAGE(bufoff, gbase, v0, v1) do { \
        __builtin_amdgcn_global_load_lds((const unsigned*)((const char*)(gbase) + (v0)), (LAS unsigned*)(lds + (bufoff) + ldsw), 16, 0, 0); \
        __builtin_amdgcn_global_load_lds((const unsigned*)((const char*)(gbase) + (v1)), (LAS unsigned*)(lds + (bufoff) + ldsw + 8192), 16, 0, 0); } while (0)
#define PG8_LDA(dst, b, h) do { if constexpr (Sched::FP8) { _Pragma("unroll") for (int m = 0; m < 4; ++m) { const v4i_t lo_ = *(const LAS v4i_t*)(lds + PG8_SA(b, h) + aoff + m * 2048), hi_ = *(const LAS v4i_t*)(lds + PG8_SA(b, h) + aoff + m * 2048 + 1024); \
            dst##8[m] = __builtin_shufflevector(lo_, hi_, 0, 1, 2, 3, 4, 5, 6, 7); } } \
        else { _Pragma("unroll") for (int m = 0; m < 4; ++m) _Pragma("unroll") for (int k = 0; k < 2; ++k) dst[m][k] = *(const LAS bf16x8*)(lds + PG8_SA(b, h) + aoff + m * 2048 + k * 1024); } } while (0)
#define PG8_LDB(dst, b, h) do { if constexpr (Sched::FP8) { _Pragma("unroll") for (int n = 0; n < 2; ++n) { const v4i_t lo_ = *(const LAS v4i_t*)(lds + PG8_SB(b, h) + boff + n * 2048), hi_ = *(const LAS v4i_t*)(lds + PG8_SB(b, h) + boff + n * 2048 + 1024); \
            dst##8[n] = __builtin_shufflevector(lo_, hi_, 0, 1, 2, 3, 4, 5, 6, 7); } } \
        else { _Pragma("unroll") for (int n = 0; n < 2; ++n) _Pragma("unroll") for (int k = 0; k < 2; ++k) dst[n][k] = *(const LAS bf16x8*)(lds + PG8_SB(b, h) + boff + n * 2048 + k * 1024); } } while (0)
#define PG8_MMA(ai, bj, At, Bt) do { __builtin_amdgcn_s_setprio(1); _Pragma("unroll") for (int m = 0; m < 4; ++m) _Pragma("unroll") for (int n = 0; n < 2; ++n) { \
        if constexpr (Sched::FP8)   \
            asm volatile("v_mfma_scale_f32_16x16x128_f8f6f4 %0, %1, %2, %0, %3, %3 op_sel_hi:[0,0,0]" : "+v"(acc[ai][bj][m][n]) : "v"(Bt##8[n]), "v"(At##8[m]), "v"(sc_one));   \
        else if constexpr (Sched::I8) { _Pragma("unroll") for (int k = 0; k < 2; ++k) acc[ai][bj][m][n] = __builtin_bit_cast(f32x4, __builtin_amdgcn_mfma_i32_16x16x64_i8(__builtin_bit_cast(v4i_t, Bt[n][k]), __builtin_bit_cast(v4i_t, At[m][k]), __builtin_bit_cast(v4i_t, acc[ai][bj][m][n]), 0, 0, 0)); }   \
        else { _Pragma("unroll") for (int k = 0; k < 2; ++k) acc[ai][bj][m][n] = __builtin_amdgcn_mfma_f32_16x16x32_bf16(Bt[n][k], At[m][k], acc[ai][bj][m][n], 0, 0, 0); } } \
        __builtin_amdgcn_s_setprio(0); } while (0)
#define PG8_WAIT_V(n) asm volatile("s_waitcnt vmcnt(" #n ")" ::: "memory")
#define PG8_WAIT_L(n) asm volatile("s_waitcnt lgkmcnt(" #n ")" ::: "memory")
#define PG8_BAR __builtin_amdgcn_s_barrier()
#define PG8_SCHED __builtin_amdgcn_sched_barrier(0)
    Unit cur, nxt; int ui = 0;
    int aux_t = 0; asm volatile("" : "+s"(aux_t));
    if (!S.next(0, cur)) return;
    f32x4 acc[2][2][4][2];
#pragma unroll
    for (int a = 0; a < 2; ++a)
#pragma unroll
        for (int b = 0; b < 2; ++b)
#pragma unroll
            for (int m = 0; m < 4; ++m)
#pragma unroll
                for (int n = 0; n < 2; ++n) acc[a][b][m][n] = (f32x4){0.f, 0.f, 0.f, 0.f};
    bf16x8 At[4][2], B0[2][2], B1[2][2];
    v8i_t At8[4], B08[2], B18[2];
    int sc_one = 0x7f7f7f7f; asm volatile("" : "+v"(sc_one));
    if constexpr (Sched::GATHER) S.rows(cur, tid, vA);
    else {
#pragma unroll
        for (int h = 0; h < 2; ++h)
#pragma unroll
            for (int i = 0; i < 2; ++i) { int R_, C_; stage_rc(tid * 16 + i * 8192, R_, C_); vA[h * 2 + i] = (unsigned)(h * HALF + R_) * S.lda + (unsigned)C_ * 2u; }
    }
    {
        const char* a0 = pa(cur, 0); const char* b0 = pb(cur, 0); const char* a1 = pa(cur, 1); const char* b1 = pb(cur, 1);
        if constexpr (PG8_SP2) {
            PG8_STAGE(PG8_SB(0, 0), b0, voffB[0], voffB[1]); PG8_STAGE(PG8_SB(0, 1), b0 + hstepB, voffB[0], voffB[1]); PG8_STAGE(PG8_SA(0, 0), a0, vA[0], vA[1]); PG8_STAGE(PG8_SA(0, 1), a0, vA[2], vA[3]);
            if (wr == 1) PG8_BAR;
            PG8_WAIT_V(2); PG8_BAR;
            PG8_STAGE(PG8_SB(1, 0), b1, voffB[0], voffB[1]); PG8_STAGE(PG8_SA(1, 0), a1, vA[0], vA[1]); PG8_STAGE(PG8_SB(1, 1), b1 + hstepB, voffB[0], voffB[1]);
            PG8_WAIT_V(6); PG8_BAR;
        } else {
        PG8_STAGE(PG8_SB(0, 0), b0, voffB[0], voffB[1]); PG8_STAGE(PG8_SA(0, 0), a0, vA[0], vA[1]); PG8_STAGE(PG8_SB(0, 1), b0 + hstepB, voffB[0], voffB[1]); PG8_STAGE(PG8_SA(0, 1), a0, vA[2], vA[3]);
        if (wr == 1) PG8_BAR;
        PG8_WAIT_V(4); PG8_BAR;
        PG8_STAGE(PG8_SB(1, 0), b1, voffB[0], voffB[1]); PG8_STAGE(PG8_SA(1, 0), a1, vA[0], vA[1]); PG8_STAGE(PG8_SB(1, 1), b1 + hstepB, voffB[0], voffB[1]);
        PG8_WAIT_V(6); PG8_BAR;
        }
    }
    for (;;) {
        const bool has_next = S.next(ui + 1, nxt);
        if (!has_next) nxt = cur;
#pragma unroll 1
        for (int t = 0; t < nt; t += 2) {
            const bool last = (t == nt - 2);
            const char* a1 = pa(cur, t + 1);
            const char* a2; const char* b2;
            if (last) { a2 = pa(nxt, 0); b2 = pb(nxt, 0); } else { a2 = pa(cur, t + 2); b2 = pb(cur, t + 2); }
            const char* a3 = a2 + 128; const char* b3 = b2 + 128;
            if constexpr (PG8_SP2) {
            PG8_LDB(B0, 0, 0); PG8_LDB(B1, 0, 1); PG8_SCHED; PG8_LDA(At, 0, 0); PG8_STAGE(PG8_SA(1, 1), a1, vA[2], vA[3]);
            if constexpr (Sched::GATHER) { if (last && has_next) S.rows(nxt, tid, vA); }
            PG8_WAIT_V(8); PG8_WAIT_L(0); PG8_BAR; PG8_MMA(0, 0, At, B0); PG8_MMA(0, 1, At, B1); PG8_BAR; PG8_SCHED;
            PG8_LDA(At, 0, 1); PG8_STAGE(PG8_SB(0, 0), b2, voffB[0], voffB[1]); PG8_STAGE(PG8_SB(0, 1), b2 + hstepB, voffB[0], voffB[1]); PG8_STAGE(PG8_SA(0, 0), a2, vA[0], vA[1]);
            if constexpr (Sched::AUX) { if (t == aux_t) S.aux(cur, nxt, lds, wid, lane); }
            PG8_WAIT_V(8); PG8_WAIT_L(0); PG8_BAR; PG8_MMA(1, 0, At, B0); PG8_MMA(1, 1, At, B1); PG8_BAR; PG8_SCHED;
            PG8_LDB(B0, 1, 0); PG8_LDB(B1, 1, 1); PG8_SCHED; PG8_LDA(At, 1, 0); PG8_STAGE(PG8_SA(0, 1), a2, vA[2], vA[3]);
            PG8_WAIT_V(8); PG8_WAIT_L(0); PG8_BAR; PG8_MMA(0, 0, At, B0); PG8_MMA(0, 1, At, B1); PG8_BAR; PG8_SCHED;
            PG8_LDA(At, 1, 1); PG8_STAGE(PG8_SB(1, 0), b3, voffB[0], voffB[1]); PG8_STAGE(PG8_SB(1, 1), b3 + hstepB, voffB[0], voffB[1]); PG8_STAGE(PG8_SA(1, 0), a3, vA[0], vA[1]);
            PG8_WAIT_V(8); PG8_WAIT_L(0); PG8_BAR; PG8_MMA(1, 0, At, B0); PG8_MMA(1, 1, At, B1); PG8_BAR; PG8_SCHED;
            } else {
            PG8_LDB(B0, 0, 0); PG8_SCHED; PG8_LDA(At, 0, 0); PG8_STAGE(PG8_SA(1, 1), a1, vA[2], vA[3]);
            if constexpr (Sched::GATHER) { if (last && has_next) S.rows(nxt, tid, vA); }
            PG8_WAIT_L(8); PG8_BAR; PG8_WAIT_L(0); PG8_MMA(0, 0, At, B0); PG8_BAR; PG8_SCHED;
            PG8_LDB(B1, 0, 1); PG8_STAGE(PG8_SB(0, 0), b2, voffB[0], voffB[1]);
            PG8_BAR; PG8_WAIT_L(0); PG8_MMA(0, 1, At, B1); PG8_BAR;
            PG8_LDA(At, 0, 1); PG8_STAGE(PG8_SA(0, 0), a2, vA[0], vA[1]);
            if constexpr (Sched::AUX) { if (t == aux_t) S.aux(cur, nxt, lds, wid, lane); }
            PG8_BAR; PG8_WAIT_L(0); PG8_MMA(1, 0, At, B0); PG8_BAR; PG8_SCHED;
            PG8_STAGE(PG8_SB(0, 1), b2 + hstepB, voffB[0], voffB[1]);
            PG8_WAIT_V(6); PG8_BAR; PG8_MMA(1, 1, At, B1); PG8_BAR;
            PG8_LDB(B0, 1, 0); PG8_SCHED; PG8_LDA(At, 1, 0); PG8_STAGE(PG8_SA(0, 1), a2, vA[2], vA[3]);
            PG8_WAIT_L(8); PG8_BAR; PG8_WAIT_L(0); PG8_MMA(0, 0, At, B0); PG8_BAR; PG8_SCHED;
            PG8_LDB(B1, 1, 1); PG8_STAGE(PG8_SB(1, 0), b3, voffB[0], voffB[1]);
            PG8_BAR; PG8_WAIT_L(0); PG8_MMA(0, 1, At, B1); PG8_BAR;
            PG8_LDA(At, 1, 1); PG8_STAGE(PG8_SA(1, 0), a3, vA[0], vA[1]);
            PG8_BAR; PG8_WAIT_L(0); PG8_MMA(1, 0, At, B0); PG8_BAR; PG8_SCHED;
            PG8_STAGE(PG8_SB(1, 1), b3 + hstepB, voffB[0], voffB[1]);
            PG8_WAIT_V(6); PG8_BAR; PG8_MMA(1, 1, At, B1); PG8_BAR;
            }
        }
        if (wr == 0) PG8_BAR;
        if constexpr (Sched::FP8) asm volatile("s_nop 15\n\ts_nop 15" ::: "memory");
        E(acc, cur, wr, wc, fr, fq);
        if (!has_next) break;
#pragma unroll
        for (int a = 0; a < 2; ++a)
#pragma unroll
            for (int b = 0; b < 2; ++b)
#pragma unroll
                for (int m = 0; m < 4; ++m)
#pragma unroll
                    for (int n = 0; n < 2; ++n) acc[a][b][m][n] = (f32x4){0.f, 0.f, 0.f, 0.f};
        cur = nxt; ++ui;
        if (wr == 1) PG8_BAR;
    }
    PG8_WAIT_V(0);
    PG8_BAR;
#undef PG8_SA
#undef PG8_SB
#undef PG8_STAGE
#undef PG8_LDA
#undef PG8_LDB
#undef PG8_MMA
#undef PG8_WAIT_V
#undef PG8_WAIT_L
#undef PG8_BAR
#undef PG8_SCHED
}

DEV void static_tile(int L, int nM, int nN, int& pm, int& pn) {
    const int nwg = nM * nN; int wgid = L;
    { const int q = nwg / 8, r = nwg % 8, xcd = wgid % 8, off = wgid / 8; wgid = (xcd < r ? xcd * (q + 1) : r * (q + 1) + (xcd - r) * q) + off; }
    const int nig = 8 * nN, gid = wgid / nig, fm = gid * 8, gsz = (nM - fm) < 8 ? (nM - fm) : 8;
    pm = fm + ((wgid % nig) % gsz); pn = (wgid % nig) / gsz;
}
}
using pg8::Unit;
constexpr int AUX_SLOT_OFF = 131072, AUX_BIAS_OFF = 131072 + 8192, AUX_TILE_OFF = AUX_BIAS_OFF + 16384;
DEV void glds16(const void* g, LAS unsigned char* l) { __builtin_amdgcn_global_load_lds((const unsigned*)g, (LAS unsigned*)l, 16, 0, 0); }

struct Args { const float* in[29]; float* out; unsigned char* ws; int ph_lo, ph_hi, flags, li; };
static_assert(sizeof(Args) == 31 * 8 + 16, "Args has no padding");
enum { I_X = 0, I_C, I_CTX, I_CCTX, I_WMOD, I_BMOD, I_N1G, I_N2G, I_WIN, I_LRE, I_LIM, I_LOGDT, I_BRE, I_BIM, I_CRE, I_CIM, I_S5D, I_WGLU, I_BGLU, I_CONVW, I_WOUT,
       I_RGW, I_RGB, I_REW, I_REB, I_W1, I_W3, I_W2, I_FING };

struct Frame {
    LAS unsigned char* lds;
    int G, bx, vcu, flags;
    const float* in[29]; float* out; unsigned char* ws;
};
#define WSP(T, off) ((T*)(F.ws + (off)))
#define F_TID ((int)threadIdx.x)
#define F_LANE ((int)threadIdx.x & 63)
#define F_WAVE (__builtin_amdgcn_readfirstlane((int)threadIdx.x >> 6))

DEV void p0_mod_item(Frame& F, int item) {
    LAS float* st = (LAS float*)F.lds;
    LAS float* red = (LAS float*)(F.lds + 512 * 36 * 4);
    const float* c = F.in[I_C]; const float* cc = F.in[I_CCTX]; const float* wm = F.in[I_WMOD]; const float* bm = F.in[I_BMOD];
    float* mod = WSP(float, WS_MOD);
    const int col = F_TID & 31, kc = F_TID >> 5, j0 = item * 32;
    float acc[36];
#pragma unroll
    for (int n = 0; n < 36; ++n) acc[n] = 0.f;
    for (int half = 0; half < 2; ++half) {
        __syncthreads();
        { float cv_[33];
#pragma unroll
          for (int n = 0; n < 33; ++n) cv_[n] = (n < 32) ? c[n * DM + half * 512 + F_TID] : cc[half * 512 + F_TID];
#pragma unroll
          for (int n = 0; n < 33; ++n) st[F_TID * 36 + n] = siluf_(cv_[n]); }
        float wv[32];
#pragma unroll
        for (int i = 0; i < 32; ++i) wv[i] = wm[(size_t)(half * 512 + kc + 16 * i) * NMOD + j0 + col];
        __syncthreads();
#pragma unroll 2
        for (int i = 0; i < 32; ++i) { const int kk = kc + 16 * i; const float w = wv[i]; const LAS f32x4* sp = (const LAS f32x4*)(st + kk * 36);
#pragma unroll
            for (int q = 0; q < 9; ++q) { const f32x4 sv = sp[q]; acc[4 * q] += sv.x * w; acc[4 * q + 1] += sv.y * w; acc[4 * q + 2] += sv.z * w; acc[4 * q + 3] += sv.w * w; }
        }
    }
#pragma unroll
    for (int n = 0; n < 33; ++n) red[(kc * 33 + n) * 32 + col] = acc[n];
    __syncthreads();
    for (int idx = F_TID; idx < 33 * 32; idx += 512) { const int n = idx >> 5, cl = idx & 31; float s_ = bm[j0 + cl];
#pragma unroll
        for (int q = 0; q < 16; ++q) s_ += red[(q * 33 + n) * 32 + cl];
        mod[n * NMOD + j0 + cl] = s_; }
    __syncthreads();
}
DEV void p0_transpose_item(const float* W, int N, int k0, int n0, bf16_t* dst, int ldk, LAS float* scr, int lane) {
    float t_[32];
#pragma unroll
    for (int i = 0; i < 32; ++i) t_[i] = W[(size_t)(k0 + 2 * i + (lane >> 5)) * N + n0 + (lane & 31)];
#pragma unroll
    for (int i = 0; i < 32; ++i) scr[(2 * i + (lane >> 5)) * 33 + (lane & 31)] = t_[i];
    asm volatile("s_waitcnt lgkmcnt(0)" ::: "memory");
    const int cch = lane & 7;
#pragma unroll
    for (int j = 0; j < 4; ++j) { const int n = (lane >> 3) + 8 * j; const LAS float* s = scr + (8 * cch) * 33 + n;
        u32x4 o; o.x = cvt_pk_bf16(s[0 * 33], s[1 * 33]); o.y = cvt_pk_bf16(s[2 * 33], s[3 * 33]); o.z = cvt_pk_bf16(s[4 * 33], s[5 * 33]); o.w = cvt_pk_bf16(s[6 * 33], s[7 * 33]);
        *(u32x4*)(dst + (size_t)n * ldk + k0 + 8 * cch) = o; }
    asm volatile("s_waitcnt lgkmcnt(0)" ::: "memory");
}
DEV void p0_transpose_item_fp8(const float* W, int N, int k0, int n0, unsigned char* dst, int ldk, float scale, LAS float* scr, int lane) {
    float t_[32];
#pragma unroll
    for (int i = 0; i < 32; ++i) t_[i] = W[(size_t)(k0 + 2 * i + (lane >> 5)) * N + n0 + (lane & 31)];
#pragma unroll
    for (int i = 0; i < 32; ++i) scr[(2 * i + (lane >> 5)) * 33 + (lane & 31)] = t_[i] * scale;
    asm volatile("s_waitcnt lgkmcnt(0)" ::: "memory");
    const int cch = lane & 7;
#pragma unroll
    for (int j = 0; j < 4; ++j) { const int n = (lane >> 3) + 8 * j; const LAS float* s = scr + (8 * cch) * 33 + n;
        u32x2 o; o.x = pk4_fp8(s[0 * 33], s[1 * 33], s[2 * 33], s[3 * 33]); o.y = pk4_fp8(s[4 * 33], s[5 * 33], s[6 * 33], s[7 * 33]);
        *(u32x2*)(dst + (size_t)n * ldk + k0 + 8 * cch) = o; }
    asm volatile("s_waitcnt lgkmcnt(0)" ::: "memory");
}
DEV void p0_win_group_i8(const float* W, int n0, unsigned char* dst, float* cscale, LAS unsigned char* lds, int wave, int lane) {
    LAS float* scr = (LAS float*)(lds + wave * 8448); LAS float* mxs = (LAS float*)(lds + 8 * 8448);
    float t0[32], t1[32];
#pragma unroll
    for (int i = 0; i < 32; ++i) { t0[i] = W[(size_t)(wave * 128 + 2 * i + (lane >> 5)) * 2560 + n0 + (lane & 31)]; t1[i] = W[(size_t)(wave * 128 + 64 + 2 * i + (lane >> 5)) * 2560 + n0 + (lane & 31)]; }
    float mx = 0.f;
#pragma unroll
    for (int i = 0; i < 32; ++i) mx = fmaxf(mx, fmaxf(fabsf(t0[i]), fabsf(t1[i])));
    mx = fmaxf(mx, __shfl_xor(mx, 32));
    if (lane < 32) mxs[wave * 32 + lane] = mx;
    __syncthreads();
    mx = 0.f;
#pragma unroll
    for (int w = 0; w < 8; ++w) mx = fmaxf(mx, mxs[w * 32 + (lane & 31)]);
    const float sc = (mx > 0.f) ? mx * (1.0f / 127.0f) : 1.0f, inv = 1.0f / sc;
    if (wave == 0 && lane < 32) cscale[lane] = sc;
#pragma unroll
    for (int hb = 0; hb < 2; ++hb) {
#pragma unroll
        for (int i = 0; i < 32; ++i) scr[(2 * i + (lane >> 5)) * 33 + (lane & 31)] = (hb ? t1[i] : t0[i]) * inv;
        asm volatile("s_waitcnt lgkmcnt(0)" ::: "memory");
        const int cch = lane & 7;
#pragma unroll
        for (int j = 0; j < 4; ++j) { const int n = (lane >> 3) + 8 * j; const LAS float* s_ = scr + (8 * cch) * 33 + n; unsigned w0 = 0, w1 = 0;
#pragma unroll
            for (int q = 0; q < 4; ++q) { w0 |= ((unsigned)__float2int_rn(s_[q * 33]) & 0xffu) << (8 * q); w1 |= ((unsigned)__float2int_rn(s_[(4 + q) * 33]) & 0xffu) << (8 * q); }
            *(u32x2*)(dst + (size_t)n * 1024 + wave * 128 + hb * 64 + 8 * cch) = (u32x2){w0, w1}; }
        asm volatile("s_waitcnt lgkmcnt(0)" ::: "memory"); }
    __syncthreads();
}
DEV void sincos_rev(double rev, double& s, double& c) {
    const double fr = rev - __builtin_rint(rev);
    const double q = __builtin_rint(fr * 4.0);
    const double y = (fr - q * 0.25) * 6.283185307179586476925;
    const double y2 = y * y;
    const double sy = y * (1.0 + y2 * (-1.0 / 6 + y2 * (1.0 / 120 + y2 * (-1.0 / 5040 + y2 * (1.0 / 362880 + y2 * (-1.0 / 39916800 + y2 * (1.0 / 6227020800.0)))))));
    const double cy = 1.0 + y2 * (-0.5 + y2 * (1.0 / 24 + y2 * (-1.0 / 720 + y2 * (1.0 / 40320 + y2 * (-1.0 / 3628800 + y2 * (1.0 / 479001600.0 + y2 * (-1.0 / 87178291200.0)))))));
    const int qi = ((int)q) & 3;
    s = (qi == 0) ? sy : (qi == 1) ? cy : (qi == 2) ? -sy : -cy;
    c = (qi == 0) ? cy : (qi == 1) ? -sy : (qi == 2) ? -cy : sy;
}
DEV double exp_d(double x) {
    const double k = __builtin_rint(x * 1.4426950408889634074);
    const double r = x - k * 0.69314718055994530942;
    double p = 1.0 / 6227020800.0;
    p = p * r + 1.0 / 479001600.0; p = p * r + 1.0 / 39916800.0; p = p * r + 1.0 / 3628800.0; p = p * r + 1.0 / 362880.0; p = p * r + 1.0 / 40320.0; p = p * r + 1.0 / 5040.0;
    p = p * r + 1.0 / 720.0; p = p * r + 1.0 / 120.0; p = p * r + 1.0 / 24.0; p = p * r + 1.0 / 6.0; p = p * r + 0.5; p = p * r + 1.0; p = p * r + 1.0;
    const long long e = (long long)k + 1023;
    return p * __builtin_bit_cast(double, (unsigned long long)e << 52);
}
DEV void p0_phase(Frame& F) {
    if (!(F.flags & 2)) for (int it = F.bx; it < NMOD / 32; it += F.G) p0_mod_item(F, it);
    __syncthreads();
    if (!(F.flags & 4) && F.bx >= F.G - 80) {
        const int n0 = (F.bx - (F.G - 80)) * 32; int drow;
        if (n0 < 1024) drow = n0;
        else if (n0 < 1792) { const int j = n0 - 1024; drow = 1024 + (j >> 7) * 256 + (j & 127); }
        else { const int j = n0 - 1792; drow = 1024 + (j >> 7) * 256 + 128 + (j & 127); }
        p0_win_group_i8(F.in[I_WIN], n0, WSP(unsigned char, WS_WIN) + (size_t)drow * 1024, WSP(float, WS_CSCALE) + drow, F.lds, F_WAVE, F_LANE);
    }
    if (!(F.flags & 4)) {
        LAS float* scr = (LAS float*)(F.lds + F_WAVE * 8448);
        bf16_t* Win = WSP(bf16_t, WS_WIN); bf16_t* Wout = WSP(bf16_t, WS_WOUT); bf16_t* Wglu = WSP(bf16_t, WS_WGLU); unsigned char* W13 = WSP(unsigned char, WS_W13); unsigned char* W2 = WSP(unsigned char, WS_W2);
        const int gw = F.vcu * 8 + F_WAVE, NGW = F.G * 8;
        constexpr int I_IN = 0, I_OUT = 16 * 32, I_GLU = 4 * 8, I_E = 16 * 256;
        for (int it = gw; it < I_IN + I_OUT + I_GLU + 3 * I_E; it += NGW) {
            int r = it;
            r -= I_IN;
            if (r < I_OUT) { const int kb = r / 32, nb = r % 32; p0_transpose_item(F.in[I_WOUT], 1024, kb * 64, nb * 32, Wout + (size_t)(nb * 32) * 1024, 1024, scr, F_LANE); continue; }
            r -= I_OUT;
            if (r < I_GLU) { const int kb = r / 8, nb = r % 8; p0_transpose_item(F.in[I_WGLU], 256, kb * 64, nb * 32, Wglu + (size_t)(nb * 32) * 256, 256, scr, F_LANE); continue; }
            r -= I_GLU;
            if (r < 2 * I_E) { const int which = r / I_E; const int rr = r % I_E; const int e = rr >> 8, rem = rr & 255, kb = rem >> 4, nb = rem & 15, n0 = nb * 32;
                const int drow = (n0 >> 7) * 256 + which * 128 + (n0 & 127);
                p0_transpose_item_fp8(F.in[which ? I_W3 : I_W1] + (size_t)e * 1024 * 512, 512, kb * 64, n0, W13 + ((size_t)e * 1024 + drow) * 1024, 1024, FP8_WSCALE, scr, F_LANE); continue; }
            r -= 2 * I_E;
            { const int e = r >> 8, rem = r & 255, kb = rem >> 5, nb = rem & 31;
                p0_transpose_item_fp8(F.in[I_W2] + (size_t)e * 512 * 1024, 1024, kb * 64, nb * 32, W2 + ((size_t)e * 1024 + nb * 32) * 512, 512, FP8_WSCALE, scr, F_LANE); }
        }
    }
    {
        bf16_t* Wr = WSP(bf16_t, WS_WR);
        for (int idx = F.bx * 512 + F_TID; idx < 32 * 1024; idx += F.G * 512) { const int l = idx >> 10, k = idx & 1023;
            const float v = (l < 4) ? F.in[I_RGW][k * 4 + l] : (l < 20) ? F.in[I_REW][k * 16 + (l - 4)] : 0.f;
            Wr[idx] = (bf16_t)(cvt_pk_bf16(v, 0.f) & 0xffffu); }
    }
    if (!(F.flags & 8)) {
        f32x2* APOW = WSP(f32x2, WS_APOW); f32x2* BBAR = WSP(f32x2, WS_BBAR);
        const int gt = F.bx * 512 + F_TID, NT = F.G * 512;
        for (int idx = gt; idx < 2 * 16 * 65 * 64; idx += NT) {
            const int p = idx & 63, j = (idx >> 6) % 65, dg = idx / (64 * 65);
            const double lre = F.in[I_LRE][dg * 64 + p], lim = F.in[I_LIM][dg * 64 + p], dt = exp_d((double)F.in[I_LOGDT][dg]);
            const double mag = exp_d(lre * dt * j); double s, c; sincos_rev(lim * dt * j * 0.15915494309189533577, s, c);
            APOW[idx] = (f32x2){(float)(mag * c), (float)(mag * s)};
        }
        for (int idx = gt; idx < 2 * 16 * 64 * 16; idx += NT) {
            const int dgp = idx >> 4, dg = dgp >> 6;
            const double lre = F.in[I_LRE][dgp], lim = F.in[I_LIM][dgp], dt = exp_d((double)F.in[I_LOGDT][dg]);
            const double mag = exp_d(lre * dt); double s, c; sincos_rev(lim * dt * 0.15915494309189533577, s, c);
            const double nr = mag * c - 1.0, ni = mag * s, d2 = lre * lre + lim * lim;
            const double qr = (nr * lre + ni * lim) / d2, qi = (ni * lre - nr * lim) / d2;
            const double br = F.in[I_BRE][idx], bi = F.in[I_BIM][idx];
            BBAR[idx] = (f32x2){(float)(qr * br - qi * bi), (float)(qr * bi + qi * br)};
        }
    }
}

constexpr int LZ_WAVE = 16384;
DEV void lz_issue(const void* g, LAS unsigned char* lz, int piece) { __builtin_amdgcn_global_load_lds((const unsigned*)g, (LAS unsigned*)(lz + piece * 1024), 16, 0, 0); }
#define LZ_WAIT(n) asm volatile("s_waitcnt vmcnt(" #n ")" ::: "memory")

DEV void p1_norm_rows(Frame& F) {
    const float* mod = WSP(float, WS_MOD); bf16_t* HX = WSP(bf16_t, WS_HX); const float* g = F.in[I_N1G];
    const bool isctx = F.bx < 32;
    const int nlw = (F.G - 32) * 8, w = (F.bx - 32) * 8 + F_WAVE, rpw = (TOK + nlw - 1) / nlw;
    const int rbeg = isctx ? (TOK + F.bx * 256 + F_WAVE * 32) : (w * rpw < TOK ? w * rpw : TOK), rend = isctx ? rbeg + 32 : ((w + 1) * rpw < TOK ? (w + 1) * rpw : TOK);
    const int nb = (rend - rbeg + 1) >> 1;
    LAS unsigned char* lz = F.lds + F_WAVE * LZ_WAVE;
#define P1_ROW0(b) (rbeg + 2 * (b))
#define P1_ISSUE(b) do { const int r0_ = P1_ROW0(b); _Pragma("unroll") for (int r = 0; r < 2; ++r) { const int m_ = (r0_ + r < rend) ? r0_ + r : rend - 1; \
        const float* xp_ = ((m_ < TOK) ? F.in[I_X] + (size_t)m_ * DM : F.in[I_CTX] + (size_t)(m_ - TOK) * DM) + 4 * F_LANE; \
        _Pragma("unroll") for (int j = 0; j < 4; ++j) lz_issue(xp_ + 256 * j, lz, ((b) & 1) * 8 + r * 4 + j); } } while (0)
    int ncur = -1; f32x4 gs[4], sh[4];
    if (nb > 0) P1_ISSUE(0);
    if (nb > 1) P1_ISSUE(1);
#pragma unroll 1
    for (int b = 0; b < nb; ++b) {
        if (b + 1 < nb) LZ_WAIT(8); else LZ_WAIT(0);
        f32x4 cur[2][4];
#pragma unroll
        for (int r = 0; r < 2; ++r)
#pragma unroll
            for (int j = 0; j < 4; ++j) cur[r][j] = *(const LAS f32x4*)(lz + ((b & 1) * 8 + r * 4 + j) * 1024 + F_LANE * 16);
        float ss[2];
#pragma unroll
        for (int r = 0; r < 2; ++r) { float a = 0.f;
#pragma unroll
            for (int j = 0; j < 4; ++j) a += (cur[r][j].x * cur[r][j].x + cur[r][j].y * cur[r][j].y) + (cur[r][j].z * cur[r][j].z + cur[r][j].w * cur[r][j].w);
            ss[r] = a; }
#pragma unroll
        for (int o = 1; o < 64; o <<= 1) { ss[0] += __shfl_xor(ss[0], o); ss[1] += __shfl_xor(ss[1], o); }
        const int r0 = P1_ROW0(b);
#pragma unroll
        for (int r = 0; r < 2; ++r) {
            const int m = (r0 + r < rend) ? r0 + r : rend - 1; const int n = (m < TOK) ? (m >> 11) : 32;
            if (n != ncur) { ncur = n;
#pragma unroll
                for (int j = 0; j < 4; ++j) { gs[j] = ((const f32x4*)g)[F_LANE + 64 * j] * (1.0f + ((const f32x4*)(mod + n * NMOD + DM))[F_LANE + 64 * j]); sh[j] = ((const f32x4*)(mod + n * NMOD))[F_LANE + 64 * j]; } }
            const float rs = 1.0f / sqrtf(ss[r] * (1.f / DM) + RMS_EPS);
            f32x4 y[4]; float mx = 0.f;
#pragma unroll
            for (int j = 0; j < 4; ++j) { y[j] = (cur[r][j] * rs) * gs[j] + sh[j]; mx = fmaxf(fmaxf(mx, fmaxf(fabsf(y[j].x), fabsf(y[j].y))), fmaxf(fabsf(y[j].z), fabsf(y[j].w))); }
#pragma unroll
            for (int o = 1; o < 64; o <<= 1) mx = fmaxf(mx, __shfl_xor(mx, o));
            const float qs = (mx > 0.f) ? mx * (1.0f / 127.0f) : 1.0f, qi = 1.0f / qs;
            if (F_LANE == 0) WSP(float, WS_RSCALE)[m] = qs;
            unsigned* o4 = (unsigned*)((unsigned char*)HX + (size_t)m * DM) + F_LANE;
#pragma unroll
            for (int j = 0; j < 4; ++j) o4[64 * j] = ((unsigned)__float2int_rn(y[j].x * qi) & 0xffu) | (((unsigned)__float2int_rn(y[j].y * qi) & 0xffu) << 8) | (((unsigned)__float2int_rn(y[j].z * qi) & 0xffu) << 16) | (((unsigned)__float2int_rn(y[j].w * qi) & 0xffu) << 24);
        }
        if (b + 2 < nb) P1_ISSUE(b + 2);
    }
#undef P1_ISSUE
#undef P1_ROW0
}
DEV void p1_tables(Frame& F) {
    const float* mod = WSP(float, WS_MOD);
    const int gw = (F.bx - 32) * 8 + F_WAVE, NGW = (F.G - 32) * 8;
    const int gt = (F.bx - 32) * 512 + F_TID, NT = (F.G - 32) * 512;
    const f32x2* APOW = WSP(f32x2, WS_APOW); const f32x2* BBAR = WSP(f32x2, WS_BBAR);
    {
        float* KT = WSP(float, WS_KTAB);
        for (int idx = gt; idx < 2 * 16 * 64 * 16; idx += NT) {
            const int h = idx & 15, j = (idx >> 4) & 63, dg = idx >> 10;
            float sacc[16];
#pragma unroll
            for (int q = 0; q < 16; ++q) sacc[q] = 0.f;
#pragma unroll 1
            for (int p4 = 0; p4 < 64; p4 += 4) {
                const f32x4 cr4 = *(const f32x4*)(F.in[I_CRE] + (dg * 16 + h) * 64 + p4), ci4 = *(const f32x4*)(F.in[I_CIM] + (dg * 16 + h) * 64 + p4);
                const f32x4 a01 = *(const f32x4*)(APOW + (dg * 65 + j) * 64 + p4), a23 = *(const f32x4*)(APOW + (dg * 65 + j) * 64 + p4 + 2);
                f32x4 bv[4][8];
#pragma unroll
                for (int u = 0; u < 4; ++u)
#pragma unroll
                    for (int q = 0; q < 8; ++q) bv[u][q] = ((const f32x4*)(BBAR + (dg * 64 + p4 + u) * 16))[q];
#pragma unroll
                for (int u = 0; u < 4; ++u) { const float cr = cr4[u], ci = ci4[u]; const float ax = (u < 2) ? a01[2 * u] : a23[2 * (u - 2)], ay = (u < 2) ? a01[2 * u + 1] : a23[2 * (u - 2) + 1];
                    const float ur = cr * ax - ci * ay, ui = cr * ay + ci * ax;
#pragma unroll
                    for (int q = 0; q < 8; ++q) { sacc[2 * q] += ur * bv[u][q].x - ui * bv[u][q].y; sacc[2 * q + 1] += ur * bv[u][q].z - ui * bv[u][q].w; } }
            }
            f32x4* op = (f32x4*)(KT + ((dg * 64 + j) * 256 + h * 16));
#pragma unroll
            for (int q = 0; q < 4; ++q) op[q] = (f32x4){sacc[4 * q], sacc[4 * q + 1], sacc[4 * q + 2], sacc[4 * q + 3]};
        }
    }
    {
        bf16_t* WE = WSP(bf16_t, WS_WE);
        constexpr int K8 = UK / 8, NWE = 16 * 256 * K8;
        for (int idx0 = gt; idx0 < NWE; idx0 += 4 * NT) {
            f32x2 a[4]; f32x4 bq[4][4];
#pragma unroll
            for (int u = 0; u < 4; ++u) { const int idx = (idx0 + u * NT < NWE) ? idx0 + u * NT : idx0;
                const int k8 = idx % K8, n = (idx / K8) & 255, g = idx / (K8 * 256), part = n >> 6, p = n & 63, dir = part >> 1, k = k8 >> 1, h0 = (k8 & 1) * 8, dg = dir * 16 + g;
                a[u] = APOW[(dg * 65 + (dir ? k : LC - 1 - k)) * 64 + p];
                const f32x4* bp = (const f32x4*)(BBAR + (dg * 64 + p) * 16 + h0);
#pragma unroll
                for (int q = 0; q < 4; ++q) bq[u][q] = bp[q]; }
#pragma unroll
            for (int u = 0; u < 4; ++u) { const int idx = idx0 + u * NT; if (idx < NWE) {
                const int k8 = idx % K8, n = (idx / K8) & 255, g = idx / (K8 * 256), part = n >> 6;
                float v[8];
#pragma unroll
                for (int q = 0; q < 4; ++q) { const f32x4 b = bq[u][q];
                    v[2 * q] = (part & 1) ? (a[u].x * b.y + a[u].y * b.x) : (a[u].x * b.x - a[u].y * b.y); v[2 * q + 1] = (part & 1) ? (a[u].x * b.w + a[u].y * b.z) : (a[u].x * b.z - a[u].y * b.w); }
                u32x4 o; o.x = cvt_pk_bf16(v[0], v[1]); o.y = cvt_pk_bf16(v[2], v[3]); o.z = cvt_pk_bf16(v[4], v[5]); o.w = cvt_pk_bf16(v[6], v[7]);
                *(u32x4*)(WE + ((size_t)(g * 256 + n) * UK + k8 * 8)) = o; } }
        }
    }
    {
        unsigned* SH2 = WSP(unsigned, WS_SH2);
        for (int idx = gt; idx < 256 * 256; idx += NT) { const int r = idx >> 8, k = (idx & 255) * 4; const float* mp = mod + r * NMOD + 3 * DM + k;
            SH2[idx] = (r < 32) ? pk4_fp8(mp[0], mp[1], mp[2], mp[3]) : 0u; }
    }
    {
        float* rb = WSP(float, WS_RB);
        for (int idx = gw; idx < 32 * 32; idx += NGW) { const int b = idx >> 5, l = idx & 31; float s = 0.f;
            if (l < 20) {
#pragma unroll 4
                for (int k = F_LANE; k < DM; k += 64) s += mod[b * NMOD + 3 * DM + k] * ((l < 4) ? F.in[I_RGW][k * 4 + l] : F.in[I_REW][k * 16 + (l - 4)]);
                s = wave_sum(s) + ((l < 4) ? F.in[I_RGB][l] : F.in[I_REB][l - 4]); }
            if (F_LANE == 0) rb[idx] = s; }
    }
}

DEV void p2_fill_tr(Frame& F) {
    const float* KT = WSP(float, WS_KTAB); const f32x2* APOW = WSP(f32x2, WS_APOW); bf16_t* TR = WSP(bf16_t, WS_TR);
    const int gt = F.bx * 512 + F_TID, NT = F.G * 512;
    constexpr int K8 = UK / 8, NT1 = 16 * TRN * K8;
    for (int idx0 = gt; idx0 < NT1; idx0 += 4 * NT) {
        f32x4 fa[4][2], fb[4][2];
#pragma unroll
        for (int u = 0; u < 4; ++u) { const int idx = (idx0 + u * NT < NT1) ? idx0 + u * NT : idx0;
            const int k8 = idx % K8, n = (idx / K8) % TRN, g = idx / (K8 * TRN), t = n >> 4, h = n & 15, k = k8 >> 1, h0 = (k8 & 1) * 8;
            const f32x4* pa_ = (const f32x4*)(KT + (((0 * 16 + g) * 64 + (t > k ? t - k : 0)) * 256 + h * 16 + h0));
            const f32x4* pb_ = (const f32x4*)(KT + (((1 * 16 + g) * 64 + (k > t ? k - t : 0)) * 256 + h * 16 + h0));
            fa[u][0] = pa_[0]; fa[u][1] = pa_[1]; fb[u][0] = pb_[0]; fb[u][1] = pb_[1]; }
#pragma unroll
        for (int u = 0; u < 4; ++u) { const int idx = idx0 + u * NT; if (idx < NT1) {
            const int k8 = idx % K8, n = (idx / K8) % TRN, g = idx / (K8 * TRN), t = n >> 4, h = n & 15, k = k8 >> 1, h0 = (k8 & 1) * 8;
            const float wa = (t >= k) ? 1.f : 0.f, wb = (k >= t) ? 1.f : 0.f, dd = (t == k) ? F.in[I_S5D][g * 16 + h] : 0.f;
            float v[8];
#pragma unroll
            for (int q = 0; q < 8; ++q) v[q] = wa * fa[u][q >> 2][q & 3] + wb * fb[u][q >> 2][q & 3] + ((h0 + q == h) ? dd : 0.f);
            u32x4 o; o.x = cvt_pk_bf16(v[0], v[1]); o.y = cvt_pk_bf16(v[2], v[3]); o.z = cvt_pk_bf16(v[4], v[5]); o.w = cvt_pk_bf16(v[6], v[7]);
            *(u32x4*)(TR + ((size_t)(g * TRN + n) * UGK + k8 * 8)) = o; } }
    }
    constexpr int NT2 = 16 * TRN * 32;
    for (int idx0 = gt; idx0 < NT2; idx0 += 4 * NT) {
        f32x4 cr_[4][2], ci_[4][2], ap_[4][4];
#pragma unroll
        for (int u = 0; u < 4; ++u) { const int idx = (idx0 + u * NT < NT2) ? idx0 + u * NT : idx0;
            const int k8 = idx & 31, n = (idx >> 5) % TRN, g = idx / (32 * TRN), t = n >> 4, h = n & 15, s0 = k8 * 8, part = s0 >> 6, p0 = s0 & 63, dir = part >> 1, dg = dir * 16 + g, j = dir ? (LC - t) : (t + 1);
            const f32x4* pc = (const f32x4*)(F.in[I_CRE] + (dg * 16 + h) * 64 + p0); const f32x4* pi = (const f32x4*)(F.in[I_CIM] + (dg * 16 + h) * 64 + p0); const f32x4* pw = (const f32x4*)(APOW + (dg * 65 + j) * 64 + p0);
            cr_[u][0] = pc[0]; cr_[u][1] = pc[1]; ci_[u][0] = pi[0]; ci_[u][1] = pi[1];
#pragma unroll
            for (int q = 0; q < 4; ++q) ap_[u][q] = pw[q]; }
#pragma unroll
        for (int u = 0; u < 4; ++u) { const int idx = idx0 + u * NT; if (idx < NT2) {
            const int k8 = idx & 31, n = (idx >> 5) % TRN, g = idx / (32 * TRN), part = (k8 * 8) >> 6;
            float v[8];
#pragma unroll
            for (int q = 0; q < 8; ++q) { const float cr = cr_[u][q >> 2][q & 3], ci = ci_[u][q >> 2][q & 3]; const float ax = ap_[u][q >> 1][(q & 1) * 2], ay = ap_[u][q >> 1][(q & 1) * 2 + 1];
                v[q] = (part & 1) ? -(cr * ay + ci * ax) : (cr * ax - ci * ay); }
            u32x4 o; o.x = cvt_pk_bf16(v[0], v[1]); o.y = cvt_pk_bf16(v[2], v[3]); o.z = cvt_pk_bf16(v[4], v[5]); o.w = cvt_pk_bf16(v[6], v[7]);
            *(u32x4*)(TR + ((size_t)(g * TRN + n) * UGK + UK + k8 * 8)) = o; } }
    }
}
struct SchedIn {
    static constexpr bool GATHER = false, AUX = true, FP8 = false, I8 = true;
    int nt; unsigned lda, ldb; int G, c; const char* HX; const char* W; int lo, hi; const char* rscale; const char* cscale;
    DEV bool next(int i, Unit& u) const {
        const int L = lo + i * G + c; if (L >= hi) return false;
        int pm, pn, ctx = 0;
        if (L < 2560) pg8::static_tile(L, 256, 10, pm, pn); else { pm = 256 + (L - 2560); pn = 0; ctx = 1; }
        u.A0 = HX + (size_t)pm * 256 * 1024; u.A1 = u.A0; u.B0 = W + (size_t)pn * 256 * 1024; u.B1 = u.B0; u.ksA = 1 << 20; u.ksB = 1 << 20;
        u.p0 = pm; u.p1 = pn; u.p2 = ctx; u.p3 = 0; return true;
    }
    DEV void rows(const Unit&, int, unsigned*) const {}
    DEV void aux(const Unit& u, const Unit&, LAS unsigned char* l, int wid, int lane) const {
        if (wid == 0) glds16(rscale + (size_t)u.p0 * 1024 + lane * 16, l + AUX_SLOT_OFF);
        if (wid == 1) glds16(cscale + (size_t)u.p1 * 1024 + lane * 16, l + AUX_SLOT_OFF + 1024);
    }
};
struct EpiIn {
    static constexpr bool PERM = true;
    bf16_t* UG; bf16_t* BG; bf16_t* CV; LAS unsigned char* lds;
    DEV void operator()(const f32x4 (&acci)[2][2][4][2], const Unit& u, int wr, int wc, int fr, int fq) const {
        const int pm = u.p0, pn = u.p1;
        f32x4 cs[2][2];
#pragma unroll
        for (int bj = 0; bj < 2; ++bj)
#pragma unroll
            for (int n = 0; n < 2; ++n) cs[bj][n] = *(const LAS f32x4*)(lds + AUX_SLOT_OFF + 1024 + (bj * 128 + wc * 32 + 8 * fq + 4 * n) * 4);
#pragma unroll
        for (int ai = 0; ai < 2; ++ai)
#pragma unroll
            for (int m = 0; m < 4; ++m) {
                const int r = ai * 128 + wr * 64 + m * 16 + fr;
                const float rs = *(const LAS float*)(lds + AUX_SLOT_OFF + r * 4);
                f32x4 a[2][2];
#pragma unroll
                for (int bj = 0; bj < 2; ++bj)
#pragma unroll
                    for (int n = 0; n < 2; ++n) { const v4i_t iv = __builtin_bit_cast(v4i_t, acci[ai][bj][m][n]); a[bj][n] = (f32x4){(float)iv[0], (float)iv[1], (float)iv[2], (float)iv[3]} * (cs[bj][n] * rs); }
                if (pn == 0) {
                    const int mm = pm * 256 + r;
                    const int chunk = mm / LC, k = mm % LC;
#pragma unroll
                    for (int bj = 0; bj < 2; ++bj) { const int c = bj * 128 + wc * 32 + 8 * fq, g = c >> 4, h0 = c & 15;
                        const f32x4 v0 = a[bj][0], v1 = a[bj][1];
                        u32x4 w; w.x = cvt_pk_bf16(v0[0], v0[1]); w.y = cvt_pk_bf16(v0[2], v0[3]); w.z = cvt_pk_bf16(v1[0], v1[1]); w.w = cvt_pk_bf16(v1[2], v1[3]);
                        *(u32x4*)(UG + ((size_t)(g * NCH_PAD + chunk) * UGK + k * 16 + h0)) = w; }
                } else if (pn < 4) {
                    bf16_t* rowp = BG + (size_t)(pm * 256 + r) * CONVW + (pn - 1) * 256 + wc * 32 + 8 * fq;
#pragma unroll
                    for (int bj = 0; bj < 2; ++bj) { const f32x4 v0 = a[bj][0], v1 = a[bj][1];
                        u32x4 w; w.x = cvt_pk_bf16(v0[0], v0[1]); w.y = cvt_pk_bf16(v0[2], v0[3]); w.z = cvt_pk_bf16(v1[0], v1[1]); w.w = cvt_pk_bf16(v1[2], v1[3]);
                        *(u32x4*)(rowp + bj * 128) = w; }
                } else {
                    const f32x4 v0 = a[0][0] * a[1][0], v1 = a[0][1] * a[1][1];
                    u32x4 w; w.x = cvt_pk_bf16(v0[0], v0[1]); w.y = cvt_pk_bf16(v0[2], v0[3]); w.z = cvt_pk_bf16(v1[0], v1[1]); w.w = cvt_pk_bf16(v1[2], v1[3]);
                    *(u32x4*)(CV + (size_t)(pm * 256 + r) * CONVW + (pn - 4) * 128 + wc * 32 + 8 * fq) = w;
                }
            }
    }
};

struct SchedE {
    static constexpr bool GATHER = false, AUX = false, FP8 = false, I8 = false;
    int nt; unsigned lda, ldb; int c; const char* UG; const char* WE;
    DEV bool next(int i, Unit& u) const {
        if (i > 0 || c >= 16 * (NCH_PAD / 256)) return false;
        const int g = c / (NCH_PAD / 256), pm = c % (NCH_PAD / 256);
        u.A0 = UG + ((size_t)g * NCH_PAD + pm * 256) * UGK * 2; u.A1 = u.A0; u.B0 = WE + (size_t)g * 256 * UK * 2; u.B1 = u.B0; u.ksA = 1 << 20; u.ksB = 1 << 20;
        u.p0 = pm; u.p1 = g; u.p2 = 0; u.p3 = 0; return true;
    }
    DEV void rows(const Unit&, int, unsigned*) const {}
    DEV void aux(const Unit&, const Unit&, LAS unsigned char*, int, int) const {}
};
struct EpiE {
    static constexpr bool PERM = false;
    float* E;
    DEV void operator()(const f32x4 (&acc)[2][2][4][2], const Unit& u, int wr, int wc, int fr, int fq) const {
        float* base = E + ((size_t)u.p1 * NCH_PAD + u.p0 * 256) * 256;
#pragma unroll
        for (int ai = 0; ai < 2; ++ai)
#pragma unroll
            for (int m = 0; m < 4; ++m) { float* rowp = base + (size_t)(ai * 128 + wr * 64 + m * 16 + fr) * 256 + wc * 32 + 4 * fq;
#pragma unroll
                for (int bj = 0; bj < 2; ++bj)
#pragma unroll
                    for (int n = 0; n < 2; ++n) *(f32x4*)(rowp + bj * 128 + n * 16) = acc[ai][bj][m][n]; }
    }
};
struct SchedSB {
    static constexpr bool GATHER = false, AUX = false, FP8 = true, I8 = false;
    int nt; unsigned lda, ldb; int c; const char* SH2; const char* W13;
    DEV bool next(int i, Unit& u) const {
        if (i > 0 || c < 0 || c >= 64) return false;
        const int e = c >> 2, ti = c & 3;
        u.A0 = SH2; u.A1 = u.A0; u.B0 = W13 + ((size_t)e * 1024 + ti * 256) * 1024; u.B1 = u.B0; u.ksA = 1 << 20; u.ksB = 1 << 20;
        u.p0 = e; u.p1 = ti; u.p2 = 0; u.p3 = 0; return true;
    }
    DEV void rows(const Unit&, int, unsigned*) const {}
    DEV void aux(const Unit&, const Unit&, LAS unsigned char*, int, int) const {}
};
struct EpiSB {
    static constexpr bool PERM = true;
    bf16_t* SB;
    DEV void operator()(const f32x4 (&acc)[2][2][4][2], const Unit& u, int wr, int wc, int fr, int fq) const {
        if (wr != 0) return;
#pragma unroll
        for (int m = 0; m < 2; ++m) { const int b = m * 16 + fr; bf16_t* rowp = SB + ((size_t)(b * 16 + u.p0) * 1024 + u.p1 * 256 + wc * 32 + 8 * fq);
#pragma unroll
            for (int bj = 0; bj < 2; ++bj) { const f32x4 v0 = acc[0][bj][m][0] * (1.0f / FP8_WSCALE), v1 = acc[0][bj][m][1] * (1.0f / FP8_WSCALE);
                u32x4 w; w.x = cvt_pk_bf16(v0[0], v0[1]); w.y = cvt_pk_bf16(v0[2], v0[3]); w.z = cvt_pk_bf16(v1[0], v1[1]); w.w = cvt_pk_bf16(v1[2], v1[3]);
                *(u32x4*)(rowp + bj * 128) = w; } }
    }
};

DEV void p4_phase(Frame& F) {
    const int gt = F.bx * 512 + F_TID, NT = F.G * 512;
    const float* E = WSP(float, WS_E); const f32x2* APOW = WSP(f32x2, WS_APOW); bf16_t* UG = WSP(bf16_t, WS_UG);
    constexpr int CC = CTXL / LC, CL = SEQ / LC;
    for (int idx = gt; idx < NB * NG * 128; idx += NT) {
        const int p = idx & 63, dir = (idx >> 6) & 1, g = (idx >> 7) & 15, b = idx >> 11;
        const f32x2 a = APOW[((dir * 16 + g) * 65 + LC) * 64 + p];
        const float* Eg = E + (size_t)g * NCH_PAD * 256 + dir * 128 + p;
        bf16_t* Ug = UG + (size_t)g * NCH_PAD * UGK + UK + dir * 128 + p;
        float sr = 0.f, si = 0.f;
        {   float er[CC], ei[CC];
#pragma unroll
            for (int c = 0; c < CC; ++c) { const int ch = NCH_LAT + b * CC + (dir ? CC - 1 - c : c); er[c] = Eg[(size_t)ch * 256]; ei[c] = Eg[(size_t)ch * 256 + 64]; }
#pragma unroll
            for (int c = 0; c < CC; ++c) { const float nr = a.x * sr - a.y * si + er[c], ni = a.x * si + a.y * sr + ei[c]; sr = nr; si = ni; } }
#pragma unroll 1
        for (int c0 = 0; c0 < CL; c0 += 16) {
            float er[16], ei[16];
#pragma unroll
            for (int c = 0; c < 16; ++c) { const int ch = b * CL + (dir ? CL - 1 - (c0 + c) : c0 + c); er[c] = Eg[(size_t)ch * 256]; ei[c] = Eg[(size_t)ch * 256 + 64]; }
#pragma unroll
            for (int c = 0; c < 16; ++c) { const int ch = b * CL + (dir ? CL - 1 - (c0 + c) : c0 + c);
                Ug[(size_t)ch * UGK] = (bf16_t)(cvt_pk_bf16(sr, 0.f) & 0xffffu); Ug[(size_t)ch * UGK + 64] = (bf16_t)(cvt_pk_bf16(si, 0.f) & 0xffffu);
                const float nr = a.x * sr - a.y * si + er[c], ni = a.x * si + a.y * sr + ei[c]; sr = nr; si = ni; }
        }
    }
}
DEV void conv_items(Frame& F, int vt, int NVT) {
    const bf16_t* BG = WSP(bf16_t, WS_BG); const bf16_t* CV = WSP(bf16_t, WS_CV); bf16_t* YM = WSP(bf16_t, WS_YMIX); const float* cw = F.in[I_CONVW];
    LAS unsigned char* lz = F.lds + F_WAVE * LZ_WAVE;
    constexpr int NIT = TOK * 96;
    const int nb = (vt < NIT) ? ((NIT - vt + 2 * NVT - 1) / (2 * NVT)) : 0;
    const int jc = (vt % 96) * 8;
    const f32x4 w0a = *(const f32x4*)(cw + jc), w0b = *(const f32x4*)(cw + jc + 4), w1a = *(const f32x4*)(cw + CONVW + jc), w1b = *(const f32x4*)(cw + CONVW + jc + 4), w2a = *(const f32x4*)(cw + 2 * CONVW + jc), w2b = *(const f32x4*)(cw + 2 * CONVW + jc + 4);
#define CV_ISSUE(b) do { _Pragma("unroll") for (int q = 0; q < 2; ++q) { const int idx_ = vt + (2 * (b) + q) * NVT; const bool ok_ = idx_ < NIT; const int j0_ = (idx_ % 96) * 8, m_ = ok_ ? idx_ / 96 : 0; \
        const bool rowp_ = j0_ < 384; const int d_ = rowp_ ? 1 : 64; \
        const bool hasl_ = ok_ && (rowp_ ? ((m_ & 63) > 0) : (((m_ >> 6) & 31) > 0)), hasr_ = ok_ && (rowp_ ? ((m_ & 63) < 63) : (((m_ >> 6) & 31) < 31)); \
        const size_t o_ = (size_t)m_ * CONVW + j0_; \
        lz_issue(CV + (hasl_ ? o_ - (size_t)d_ * CONVW : o_), lz, ((b) & 1) * 8 + q * 4 + 0); lz_issue(CV + o_, lz, ((b) & 1) * 8 + q * 4 + 1); \
        lz_issue(CV + (hasr_ ? o_ + (size_t)d_ * CONVW : o_), lz, ((b) & 1) * 8 + q * 4 + 2); lz_issue(BG + o_, lz, ((b) & 1) * 8 + q * 4 + 3); } } while (0)
    asm volatile("s_waitcnt lgkmcnt(0)" ::: "memory");
    if (nb > 0) CV_ISSUE(0);
    if (nb > 1) CV_ISSUE(1);
#pragma unroll 1
    for (int b = 0; b < nb; ++b) {
        if (b + 1 < nb) LZ_WAIT(8); else LZ_WAIT(0);
#pragma unroll
        for (int q = 0; q < 2; ++q) { const int idx = vt + (2 * b + q) * NVT; const bool ok = idx < NIT; const int j0 = (idx % 96) * 8, m = ok ? idx / 96 : 0;
            const bool rowp = j0 < 384;
            const bool hasl = rowp ? ((m & 63) > 0) : (((m >> 6) & 31) > 0), hasr = rowp ? ((m & 63) < 63) : (((m >> 6) & 31) < 31);
            const LAS unsigned char* zp = lz + ((b & 1) * 8 + q * 4) * 1024 + F_LANE * 16;
            const u32x4 z = (u32x4){0u, 0u, 0u, 0u};
            u32x4 c0 = *(const LAS u32x4*)zp; const u32x4 c1 = *(const LAS u32x4*)(zp + 1024); u32x4 c2 = *(const LAS u32x4*)(zp + 2048); const u32x4 bb = *(const LAS u32x4*)(zp + 3072);
            c0 = hasl ? c0 : z; c2 = hasr ? c2 : z;
            float o[8];
            o[0] = bflo(bb.x) * (bflo(c0.x) * w0a[0] + bflo(c1.x) * w1a[0] + bflo(c2.x) * w2a[0]); o[1] = bfhi(bb.x) * (bfhi(c0.x) * w0a[1] + bfhi(c1.x) * w1a[1] + bfhi(c2.x) * w2a[1]);
            o[2] = bflo(bb.y) * (bflo(c0.y) * w0a[2] + bflo(c1.y) * w1a[2] + bflo(c2.y) * w2a[2]); o[3] = bfhi(bb.y) * (bfhi(c0.y) * w0a[3] + bfhi(c1.y) * w1a[3] + bfhi(c2.y) * w2a[3]);
            o[4] = bflo(bb.z) * (bflo(c0.z) * w0b[0] + bflo(c1.z) * w1b[0] + bflo(c2.z) * w2b[0]); o[5] = bfhi(bb.z) * (bfhi(c0.z) * w0b[1] + bfhi(c1.z) * w1b[1] + bfhi(c2.z) * w2b[1]);
            o[6] = bflo(bb.w) * (bflo(c0.w) * w0b[2] + bflo(c1.w) * w1b[2] + bflo(c2.w) * w2b[2]); o[7] = bfhi(bb.w) * (bfhi(c0.w) * w0b[3] + bfhi(c1.w) * w1b[3] + bfhi(c2.w) * w2b[3]);
            u32x4 w; w.x = cvt_pk_bf16(o[0], o[1]); w.y = cvt_pk_bf16(o[2], o[3]); w.z = cvt_pk_bf16(o[4], o[5]); w.w = cvt_pk_bf16(o[6], o[7]);
            if (ok) *(u32x4*)(YM + (size_t)m * DM + 256 + j0) = w; }
        if (b + 2 < nb) CV_ISSUE(b + 2);
    }
#undef CV_ISSUE
}

struct SchedY {
    static constexpr bool GATHER = false, AUX = false, FP8 = false, I8 = false;
    int nt; unsigned lda, ldb; int c; const char* UG; const char* TR;
    DEV bool next(int i, Unit& u) const {
        if (i > 0 || c >= 256) return false;
        const int x = c & 7, k = c >> 3;
        constexpr int NPM = NCH_LAT / 256, NPN = TRN / 256;
        static_assert(NPM * NPN == 16, "16 units per group");
        const int g = 2 * x + (k >> 4), pm = (k & 15) / NPN, pn = (k & 15) % NPN;
        u.A0 = UG + ((size_t)g * NCH_PAD + pm * 256) * UGK * 2; u.A1 = u.A0; u.B0 = TR + ((size_t)g * TRN + pn * 256) * UGK * 2; u.B1 = u.B0; u.ksA = 1 << 20; u.ksB = 1 << 20;
        u.p0 = pm; u.p1 = pn; u.p2 = g; u.p3 = 0; return true;
    }
    DEV void rows(const Unit&, int, unsigned*) const {}
    DEV void aux(const Unit&, const Unit&, LAS unsigned char*, int, int) const {}
};
struct EpiY {
    static constexpr bool PERM = true;
    bf16_t* Gb;
    DEV void operator()(const f32x4 (&acc)[2][2][4][2], const Unit& u, int wr, int wc, int fr, int fq) const {
#pragma unroll
        for (int ai = 0; ai < 2; ++ai)
#pragma unroll
            for (int m = 0; m < 4; ++m) { const int chunk = u.p0 * 256 + ai * 128 + wr * 64 + m * 16 + fr;
#pragma unroll
                for (int bj = 0; bj < 2; ++bj) { const int n = u.p1 * 256 + bj * 128 + wc * 32 + 8 * fq, t = n >> 4, h0 = n & 15;
                    const f32x4 v0 = acc[ai][bj][m][0], v1 = acc[ai][bj][m][1];
                    u32x4 w; w.x = cvt_pk_bf16(gelu_tanh(v0[0]), gelu_tanh(v0[1])); w.y = cvt_pk_bf16(gelu_tanh(v0[2]), gelu_tanh(v0[3]));
                    w.z = cvt_pk_bf16(gelu_tanh(v1[0]), gelu_tanh(v1[1])); w.w = cvt_pk_bf16(gelu_tanh(v1[2]), gelu_tanh(v1[3]));
                    *(u32x4*)(Gb + ((size_t)(chunk * LC + t) * 256 + u.p2 * 16 + h0)) = w; } }
    }
};

struct SchedGlu {
    static constexpr bool GATHER = false, AUX = false, FP8 = false, I8 = false;
    int nt; unsigned lda, ldb; int G, c; const char* Gb; const char* W;
    DEV bool next(int i, Unit& u) const {
        const int L = i * G + c; if (L >= 256) return false;
        u.A0 = Gb + (size_t)L * 256 * 512; u.A1 = u.A0; u.B0 = W; u.B1 = u.B0; u.ksA = 1 << 20; u.ksB = 1 << 20; u.p0 = L; u.p1 = 0; u.p2 = 0; u.p3 = 0; return true;
    }
    DEV void rows(const Unit&, int, unsigned*) const {}
    DEV void aux(const Unit&, const Unit&, LAS unsigned char*, int, int) const {}
};
struct EpiGlu {
    static constexpr bool PERM = true;
    const bf16_t* Gb; bf16_t* YM; const float* bglu;
    DEV void operator()(const f32x4 (&acc)[2][2][4][2], const Unit& u, int wr, int wc, int fr, int fq) const {
        u32x4 gq[2][4][2];
#pragma unroll
        for (int ai = 0; ai < 2; ++ai)
#pragma unroll
            for (int m = 0; m < 4; ++m)
#pragma unroll
                for (int bj = 0; bj < 2; ++bj) gq[ai][m][bj] = *(const u32x4*)(Gb + (size_t)(u.p0 * 256 + ai * 128 + wr * 64 + m * 16 + fr) * 256 + bj * 128 + wc * 32 + 8 * fq);
        f32x4 bq[2][2];
#pragma unroll
        for (int bj = 0; bj < 2; ++bj) { bq[bj][0] = *(const f32x4*)(bglu + bj * 128 + wc * 32 + 8 * fq); bq[bj][1] = *(const f32x4*)(bglu + bj * 128 + wc * 32 + 8 * fq + 4); }
        asm volatile("" ::: "memory");
#pragma unroll
        for (int ai = 0; ai < 2; ++ai)
#pragma unroll
            for (int m = 0; m < 4; ++m) { const int row = u.p0 * 256 + ai * 128 + wr * 64 + m * 16 + fr;
#pragma unroll
                for (int bj = 0; bj < 2; ++bj) { const int c = bj * 128 + wc * 32 + 8 * fq;
                    const u32x4 gv = gq[ai][m][bj];
                    const f32x4 z0 = acc[ai][bj][m][0] + bq[bj][0], z1 = acc[ai][bj][m][1] + bq[bj][1];
                    u32x4 w; w.x = cvt_pk_bf16(bflo(gv.x) * sigmoidf_(z0[0]), bfhi(gv.x) * sigmoidf_(z0[1])); w.y = cvt_pk_bf16(bflo(gv.y) * sigmoidf_(z0[2]), bfhi(gv.y) * sigmoidf_(z0[3]));
                    w.z = cvt_pk_bf16(bflo(gv.z) * sigmoidf_(z1[0]), bfhi(gv.z) * sigmoidf_(z1[1])); w.w = cvt_pk_bf16(bflo(gv.w) * sigmoidf_(z1[2]), bfhi(gv.w) * sigmoidf_(z1[3]));
                    *(u32x4*)(YM + (size_t)row * DM + c) = w; } }
    }
};

struct SchedOut {
    static constexpr bool GATHER = false, AUX = false, FP8 = false, I8 = false;
    int nt; unsigned lda, ldb; int G, c; const char* A; const char* W;
    DEV bool next(int i, Unit& u) const {
        const int L = i * G + c; if (L >= 1024) return false;
        int pm, pn; pg8::static_tile(L, 256, 4, pm, pn);
        u.A0 = A + (size_t)pm * 256 * 2048; u.A1 = u.A0; u.B0 = W + (size_t)pn * 256 * 2048; u.B1 = u.B0; u.ksA = 1 << 20; u.ksB = 1 << 20; u.p0 = pm; u.p1 = pn; u.p2 = 0; u.p3 = 0; return true;
    }
    DEV void rows(const Unit&, int, unsigned*) const {}
    DEV void aux(const Unit&, const Unit&, LAS unsigned char*, int, int) const {}
};
struct EpiYX {
    static constexpr bool PERM = true;
    bf16_t* YX; int nostore;
    DEV void operator()(const f32x4 (&acc)[2][2][4][2], const Unit& u, int wr, int wc, int fr, int fq) const {
        if (nostore) { float t = 0.f;
#pragma unroll
            for (int ai = 0; ai < 2; ++ai)
#pragma unroll
                for (int m = 0; m < 4; ++m)
#pragma unroll
                    for (int bj = 0; bj < 2; ++bj) t += acc[ai][bj][m][0][0] + acc[ai][bj][m][1][3];
            if (t == 1.2345e38f) YX[0] = 0; return; }
#pragma unroll
        for (int ai = 0; ai < 2; ++ai)
#pragma unroll
            for (int m = 0; m < 4; ++m) { bf16_t* rowp = YX + (size_t)(u.p0 * 256 + ai * 128 + wr * 64 + m * 16 + fr) * DM + u.p1 * 256 + wc * 32 + 8 * fq;
#pragma unroll
                for (int bj = 0; bj < 2; ++bj) { const f32x4 v0 = acc[ai][bj][m][0], v1 = acc[ai][bj][m][1];
                    u32x4 w; w.x = cvt_pk_bf16(v0[0], v0[1]); w.y = cvt_pk_bf16(v0[2], v0[3]); w.z = cvt_pk_bf16(v1[0], v1[1]); w.w = cvt_pk_bf16(v1[2], v1[3]);
                    *(u32x4*)(rowp + bj * 128) = w; } }
    }
};

constexpr int P8_WR_STRIDE = 2064;
constexpr int P8_GT_OFF = 41472, P8_GS_OFF = P8_GT_OFF + 4096, P8_HIST_OFF = P8_GS_OFF + 4096, P8_LZ_OFF = P8_HIST_OFF + 256, P8_LZ_WAVE = 10240;
static_assert(20 * P8_WR_STRIDE <= P8_GT_OFF && P8_LZ_OFF + 8 * P8_LZ_WAVE <= 163840 - 256, "P8 LDS map");
DEV void p8_phase(Frame& F) {
    const float* X = F.in[I_X]; const bf16_t* YX = WSP(bf16_t, WS_YX); bf16_t* X1B = WSP(bf16_t, WS_X1B); unsigned char* X1G = WSP(unsigned char, WS_X1G);
    const bf16_t* Wr = WSP(bf16_t, WS_WR); const float* rb = WSP(float, WS_RB); const float* mod = WSP(float, WS_MOD); const float* n2g = F.in[I_N2G];
    int* tokb = WSP(int, WS_TOKB); float* tokw = WSP(float, WS_TOKW); float* tokr = WSP(float, WS_TOKR); int* segc = WSP(int, WS_SEGC);
    LAS int* hist = (LAS int*)(F.lds + P8_HIST_OFF);
    LAS float* gt = (LAS float*)(F.lds + P8_GT_OFF); LAS float* gsl = (LAS float*)(F.lds + P8_GS_OFF);
    const int l15 = F_LANE & 15, q = F_LANE >> 4;
    for (int idx = F_TID; idx < 20 * 128; idx += 512) { const int r = idx >> 7, c16 = idx & 127; *(LAS u32x4*)(F.lds + r * P8_WR_STRIDE + c16 * 16) = *(const u32x4*)(Wr + (size_t)r * DM + c16 * 8); }
    LAS unsigned char* lz = F.lds + P8_LZ_OFF + F_WAVE * P8_LZ_WAVE;
    for (int seg = F.bx; seg < TOK / 256; seg += F.G) {
        const int b = seg >> 3;
        __syncthreads();
        if (F_TID < 32) hist[F_TID] = 0;
        for (int k = F_TID; k < DM; k += 512) { gt[k] = mod[b * NMOD + 2 * DM + k]; gsl[k] = n2g[k] * (1.0f + mod[b * NMOD + 4 * DM + k]); }
        __syncthreads();
        const int tok0 = seg * 256 + F_WAVE * 32;
#pragma unroll 1
        for (int rg = 0; rg < 2; ++rg) {
            const int tok = tok0 + rg * 16 + l15;
            const float* xp = X + (size_t)tok * DM + 8 * q; const bf16_t* yp = YX + (size_t)tok * DM + 8 * q;
            bf16_t* o1 = X1B + (size_t)tok * DM + 8 * q; unsigned char* og = X1G + (size_t)tok * DM + 8 * q;
            const LAS unsigned char* wl = F.lds + l15 * P8_WR_STRIDE + q * 16;
            f32x4 acc0 = (f32x4){0.f, 0.f, 0.f, 0.f}, acc1 = acc0; float sq = 0.f;
            const LAS unsigned char* wl2 = F.lds + (16 + (l15 & 3)) * P8_WR_STRIDE + q * 16;
#define P8_ISSUE(ks_, sl_) do { lz_issue(xp + (ks_) * 32, lz, (sl_) * 3 + 0); lz_issue(xp + (ks_) * 32 + 4, lz, (sl_) * 3 + 1); lz_issue(yp + (ks_) * 32, lz, (sl_) * 3 + 2); } while (0)
            asm volatile("s_waitcnt lgkmcnt(0)" ::: "memory");
            P8_ISSUE(0, 0); P8_ISSUE(1, 1); P8_ISSUE(2, 2);
            int sl = 0;
#pragma unroll 1
            for (int ks = 0; ks < 32; ++ks) {
                if (ks <= 29) LZ_WAIT(6); else if (ks == 30) LZ_WAIT(3); else LZ_WAIT(0);
                const LAS unsigned char* zp = lz + sl * 3072 + F_LANE * 16;
                const f32x4 xa = *(const LAS f32x4*)zp, xb = *(const LAS f32x4*)(zp + 1024); const u32x4 yv = *(const LAS u32x4*)(zp + 2048);
                const f32x4 g0 = *(const LAS f32x4*)(gt + ks * 32 + 8 * q), g1 = *(const LAS f32x4*)(gt + ks * 32 + 8 * q + 4);
                const f32x4 s0 = *(const LAS f32x4*)(gsl + ks * 32 + 8 * q), s1 = *(const LAS f32x4*)(gsl + ks * 32 + 8 * q + 4);
                f32x4 va, vb;
                va[0] = xa[0] + g0[0] * bflo(yv.x); va[1] = xa[1] + g0[1] * bfhi(yv.x); va[2] = xa[2] + g0[2] * bflo(yv.y); va[3] = xa[3] + g0[3] * bfhi(yv.y);
                vb[0] = xb[0] + g1[0] * bflo(yv.z); vb[1] = xb[1] + g1[1] * bfhi(yv.z); vb[2] = xb[2] + g1[2] * bflo(yv.w); vb[3] = xb[3] + g1[3] * bfhi(yv.w);
                sq += ((va[0] * va[0] + va[1] * va[1]) + (va[2] * va[2] + va[3] * va[3])) + ((vb[0] * vb[0] + vb[1] * vb[1]) + (vb[2] * vb[2] + vb[3] * vb[3]));
                u32x4 w1; w1.x = cvt_pk_bf16(va[0], va[1]); w1.y = cvt_pk_bf16(va[2], va[3]); w1.z = cvt_pk_bf16(vb[0], vb[1]); w1.w = cvt_pk_bf16(vb[2], vb[3]);
                *(u32x4*)(o1 + ks * 32) = w1;
                const f32x4 ga = va * s0, gb = vb * s1;
                u32x4 wg; wg.x = cvt_pk_bf16(ga[0], ga[1]); wg.y = cvt_pk_bf16(ga[2], ga[3]); wg.z = cvt_pk_bf16(gb[0], gb[1]); wg.w = cvt_pk_bf16(gb[2], gb[3]);
                { u32x2 w8; w8.x = pk4_fp8(ga[0], ga[1], ga[2], ga[3]); w8.y = pk4_fp8(gb[0], gb[1], gb[2], gb[3]); *(u32x2*)(og + ks * 32) = w8; }
                const bf16x8 xf = __builtin_bit_cast(bf16x8, wg);
                const bf16x8 wa = *(const LAS bf16x8*)(wl + ks * 64), wb = *(const LAS bf16x8*)(wl2 + ks * 64);
                acc0 = __builtin_amdgcn_mfma_f32_16x16x32_bf16(wa, xf, acc0, 0, 0, 0); acc1 = __builtin_amdgcn_mfma_f32_16x16x32_bf16(wb, xf, acc1, 0, 0, 0);
                if (ks + 3 < 32) P8_ISSUE(ks + 3, sl);
                sl = (sl == 2) ? 0 : sl + 1;
            }
#undef P8_ISSUE
            sq += __shfl_xor(sq, 16); sq += __shfl_xor(sq, 32);
            const float rstd = 1.0f / sqrtf(sq * (1.f / DM) + RMS_EPS);
            float lg[4], l2[4], gl[4], t1[4], t2[4], v[4];
#pragma unroll
            for (int r = 0; r < 4; ++r) { lg[r] = rstd * acc0[r] + rb[b * 32 + 4 * q + r]; l2[r] = rstd * acc1[r] + rb[b * 32 + 16 + ((4 * q + r) & 15)]; }
#pragma unroll
            for (int r = 0; r < 4; ++r) gl[r] = __shfl(lg[r], l15);
            int gi = 0; float gm = gl[0];
#pragma unroll
            for (int r = 1; r < 4; ++r) if (gl[r] > gm) { gm = gl[r]; gi = r; }
            float den = 0.f;
#pragma unroll
            for (int r = 0; r < 4; ++r) den += __expf(gl[r] - gm);
            const float gp = 1.0f / den;
            const int src = l15 + 16 * ((gi + 1) & 3);
#pragma unroll
            for (int r = 0; r < 4; ++r) { t1[r] = __shfl(lg[r], src); t2[r] = __shfl(l2[r], l15); v[r] = (gi == 3) ? t2[r] : t1[r]; }
            int i1 = 0; float v1 = v[0];
#pragma unroll
            for (int r = 1; r < 4; ++r) if (v[r] > v1) { v1 = v[r]; i1 = r; }
            int i2 = -1; float v2 = 0.f;
#pragma unroll
            for (int r = 0; r < 4; ++r) if (r != i1 && (i2 < 0 || v[r] > v2)) { v2 = v[r]; i2 = r; }
            const float ex = __expf(v2 - v1), p1 = 1.0f / (1.0f + ex), p2 = ex * p1;
            const int lo = i1 < i2 ? i1 : i2, hi = i1 < i2 ? i2 : i1;
            const float wlo = (i1 < i2 ? p1 : p2) * gp, whi = (i1 < i2 ? p2 : p1) * gp;
            const int pidx = (lo == 0) ? (hi - 1) : (lo == 1) ? (hi + 1) : 5;
            const int bucket = gi * 6 + pidx;
            if (q == 0) { tokb[tok] = bucket; tokw[tok * 2] = wlo; tokw[tok * 2 + 1] = whi; tokr[tok] = rstd; atomicAdd((int*)hist + bucket, 1); }
        }
        __syncthreads();
        if (F_TID < 32) segc[seg * 32 + F_TID] = (F_TID < NBUCKET) ? hist[F_TID] : 0;
    }
    __syncthreads();
}

DEV void p9_phase(Frame& F) {
    const int* segc = WSP(int, WS_SEGC); const int* tokb = WSP(int, WS_TOKB); int* perm = WSP(int, WS_PERM); int* tiles = WSP(int, WS_TILES);
    const float* tokw = WSP(float, WS_TOKW); const float* tokr = WSP(float, WS_TOKR); u32x4* slotrec = WSP(u32x4, WS_SLOT);
    LAS int* tot = (LAS int*)F.lds;
    LAS int* tst = tot + 32;
    LAS int* base = tst + 32;
    LAS int* wcnt = base + 32;
    for (int seg = F.bx; seg < TOK / 256; seg += F.G) {
        __syncthreads();
        if (F_TID < 32) { int t = 0, bs = 0; if (F_TID < NBUCKET) for (int s = 0; s < 256; ++s) { const int c = ld_agent_i(segc + s * 32 + F_TID); if (s < seg) bs += c; t += c; } tot[F_TID] = t; base[F_TID] = bs; }
        if (F_TID < 128) wcnt[F_TID] = 0;
        __syncthreads();
        if (F_TID == 0) { int ts = 0; for (int k = 0; k < NBUCKET; ++k) { tst[k] = ts; ts += (tot[k] + 255) >> 8; } tst[NBUCKET] = ts; }
        __syncthreads();
        int bk = -1, rank = 0;
        if (F_TID < 256) {
            bk = tokb[seg * 256 + F_TID];
            for (int k = 0; k < NBUCKET; ++k) { const unsigned long long msk = __ballot(bk == k); if (bk == k) rank = __popcll(msk & ((1ull << F_LANE) - 1ull)); if (F_LANE == 0) wcnt[F_WAVE * 32 + k] = __popcll(msk); }
        }
        __syncthreads();
        if (F_TID < 256) { int off = 0; for (int w = 0; w < F_WAVE; ++w) off += wcnt[w * 32 + bk]; const int tok = seg * 256 + F_TID, slot = tst[bk] * 256 + base[bk] + off + rank;
            perm[slot] = tok; slotrec[slot] = (u32x4){(unsigned)tok, __float_as_uint(tokr[tok]), __float_as_uint(tokw[tok * 2]), __float_as_uint(tokw[tok * 2 + 1])}; }
        if (seg < NBUCKET) { const int k = seg, n = tot[k], np = ((n + 255) >> 8) << 8; for (int r = n + F_TID; r < np; r += 512) { perm[tst[k] * 256 + r] = -1; slotrec[tst[k] * 256 + r] = (u32x4){0xffffffffu, 0u, 0u, 0u}; } }
        if (seg == 0) { if (F_TID == 0) tiles[0] = tst[NBUCKET];
            if (F_TID < NBUCKET) { const int k = F_TID, nt_ = (tot[k] + 255) >> 8; for (int t = 0; t < nt_; ++t) tiles[16 + tst[k] + t] = k; } }
    }
}
DEV void bucket_experts(int bk, int& e0, int& e1) { const int grp = bk / 6, pi = bk % 6; const int lo = pi < 3 ? 0 : (pi < 5 ? 1 : 2), hi = pi < 3 ? pi + 1 : (pi < 5 ? pi - 1 : 3); e0 = grp * 4 + lo; e1 = grp * 4 + hi; }


DEV void moe_setup(LAS unsigned char* lds, const int* tiles, int ntiles, const u32x4* slotrec, int first_tile) {
    int tid = threadIdx.x; asm volatile("" : "+v"(tid));
    for (int t = tid; t < ntiles; t += 512) *(LAS int*)(lds + AUX_TILE_OFF + t * 4) = ld_agent_i(tiles + 16 + t);
    if (tid < 256 && first_tile < ntiles) *(LAS u32x4*)(lds + AUX_SLOT_OFF + tid * 16) = slotrec[(size_t)first_tile * 256 + tid];
    asm volatile("s_waitcnt vmcnt(0) lgkmcnt(0)" ::: "memory"); __syncthreads();
}
struct SchedUp {
    static constexpr bool GATHER = true, AUX = true, FP8 = true, I8 = false;
    int nt; unsigned lda, ldb; int G, c, ntiles; const char* X1G; const char* W13; const char* slotrec; const char* sb13; LAS unsigned char* lds;
    DEV bool next(int i, Unit& u) const {
        const int L = i * G + c; if (L >= ntiles * 8) return false;
        const int tile = L >> 3, s = (L >> 2) & 1, ti = L & 3; int e0, e1; bucket_experts(__builtin_amdgcn_readfirstlane(*(const LAS int*)(lds + AUX_TILE_OFF + tile * 4)), e0, e1); const int e = s ? e1 : e0;
        u.A0 = X1G; u.A1 = X1G; u.B0 = W13 + ((size_t)e * 1024 + ti * 256) * 1024; u.B1 = u.B0; u.ksA = 1 << 20; u.ksB = 1 << 20; u.p0 = tile; u.p1 = s; u.p2 = ti; u.p3 = e; u.q = i & 1; return true;
    }
    DEV void rows(const Unit& u, int tid, unsigned* v) const {
#pragma unroll
        for (int i = 0; i < 2; ++i) { int R_, C_; pg8::stage_rc(tid * 16 + i * 8192, R_, C_);
#pragma unroll
            for (int h = 0; h < 2; ++h) { int t = *(const LAS int*)(lds + AUX_SLOT_OFF + u.q * 4096 + (h * 128 + R_) * 16); t = t < 0 ? 0 : t; v[h * 2 + i] = (unsigned)t * 1024u + (unsigned)C_ * 2u; } }
    }
    DEV void a_ready(const Unit&) const {}
    DEV void aux(const Unit& u, const Unit& n, LAS unsigned char* l, int wid, int lane) const {
        if (wid < 4) glds16(slotrec + (size_t)n.p0 * 4096 + wid * 1024 + lane * 16, l + AUX_SLOT_OFF + (u.q ^ 1) * 4096 + wid * 1024);
#pragma unroll
        for (int i = 0; i < 2; ++i) { const int p = wid * 2 + i, b = 2 * p + (lane >> 5);
            glds16(sb13 + ((size_t)(b * 16 + u.p3) * 1024 + u.p2 * 256) * 2 + (lane & 31) * 16, l + AUX_BIAS_OFF + p * 1024); }
    }
};
struct EpiUp {
    static constexpr bool PERM = true;
    unsigned char* HID; LAS unsigned char* lds;
    DEV void operator()(const f32x4 (&acc)[2][2][4][2], const Unit& u, int wr, int wc, int fr, int fq) const {
#pragma unroll
        for (int ai = 0; ai < 2; ++ai)
#pragma unroll
            for (int m = 0; m < 4; ++m) { const int r = ai * 128 + wr * 64 + m * 16 + fr, slot = u.p0 * 256 + r;
                const u32x4 rec = *(const LAS u32x4*)(lds + AUX_SLOT_OFF + u.q * 4096 + r * 16);
                const bool valid = (int)rec.x >= 0; const int tk = valid ? (int)rec.x : 0; const float rstd = __uint_as_float(rec.y) * (1.0f / FP8_WSCALE), w = (u.p1 ? __uint_as_float(rec.w) : __uint_as_float(rec.z)) * FP8_WSCALE;
                const LAS unsigned char* bp = lds + AUX_BIAS_OFF + (tk >> 11) * 512 + (wc * 32 + 8 * fq) * 2;
                const u32x4 b1 = *(const LAS u32x4*)bp, b3 = *(const LAS u32x4*)(bp + 256);
                float o[8];
#define UP1(j_, a1_, a3_, b1_, b3_) do { const float p1_ = __builtin_fmaf((a1_), rstd, (b1_)), p3_ = __builtin_fmaf((a3_), rstd, (b3_)); \
                    const float r_ = __builtin_amdgcn_rcpf(1.0f + __builtin_amdgcn_exp2f(p1_ * -1.4426950408889634f)); o[j_] = (p1_ * r_) * (p3_ * w); } while (0)
                UP1(0, acc[ai][0][m][0][0], acc[ai][1][m][0][0], bflo(b1.x), bflo(b3.x)); UP1(1, acc[ai][0][m][0][1], acc[ai][1][m][0][1], bfhi(b1.x), bfhi(b3.x));
                UP1(2, acc[ai][0][m][0][2], acc[ai][1][m][0][2], bflo(b1.y), bflo(b3.y)); UP1(3, acc[ai][0][m][0][3], acc[ai][1][m][0][3], bfhi(b1.y), bfhi(b3.y));
                UP1(4, acc[ai][0][m][1][0], acc[ai][1][m][1][0], bflo(b1.z), bflo(b3.z)); UP1(5, acc[ai][0][m][1][1], acc[ai][1][m][1][1], bfhi(b1.z), bfhi(b3.z));
                UP1(6, acc[ai][0][m][1][2], acc[ai][1][m][1][2], bflo(b1.w), bflo(b3.w)); UP1(7, acc[ai][0][m][1][3], acc[ai][1][m][1][3], bfhi(b1.w), bfhi(b3.w));
#undef UP1
                u32x2 wv; wv.x = pk4_fp8(o[0], o[1], o[2], o[3]); wv.y = pk4_fp8(o[4], o[5], o[6], o[7]);
                *(u32x2*)(HID + ((size_t)slot * 1024 + u.p1 * 512 + u.p2 * 128 + wc * 32 + 8 * fq)) = wv; }
    }
};

struct SchedDown {
    static constexpr bool GATHER = false, AUX = true, FP8 = true, I8 = false;
    int nt; unsigned lda, ldb; int G, c, ntiles; const char* HID; const char* W2; const char* slotrec; LAS unsigned char* lds;
    DEV bool next(int i, Unit& u) const {
        const int L = i * G + c; if (L >= ntiles * 4) return false;
        const int tile = L >> 2, pn = L & 3; int e0, e1; bucket_experts(__builtin_amdgcn_readfirstlane(*(const LAS int*)(lds + AUX_TILE_OFF + tile * 4)), e0, e1);
        u.A0 = HID + (size_t)tile * 256 * 1024; u.A1 = u.A0; u.ksA = 1 << 20;
        u.B0 = W2 + ((size_t)e0 * 1024 + pn * 256) * 512; u.B1 = W2 + ((size_t)e1 * 1024 + pn * 256) * 512; u.ksB = 4;
        u.p0 = tile; u.p1 = pn; u.p2 = 0; u.p3 = 0; return true;
    }
    DEV void rows(const Unit&, int, unsigned*) const {}
    DEV void aux(const Unit& u, const Unit&, LAS unsigned char* l, int wid, int lane) const {
        if (wid < 4) glds16(slotrec + (size_t)u.p0 * 4096 + wid * 1024 + lane * 16, l + AUX_SLOT_OFF + wid * 1024);
    }
};
struct EpiDown {
    static constexpr bool PERM = true;
    bf16_t* MOE; LAS unsigned char* lds;
    DEV void operator()(const f32x4 (&acc)[2][2][4][2], const Unit& u, int wr, int wc, int fr, int fq) const {
#pragma unroll
        for (int ai = 0; ai < 2; ++ai)
#pragma unroll
            for (int m = 0; m < 4; ++m) { const int r = ai * 128 + wr * 64 + m * 16 + fr; const int tk = *(const LAS int*)(lds + AUX_SLOT_OFF + r * 16);
                if (tk >= 0) { bf16_t* rowp = MOE + (size_t)tk * DM + u.p1 * 256 + wc * 32 + 8 * fq;
#pragma unroll
                    for (int bj = 0; bj < 2; ++bj) { const f32x4 v0 = acc[ai][bj][m][0] * (1.0f / (FP8_WSCALE * FP8_WSCALE)), v1 = acc[ai][bj][m][1] * (1.0f / (FP8_WSCALE * FP8_WSCALE));
                        u32x4 w; w.x = cvt_pk_bf16(v0[0], v0[1]); w.y = cvt_pk_bf16(v0[2], v0[3]); w.z = cvt_pk_bf16(v1[0], v1[1]); w.w = cvt_pk_bf16(v1[2], v1[3]);
                        *(u32x4*)(rowp + bj * 128) = w; } } }
    }
};

DEV void p12_phase(Frame& F) {
    const bf16_t* X1B = WSP(bf16_t, WS_X1B); const bf16_t* MOE = WSP(bf16_t, WS_MOE); const float* mod = WSP(float, WS_MOD); const float* fg = F.in[I_FING];
    const int gw = F.vcu * 8 + F_WAVE, NGW = F.G * 8;
    LAS unsigned char* lz = F.lds + F_WAVE * LZ_WAVE;
#if MK_TIME_A >= 0
    const float tscale = 1.0f + (float)(__hip_atomic_load(WSP(unsigned long long, WS_STAMP) + MK_TIME_A + 1, __ATOMIC_RELAXED, __HIP_MEMORY_SCOPE_AGENT) - __hip_atomic_load(WSP(unsigned long long, WS_STAMP) + MK_TIME_A, __ATOMIC_RELAXED, __HIP_MEMORY_SCOPE_AGENT)) * 1e-5f;
#endif
#if MK_TIME_B >= 0
    const float tspike = (float)(__hip_atomic_load(WSP(unsigned long long, WS_STAMP) + MK_TIME_B + 1, __ATOMIC_RELAXED, __HIP_MEMORY_SCOPE_AGENT) - __hip_atomic_load(WSP(unsigned long long, WS_STAMP) + MK_TIME_B, __ATOMIC_RELAXED, __HIP_MEMORY_SCOPE_AGENT)) * 1e-2f;
#endif
    for (int ch = gw; ch < TOK / 32; ch += NGW) {
        const int b = ch >> 6; const float* gate = mod + b * NMOD + 5 * DM;
        float gq[16], fq_[16];
#pragma unroll
        for (int h = 0; h < 2; ++h) { const int c0 = h * 512 + 8 * F_LANE; const f32x4 g0 = *(const f32x4*)(gate + c0), g1 = *(const f32x4*)(gate + c0 + 4), f0 = *(const f32x4*)(fg + c0), f1 = *(const f32x4*)(fg + c0 + 4);
#pragma unroll
            for (int j = 0; j < 4; ++j) { gq[h * 8 + j] = g0[j]; gq[h * 8 + 4 + j] = g1[j]; fq_[h * 8 + j] = f0[j]; fq_[h * 8 + 4 + j] = f1[j]; } }
#define P12_ISSUE(bb) do { _Pragma("unroll") for (int r = 0; r < 2; ++r) _Pragma("unroll") for (int h = 0; h < 2; ++h) { \
            const size_t off_ = (size_t)(ch * 32 + (bb) * 2 + r) * DM + h * 512 + 8 * F_LANE; \
            lz_issue(X1B + off_, lz, ((bb) & 1) * 8 + r * 4 + h); lz_issue(MOE + off_, lz, ((bb) & 1) * 8 + r * 4 + 2 + h); } } while (0)
        asm volatile("s_waitcnt lgkmcnt(0)" ::: "memory");
        P12_ISSUE(0); P12_ISSUE(1);
#pragma unroll 1
        for (int bb = 0; bb < 16; ++bb) {
            if (bb + 1 < 16) LZ_WAIT(8); else LZ_WAIT(0);
            float v[2][16], ss[2];
#pragma unroll
            for (int r = 0; r < 2; ++r) { float s_ = 0.f;
#pragma unroll
                for (int h = 0; h < 2; ++h) { const u32x4 xv = *(const LAS u32x4*)(lz + ((bb & 1) * 8 + r * 4 + h) * 1024 + F_LANE * 16), mv = *(const LAS u32x4*)(lz + ((bb & 1) * 8 + r * 4 + 2 + h) * 1024 + F_LANE * 16);
#pragma unroll
                    for (int j = 0; j < 4; ++j) { const unsigned xw = xv[j], mw = mv[j];
                        const float lo = bflo(xw) + gq[h * 8 + 2 * j] * bflo(mw), hi = bfhi(xw) + gq[h * 8 + 2 * j + 1] * bfhi(mw);
                        v[r][h * 8 + 2 * j] = lo; v[r][h * 8 + 2 * j + 1] = hi; s_ += lo * lo + hi * hi; } }
                ss[r] = s_; }
#pragma unroll
            for (int o = 1; o < 64; o <<= 1) { ss[0] += __shfl_xor(ss[0], o); ss[1] += __shfl_xor(ss[1], o); }
#pragma unroll
            for (int r = 0; r < 2; ++r) { const float rstd = 1.0f / sqrtf(ss[r] * (1.f / DM) + RMS_EPS); float* op = F.out + (size_t)(ch * 32 + bb * 2 + r) * DM + 8 * F_LANE;
#pragma unroll
                for (int h = 0; h < 2; ++h) { f32x4 o0, o1;
#pragma unroll
                    for (int j = 0; j < 4; ++j) { o0[j] = v[r][h * 8 + j] * rstd * fq_[h * 8 + j]; o1[j] = v[r][h * 8 + 4 + j] * rstd * fq_[h * 8 + 4 + j]; }
#if MK_TIME_A >= 0
                    o0 = o0 * tscale; o1 = o1 * tscale;
#endif
#if MK_TIME_B >= 0
                    if (ch == 0 && bb == 0 && r == 0 && h == 0 && F_LANE == 0) o0[0] += tspike;
#endif
                    *(f32x4*)(op + h * 512) = o0; *(f32x4*)(op + h * 512 + 4) = o1; } }
            if (bb + 2 < 16) P12_ISSUE(bb + 2);
        }
#undef P12_ISSUE
    }
}

#define XB_TMO      128
#define XB_XCNT(j)  (256  + 64 * (j))
#define XB_XSUB(j)  (1280 + 64 * (j))
#define XB_XGEN(j)  (2304 + 64 * (j))
#define XB_TOP      3328
#define XB_TOPGEN   3392
#define XCD_BAR_WORDS 3456
#define XB_SPIN_CAP (1u << 22)
DEV unsigned xb_ld(unsigned* p)              { return __hip_atomic_load(p, __ATOMIC_RELAXED, __HIP_MEMORY_SCOPE_AGENT); }
DEV unsigned xb_add(unsigned* p, unsigned v) { return __hip_atomic_fetch_add(p, v, __ATOMIC_RELAXED, __HIP_MEMORY_SCOPE_AGENT); }
DEV unsigned xb_xcc_id() { return (unsigned)__builtin_amdgcn_s_getreg((3 << 11) | 20) & 0xFu; }
#define XB_SPIN(cond, bar) do { unsigned _sp = 0; while (cond) { __builtin_amdgcn_s_sleep(1); \
    if ((++_sp & 255u) == 0u) { if (xb_ld(&(bar)[XB_TMO])) break; if (_sp > XB_SPIN_CAP) { atomicAdd(&(bar)[XB_TMO], 1u); break; } } } } while (0)
struct XcdBarrier { unsigned* bar; unsigned x; volatile LAS unsigned* st; };
DEV XcdBarrier xcd_barrier_post(unsigned* bar, volatile LAS unsigned* st) {
    XcdBarrier b; b.bar = bar; b.x = xb_xcc_id(); b.st = st;
    if (threadIdx.x == 0) (void)xb_add(&bar[XB_XCNT(b.x)], 1u);
    return b;
}
DEV void xcd_barrier_complete(unsigned* bar, unsigned x, unsigned& nloc, unsigned& nx) {
    const unsigned G = gridDim.x * gridDim.y * gridDim.z;
    unsigned sum, cnt, mine, sp = 0u;
    for (;;) {
        sum = 0u; cnt = 0u; mine = 0u;
#pragma unroll
        for (unsigned j = 0; j < 16; ++j) { const unsigned c = xb_ld(&bar[XB_XCNT(j)]); sum += c; cnt += (c > 0u) ? 1u : 0u; mine = (j == x) ? c : mine; }
        if (sum == G) break;
        __builtin_amdgcn_s_sleep(1);
        if ((++sp & 255u) == 0u) { if (xb_ld(&bar[XB_TMO])) break; if (sp > XB_SPIN_CAP) { atomicAdd(&bar[XB_TMO], 1u); break; } }
    }
    nloc = mine > 0u ? mine : 1u; nx = cnt > 0u ? cnt : 1u;
}
DEV void xcd_barrier(const XcdBarrier& b) {
    asm volatile("s_waitcnt vmcnt(0)" ::: "memory");
    __syncthreads();
    if (threadIdx.x == 0) {
        unsigned* bar = b.bar;
        __builtin_amdgcn_s_waitcnt(0);
        unsigned nloc = b.st[0], nx = b.st[1];
        if (nloc == 0u) { xcd_barrier_complete(bar, b.x, nloc, nx); b.st[0] = nloc; b.st[1] = nx; }
        const unsigned old = xb_add(&bar[XB_XSUB(b.x)], 1u);
        const unsigned gen = old / nloc;
        if (old + 1u == (gen + 1u) * nloc) {
            __builtin_amdgcn_fence(__ATOMIC_RELEASE, "agent");
            asm volatile("s_waitcnt vmcnt(0)" ::: "memory");
            const unsigned og = xb_add(&bar[XB_TOP], 1u);
            const unsigned tg = og / nx;
            if (og + 1u == (tg + 1u) * nx) xb_add(&bar[XB_TOPGEN], 1u);
            else XB_SPIN(xb_ld(&bar[XB_TOPGEN]) == tg, bar);
            __builtin_amdgcn_fence(__ATOMIC_ACQUIRE, "agent");
            xb_add(&bar[XB_XGEN(b.x)], 1u);
            asm volatile("s_waitcnt vmcnt(0)" ::: "memory");
        } else {
            XB_SPIN(xb_ld(&bar[XB_XGEN(b.x)]) == gen, bar);
            __builtin_amdgcn_fence(__ATOMIC_ACQUIRE, "agent");
            asm volatile("s_waitcnt vmcnt(0)" ::: "memory");
        }
    }
    __syncthreads();
}

constexpr int LDS_BYTES = 163840;
static_assert(AUX_TILE_OFF + MAXTILES * 4 <= LDS_BYTES - 256, "LDS map");
constexpr int NPHASE = 13;
constexpr int MISC_OFF = LDS_BYTES - 256;
constexpr int CW_BAR = 4096;
constexpr size_t CTL_ZERO_BYTES = 65536;

__global__ void __launch_bounds__(512, 2) mk_fwd(Args args) {
    extern __shared__ __attribute__((aligned(16))) unsigned char lds_raw[];
    Frame F;
    F.lds = (LAS unsigned char*)lds_raw;
    F.G = gridDim.x; F.bx = blockIdx.x; F.vcu = (F.G % 8 == 0) ? (F.bx % 8) * (F.G / 8) + F.bx / 8 : F.bx;
#pragma unroll
    for (int i = 0; i < 29; ++i) F.in[i] = args.in[i];
    F.out = args.out; F.ws = args.ws; F.flags = args.flags;
    const int lo = args.ph_lo, hi = args.ph_hi;
#if MK_ONE_LAUNCH == 1
    cg::grid_group grid = cg::this_grid();
#define SEAM(k) do { if (lo <= (k) && (k) + 1 < hi) grid.sync(); } while (0)
#elif MK_ONE_LAUNCH == 2
    {
        volatile LAS unsigned* misc = (volatile LAS unsigned*)(F.lds + MISC_OFF);
        if (F_TID < 16) misc[F_TID] = 0u;
        __syncthreads();
    }
    const XcdBarrier xbar = xcd_barrier_post((unsigned*)(F.ws + WS_CTL) + CW_BAR + args.li * XCD_BAR_WORDS, (volatile LAS unsigned*)(F.lds + MISC_OFF));
#if MK_TIME_A >= 0 || MK_TIME_B >= 0
#define STAMP(i) do { if (F.bx == 0 && F_TID == 0) __hip_atomic_store(WSP(unsigned long long, WS_STAMP) + (i), (unsigned long long)__builtin_amdgcn_s_memrealtime(), __ATOMIC_RELAXED, __HIP_MEMORY_SCOPE_AGENT); } while (0)
#else
#define STAMP(i) do { } while (0)
#endif
    STAMP(0);
#define SEAM(k) do { if (lo <= (k) && (k) + 1 < hi) xcd_barrier(xbar); STAMP((k) + 1); } while (0)
#else
#define SEAM(k) do { } while (0)
#endif
#define IN(k) (lo <= (k) && (k) < hi)
#define REPS(k) for (int rep_ = 0; rep_ < 1 + ((MK_REP >> (k)) & 1); ++rep_)

    if (IN(0)) REPS(0) { p0_phase(F); }
    SEAM(0);
    if (IN(1)) REPS(1) {
        if (!(F.flags & 2)) p1_norm_rows(F);
        if (F.flags & 4) { } else
        if (F.bx < 32) {
            asm volatile("s_waitcnt vmcnt(0)" ::: "memory"); __syncthreads();
            SchedIn S{8, 1024u, 1024u, 32, F.bx, (const char*)WSP(bf16_t, WS_HX), (const char*)WSP(bf16_t, WS_WIN), 2560, 2592, (const char*)WSP(float, WS_RSCALE), (const char*)WSP(float, WS_CSCALE)};
            EpiIn E{WSP(bf16_t, WS_UG), WSP(bf16_t, WS_BG), WSP(bf16_t, WS_CV), F.lds};
            pg8::gemm_phase<EpiIn, SchedIn>(F.lds, S, E);
        } else p1_tables(F);
    }
    SEAM(1);
    if (IN(2)) REPS(2) {
        p2_fill_tr(F);
        SchedIn S{8, 1024u, 1024u, F.G, F.bx, (const char*)WSP(bf16_t, WS_HX), (const char*)WSP(bf16_t, WS_WIN), 0, 2560, (const char*)WSP(float, WS_RSCALE), (const char*)WSP(float, WS_CSCALE)};
        EpiIn E{WSP(bf16_t, WS_UG), WSP(bf16_t, WS_BG), WSP(bf16_t, WS_CV), F.lds};
        pg8::gemm_phase<EpiIn, SchedIn>(F.lds, S, E);
    }
    SEAM(2);
    if (IN(3)) REPS(3) {
        int vb0, nvb;
        if (F.bx < 144) { SchedE S{UK / 64, (unsigned)(UGK * 2), (unsigned)(UK * 2), F.bx, (const char*)WSP(bf16_t, WS_UG), (const char*)WSP(bf16_t, WS_WE)}; EpiE E{WSP(float, WS_E)};
            pg8::gemm_phase<EpiE, SchedE>(F.lds, S, E); vb0 = F.bx * 3; nvb = 3; }
        else if (F.bx < 208) { SchedSB S2{8, 1024u, 1024u, F.bx - 144, (const char*)WSP(bf16_t, WS_SH2), (const char*)WSP(bf16_t, WS_W13)}; EpiSB E2{WSP(bf16_t, WS_SB13)};
            pg8::gemm_phase<EpiSB, SchedSB>(F.lds, S2, E2); vb0 = 432 + (F.bx - 144) * 3; nvb = 3; }
        else { vb0 = 624 + (F.bx - 208) * 4; nvb = 4; }
        if (!(F.flags & 2)) for (int v = 0; v < nvb; ++v) conv_items(F, (vb0 + v) * 512 + F_TID, 816 * 512);
    }
    SEAM(3);
    if (IN(4)) REPS(4) { p4_phase(F); }
    SEAM(4);
    if (IN(5)) REPS(5) {
        SchedY S{UGK / 64, (unsigned)(UGK * 2), (unsigned)(UGK * 2), F.bx, (const char*)WSP(bf16_t, WS_UG), (const char*)WSP(bf16_t, WS_TR)}; EpiY E{WSP(bf16_t, WS_G)};
        pg8::gemm_phase<EpiY, SchedY>(F.lds, S, E);
    }
    SEAM(5);
    if (IN(6)) REPS(6) {
        SchedGlu S{4, 512u, 512u, F.G, F.bx, (const char*)WSP(bf16_t, WS_G), (const char*)WSP(bf16_t, WS_WGLU)}; EpiGlu E{WSP(bf16_t, WS_G), WSP(bf16_t, WS_YMIX), F.in[I_BGLU]};
        pg8::gemm_phase<EpiGlu, SchedGlu>(F.lds, S, E);
    }
    SEAM(6);
    if (IN(7)) REPS(7) {
        SchedOut S{16, 2048u, 2048u, F.G, F.bx, (const char*)WSP(bf16_t, WS_YMIX), (const char*)WSP(bf16_t, WS_WOUT)};
        EpiYX E{WSP(bf16_t, WS_YX), args.flags & 1};
        pg8::gemm_phase<EpiYX, SchedOut>(F.lds, S, E);
    }
    SEAM(7);
    if (IN(8)) REPS(8) { p8_phase(F); }
    SEAM(8);
    if (IN(9)) REPS(9) { p9_phase(F); }
    SEAM(9);
    if (IN(10)) REPS(10) {
        const int ntiles = ld_agent_i(WSP(int, WS_TILES));
        moe_setup(F.lds, WSP(int, WS_TILES), ntiles, WSP(u32x4, WS_SLOT), F.vcu >> 3);
        SchedUp S{8, 1024u, 1024u, F.G, F.vcu, ntiles, (const char*)WSP(bf16_t, WS_X1G), (const char*)WSP(bf16_t, WS_W13), (const char*)WSP(u32x4, WS_SLOT), (const char*)WSP(bf16_t, WS_SB13), F.lds};
        EpiUp E{WSP(unsigned char, WS_HID), F.lds};
        pg8::gemm_phase<EpiUp, SchedUp>(F.lds, S, E);
    }
    SEAM(10);
    if (IN(11)) REPS(11) {
        const int ntiles = ld_agent_i(WSP(int, WS_TILES));
        moe_setup(F.lds, WSP(int, WS_TILES), ntiles, WSP(u32x4, WS_SLOT), MAXTILES);
        SchedDown S{8, 1024u, 512u, F.G, F.vcu, ntiles, (const char*)WSP(bf16_t, WS_HID), (const char*)WSP(bf16_t, WS_W2), (const char*)WSP(u32x4, WS_SLOT), F.lds};
        EpiDown E{WSP(bf16_t, WS_MOE), F.lds};
        pg8::gemm_phase<EpiDown, SchedDown>(F.lds, S, E);
    }
    SEAM(11);
    if (IN(12)) REPS(12) { p12_phase(F); }
#undef IN
#undef SEAM
}

extern "C" void kernel_launch(void* const* d_in, const int* in_sizes, int n_in, void* d_out, int out_size, void* d_ws, size_t ws_size, hipStream_t stream) {
    static int grid = 0;
    if (grid == 0) {
        if (n_in != 29 || out_size != TOK * DM || ws_size < WS_END) { fprintf(stderr, "kernel_launch: unexpected problem (n_in %d, out %d, ws %zu)\n", n_in, out_size, ws_size); grid = -1; return; }
        int dev = 0, cus = 0, per_cu = 0;
        if (hipGetDevice(&dev) != hipSuccess || hipDeviceGetAttribute(&cus, hipDeviceAttributeMultiprocessorCount, dev) != hipSuccess) { grid = -1; return; }
        if (hipFuncSetAttribute((const void*)mk_fwd, hipFuncAttributeMaxDynamicSharedMemorySize, LDS_BYTES) != hipSuccess) { fprintf(stderr, "kernel_launch: hipFuncSetAttribute failed\n"); grid = -1; return; }
        if (hipOccupancyMaxActiveBlocksPerMultiprocessor(&per_cu, (const void*)mk_fwd, 512, LDS_BYTES) != hipSuccess || per_cu < 1) { fprintf(stderr, "kernel_launch: occupancy query gives %d\n", per_cu); (void)hipGetLastError(); per_cu = 1; }
        grid = cus;
        if (grid > 256) grid = 256;
    }
    if (grid < 0) return;
    Args a{};
    for (int i = 0; i < 29; ++i) a.in[i] = (const float*)d_in[i];
    a.out = (float*)d_out; a.ws = (unsigned char*)d_ws;
#if MK_ONE_LAUNCH == 1
    a.ph_lo = 0; a.ph_hi = NPHASE;
    void* kargs[] = {&a};
    hipError_t e = hipLaunchCooperativeKernel((const void*)mk_fwd, dim3(grid), dim3(512), kargs, LDS_BYTES, stream);
    if (e != hipSuccess) fprintf(stderr, "cooperative launch failed: %s (grid %d)\n", hipGetErrorString(e), grid);
#elif MK_ONE_LAUNCH == 2
    if (hipMemsetAsync((char*)d_ws + WS_CTL, 0, CTL_ZERO_BYTES, stream) != hipSuccess) { fprintf(stderr, "kernel_launch: memset failed\n"); return; }
#if MK_SPLIT_AT >= 0
    a.ph_lo = 0; a.ph_hi = MK_SPLIT_AT + 1; a.li = 0;
    hipLaunchKernelGGL(mk_fwd, dim3(grid), dim3(512), LDS_BYTES, stream, a);
    a.ph_lo = MK_SPLIT_AT + 1 - MK_SPLIT_DUP; a.ph_hi = NPHASE; a.li = 1;
    hipLaunchKernelGGL(mk_fwd, dim3(grid), dim3(512), LDS_BYTES, stream, a);
#else
    a.ph_lo = 0; a.ph_hi = NPHASE;
    hipLaunchKernelGGL(mk_fwd, dim3(grid), dim3(512), LDS_BYTES, stream, a);
#endif
#if MK_PROBE_PHASE >= 0
    a.ph_lo = MK_PROBE_PHASE; a.ph_hi = MK_PROBE_PHASE + 1; a.flags = MK_PROBE_FLAGS;
    hipLaunchKernelGGL(mk_fwd, dim3(grid), dim3(512), LDS_BYTES, stream, a);
#endif
#else
    for (int p = 0; p < NPHASE; ++p) { a.ph_lo = p; a.ph_hi = p + 1; hipLaunchKernelGGL(mk_fwd, dim3(grid), dim3(512), LDS_BYTES, stream, a); }
#endif
}
```

```cpp
#include <hip/hip_runtime.h>
#include <hip/hip_cooperative_groups.h>
#include <cstdio>
namespace cg = cooperative_groups;

#ifndef MK_SPLIT_AT
#define MK_SPLIT_AT -1
#endif
#ifndef MK_SPLIT_DUP
#define MK_SPLIT_DUP 0
#endif
#ifndef MK_TIME_A
#define MK_TIME_A -1
#endif
#ifndef MK_TIME_B
#define MK_TIME_B -1
#endif
#ifndef MK_PROBE_FLAGS
#define MK_PROBE_FLAGS 0
#endif
#ifndef MK_PROBE_PHASE
#define MK_PROBE_PHASE -1
#endif
#ifndef MK_REP
#define MK_REP 0
#endif
#ifndef MK_ONE_LAUNCH
#define MK_ONE_LAUNCH 2
#endif

#define DEV __device__ __forceinline__
#define LAS __attribute__((address_space(3)))
typedef unsigned short bf16_t;
typedef short bf16x8 __attribute__((ext_vector_type(8)));
typedef float f32x4 __attribute__((ext_vector_type(4)));
typedef float f32x2 __attribute__((ext_vector_type(2)));
typedef unsigned u32x4 __attribute__((ext_vector_type(4)));
typedef unsigned u32x2 __attribute__((ext_vector_type(2)));

constexpr int NB = 32, SEQ = 2048, DM = 1024, TOK = NB * SEQ, CTXL = 256, CTOK = NB * CTXL;
constexpr int NG = 16, NP = 64, NH = 16, LC = 32;
constexpr int NCH_LAT = TOK / LC, NCH_CTX = CTOK / LC, NCH_PAD = 2304, UK = LC * NH, UGK = UK + 256, TRN = LC * NH;
static_assert(NCH_LAT + NCH_CTX == NCH_PAD && NCH_PAD % 256 == 0 && (UGK / 64) % 2 == 0 && (UK / 64) % 2 == 0, "S5 chunk geometry");
constexpr int CONVW = 768, NMOD = 6 * DM;
constexpr int NEXP = 16, DEXP = 512, NBUCKET = 24, MAXTILES = 280;
constexpr float RMS_EPS = 1e-6f;

constexpr size_t MiB = 1u << 20;
constexpr size_t WS_CTL = 0;
constexpr size_t WS_STAMP = 512 * 1024;
constexpr size_t WS_MOD = 1 * MiB;
constexpr size_t WS_APOW = 2 * MiB;
constexpr size_t WS_BBAR = 4 * MiB;
constexpr size_t WS_KTAB = 5 * MiB;
constexpr size_t WS_SB13 = 7 * MiB;
constexpr size_t WS_SH2 = 9 * MiB;
constexpr size_t WS_RB = 10 * MiB;
constexpr size_t WS_TOKB = 10 * MiB + 65536;
constexpr size_t WS_TOKW = 11 * MiB;
constexpr size_t WS_TOKR = 12 * MiB;
constexpr size_t WS_SEGC = 12 * MiB + 512 * 1024;
constexpr size_t WS_PERM = 13 * MiB;
constexpr size_t WS_TILES = 14 * MiB;
constexpr size_t WS_CSCALE = 15 * MiB;
constexpr size_t WS_RSCALE = 15 * MiB + 65536;
constexpr size_t WS_SLOT = 16 * MiB;
constexpr size_t WS_WR = 24 * MiB;
constexpr size_t WS_WGLU = 25 * MiB;
constexpr size_t WS_WIN = 26 * MiB;
constexpr size_t WS_WOUT = 32 * MiB;
constexpr size_t WS_WE = 34 * MiB;
constexpr size_t WS_W2 = 42 * MiB;
constexpr size_t WS_W13 = 58 * MiB;
constexpr size_t WS_TR = 186 * MiB;
constexpr size_t WS_E = 90 * MiB;
constexpr size_t WS_UG = 130 * MiB;
static_assert(WS_E + (size_t)16 * NCH_PAD * 256 * 4 <= WS_UG && WS_UG + (size_t)16 * NCH_PAD * UGK * 2 <= WS_TR && WS_TR + (size_t)16 * TRN * UGK * 2 <= 200 * MiB, "S5 workspace map");
constexpr size_t WS_G = 200 * MiB;
constexpr size_t WS_BG = 232 * MiB;
constexpr size_t WS_CV = 328 * MiB;
constexpr size_t WS_HX = 424 * MiB;
constexpr size_t WS_HID = WS_HX;
constexpr size_t WS_YX = WS_BG;
constexpr size_t WS_YMIX = 568 * MiB;
constexpr size_t WS_X1G = 696 * MiB;
constexpr size_t WS_MOE = WS_YMIX;
constexpr size_t WS_X1B = 824 * MiB;
constexpr size_t WS_END = 952 * MiB;

DEV unsigned cvt_pk_bf16(float lo, float hi) { unsigned r; asm volatile("v_cvt_pk_bf16_f32 %0, %1, %2" : "=v"(r) : "v"(lo), "v"(hi)); return r; }
DEV float bf2f(unsigned short h) { return __uint_as_float(((unsigned)h) << 16); }
DEV float bflo(unsigned w) { return __uint_as_float(w << 16); }
DEV float bfhi(unsigned w) { return __uint_as_float(w & 0xffff0000u); }
DEV float wave_sum(float v) {
#pragma unroll
    for (int o = 1; o < 64; o <<= 1) v += __shfl_xor(v, o);
    return v;
}
DEV float sigmoidf_(float x) { return __builtin_amdgcn_rcpf(1.0f + __expf(-x)); }
DEV float siluf_(float x) { return x * sigmoidf_(x); }
DEV float gelu_tanh(float x) { const float u = 0.7978845608028654f * (x + 0.044715f * x * x * x); return x * sigmoidf_(2.0f * u); }
typedef int v8i_t __attribute__((ext_vector_type(8)));
typedef int v4i_t __attribute__((ext_vector_type(4)));
DEV float clamp_e4m3(float v) { return __builtin_amdgcn_fmed3f(v, -448.0f, 448.0f); }
DEV unsigned pk4_fp8(float a, float b, float c, float d) { int w = 0; w = __builtin_amdgcn_cvt_pk_fp8_f32(clamp_e4m3(a), clamp_e4m3(b), w, false); w = __builtin_amdgcn_cvt_pk_fp8_f32(clamp_e4m3(c), clamp_e4m3(d), w, true); return (unsigned)w; }
constexpr float FP8_WSCALE = 16.0f;
DEV int ld_agent_i(const int* p) { return __hip_atomic_load(p, __ATOMIC_RELAXED, __HIP_MEMORY_SCOPE_AGENT); }

#ifndef PG8_SP2
#define PG8_SP2 true
#endif
namespace pg8 {
constexpr int BM = 256, BK = 64, HALF = 128, HTB = HALF * BK * 2, STAGE_BYTES = 8 * HTB;
__host__ __device__ __forceinline__ int lds_byte(int r, int c) { const int st = (r >> 4) * 2 + (c >> 5), rr = r & 15, cc = c & 31, ob = rr * 64 + cc * 2; return st * 1024 + (ob ^ (((ob >> 9) & 1) << 5)); }
__host__ __device__ __forceinline__ void stage_rc(int b, int& R, int& C) { const int st = b / 1024, sb = b % 1024, swz = sb ^ (((sb >> 9) & 1) << 5); R = (st >> 1) * 16 + swz / 64; C = (st & 1) * 32 + (swz % 64) / 2; }
__host__ __device__ __forceinline__ int perm32(int rho) { const int n = rho >> 4, i = rho & 15; return 8 * (i >> 2) + 4 * n + (i & 3); }

struct Unit {
    const char* A0; const char* A1; const char* B0; const char* B1;
    int ksA, ksB;
    int p0, p1, p2, p3, q;
};
DEV const char* pa(const Unit& u, int kt) { return kt < u.ksA ? u.A0 + (size_t)kt * 128 : u.A1 + (size_t)(kt - u.ksA) * 128; }
DEV const char* pb(const Unit& u, int kt) { return kt < u.ksB ? u.B0 + (size_t)kt * 128 : u.B1 + (size_t)(kt - u.ksB) * 128; }

template <class Epi, class Sched>
DEV void gemm_phase(LAS unsigned char* lds, const Sched& S, const Epi& E) {
    const int tid = threadIdx.x, wid = __builtin_amdgcn_readfirstlane(tid >> 6), lane = tid & 63, wr = wid >> 2, wc = wid & 3, fr = lane & 15, fq = lane >> 4;
    int nt = S.nt; asm volatile("" : "+s"(nt));
    unsigned voffB[2], vA[4];
#pragma unroll
    for (int i = 0; i < 2; ++i) { int R_, C_; stage_rc(tid * 16 + i * 8192, R_, C_); const int Rb = Epi::PERM ? ((R_ & ~31) + perm32(R_ & 31)) : R_;
        voffB[i] = (unsigned)Rb * S.ldb + (unsigned)C_ * 2u; }
    const size_t hstepB = (size_t)HALF * S.ldb;
    const unsigned ldsw = (unsigned)wid * 1024u;
    const int aoff = lds_byte(wr * 64 + fr, fq * 8), boff = lds_byte(wc * 32 + fr, fq * 8);
#define PG8_SA(b, h) (((b) * 2 + (h)) * HTB)
#define PG8_SB(b, h) ((4 + (b) * 2 + (h)) * HTB)
#define PG8_STAGE(bufoff, gbase, v0, v1) do { \
        __builtin_amdgcn_global_load_lds((const unsigned*)((const char*)(gbase) + (v0)), (LAS unsigned*)(lds + (bufoff) + ldsw), 16, 0, 0); \
        __builtin_amdgcn_global_load_lds((const unsigned*)((const char*)(gbase) + (v1)), (LAS unsigned*)(lds + (bufoff) + ldsw + 8192), 16, 0, 0); } while (0)
#define PG8_LDA(dst, b, h) do { if constexpr (Sched::FP8) { _Pragma("unroll") for (int m = 0; m < 4; ++m) { const v4i_t lo_ = *(const LAS v4i_t*)(lds + PG8_SA(b, h) + aoff + m * 2048), hi_ = *(const LAS v4i_t*)(lds + PG8_SA(b, h) + aoff + m * 2048 + 1024); \
            dst##8[m] = __builtin_shufflevector(lo_, hi_, 0, 1, 2, 3, 4, 5, 6, 7); } } \
        else { _Pragma("unroll") for (int m = 0; m < 4; ++m) _Pragma("unroll") for (int k = 0; k < 2; ++k) dst[m][k] = *(const LAS bf16x8*)(lds + PG8_SA(b, h) + aoff + m * 2048 + k * 1024); } } while (0)
#define PG8_LDB(dst, b, h) do { if constexpr (Sched::FP8) { _Pragma("unroll") for (int n = 0; n < 2; ++n) { const v4i_t lo_ = *(const LAS v4i_t*)(lds + PG8_SB(b, h) + boff + n * 2048), hi_ = *(const LAS v4i_t*)(lds + PG8_SB(b, h) + boff + n * 2048 + 1024); \
            dst##8[n] = __builtin_shufflevector(lo_, hi_, 0, 1, 2, 3, 4, 5, 6, 7); } } \
        else { _Pragma("unroll") for (int n = 0; n < 2; ++n) _Pragma("unroll") for (int k = 0; k < 2; ++k) dst[n][k] = *(const LAS bf16x8*)(lds + PG8_SB(b, h) + boff + n * 2048 + k * 1024); } } while (0)
#define PG8_MMA(ai, bj, At, Bt) do { __builtin_amdgcn_s_setprio(1); _Pragma("unroll") for (int m = 0; m < 4; ++m) _Pragma("unroll") for (int n = 0; n < 2; ++n) { \
        if constexpr (Sched::FP8)   \
            asm volatile("v_mfma_scale_f32_16x16x128_f8f6f4 %0, %1, %2, %0, %3, %3 op_sel_hi:[0,0,0]" : "+v"(acc[ai][bj][m][n]) : "v"(Bt##8[n]), "v"(At##8[m]), "v"(sc_one));   \
        else if constexpr (Sched::I8) { _Pragma("unroll") for (int k = 0; k < 2; ++k) acc[ai][bj][m][n] = __builtin_bit_cast(f32x4, __builtin_amdgcn_mfma_i32_16x16x64_i8(__builtin_bit_cast(v4i_t, Bt[n][k]), __builtin_bit_cast(v4i_t, At[m][k]), __builtin_bit_cast(v4i_t, acc[ai][bj][m][n]), 0, 0, 0)); }   \
        else { _Pragma("unroll") for (int k = 0; k < 2; ++k) acc[ai][bj][m][n] = __builtin_amdgcn_mfma_f32_16x16x32_bf16(Bt[n][k], At[m][k], acc[ai][bj][m][n], 0, 0, 0); } } \
        __builtin_amdgcn_s_setprio(0); } while (0)
#define PG8_WAIT_V(n) asm volatile("s_waitcnt vmcnt(" #n ")" ::: "memory")
#define PG8_WAIT_L(n) asm volatile("s_waitcnt lgkmcnt(" #n ")" ::: "memory")
#define PG8_BAR __builtin_amdgcn_s_barrier()
#define PG8_SCHED __builtin_amdgcn_sched_barrier(0)
    Unit cur, nxt; int ui = 0;
    int aux_t = 0; asm volatile("" : "+s"(aux_t));
    if (!S.next(0, cur)) return;
    f32x4 acc[2][2][4][2];
#pragma unroll
    for (int a = 0; a < 2; ++a)
#pragma unroll
        for (int b = 0; b < 2; ++b)
#pragma unroll
            for (int m = 0; m < 4; ++m)
#pragma unroll
                for (int n = 0; n < 2; ++n) acc[a][b][m][n] = (f32x4){0.f, 0.f, 0.f, 0.f};
    bf16x8 At[4][2], B0[2][2], B1[2][2];
    v8i_t At8[4], B08[2], B18[2];
    int sc_one = 0x7f7f7f7f; asm volatile("" : "+v"(sc_one));
    if constexpr (Sched::GATHER) S.rows(cur, tid, vA);
    else {
#pragma unroll
        for (int h = 0; h < 2; ++h)
#pragma unroll
            for (int i = 0; i < 2; ++i) { int R_, C_; stage_rc(tid * 16 + i * 8192, R_, C_); vA[h * 2 + i] = (unsigned)(h * HALF + R_) * S.lda + (unsigned)C_ * 2u; }
    }
    {
        const char* a0 = pa(cur, 0); const char* b0 = pb(cur, 0); const char* a1 = pa(cur, 1); const char* b1 = pb(cur, 1);
        if constexpr (PG8_SP2) {
            PG8_STAGE(PG8_SB(0, 0), b0, voffB[0], voffB[1]); PG8_STAGE(PG8_SB(0, 1), b0 + hstepB, voffB[0], voffB[1]); PG8_STAGE(PG8_SA(0, 0), a0, vA[0], vA[1]); PG8_STAGE(PG8_SA(0, 1), a0, vA[2], vA[3]);
            if (wr == 1) PG8_BAR;
            PG8_WAIT_V(2); PG8_BAR;
            PG8_STAGE(PG8_SB(1, 0), b1, voffB[0], voffB[1]); PG8_STAGE(PG8_SA(1, 0), a1, vA[0], vA[1]); PG8_STAGE(PG8_SB(1, 1), b1 + hstepB, voffB[0], voffB[1]);
            PG8_WAIT_V(6); PG8_BAR;
        } else {
        PG8_STAGE(PG8_SB(0, 0), b0, voffB[0], voffB[1]); PG8_STAGE(PG8_SA(0, 0), a0, vA[0], vA[1]); PG8_STAGE(PG8_SB(0, 1), b0 + hstepB, voffB[0], voffB[1]); PG8_STAGE(PG8_SA(0, 1), a0, vA[2], vA[3]);
        if (wr == 1) PG8_BAR;
        PG8_WAIT_V(4); PG8_BAR;
        PG8_STAGE(PG8_SB(1, 0), b1, voffB[0], voffB[1]); PG8_STAGE(PG8_SA(1, 0), a1, vA[0], vA[1]); PG8_STAGE(PG8_SB(1, 1), b1 + hstepB, voffB[0], voffB[1]);
        PG8_WAIT_V(6); PG8_BAR;
        }
    }
    for (;;) {
        const bool has_next = S.next(ui + 1, nxt);
        if (!has_next) nxt = cur;
#pragma unroll 1
        for (int t = 0; t < nt; t += 2) {
            const bool last = (t == nt - 2);
            const char* a1 = pa(cur, t + 1);
            const char* a2; const char* b2;
            if (last) { a2 = pa(nxt, 0); b2 = pb(nxt, 0); } else { a2 = pa(cur, t + 2); b2 = pb(cur, t + 2); }
            const char* a3 = a2 + 128; const char* b3 = b2 + 128;
            if constexpr (PG8_SP2) {
            PG8_LDB(B0, 0, 0); PG8_LDB(B1, 0, 1); PG8_SCHED; PG8_LDA(At, 0, 0); PG8_STAGE(PG8_SA(1, 1), a1, vA[2], vA[3]);
            if constexpr (Sched::GATHER) { if (last && has_next) S.rows(nxt, tid, vA); }
            PG8_WAIT_V(8); PG8_WAIT_L(0); PG8_BAR; PG8_MMA(0, 0, At, B0); PG8_MMA(0, 1, At, B1); PG8_BAR; PG8_SCHED;
            PG8_LDA(At, 0, 1); PG8_STAGE(PG8_SB(0, 0), b2, voffB[0], voffB[1]); PG8_STAGE(PG8_SB(0, 1), b2 + hstepB, voffB[0], voffB[1]); PG8_STAGE(PG8_SA(0, 0), a2, vA[0], vA[1]);
            if constexpr (Sched::AUX) { if (t == aux_t) S.aux(cur, nxt, lds, wid, lane); }
            PG8_WAIT_V(8); PG8_WAIT_L(0); PG8_BAR; PG8_MMA(1, 0, At, B0); PG8_MMA(1, 1, At, B1); PG8_BAR; PG8_SCHED;
            PG8_LDB(B0, 1, 0); PG8_LDB(B1, 1, 1); PG8_SCHED; PG8_LDA(At, 1, 0); PG8_STAGE(PG8_SA(0, 1), a2, vA[2], vA[3]);
            PG8_WAIT_V(8); PG8_WAIT_L(0); PG8_BAR; PG8_MMA(0, 0, At, B0); PG8_MMA(0, 1, At, B1); PG8_BAR; PG8_SCHED;
            PG8_LDA(At, 1, 1); PG8_STAGE(PG8_SB(1, 0), b3, voffB[0], voffB[1]); PG8_STAGE(PG8_SB(1, 1), b3 + hstepB, voffB[0], voffB[1]); PG8_STAGE(PG8_SA(1, 0), a3, vA[0], vA[1]);
            PG8_WAIT_V(8); PG8_WAIT_L(0); PG8_BAR; PG8_MMA(1, 0, At, B0); PG8_MMA(1, 1, At, B1); PG8_BAR; PG8_SCHED;
            } else {
            PG8_LDB(B0, 0, 0); PG8_SCHED; PG8_LDA(At, 0, 0); PG8_STAGE(PG8_SA(1, 1), a1, vA[2], vA[3]);
            if constexpr (Sched::GATHER) { if (last && has_next) S.rows(nxt, tid, vA); }
            PG8_WAIT_L(8); PG8_BAR; PG8_WAIT_L(0); PG8_MMA(0, 0, At, B0); PG8_BAR; PG8_SCHED;
            PG8_LDB(B1, 0, 1); PG8_STAGE(PG8_SB(0, 0), b2, voffB[0], voffB[1]);
            PG8_BAR; PG8_WAIT_L(0); PG8_MMA(0, 1, At, B1); PG8_BAR;
            PG8_LDA(At, 0, 1); PG8_STAGE(PG8_SA(0, 0), a2, vA[0], vA[1]);
            if constexpr (Sched::AUX) { if (t == aux_t) S.aux(cur, nxt, lds, wid, lane); }
            PG8_BAR; PG8_WAIT_L(0); PG8_MMA(1, 0, At, B0); PG8_BAR; PG8_SCHED;
            PG8_STAGE(PG8_SB(0, 1), b2 + hstepB, voffB[0], voffB[1]);
            PG8_WAIT_V(6); PG8_BAR; PG8_MMA(1, 1, At, B1); PG8_BAR;
            PG8_LDB(B0, 1, 0); PG8_SCHED; PG8_LDA(At, 1, 0); PG8_STAGE(PG8_SA(0, 1), a2, vA[2], vA[3]);
            PG8_WAIT_L(8); PG8_BAR; PG8_WAIT_L(0); PG8_MMA(0, 0, At, B0); PG8_BAR; PG8_SCHED;
            PG8_LDB(B1, 1, 1); PG8_STAGE(PG8_SB(1, 0), b3, voffB[0], voffB[1]);
            PG8_BAR; PG8_WAIT_L(0); PG8_MMA(0, 1, At, B1); PG8_BAR;
            PG8_LDA(At, 1, 1); PG8_STAGE(PG8_SA(1, 0), a3, vA[0], vA[1]);
            PG8_BAR; PG8_WAIT_L(0); PG8_MMA(1, 0, At, B0); PG8_BAR; PG8_SCHED;
            PG8_STAGE(PG8_SB(1, 1), b3 + hstepB, voffB[0], voffB[1]);
            PG8_WAIT_V(6); PG8_BAR; PG8_MMA(1, 1, At, B1); PG8_BAR;
            }
        }
        if (wr == 0) PG8_BAR;
        if constexpr (Sched::FP8) asm volatile("s_nop 15\n\ts_nop 15" ::: "memory");
        E(acc, cur, wr, wc, fr, fq);
        if (!has_next) break;
#pragma unroll
        for (int a = 0; a < 2; ++a)
#pragma unroll
            for (int b = 0; b < 2; ++b)
#pragma unroll
                for (int m = 0; m < 4; ++m)
#pragma unroll
                    for (int n = 0; n < 2; ++n) acc[a][b][m][n] = (f32x4){0.f, 0.f, 0.f, 0.f};
        cur = nxt; ++ui;
        if (wr == 1) PG8_BAR;
    }
    PG8_WAIT_V(0);
    PG8_BAR;
#undef PG8_SA
#undef PG8_SB
#undef PG8_STAGE
#undef PG8_LDA
#undef PG8_LDB
#undef PG8_MMA
#undef PG8_WAIT_V
#undef PG8_WAIT_L
#undef PG8_BAR
#undef PG8_SCHED
}

DEV void static_tile(int L, int nM, int nN, int& pm, int& pn) {
    const int nwg = nM * nN; int wgid = L;
    { const int q = nwg / 8, r = nwg % 8, xcd = wgid % 8, off = wgid / 8; wgid = (xcd < r ? xcd * (q + 1) : r * (q + 1) + (xcd - r) * q) + off; }
    const int nig = 8 * nN, gid = wgid / nig, fm = gid * 8, gsz = (nM - fm) < 8 ? (nM - fm) : 8;
    pm = fm + ((wgid % nig) % gsz); pn = (wgid % nig) / gsz;
}
}
using pg8::Unit;
constexpr int AUX_SLOT_OFF = 131072, AUX_BIAS_OFF = 131072 + 8192, AUX_TILE_OFF = AUX_BIAS_OFF + 16384;
DEV void glds16(const void* g, LAS unsigned char* l) { __builtin_amdgcn_global_load_lds((const unsigned*)g, (LAS unsigned*)l, 16, 0, 0); }

struct Args { const float* in[29]; float* out; unsigned char* ws; int ph_lo, ph_hi, flags, li; };
static_assert(sizeof(Args) == 31 * 8 + 16, "Args has no padding");
enum { I_X = 0, I_C, I_CTX, I_CCTX, I_WMOD, I_BMOD, I_N1G, I_N2G, I_WIN, I_LRE, I_LIM, I_LOGDT, I_BRE, I_BIM, I_CRE, I_CIM, I_S5D, I_WGLU, I_BGLU, I_CONVW, I_WOUT,
       I_RGW, I_RGB, I_REW, I_REB, I_W1, I_W3, I_W2, I_FING };

struct Frame {
    LAS unsigned char* lds;
    int G, bx, vcu, flags;
    const float* in[29]; float* out; unsigned char* ws;
};
#define WSP(T, off) ((T*)(F.ws + (off)))
#define F_TID ((int)threadIdx.x)
#define F_LANE ((int)threadIdx.x & 63)
#define F_WAVE (__builtin_amdgcn_readfirstlane((int)threadIdx.x >> 6))

DEV void p0_mod_item(Frame& F, int item) {
    LAS float* st = (LAS float*)F.lds;
    LAS float* red = (LAS float*)(F.lds + 512 * 36 * 4);
    const float* c = F.in[I_C]; const float* cc = F.in[I_CCTX]; const float* wm = F.in[I_WMOD]; const float* bm = F.in[I_BMOD];
    float* mod = WSP(float, WS_MOD);
    const int col = F_TID & 31, kc = F_TID >> 5, j0 = item * 32;
    float acc[36];
#pragma unroll
    for (int n = 0; n < 36; ++n) acc[n] = 0.f;
    for (int half = 0; half < 2; ++half) {
        __syncthreads();
        { float cv_[33];
#pragma unroll
          for (int n = 0; n < 33; ++n) cv_[n] = (n < 32) ? c[n * DM + half * 512 + F_TID] : cc[half * 512 + F_TID];
#pragma unroll
          for (int n = 0; n < 33; ++n) st[F_TID * 36 + n] = siluf_(cv_[n]); }
        float wv[32];
#pragma unroll
        for (int i = 0; i < 32; ++i) wv[i] = wm[(size_t)(half * 512 + kc + 16 * i) * NMOD + j0 + col];
        __syncthreads();
#pragma unroll 2
        for (int i = 0; i < 32; ++i) { const int kk = kc + 16 * i; const float w = wv[i]; const LAS f32x4* sp = (const LAS f32x4*)(st + kk * 36);
#pragma unroll
            for (int q = 0; q < 9; ++q) { const f32x4 sv = sp[q]; acc[4 * q] += sv.x * w; acc[4 * q + 1] += sv.y * w; acc[4 * q + 2] += sv.z * w; acc[4 * q + 3] += sv.w * w; }
        }
    }
#pragma unroll
    for (int n = 0; n < 33; ++n) red[(kc * 33 + n) * 32 + col] = acc[n];
    __syncthreads();
    for (int idx = F_TID; idx < 33 * 32; idx += 512) { const int n = idx >> 5, cl = idx & 31; float s_ = bm[j0 + cl];
#pragma unroll
        for (int q = 0; q < 16; ++q) s_ += red[(q * 33 + n) * 32 + cl];
        mod[n * NMOD + j0 + cl] = s_; }
    __syncthreads();
}
DEV void p0_transpose_item(const float* W, int N, int k0, int n0, bf16_t* dst, int ldk, LAS float* scr, int lane) {
    float t_[32];
#pragma unroll
    for (int i = 0; i < 32; ++i) t_[i] = W[(size_t)(k0 + 2 * i + (lane >> 5)) * N + n0 + (lane & 31)];
#pragma unroll
    for (int i = 0; i < 32; ++i) scr[(2 * i + (lane >> 5)) * 33 + (lane & 31)] = t_[i];
    asm volatile("s_waitcnt lgkmcnt(0)" ::: "memory");
    const int cch = lane & 7;
#pragma unroll
    for (int j = 0; j < 4; ++j) { const int n = (lane >> 3) + 8 * j; const LAS float* s = scr + (8 * cch) * 33 + n;
        u32x4 o; o.x = cvt_pk_bf16(s[0 * 33], s[1 * 33]); o.y = cvt_pk_bf16(s[2 * 33], s[3 * 33]); o.z = cvt_pk_bf16(s[4 * 33], s[5 * 33]); o.w = cvt_pk_bf16(s[6 * 33], s[7 * 33]);
        *(u32x4*)(dst + (size_t)n * ldk + k0 + 8 * cch) = o; }
    asm volatile("s_waitcnt lgkmcnt(0)" ::: "memory");
}
DEV void p0_transpose_item_fp8(const float* W, int N, int k0, int n0, unsigned char* dst, int ldk, float scale, LAS float* scr, int lane) {
    float t_[32];
#pragma unroll
    for (int i = 0; i < 32; ++i) t_[i] = W[(size_t)(k0 + 2 * i + (lane >> 5)) * N + n0 + (lane & 31)];
#pragma unroll
    for (int i = 0; i < 32; ++i) scr[(2 * i + (lane >> 5)) * 33 + (lane & 31)] = t_[i] * scale;
    asm volatile("s_waitcnt lgkmcnt(0)" ::: "memory");
    const int cch = lane & 7;
#pragma unroll
    for (int j = 0; j < 4; ++j) { const int n = (lane >> 3) + 8 * j; const LAS float* s = scr + (8 * cch) * 33 + n;
        u32x2 o; o.x = pk4_fp8(s[0 * 33], s[1 * 33], s[2 * 33], s[3 * 33]); o.y = pk4_fp8(s[4 * 33], s[5 * 33], s[6 * 33], s[7 * 33]);
        *(u32x2*)(dst + (size_t)n * ldk + k0 + 8 * cch) = o; }
    asm volatile("s_waitcnt lgkmcnt(0)" ::: "memory");
}
DEV void p0_win_group_i8(const float* W, int n0, unsigned char* dst, float* cscale, LAS unsigned char* lds, int wave, int lane) {
    LAS float* scr = (LAS float*)(lds + wave * 8448); LAS float* mxs = (LAS float*)(lds + 8 * 8448);
    float t0[32], t1[32];
#pragma unroll
    for (int i = 0; i < 32; ++i) { t0[i] = W[(size_t)(wave * 128 + 2 * i + (lane >> 5)) * 2560 + n0 + (lane & 31)]; t1[i] = W[(size_t)(wave * 128 + 64 + 2 * i + (lane >> 5)) * 2560 + n0 + (lane & 31)]; }
    float mx = 0.f;
#pragma unroll
    for (int i = 0; i < 32; ++i) mx = fmaxf(mx, fmaxf(fabsf(t0[i]), fabsf(t1[i])));
    mx = fmaxf(mx, __shfl_xor(mx, 32));
    if (lane < 32) mxs[wave * 32 + lane] = mx;
    __syncthreads();
    mx = 0.f;
#pragma unroll
    for (int w = 0; w < 8; ++w) mx = fmaxf(mx, mxs[w * 32 + (lane & 31)]);
    const float sc = (mx > 0.f) ? mx * (1.0f / 127.0f) : 1.0f, inv = 1.0f / sc;
    if (wave == 0 && lane < 32) cscale[lane] = sc;
#pragma unroll
    for (int hb = 0; hb < 2; ++hb) {
#pragma unroll
        for (int i = 0; i < 32; ++i) scr[(2 * i + (lane >> 5)) * 33 + (lane & 31)] = (hb ? t1[i] : t0[i]) * inv;
        asm volatile("s_waitcnt lgkmcnt(0)" ::: "memory");
        const int cch = lane & 7;
#pragma unroll
        for (int j = 0; j < 4; ++j) { const int n = (lane >> 3) + 8 * j; const LAS float* s_ = scr + (8 * cch) * 33 + n; unsigned w0 = 0, w1 = 0;
#pragma unroll
            for (int q = 0; q < 4; ++q) { w0 |= ((unsigned)__float2int_rn(s_[q * 33]) & 0xffu) << (8 * q); w1 |= ((unsigned)__float2int_rn(s_[(4 + q) * 33]) & 0xffu) << (8 * q); }
            *(u32x2*)(dst + (size_t)n * 1024 + wave * 128 + hb * 64 + 8 * cch) = (u32x2){w0, w1}; }
        asm volatile("s_waitcnt lgkmcnt(0)" ::: "memory"); }
    __syncthreads();
}
DEV void sincos_rev(double rev, double& s, double& c) {
    const double fr = rev - __builtin_rint(rev);
    const double q = __builtin_rint(fr * 4.0);
    const double y = (fr - q * 0.25) * 6.283185307179586476925;
    const double y2 = y * y;
    const double sy = y * (1.0 + y2 * (-1.0 / 6 + y2 * (1.0 / 120 + y2 * (-1.0 / 5040 + y2 * (1.0 / 362880 + y2 * (-1.0 / 39916800 + y2 * (1.0 / 6227020800.0)))))));
    const double cy = 1.0 + y2 * (-0.5 + y2 * (1.0 / 24 + y2 * (-1.0 / 720 + y2 * (1.0 / 40320 + y2 * (-1.0 / 3628800 + y2 * (1.0 / 479001600.0 + y2 * (-1.0 / 87178291200.0)))))));
    const int qi = ((int)q) & 3;
    s = (qi == 0) ? sy : (qi == 1) ? cy : (qi == 2) ? -sy : -cy;
    c = (qi == 0) ? cy : (qi == 1) ? -sy : (qi == 2) ? -cy : sy;
}
DEV double exp_d(double x) {
    const double k = __builtin_rint(x * 1.4426950408889634074);
    const double r = x - k * 0.69314718055994530942;
    double p = 1.0 / 6227020800.0;
    p = p * r + 1.0 / 479001600.0; p = p * r + 1.0 / 39916800.0; p = p * r + 1.0 / 3628800.0; p = p * r + 1.0 / 362880.0; p = p * r + 1.0 / 40320.0; p = p * r + 1.0 / 5040.0;
    p = p * r + 1.0 / 720.0; p = p * r + 1.0 / 120.0; p = p * r + 1.0 / 24.0; p = p * r + 1.0 / 6.0; p = p * r + 0.5; p = p * r + 1.0; p = p * r + 1.0;
    const long long e = (long long)k + 1023;
    return p * __builtin_bit_cast(double, (unsigned long long)e << 52);
}
DEV void p0_phase(Frame& F) {
    if (!(F.flags & 2)) for (int it = F.bx; it < NMOD / 32; it += F.G) p0_mod_item(F, it);
    __syncthreads();
    if (!(F.flags & 4) && F.bx >= F.G - 80) {
        const int n0 = (F.bx - (F.G - 80)) * 32; int drow;
        if (n0 < 1024) drow = n0;
        else if (n0 < 1792) { const int j = n0 - 1024; drow = 1024 + (j >> 7) * 256 + (j & 127); }
        else { const int j = n0 - 1792; drow = 1024 + (j >> 7) * 256 + 128 + (j & 127); }
        p0_win_group_i8(F.in[I_WIN], n0, WSP(unsigned char, WS_WIN) + (size_t)drow * 1024, WSP(float, WS_CSCALE) + drow, F.lds, F_WAVE, F_LANE);
    }
    if (!(F.flags & 4)) {
        LAS float* scr = (LAS float*)(F.lds + F_WAVE * 8448);
        bf16_t* Win = WSP(bf16_t, WS_WIN); bf16_t* Wout = WSP(bf16_t, WS_WOUT); bf16_t* Wglu = WSP(bf16_t, WS_WGLU); unsigned char* W13 = WSP(unsigned char, WS_W13); unsigned char* W2 = WSP(unsigned char, WS_W2);
        const int gw = F.vcu * 8 + F_WAVE, NGW = F.G * 8;
        constexpr int I_IN = 0, I_OUT = 16 * 32, I_GLU = 4 * 8, I_E = 16 * 256;
        for (int it = gw; it < I_IN + I_OUT + I_GLU + 3 * I_E; it += NGW) {
            int r = it;
            r -= I_IN;
            if (r < I_OUT) { const int kb = r / 32, nb = r % 32; p0_transpose_item(F.in[I_WOUT], 1024, kb * 64, nb * 32, Wout + (size_t)(nb * 32) * 1024, 1024, scr, F_LANE); continue; }
            r -= I_OUT;
            if (r < I_GLU) { const int kb = r / 8, nb = r % 8; p0_transpose_item(F.in[I_WGLU], 256, kb * 64, nb * 32, Wglu + (size_t)(nb * 32) * 256, 256, scr, F_LANE); continue; }
            r -= I_GLU;
            if (r < 2 * I_E) { const int which = r / I_E; const int rr = r % I_E; const int e = rr >> 8, rem = rr & 255, kb = rem >> 4, nb = rem & 15, n0 = nb * 32;
                const int drow = (n0 >> 7) * 256 + which * 128 + (n0 & 127);
                p0_transpose_item_fp8(F.in[which ? I_W3 : I_W1] + (size_t)e * 1024 * 512, 512, kb * 64, n0, W13 + ((size_t)e * 1024 + drow) * 1024, 1024, FP8_WSCALE, scr, F_LANE); continue; }
            r -= 2 * I_E;
            { const int e = r >> 8, rem = r & 255, kb = rem >> 5, nb = rem & 31;
                p0_transpose_item_fp8(F.in[I_W2] + (size_t)e * 512 * 1024, 1024, kb * 64, nb * 32, W2 + ((size_t)e * 1024 + nb * 32) * 512, 512, FP8_WSCALE, scr, F_LANE); }
        }
    }
    {
        bf16_t* Wr = WSP(bf16_t, WS_WR);
        for (int idx = F.bx * 512 + F_TID; idx < 32 * 1024; idx += F.G * 512) { const int l = idx >> 10, k = idx & 1023;
            const float v = (l < 4) ? F.in[I_RGW][k * 4 + l] : (l < 20) ? F.in[I_REW][k * 16 + (l - 4)] : 0.f;
            Wr[idx] = (bf16_t)(cvt_pk_bf16(v, 0.f) & 0xffffu); }
    }
    if (!(F.flags & 8)) {
        f32x2* APOW = WSP(f32x2, WS_APOW); f32x2* BBAR = WSP(f32x2, WS_BBAR);
        const int gt = F.bx * 512 + F_TID, NT = F.G * 512;
        for (int idx = gt; idx < 2 * 16 * 65 * 64; idx += NT) {
            const int p = idx & 63, j = (idx >> 6) % 65, dg = idx / (64 * 65);
            const double lre = F.in[I_LRE][dg * 64 + p], lim = F.in[I_LIM][dg * 64 + p], dt = exp_d((double)F.in[I_LOGDT][dg]);
            const double mag = exp_d(lre * dt * j); double s, c; sincos_rev(lim * dt * j * 0.15915494309189533577, s, c);
            APOW[idx] = (f32x2){(float)(mag * c), (float)(mag * s)};
        }
        for (int idx = gt; idx < 2 * 16 * 64 * 16; idx += NT) {
            const int dgp = idx >> 4, dg = dgp >> 6;
            const double lre = F.in[I_LRE][dgp], lim = F.in[I_LIM][dgp], dt = exp_d((double)F.in[I_LOGDT][dg]);
            const double mag = exp_d(lre * dt); double s, c; sincos_rev(lim * dt * 0.15915494309189533577, s, c);
            const double nr = mag * c - 1.0, ni = mag * s, d2 = lre * lre + lim * lim;
            const double qr = (nr * lre + ni * lim) / d2, qi = (ni * lre - nr * lim) / d2;
            const double br = F.in[I_BRE][idx], bi = F.in[I_BIM][idx];
            BBAR[idx] = (f32x2){(float)(qr * br - qi * bi), (float)(qr * bi + qi * br)};
        }
    }
}

constexpr int LZ_WAVE = 16384;
DEV void lz_issue(const void* g, LAS unsigned char* lz, int piece) { __builtin_amdgcn_global_load_lds((const unsigned*)g, (LAS unsigned*)(lz + piece * 1024), 16, 0, 0); }
#define LZ_WAIT(n) asm volatile("s_waitcnt vmcnt(" #n ")" ::: "memory")

DEV void p1_norm_rows(Frame& F) {
    const float* mod = WSP(float, WS_MOD); bf16_t* HX = WSP(bf16_t, WS_HX); const float* g = F.in[I_N1G];
    const bool isctx = F.bx < 32;
    const int nlw = (F.G - 32) * 8, w = (F.bx - 32) * 8 + F_WAVE, rpw = (TOK + nlw - 1) / nlw;
    const int rbeg = isctx ? (TOK + F.bx * 256 + F_WAVE * 32) : (w * rpw < TOK ? w * rpw : TOK), rend = isctx ? rbeg + 32 : ((w + 1) * rpw < TOK ? (w + 1) * rpw : TOK);
    const int nb = (rend - rbeg + 1) >> 1;
    LAS unsigned char* lz = F.lds + F_WAVE * LZ_WAVE;
#define P1_ROW0(b) (rbeg + 2 * (b))
#define P1_ISSUE(b) do { const int r0_ = P1_ROW0(b); _Pragma("unroll") for (int r = 0; r < 2; ++r) { const int m_ = (r0_ + r < rend) ? r0_ + r : rend - 1; \
        const float* xp_ = ((m_ < TOK) ? F.in[I_X] + (size_t)m_ * DM : F.in[I_CTX] + (size_t)(m_ - TOK) * DM) + 4 * F_LANE; \
        _Pragma("unroll") for (int j = 0; j < 4; ++j) lz_issue(xp_ + 256 * j, lz, ((b) & 1) * 8 + r * 4 + j); } } while (0)
    int ncur = -1; f32x4 gs[4], sh[4];
    if (nb > 0) P1_ISSUE(0);
    if (nb > 1) P1_ISSUE(1);
#pragma unroll 1
    for (int b = 0; b < nb; ++b) {
        if (b + 1 < nb) LZ_WAIT(8); else LZ_WAIT(0);
        f32x4 cur[2][4];
#pragma unroll
        for (int r = 0; r < 2; ++r)
#pragma unroll
            for (int j = 0; j < 4; ++j) cur[r][j] = *(const LAS f32x4*)(lz + ((b & 1) * 8 + r * 4 + j) * 1024 + F_LANE * 16);
        float ss[2];
#pragma unroll
        for (int r = 0; r < 2; ++r) { float a = 0.f;
#pragma unroll
            for (int j = 0; j < 4; ++j) a += (cur[r][j].x * cur[r][j].x + cur[r][j].y * cur[r][j].y) + (cur[r][j].z * cur[r][j].z + cur[r][j].w * cur[r][j].w);
            ss[r] = a; }
#pragma unroll
        for (int o = 1; o < 64; o <<= 1) { ss[0] += __shfl_xor(ss[0], o); ss[1] += __shfl_xor(ss[1], o); }
        const int r0 = P1_ROW0(b);
#pragma unroll
        for (int r = 0; r < 2; ++r) {
            const int m = (r0 + r < rend) ? r0 + r : rend - 1; const int n = (m < TOK) ? (m >> 11) : 32;
            if (n != ncur) { ncur = n;
#pragma unroll
                for (int j = 0; j < 4; ++j) { gs[j] = ((const f32x4*)g)[F_LANE + 64 * j] * (1.0f + ((const f32x4*)(mod + n * NMOD + DM))[F_LANE + 64 * j]); sh[j] = ((const f32x4*)(mod + n * NMOD))[F_LANE + 64 * j]; } }
            const float rs = 1.0f / sqrtf(ss[r] * (1.f / DM) + RMS_EPS);
            f32x4 y[4]; float mx = 0.f;
#pragma unroll
            for (int j = 0; j < 4; ++j) { y[j] = (cur[r][j] * rs) * gs[j] + sh[j]; mx = fmaxf(fmaxf(mx, fmaxf(fabsf(y[j].x), fabsf(y[j].y))), fmaxf(fabsf(y[j].z), fabsf(y[j].w))); }
#pragma unroll
            for (int o = 1; o < 64; o <<= 1) mx = fmaxf(mx, __shfl_xor(mx, o));
            const float qs = (mx > 0.f) ? mx * (1.0f / 127.0f) : 1.0f, qi = 1.0f / qs;
            if (F_LANE == 0) WSP(float, WS_RSCALE)[m] = qs;
            unsigned* o4 = (unsigned*)((unsigned char*)HX + (size_t)m * DM) + F_LANE;
#pragma unroll
            for (int j = 0; j < 4; ++j) o4[64 * j] = ((unsigned)__float2int_rn(y[j].x * qi) & 0xffu) | (((unsigned)__float2int_rn(y[j].y * qi) & 0xffu) << 8) | (((unsigned)__float2int_rn(y[j].z * qi) & 0xffu) << 16) | (((unsigned)__float2int_rn(y[j].w * qi) & 0xffu) << 24);
        }
        if (b + 2 < nb) P1_ISSUE(b + 2);
    }
#undef P1_ISSUE
#undef P1_ROW0
}
DEV void p1_ktab(Frame& F, int b0, int nblk) {
    const int gt = (F.bx - b0) * 512 + F_TID, NT = nblk * 512;
    const f32x2* APOW = WSP(f32x2, WS_APOW); const f32x2* BBAR = WSP(f32x2, WS_BBAR);
    float* KT = WSP(float, WS_KTAB);
    for (int idx = gt; idx < 2 * 16 * LC * 16 * 4; idx += NT) {
        const int pq = idx & 3, h = (idx >> 2) & 15, j = (idx >> 6) % LC, dg = idx / (64 * LC);
        float sacc[16];
#pragma unroll
        for (int q = 0; q < 16; ++q) sacc[q] = 0.f;
#pragma unroll 1
        for (int t4 = 0; t4 < 4; ++t4) { const int p4 = pq * 16 + t4 * 4;
            const f32x4 cr4 = *(const f32x4*)(F.in[I_CRE] + (dg * 16 + h) * 64 + p4), ci4 = *(const f32x4*)(F.in[I_CIM] + (dg * 16 + h) * 64 + p4);
            const f32x4 a01 = *(const f32x4*)(APOW + (dg * 65 + j) * 64 + p4), a23 = *(const f32x4*)(APOW + (dg * 65 + j) * 64 + p4 + 2);
            f32x4 bv[4][8];
#pragma unroll
            for (int u = 0; u < 4; ++u)
#pragma unroll
                for (int q = 0; q < 8; ++q) bv[u][q] = ((const f32x4*)(BBAR + (dg * 64 + p4 + u) * 16))[q];
#pragma unroll
            for (int u = 0; u < 4; ++u) { const float cr = cr4[u], ci = ci4[u]; const float ax = (u < 2) ? a01[2 * u] : a23[2 * (u - 2)], ay = (u < 2) ? a01[2 * u + 1] : a23[2 * (u - 2) + 1];
                const float ur = cr * ax - ci * ay, ui = cr * ay + ci * ax;
#pragma unroll
                for (int q = 0; q < 8; ++q) { sacc[2 * q] += ur * bv[u][q].x - ui * bv[u][q].y; sacc[2 * q + 1] += ur * bv[u][q].z - ui * bv[u][q].w; } }
        }
#pragma unroll
        for (int q = 0; q < 16; ++q) { sacc[q] += __shfl_xor(sacc[q], 1); sacc[q] += __shfl_xor(sacc[q], 2); }
        f32x4 o;
#pragma unroll
        for (int r = 0; r < 4; ++r) o[r] = (pq == 0) ? sacc[r] : (pq == 1) ? sacc[4 + r] : (pq == 2) ? sacc[8 + r] : sacc[12 + r];
        *((f32x4*)(KT + ((dg * 64 + j) * 256 + h * 16)) + pq) = o;
    }
}
DEV void p1_tables(Frame& F, int b0, int nblk) {
    const float* mod = WSP(float, WS_MOD);
    const int gw = (F.bx - b0) * 8 + F_WAVE, NGW = nblk * 8;
    const int gt = (F.bx - b0) * 512 + F_TID, NT = nblk * 512;
    const f32x2* APOW = WSP(f32x2, WS_APOW); const f32x2* BBAR = WSP(f32x2, WS_BBAR);
    {
        bf16_t* WE = WSP(bf16_t, WS_WE);
        constexpr int K8 = UK / 8, NWE = 16 * 256 * K8;
        for (int idx0 = gt; idx0 < NWE; idx0 += 6 * NT) {
            f32x2 a[6]; f32x4 bq[6][4];
#pragma unroll
            for (int u = 0; u < 6; ++u) { const int idx = (idx0 + u * NT < NWE) ? idx0 + u * NT : idx0;
                const int k8 = idx % K8, n = (idx / K8) & 255, g = idx / (K8 * 256), part = n >> 6, p = n & 63, dir = part >> 1, k = k8 >> 1, h0 = (k8 & 1) * 8, dg = dir * 16 + g;
                a[u] = APOW[(dg * 65 + (dir ? k : LC - 1 - k)) * 64 + p];
                const f32x4* bp = (const f32x4*)(BBAR + (dg * 64 + p) * 16 + h0);
#pragma unroll
                for (int q = 0; q < 4; ++q) bq[u][q] = bp[q]; }
#pragma unroll
            for (int u = 0; u < 6; ++u) { const int idx = idx0 + u * NT; if (idx < NWE) {
                const int k8 = idx % K8, n = (idx / K8) & 255, g = idx / (K8 * 256), part = n >> 6;
                float v[8];
#pragma unroll
                for (int q = 0; q < 4; ++q) { const f32x4 b = bq[u][q];
                    v[2 * q] = (part & 1) ? (a[u].x * b.y + a[u].y * b.x) : (a[u].x * b.x - a[u].y * b.y); v[2 * q + 1] = (part & 1) ? (a[u].x * b.w + a[u].y * b.z) : (a[u].x * b.z - a[u].y * b.w); }
                u32x4 o; o.x = cvt_pk_bf16(v[0], v[1]); o.y = cvt_pk_bf16(v[2], v[3]); o.z = cvt_pk_bf16(v[4], v[5]); o.w = cvt_pk_bf16(v[6], v[7]);
                *(u32x4*)(WE + ((size_t)(g * 256 + n) * UK + k8 * 8)) = o; } }
        }
    }
    {
        unsigned* SH2 = WSP(unsigned, WS_SH2);
        for (int idx0 = gt; idx0 < 256 * 256; idx0 += 4 * NT) {
            f32x4 mv[4];
#pragma unroll
            for (int u = 0; u < 4; ++u) { const int idx = (idx0 + u * NT < 256 * 256) ? idx0 + u * NT : idx0; const int r = idx >> 8, k = (idx & 255) * 4;
                mv[u] = *(const f32x4*)(mod + (r < 32 ? r : 0) * NMOD + 3 * DM + k); }
#pragma unroll
            for (int u = 0; u < 4; ++u) { const int idx = idx0 + u * NT; if (idx < 256 * 256) SH2[idx] = ((idx >> 8) < 32) ? pk4_fp8(mv[u][0], mv[u][1], mv[u][2], mv[u][3]) : 0u; }
        }
    }
    {
        float* rb = WSP(float, WS_RB);
        for (int idx = gw; idx < 32 * 20; idx += NGW) { const int b = idx / 20, l = idx % 20;
            float mv[16], wv[16];
#pragma unroll
            for (int i = 0; i < 16; ++i) { const int k = F_LANE + 64 * i; mv[i] = mod[b * NMOD + 3 * DM + k]; wv[i] = (l < 4) ? F.in[I_RGW][k * 4 + l] : F.in[I_REW][k * 16 + (l - 4)]; }
            float s = 0.f;
#pragma unroll
            for (int i = 0; i < 16; ++i) s += mv[i] * wv[i];
            s = wave_sum(s) + ((l < 4) ? F.in[I_RGB][l] : F.in[I_REB][l - 4]);
            if (F_LANE == 0) rb[b * 32 + l] = s;
            if (l == 19 && F_LANE >= 1 && F_LANE <= 12) rb[b * 32 + 19 + F_LANE] = 0.f; }
    }
}

DEV void p2_fill_tr(Frame& F) {
    const float* KT = WSP(float, WS_KTAB); const f32x2* APOW = WSP(f32x2, WS_APOW); bf16_t* TR = WSP(bf16_t, WS_TR);
    const int gt = F.bx * 512 + F_TID, NT = F.G * 512;
    constexpr int K8 = UK / 8, NT1 = 16 * TRN * K8;
    for (int idx0 = gt; idx0 < NT1; idx0 += 4 * NT) {
        f32x4 fa[4][2], fb[4][2];
#pragma unroll
        for (int u = 0; u < 4; ++u) { const int idx = (idx0 + u * NT < NT1) ? idx0 + u * NT : idx0;
            const int k8 = idx % K8, n = (idx / K8) % TRN, g = idx / (K8 * TRN), t = n >> 4, h = n & 15, k = k8 >> 1, h0 = (k8 & 1) * 8;
            const f32x4* pa_ = (const f32x4*)(KT + (((0 * 16 + g) * 64 + (t > k ? t - k : 0)) * 256 + h * 16 + h0));
            const f32x4* pb_ = (const f32x4*)(KT + (((1 * 16 + g) * 64 + (k > t ? k - t : 0)) * 256 + h * 16 + h0));
            fa[u][0] = pa_[0]; fa[u][1] = pa_[1]; fb[u][0] = pb_[0]; fb[u][1] = pb_[1]; }
#pragma unroll
        for (int u = 0; u < 4; ++u) { const int idx = idx0 + u * NT; if (idx < NT1) {
            const int k8 = idx % K8, n = (idx / K8) % TRN, g = idx / (K8 * TRN), t = n >> 4, h = n & 15, k = k8 >> 1, h0 = (k8 & 1) * 8;
            const float wa = (t >= k) ? 1.f : 0.f, wb = (k >= t) ? 1.f : 0.f, dd = (t == k) ? F.in[I_S5D][g * 16 + h] : 0.f;
            float v[8];
#pragma unroll
            for (int q = 0; q < 8; ++q) v[q] = wa * fa[u][q >> 2][q & 3] + wb * fb[u][q >> 2][q & 3] + ((h0 + q == h) ? dd : 0.f);
            u32x4 o; o.x = cvt_pk_bf16(v[0], v[1]); o.y = cvt_pk_bf16(v[2], v[3]); o.z = cvt_pk_bf16(v[4], v[5]); o.w = cvt_pk_bf16(v[6], v[7]);
            *(u32x4*)(TR + ((size_t)(g * TRN + n) * UGK + k8 * 8)) = o; } }
    }
    constexpr int NT2 = 16 * TRN * 32;
    for (int idx0 = gt; idx0 < NT2; idx0 += 4 * NT) {
        f32x4 cr_[4][2], ci_[4][2], ap_[4][4];
#pragma unroll
        for (int u = 0; u < 4; ++u) { const int idx = (idx0 + u * NT < NT2) ? idx0 + u * NT : idx0;
            const int k8 = idx & 31, n = (idx >> 5) % TRN, g = idx / (32 * TRN), t = n >> 4, h = n & 15, s0 = k8 * 8, part = s0 >> 6, p0 = s0 & 63, dir = part >> 1, dg = dir * 16 + g, j = dir ? (LC - t) : (t + 1);
            const f32x4* pc = (const f32x4*)(F.in[I_CRE] + (dg * 16 + h) * 64 + p0); const f32x4* pi = (const f32x4*)(F.in[I_CIM] + (dg * 16 + h) * 64 + p0); const f32x4* pw = (const f32x4*)(APOW + (dg * 65 + j) * 64 + p0);
            cr_[u][0] = pc[0]; cr_[u][1] = pc[1]; ci_[u][0] = pi[0]; ci_[u][1] = pi[1];
#pragma unroll
            for (int q = 0; q < 4; ++q) ap_[u][q] = pw[q]; }
#pragma unroll
        for (int u = 0; u < 4; ++u) { const int idx = idx0 + u * NT; if (idx < NT2) {
            const int k8 = idx & 31, n = (idx >> 5) % TRN, g = idx / (32 * TRN), part = (k8 * 8) >> 6;
            float v[8];
#pragma unroll
            for (int q = 0; q < 8; ++q) { const float cr = cr_[u][q >> 2][q & 3], ci = ci_[u][q >> 2][q & 3]; const float ax = ap_[u][q >> 1][(q & 1) * 2], ay = ap_[u][q >> 1][(q & 1) * 2 + 1];
                v[q] = (part & 1) ? -(cr * ay + ci * ax) : (cr * ax - ci * ay); }
            u32x4 o; o.x = cvt_pk_bf16(v[0], v[1]); o.y = cvt_pk_bf16(v[2], v[3]); o.z = cvt_pk_bf16(v[4], v[5]); o.w = cvt_pk_bf16(v[6], v[7]);
            *(u32x4*)(TR + ((size_t)(g * TRN + n) * UGK + UK + k8 * 8)) = o; } }
    }
}
struct SchedIn {
    static constexpr bool GATHER = false, AUX = true, FP8 = false, I8 = true;
    int nt; unsigned lda, ldb; int G, c; const char* HX; const char* W; int lo, hi; const char* rscale; const char* cscale;
    DEV bool next(int i, Unit& u) const {
        const int L = lo + i * G + c; if (L >= hi) return false;
        int pm, pn, ctx = 0;
        if (L < 2560) pg8::static_tile(L, 256, 10, pm, pn); else { pm = 256 + (L - 2560); pn = 0; ctx = 1; }
        u.A0 = HX + (size_t)pm * 256 * 1024; u.A1 = u.A0; u.B0 = W + (size_t)pn * 256 * 1024; u.B1 = u.B0; u.ksA = 1 << 20; u.ksB = 1 << 20;
        u.p0 = pm; u.p1 = pn; u.p2 = ctx; u.p3 = 0; return true;
    }
    DEV void rows(const Unit&, int, unsigned*) const {}
    DEV void aux(const Unit& u, const Unit&, LAS unsigned char* l, int wid, int lane) const {
        if (wid == 0) glds16(rscale + (size_t)u.p0 * 1024 + lane * 16, l + AUX_SLOT_OFF);
        if (wid == 1) glds16(cscale + (size_t)u.p1 * 1024 + lane * 16, l + AUX_SLOT_OFF + 1024);
    }
};
struct EpiIn {
    static constexpr bool PERM = true;
    bf16_t* UG; bf16_t* BG; bf16_t* CV; LAS unsigned char* lds;
    DEV void operator()(const f32x4 (&acci)[2][2][4][2], const Unit& u, int wr, int wc, int fr, int fq) const {
        const int pm = u.p0, pn = u.p1;
        f32x4 cs[2][2];
#pragma unroll
        for (int bj = 0; bj < 2; ++bj)
#pragma unroll
            for (int n = 0; n < 2; ++n) cs[bj][n] = *(const LAS f32x4*)(lds + AUX_SLOT_OFF + 1024 + (bj * 128 + wc * 32 + 8 * fq + 4 * n) * 4);
#pragma unroll
        for (int ai = 0; ai < 2; ++ai)
#pragma unroll
            for (int m = 0; m < 4; ++m) {
                const int r = ai * 128 + wr * 64 + m * 16 + fr;
                const float rs = *(const LAS float*)(lds + AUX_SLOT_OFF + r * 4);
                f32x4 a[2][2];
#pragma unroll
                for (int bj = 0; bj < 2; ++bj)
#pragma unroll
                    for (int n = 0; n < 2; ++n) { const v4i_t iv = __builtin_bit_cast(v4i_t, acci[ai][bj][m][n]); a[bj][n] = (f32x4){(float)iv[0], (float)iv[1], (float)iv[2], (float)iv[3]} * (cs[bj][n] * rs); }
                if (pn == 0) {
                    const int mm = pm * 256 + r;
                    const int chunk = mm / LC, k = mm % LC;
#pragma unroll
                    for (int bj = 0; bj < 2; ++bj) { const int c = bj * 128 + wc * 32 + 8 * fq, g = c >> 4, h0 = c & 15;
                        const f32x4 v0 = a[bj][0], v1 = a[bj][1];
                        u32x4 w; w.x = cvt_pk_bf16(v0[0], v0[1]); w.y = cvt_pk_bf16(v0[2], v0[3]); w.z = cvt_pk_bf16(v1[0], v1[1]); w.w = cvt_pk_bf16(v1[2], v1[3]);
                        *(u32x4*)(UG + ((size_t)(g * NCH_PAD + chunk) * UGK + k * 16 + h0)) = w; }
                } else if (pn < 4) {
                    bf16_t* rowp = BG + (size_t)(pm * 256 + r) * CONVW + (pn - 1) * 256 + wc * 32 + 8 * fq;
#pragma unroll
                    for (int bj = 0; bj < 2; ++bj) { const f32x4 v0 = a[bj][0], v1 = a[bj][1];
                        u32x4 w; w.x = cvt_pk_bf16(v0[0], v0[1]); w.y = cvt_pk_bf16(v0[2], v0[3]); w.z = cvt_pk_bf16(v1[0], v1[1]); w.w = cvt_pk_bf16(v1[2], v1[3]);
                        *(u32x4*)(rowp + bj * 128) = w; }
                } else {
                    const f32x4 v0 = a[0][0] * a[1][0], v1 = a[0][1] * a[1][1];
                    u32x4 w; w.x = cvt_pk_bf16(v0[0], v0[1]); w.y = cvt_pk_bf16(v0[2], v0[3]); w.z = cvt_pk_bf16(v1[0], v1[1]); w.w = cvt_pk_bf16(v1[2], v1[3]);
                    *(u32x4*)(CV + (size_t)(pm * 256 + r) * CONVW + (pn - 4) * 128 + wc * 32 + 8 * fq) = w;
                }
            }
    }
};

struct SchedE {
    static constexpr bool GATHER = false, AUX = false, FP8 = false, I8 = false;
    int nt; unsigned lda, ldb; int c; const char* UG; const char* WE;
    DEV bool next(int i, Unit& u) const {
        if (i > 0 || c >= 16 * (NCH_PAD / 256)) return false;
        const int g = c / (NCH_PAD / 256), pm = c % (NCH_PAD / 256);
        u.A0 = UG + ((size_t)g * NCH_PAD + pm * 256) * UGK * 2; u.A1 = u.A0; u.B0 = WE + (size_t)g * 256 * UK * 2; u.B1 = u.B0; u.ksA = 1 << 20; u.ksB = 1 << 20;
        u.p0 = pm; u.p1 = g; u.p2 = 0; u.p3 = 0; return true;
    }
    DEV void rows(const Unit&, int, unsigned*) const {}
    DEV void aux(const Unit&, const Unit&, LAS unsigned char*, int, int) const {}
};
struct EpiE {
    static constexpr bool PERM = false;
    float* E;
    DEV void operator()(const f32x4 (&acc)[2][2][4][2], const Unit& u, int wr, int wc, int fr, int fq) const {
        float* base = E + ((size_t)u.p1 * NCH_PAD + u.p0 * 256) * 256;
#pragma unroll
        for (int ai = 0; ai < 2; ++ai)
#pragma unroll
            for (int m = 0; m < 4; ++m) { float* rowp = base + (size_t)(ai * 128 + wr * 64 + m * 16 + fr) * 256 + wc * 32 + 4 * fq;
#pragma unroll
                for (int bj = 0; bj < 2; ++bj)
#pragma unroll
                    for (int n = 0; n < 2; ++n) *(f32x4*)(rowp + bj * 128 + n * 16) = acc[ai][bj][m][n]; }
    }
};
struct SchedSB {
    static constexpr bool GATHER = false, AUX = false, FP8 = true, I8 = false;
    int nt; unsigned lda, ldb; int c; const char* SH2; const char* W13;
    DEV bool next(int i, Unit& u) const {
        if (i > 0 || c < 0 || c >= 64) return false;
        const int e = c >> 2, ti = c & 3;
        u.A0 = SH2; u.A1 = u.A0; u.B0 = W13 + ((size_t)e * 1024 + ti * 256) * 1024; u.B1 = u.B0; u.ksA = 1 << 20; u.ksB = 1 << 20;
        u.p0 = e; u.p1 = ti; u.p2 = 0; u.p3 = 0; return true;
    }
    DEV void rows(const Unit&, int, unsigned*) const {}
    DEV void aux(const Unit&, const Unit&, LAS unsigned char*, int, int) const {}
};
struct EpiSB {
    static constexpr bool PERM = true;
    bf16_t* SB;
    DEV void operator()(const f32x4 (&acc)[2][2][4][2], const Unit& u, int wr, int wc, int fr, int fq) const {
        if (wr != 0) return;
#pragma unroll
        for (int m = 0; m < 2; ++m) { const int b = m * 16 + fr; bf16_t* rowp = SB + ((size_t)(b * 16 + u.p0) * 1024 + u.p1 * 256 + wc * 32 + 8 * fq);
#pragma unroll
            for (int bj = 0; bj < 2; ++bj) { const f32x4 v0 = acc[0][bj][m][0] * (1.0f / FP8_WSCALE), v1 = acc[0][bj][m][1] * (1.0f / FP8_WSCALE);
                u32x4 w; w.x = cvt_pk_bf16(v0[0], v0[1]); w.y = cvt_pk_bf16(v0[2], v0[3]); w.z = cvt_pk_bf16(v1[0], v1[1]); w.w = cvt_pk_bf16(v1[2], v1[3]);
                *(u32x4*)(rowp + bj * 128) = w; } }
    }
};

DEV void p4_phase(Frame& F) {
    const int gt = F.bx * 512 + F_TID, NT = F.G * 512;
    const float* E = WSP(float, WS_E); const f32x2* APOW = WSP(f32x2, WS_APOW); bf16_t* UG = WSP(bf16_t, WS_UG);
    constexpr int CC = CTXL / LC, CL = SEQ / LC;
    for (int idx = gt; idx < NB * NG * 128; idx += NT) {
        const int p = idx & 63, dir = (idx >> 6) & 1, g = (idx >> 7) & 15, b = idx >> 11;
        const f32x2 a = APOW[((dir * 16 + g) * 65 + LC) * 64 + p];
        const float* Eg = E + (size_t)g * NCH_PAD * 256 + dir * 128 + p;
        bf16_t* Ug = UG + (size_t)g * NCH_PAD * UGK + UK + dir * 128 + p;
        float sr = 0.f, si = 0.f;
        {   float er[CC], ei[CC];
#pragma unroll
            for (int c = 0; c < CC; ++c) { const int ch = NCH_LAT + b * CC + (dir ? CC - 1 - c : c); er[c] = Eg[(size_t)ch * 256]; ei[c] = Eg[(size_t)ch * 256 + 64]; }
#pragma unroll
            for (int c = 0; c < CC; ++c) { const float nr = a.x * sr - a.y * si + er[c], ni = a.x * si + a.y * sr + ei[c]; sr = nr; si = ni; } }
#pragma unroll 1
        for (int c0 = 0; c0 < CL; c0 += 16) {
            float er[16], ei[16];
#pragma unroll
            for (int c = 0; c < 16; ++c) { const int ch = b * CL + (dir ? CL - 1 - (c0 + c) : c0 + c); er[c] = Eg[(size_t)ch * 256]; ei[c] = Eg[(size_t)ch * 256 + 64]; }
#pragma unroll
            for (int c = 0; c < 16; ++c) { const int ch = b * CL + (dir ? CL - 1 - (c0 + c) : c0 + c);
                Ug[(size_t)ch * UGK] = (bf16_t)(cvt_pk_bf16(sr, 0.f) & 0xffffu); Ug[(size_t)ch * UGK + 64] = (bf16_t)(cvt_pk_bf16(si, 0.f) & 0xffffu);
                const float nr = a.x * sr - a.y * si + er[c], ni = a.x * si + a.y * sr + ei[c]; sr = nr; si = ni; }
        }
    }
}
DEV void conv_items(Frame& F, int vt, int NVT) {
    const bf16_t* BG = WSP(bf16_t, WS_BG); const bf16_t* CV = WSP(bf16_t, WS_CV); bf16_t* YM = WSP(bf16_t, WS_YMIX); const float* cw = F.in[I_CONVW];
    LAS unsigned char* lz = F.lds + F_WAVE * LZ_WAVE;
    constexpr int NIT = TOK * 96;
    const int nb = (vt < NIT) ? ((NIT - vt + 2 * NVT - 1) / (2 * NVT)) : 0;
    const int jc = (vt % 96) * 8;
    const f32x4 w0a = *(const f32x4*)(cw + jc), w0b = *(const f32x4*)(cw + jc + 4), w1a = *(const f32x4*)(cw + CONVW + jc), w1b = *(const f32x4*)(cw + CONVW + jc + 4), w2a = *(const f32x4*)(cw + 2 * CONVW + jc), w2b = *(const f32x4*)(cw + 2 * CONVW + jc + 4);
#define CV_ISSUE(b) do { _Pragma("unroll") for (int q = 0; q < 2; ++q) { const int idx_ = vt + (2 * (b) + q) * NVT; const bool ok_ = idx_ < NIT; const int j0_ = (idx_ % 96) * 8, m_ = ok_ ? idx_ / 96 : 0; \
        const bool rowp_ = j0_ < 384; const int d_ = rowp_ ? 1 : 64; \
        const bool hasl_ = ok_ && (rowp_ ? ((m_ & 63) > 0) : (((m_ >> 6) & 31) > 0)), hasr_ = ok_ && (rowp_ ? ((m_ & 63) < 63) : (((m_ >> 6) & 31) < 31)); \
        const size_t o_ = (size_t)m_ * CONVW + j0_; \
        lz_issue(CV + (hasl_ ? o_ - (size_t)d_ * CONVW : o_), lz, ((b) & 1) * 8 + q * 4 + 0); lz_issue(CV + o_, lz, ((b) & 1) * 8 + q * 4 + 1); \
        lz_issue(CV + (hasr_ ? o_ + (size_t)d_ * CONVW : o_), lz, ((b) & 1) * 8 + q * 4 + 2); lz_issue(BG + o_, lz, ((b) & 1) * 8 + q * 4 + 3); } } while (0)
    asm volatile("s_waitcnt lgkmcnt(0)" ::: "memory");
    if (nb > 0) CV_ISSUE(0);
    if (nb > 1) CV_ISSUE(1);
#pragma unroll 1
    for (int b = 0; b < nb; ++b) {
        if (b + 1 < nb) LZ_WAIT(8); else LZ_WAIT(0);
#pragma unroll
        for (int q = 0; q < 2; ++q) { const int idx = vt + (2 * b + q) * NVT; const bool ok = idx < NIT; const int j0 = (idx % 96) * 8, m = ok ? idx / 96 : 0;
            const bool rowp = j0 < 384;
            const bool hasl = rowp ? ((m & 63) > 0) : (((m >> 6) & 31) > 0), hasr = rowp ? ((m & 63) < 63) : (((m >> 6) & 31) < 31);
            const LAS unsigned char* zp = lz + ((b & 1) * 8 + q * 4) * 1024 + F_LANE * 16;
            const u32x4 z = (u32x4){0u, 0u, 0u, 0u};
            u32x4 c0 = *(const LAS u32x4*)zp; const u32x4 c1 = *(const LAS u32x4*)(zp + 1024); u32x4 c2 = *(const LAS u32x4*)(zp + 2048); const u32x4 bb = *(const LAS u32x4*)(zp + 3072);
            c0 = hasl ? c0 : z; c2 = hasr ? c2 : z;
            float o[8];
            o[0] = bflo(bb.x) * (bflo(c0.x) * w0a[0] + bflo(c1.x) * w1a[0] + bflo(c2.x) * w2a[0]); o[1] = bfhi(bb.x) * (bfhi(c0.x) * w0a[1] + bfhi(c1.x) * w1a[1] + bfhi(c2.x) * w2a[1]);
            o[2] = bflo(bb.y) * (bflo(c0.y) * w0a[2] + bflo(c1.y) * w1a[2] + bflo(c2.y) * w2a[2]); o[3] = bfhi(bb.y) * (bfhi(c0.y) * w0a[3] + bfhi(c1.y) * w1a[3] + bfhi(c2.y) * w2a[3]);
            o[4] = bflo(bb.z) * (bflo(c0.z) * w0b[0] + bflo(c1.z) * w1b[0] + bflo(c2.z) * w2b[0]); o[5] = bfhi(bb.z) * (bfhi(c0.z) * w0b[1] + bfhi(c1.z) * w1b[1] + bfhi(c2.z) * w2b[1]);
            o[6] = bflo(bb.w) * (bflo(c0.w) * w0b[2] + bflo(c1.w) * w1b[2] + bflo(c2.w) * w2b[2]); o[7] = bfhi(bb.w) * (bfhi(c0.w) * w0b[3] + bfhi(c1.w) * w1b[3] + bfhi(c2.w) * w2b[3]);
            u32x4 w; w.x = cvt_pk_bf16(o[0], o[1]); w.y = cvt_pk_bf16(o[2], o[3]); w.z = cvt_pk_bf16(o[4], o[5]); w.w = cvt_pk_bf16(o[6], o[7]);
            if (ok) *(u32x4*)(YM + (size_t)m * DM + 256 + j0) = w; }
        if (b + 2 < nb) CV_ISSUE(b + 2);
    }
#undef CV_ISSUE
}

struct SchedY {
    static constexpr bool GATHER = false, AUX = false, FP8 = false, I8 = false;
    int nt; unsigned lda, ldb; int c; const char* UG; const char* TR;
    DEV bool next(int i, Unit& u) const {
        if (i > 0 || c >= 256) return false;
        const int x = c & 7, k = c >> 3;
        constexpr int NPM = NCH_LAT / 256, NPN = TRN / 256;
        static_assert(NPM * NPN == 16, "16 units per group");
        const int g = 2 * x + (k >> 4), pm = (k & 15) / NPN, pn = (k & 15) % NPN;
        u.A0 = UG + ((size_t)g * NCH_PAD + pm * 256) * UGK * 2; u.A1 = u.A0; u.B0 = TR + ((size_t)g * TRN + pn * 256) * UGK * 2; u.B1 = u.B0; u.ksA = 1 << 20; u.ksB = 1 << 20;
        u.p0 = pm; u.p1 = pn; u.p2 = g; u.p3 = 0; return true;
    }
    DEV void rows(const Unit&, int, unsigned*) const {}
    DEV void aux(const Unit&, const Unit&, LAS unsigned char*, int, int) const {}
};
struct EpiY {
    static constexpr bool PERM = true;
    bf16_t* Gb;
    DEV void operator()(const f32x4 (&acc)[2][2][4][2], const Unit& u, int wr, int wc, int fr, int fq) const {
#pragma unroll
        for (int ai = 0; ai < 2; ++ai)
#pragma unroll
            for (int m = 0; m < 4; ++m) { const int chunk = u.p0 * 256 + ai * 128 + wr * 64 + m * 16 + fr;
#pragma unroll
                for (int bj = 0; bj < 2; ++bj) { const int n = u.p1 * 256 + bj * 128 + wc * 32 + 8 * fq, t = n >> 4, h0 = n & 15;
                    const f32x4 v0 = acc[ai][bj][m][0], v1 = acc[ai][bj][m][1];
                    u32x4 w; w.x = cvt_pk_bf16(gelu_tanh(v0[0]), gelu_tanh(v0[1])); w.y = cvt_pk_bf16(gelu_tanh(v0[2]), gelu_tanh(v0[3]));
                    w.z = cvt_pk_bf16(gelu_tanh(v1[0]), gelu_tanh(v1[1])); w.w = cvt_pk_bf16(gelu_tanh(v1[2]), gelu_tanh(v1[3]));
                    *(u32x4*)(Gb + ((size_t)(chunk * LC + t) * 256 + u.p2 * 16 + h0)) = w; } }
    }
};

struct SchedGlu {
    static constexpr bool GATHER = false, AUX = false, FP8 = false, I8 = false;
    int nt; unsigned lda, ldb; int G, c; const char* Gb; const char* W;
    DEV bool next(int i, Unit& u) const {
        const int L = i * G + c; if (L >= 256) return false;
        u.A0 = Gb + (size_t)L * 256 * 512; u.A1 = u.A0; u.B0 = W; u.B1 = u.B0; u.ksA = 1 << 20; u.ksB = 1 << 20; u.p0 = L; u.p1 = 0; u.p2 = 0; u.p3 = 0; return true;
    }
    DEV void rows(const Unit&, int, unsigned*) const {}
    DEV void aux(const Unit&, const Unit&, LAS unsigned char*, int, int) const {}
};
struct EpiGlu {
    static constexpr bool PERM = true;
    const bf16_t* Gb; bf16_t* YM; const float* bglu;
    DEV void operator()(const f32x4 (&acc)[2][2][4][2], const Unit& u, int wr, int wc, int fr, int fq) const {
        u32x4 gq[2][4][2];
#pragma unroll
        for (int ai = 0; ai < 2; ++ai)
#pragma unroll
            for (int m = 0; m < 4; ++m)
#pragma unroll
                for (int bj = 0; bj < 2; ++bj) gq[ai][m][bj] = *(const u32x4*)(Gb + (size_t)(u.p0 * 256 + ai * 128 + wr * 64 + m * 16 + fr) * 256 + bj * 128 + wc * 32 + 8 * fq);
        f32x4 bq[2][2];
#pragma unroll
        for (int bj = 0; bj < 2; ++bj) { bq[bj][0] = *(const f32x4*)(bglu + bj * 128 + wc * 32 + 8 * fq); bq[bj][1] = *(const f32x4*)(bglu + bj * 128 + wc * 32 + 8 * fq + 4); }
        asm volatile("" ::: "memory");
#pragma unroll
        for (int ai = 0; ai < 2; ++ai)
#pragma unroll
            for (int m = 0; m < 4; ++m) { const int row = u.p0 * 256 + ai * 128 + wr * 64 + m * 16 + fr;
#pragma unroll
                for (int bj = 0; bj < 2; ++bj) { const int c = bj * 128 + wc * 32 + 8 * fq;
                    const u32x4 gv = gq[ai][m][bj];
                    const f32x4 z0 = acc[ai][bj][m][0] + bq[bj][0], z1 = acc[ai][bj][m][1] + bq[bj][1];
                    u32x4 w; w.x = cvt_pk_bf16(bflo(gv.x) * sigmoidf_(z0[0]), bfhi(gv.x) * sigmoidf_(z0[1])); w.y = cvt_pk_bf16(bflo(gv.y) * sigmoidf_(z0[2]), bfhi(gv.y) * sigmoidf_(z0[3]));
                    w.z = cvt_pk_bf16(bflo(gv.z) * sigmoidf_(z1[0]), bfhi(gv.z) * sigmoidf_(z1[1])); w.w = cvt_pk_bf16(bflo(gv.w) * sigmoidf_(z1[2]), bfhi(gv.w) * sigmoidf_(z1[3]));
                    *(u32x4*)(YM + (size_t)row * DM + c) = w; } }
    }
};

struct SchedOut {
    static constexpr bool GATHER = false, AUX = false, FP8 = false, I8 = false;
    int nt; unsigned lda, ldb; int G, c; const char* A; const char* W;
    DEV bool next(int i, Unit& u) const {
        const int L = i * G + c; if (L >= 1024) return false;
        int pm, pn; pg8::static_tile(L, 256, 4, pm, pn);
        u.A0 = A + (size_t)pm * 256 * 2048; u.A1 = u.A0; u.B0 = W + (size_t)pn * 256 * 2048; u.B1 = u.B0; u.ksA = 1 << 20; u.ksB = 1 << 20; u.p0 = pm; u.p1 = pn; u.p2 = 0; u.p3 = 0; return true;
    }
    DEV void rows(const Unit&, int, unsigned*) const {}
    DEV void aux(const Unit&, const Unit&, LAS unsigned char*, int, int) const {}
};
struct EpiYX {
    static constexpr bool PERM = true;
    bf16_t* YX; int nostore;
    DEV void operator()(const f32x4 (&acc)[2][2][4][2], const Unit& u, int wr, int wc, int fr, int fq) const {
        if (nostore) { float t = 0.f;
#pragma unroll
            for (int ai = 0; ai < 2; ++ai)
#pragma unroll
                for (int m = 0; m < 4; ++m)
#pragma unroll
                    for (int bj = 0; bj < 2; ++bj) t += acc[ai][bj][m][0][0] + acc[ai][bj][m][1][3];
            if (t == 1.2345e38f) YX[0] = 0; return; }
#pragma unroll
        for (int ai = 0; ai < 2; ++ai)
#pragma unroll
            for (int m = 0; m < 4; ++m) { bf16_t* rowp = YX + (size_t)(u.p0 * 256 + ai * 128 + wr * 64 + m * 16 + fr) * DM + u.p1 * 256 + wc * 32 + 8 * fq;
#pragma unroll
                for (int bj = 0; bj < 2; ++bj) { const f32x4 v0 = acc[ai][bj][m][0], v1 = acc[ai][bj][m][1];
                    u32x4 w; w.x = cvt_pk_bf16(v0[0], v0[1]); w.y = cvt_pk_bf16(v0[2], v0[3]); w.z = cvt_pk_bf16(v1[0], v1[1]); w.w = cvt_pk_bf16(v1[2], v1[3]);
                    *(u32x4*)(rowp + bj * 128) = w; } }
    }
};

constexpr int P8_WR_STRIDE = 2064;
constexpr int P8_GT_OFF = 41472, P8_GS_OFF = P8_GT_OFF + 4096, P8_HIST_OFF = P8_GS_OFF + 4096, P8_LZ_OFF = P8_HIST_OFF + 256, P8_LZ_WAVE = 10240;
static_assert(20 * P8_WR_STRIDE <= P8_GT_OFF && P8_LZ_OFF + 8 * P8_LZ_WAVE <= 163840 - 256, "P8 LDS map");
DEV void p8_phase(Frame& F) {
    const float* X = F.in[I_X]; const bf16_t* YX = WSP(bf16_t, WS_YX); bf16_t* X1B = WSP(bf16_t, WS_X1B); unsigned char* X1G = WSP(unsigned char, WS_X1G);
    const bf16_t* Wr = WSP(bf16_t, WS_WR); const float* rb = WSP(float, WS_RB); const float* mod = WSP(float, WS_MOD); const float* n2g = F.in[I_N2G];
    int* tokb = WSP(int, WS_TOKB); float* tokw = WSP(float, WS_TOKW); float* tokr = WSP(float, WS_TOKR); int* segc = WSP(int, WS_SEGC);
    LAS int* hist = (LAS int*)(F.lds + P8_HIST_OFF);
    LAS float* gt = (LAS float*)(F.lds + P8_GT_OFF); LAS float* gsl = (LAS float*)(F.lds + P8_GS_OFF);
    const int l15 = F_LANE & 15, q = F_LANE >> 4;
    for (int idx = F_TID; idx < 20 * 128; idx += 512) { const int r = idx >> 7, c16 = idx & 127; *(LAS u32x4*)(F.lds + r * P8_WR_STRIDE + c16 * 16) = *(const u32x4*)(Wr + (size_t)r * DM + c16 * 8); }
    LAS unsigned char* lz = F.lds + P8_LZ_OFF + F_WAVE * P8_LZ_WAVE;
    for (int seg = F.bx; seg < TOK / 256; seg += F.G) {
        const int b = seg >> 3;
        __syncthreads();
        if (F_TID < 32) hist[F_TID] = 0;
        for (int k = F_TID; k < DM; k += 512) { gt[k] = mod[b * NMOD + 2 * DM + k]; gsl[k] = n2g[k] * (1.0f + mod[b * NMOD + 4 * DM + k]); }
        __syncthreads();
        const int tok0 = seg * 256 + F_WAVE * 32;
#pragma unroll 1
        for (int rg = 0; rg < 2; ++rg) {
            const int tok = tok0 + rg * 16 + l15;
            const float* xp = X + (size_t)tok * DM + 8 * q; const bf16_t* yp = YX + (size_t)tok * DM + 8 * q;
            bf16_t* o1 = X1B + (size_t)tok * DM + 8 * q; unsigned char* og = X1G + (size_t)tok * DM + 8 * q;
            const LAS unsigned char* wl = F.lds + l15 * P8_WR_STRIDE + q * 16;
            f32x4 acc0 = (f32x4){0.f, 0.f, 0.f, 0.f}, acc1 = acc0; float sq = 0.f;
            const LAS unsigned char* wl2 = F.lds + (16 + (l15 & 3)) * P8_WR_STRIDE + q * 16;
#define P8_ISSUE(ks_, sl_) do { lz_issue(xp + (ks_) * 32, lz, (sl_) * 3 + 0); lz_issue(xp + (ks_) * 32 + 4, lz, (sl_) * 3 + 1); lz_issue(yp + (ks_) * 32, lz, (sl_) * 3 + 2); } while (0)
            asm volatile("s_waitcnt lgkmcnt(0)" ::: "memory");
            P8_ISSUE(0, 0); P8_ISSUE(1, 1); P8_ISSUE(2, 2);
            int sl = 0;
#pragma unroll 1
            for (int ks = 0; ks < 32; ++ks) {
                if (ks <= 29) LZ_WAIT(6); else if (ks == 30) LZ_WAIT(3); else LZ_WAIT(0);
                const LAS unsigned char* zp = lz + sl * 3072 + F_LANE * 16;
                const f32x4 xa = *(const LAS f32x4*)zp, xb = *(const LAS f32x4*)(zp + 1024); const u32x4 yv = *(const LAS u32x4*)(zp + 2048);
                const f32x4 g0 = *(const LAS f32x4*)(gt + ks * 32 + 8 * q), g1 = *(const LAS f32x4*)(gt + ks * 32 + 8 * q + 4);
                const f32x4 s0 = *(const LAS f32x4*)(gsl + ks * 32 + 8 * q), s1 = *(const LAS f32x4*)(gsl + ks * 32 + 8 * q + 4);
                f32x4 va, vb;
                va[0] = xa[0] + g0[0] * bflo(yv.x); va[1] = xa[1] + g0[1] * bfhi(yv.x); va[2] = xa[2] + g0[2] * bflo(yv.y); va[3] = xa[3] + g0[3] * bfhi(yv.y);
                vb[0] = xb[0] + g1[0] * bflo(yv.z); vb[1] = xb[1] + g1[1] * bfhi(yv.z); vb[2] = xb[2] + g1[2] * bflo(yv.w); vb[3] = xb[3] + g1[3] * bfhi(yv.w);
                sq += ((va[0] * va[0] + va[1] * va[1]) + (va[2] * va[2] + va[3] * va[3])) + ((vb[0] * vb[0] + vb[1] * vb[1]) + (vb[2] * vb[2] + vb[3] * vb[3]));
                u32x4 w1; w1.x = cvt_pk_bf16(va[0], va[1]); w1.y = cvt_pk_bf16(va[2], va[3]); w1.z = cvt_pk_bf16(vb[0], vb[1]); w1.w = cvt_pk_bf16(vb[2], vb[3]);
                *(u32x4*)(o1 + ks * 32) = w1;
                const f32x4 ga = va * s0, gb = vb * s1;
                u32x4 wg; wg.x = cvt_pk_bf16(ga[0], ga[1]); wg.y = cvt_pk_bf16(ga[2], ga[3]); wg.z = cvt_pk_bf16(gb[0], gb[1]); wg.w = cvt_pk_bf16(gb[2], gb[3]);
                { u32x2 w8; w8.x = pk4_fp8(ga[0], ga[1], ga[2], ga[3]); w8.y = pk4_fp8(gb[0], gb[1], gb[2], gb[3]); *(u32x2*)(og + ks * 32) = w8; }
                const bf16x8 xf = __builtin_bit_cast(bf16x8, wg);
                const bf16x8 wa = *(const LAS bf16x8*)(wl + ks * 64), wb = *(const LAS bf16x8*)(wl2 + ks * 64);
                acc0 = __builtin_amdgcn_mfma_f32_16x16x32_bf16(wa, xf, acc0, 0, 0, 0); acc1 = __builtin_amdgcn_mfma_f32_16x16x32_bf16(wb, xf, acc1, 0, 0, 0);
                if (ks + 3 < 32) P8_ISSUE(ks + 3, sl);
                sl = (sl == 2) ? 0 : sl + 1;
            }
#undef P8_ISSUE
            sq += __shfl_xor(sq, 16); sq += __shfl_xor(sq, 32);
            const float rstd = 1.0f / sqrtf(sq * (1.f / DM) + RMS_EPS);
            float lg[4], l2[4], gl[4], t1[4], t2[4], v[4];
#pragma unroll
            for (int r = 0; r < 4; ++r) { lg[r] = rstd * acc0[r] + rb[b * 32 + 4 * q + r]; l2[r] = rstd * acc1[r] + rb[b * 32 + 16 + ((4 * q + r) & 15)]; }
#pragma unroll
            for (int r = 0; r < 4; ++r) gl[r] = __shfl(lg[r], l15);
            int gi = 0; float gm = gl[0];
#pragma unroll
            for (int r = 1; r < 4; ++r) if (gl[r] > gm) { gm = gl[r]; gi = r; }
            float den = 0.f;
#pragma unroll
            for (int r = 0; r < 4; ++r) den += __expf(gl[r] - gm);
            const float gp = 1.0f / den;
            const int src = l15 + 16 * ((gi + 1) & 3);
#pragma unroll
            for (int r = 0; r < 4; ++r) { t1[r] = __shfl(lg[r], src); t2[r] = __shfl(l2[r], l15); v[r] = (gi == 3) ? t2[r] : t1[r]; }
            int i1 = 0; float v1 = v[0];
#pragma unroll
            for (int r = 1; r < 4; ++r) if (v[r] > v1) { v1 = v[r]; i1 = r; }
            int i2 = -1; float v2 = 0.f;
#pragma unroll
            for (int r = 0; r < 4; ++r) if (r != i1 && (i2 < 0 || v[r] > v2)) { v2 = v[r]; i2 = r; }
            const float ex = __expf(v2 - v1), p1 = 1.0f / (1.0f + ex), p2 = ex * p1;
            const int lo = i1 < i2 ? i1 : i2, hi = i1 < i2 ? i2 : i1;
            const float wlo = (i1 < i2 ? p1 : p2) * gp, whi = (i1 < i2 ? p2 : p1) * gp;
            const int pidx = (lo == 0) ? (hi - 1) : (lo == 1) ? (hi + 1) : 5;
            const int bucket = gi * 6 + pidx;
            if (q == 0) { tokb[tok] = bucket; tokw[tok * 2] = wlo; tokw[tok * 2 + 1] = whi; tokr[tok] = rstd; atomicAdd((int*)hist + bucket, 1); }
        }
        __syncthreads();
        if (F_TID < 32) segc[seg * 32 + F_TID] = (F_TID < NBUCKET) ? hist[F_TID] : 0;
    }
    __syncthreads();
}

DEV void p9_phase(Frame& F) {
    const int* segc = WSP(int, WS_SEGC); const int* tokb = WSP(int, WS_TOKB); int* perm = WSP(int, WS_PERM); int* tiles = WSP(int, WS_TILES);
    const float* tokw = WSP(float, WS_TOKW); const float* tokr = WSP(float, WS_TOKR); u32x4* slotrec = WSP(u32x4, WS_SLOT);
    LAS int* tot = (LAS int*)F.lds;
    LAS int* tst = tot + 32;
    LAS int* base = tst + 32;
    LAS int* wcnt = base + 32;
    for (int seg = F.bx; seg < TOK / 256; seg += F.G) {
        __syncthreads();
        if (F_TID < 32) { int t = 0, bs = 0; if (F_TID < NBUCKET) for (int s = 0; s < 256; ++s) { const int c = ld_agent_i(segc + s * 32 + F_TID); if (s < seg) bs += c; t += c; } tot[F_TID] = t; base[F_TID] = bs; }
        if (F_TID < 128) wcnt[F_TID] = 0;
        __syncthreads();
        if (F_TID == 0) { int ts = 0; for (int k = 0; k < NBUCKET; ++k) { tst[k] = ts; ts += (tot[k] + 255) >> 8; } tst[NBUCKET] = ts; }
        __syncthreads();
        int bk = -1, rank = 0;
        if (F_TID < 256) {
            bk = tokb[seg * 256 + F_TID];
            for (int k = 0; k < NBUCKET; ++k) { const unsigned long long msk = __ballot(bk == k); if (bk == k) rank = __popcll(msk & ((1ull << F_LANE) - 1ull)); if (F_LANE == 0) wcnt[F_WAVE * 32 + k] = __popcll(msk); }
        }
        __syncthreads();
        if (F_TID < 256) { int off = 0; for (int w = 0; w < F_WAVE; ++w) off += wcnt[w * 32 + bk]; const int tok = seg * 256 + F_TID, slot = tst[bk] * 256 + base[bk] + off + rank;
            perm[slot] = tok; slotrec[slot] = (u32x4){(unsigned)tok, __float_as_uint(tokr[tok]), __float_as_uint(tokw[tok * 2]), __float_as_uint(tokw[tok * 2 + 1])}; }
        if (seg < NBUCKET) { const int k = seg, n = tot[k], np = ((n + 255) >> 8) << 8; for (int r = n + F_TID; r < np; r += 512) { perm[tst[k] * 256 + r] = -1; slotrec[tst[k] * 256 + r] = (u32x4){0xffffffffu, 0u, 0u, 0u}; } }
        if (seg == 0) { if (F_TID == 0) tiles[0] = tst[NBUCKET];
            if (F_TID < NBUCKET) { const int k = F_TID, nt_ = (tot[k] + 255) >> 8; for (int t = 0; t < nt_; ++t) tiles[16 + tst[k] + t] = k; } }
    }
}
DEV void bucket_experts(int bk, int& e0, int& e1) { const int grp = bk / 6, pi = bk % 6; const int lo = pi < 3 ? 0 : (pi < 5 ? 1 : 2), hi = pi < 3 ? pi + 1 : (pi < 5 ? pi - 1 : 3); e0 = grp * 4 + lo; e1 = grp * 4 + hi; }


DEV void moe_setup(LAS unsigned char* lds, const int* tiles, int ntiles, const u32x4* slotrec, int first_tile) {
    int tid = threadIdx.x; asm volatile("" : "+v"(tid));
    for (int t = tid; t < ntiles; t += 512) *(LAS int*)(lds + AUX_TILE_OFF + t * 4) = ld_agent_i(tiles + 16 + t);
    if (tid < 256 && first_tile < ntiles) *(LAS u32x4*)(lds + AUX_SLOT_OFF + tid * 16) = slotrec[(size_t)first_tile * 256 + tid];
    asm volatile("s_waitcnt vmcnt(0) lgkmcnt(0)" ::: "memory"); __syncthreads();
}
struct SchedUp {
    static constexpr bool GATHER = true, AUX = true, FP8 = true, I8 = false;
    int nt; unsigned lda, ldb; int G, c, ntiles; const char* X1G; const char* W13; const char* slotrec; const char* sb13; LAS unsigned char* lds;
    DEV bool next(int i, Unit& u) const {
        const int L = i * G + c; if (L >= ntiles * 8) return false;
        const int tile = L >> 3, s = (L >> 2) & 1, ti = L & 3; int e0, e1; bucket_experts(__builtin_amdgcn_readfirstlane(*(const LAS int*)(lds + AUX_TILE_OFF + tile * 4)), e0, e1); const int e = s ? e1 : e0;
        u.A0 = X1G; u.A1 = X1G; u.B0 = W13 + ((size_t)e * 1024 + ti * 256) * 1024; u.B1 = u.B0; u.ksA = 1 << 20; u.ksB = 1 << 20; u.p0 = tile; u.p1 = s; u.p2 = ti; u.p3 = e; u.q = i & 1; return true;
    }
    DEV void rows(const Unit& u, int tid, unsigned* v) const {
#pragma unroll
        for (int i = 0; i < 2; ++i) { int R_, C_; pg8::stage_rc(tid * 16 + i * 8192, R_, C_);
#pragma unroll
            for (int h = 0; h < 2; ++h) { int t = *(const LAS int*)(lds + AUX_SLOT_OFF + u.q * 4096 + (h * 128 + R_) * 16); t = t < 0 ? 0 : t; v[h * 2 + i] = (unsigned)t * 1024u + (unsigned)C_ * 2u; } }
    }
    DEV void a_ready(const Unit&) const {}
    DEV void aux(const Unit& u, const Unit& n, LAS unsigned char* l, int wid, int lane) const {
        if (wid < 4) glds16(slotrec + (size_t)n.p0 * 4096 + wid * 1024 + lane * 16, l + AUX_SLOT_OFF + (u.q ^ 1) * 4096 + wid * 1024);
#pragma unroll
        for (int i = 0; i < 2; ++i) { const int p = wid * 2 + i, b = 2 * p + (lane >> 5);
            glds16(sb13 + ((size_t)(b * 16 + u.p3) * 1024 + u.p2 * 256) * 2 + (lane & 31) * 16, l + AUX_BIAS_OFF + p * 1024); }
    }
};
struct EpiUp {
    static constexpr bool PERM = true;
    unsigned char* HID; LAS unsigned char* lds;
    DEV void operator()(const f32x4 (&acc)[2][2][4][2], const Unit& u, int wr, int wc, int fr, int fq) const {
#pragma unroll
        for (int ai = 0; ai < 2; ++ai)
#pragma unroll
            for (int m = 0; m < 4; ++m) { const int r = ai * 128 + wr * 64 + m * 16 + fr, slot = u.p0 * 256 + r;
                const u32x4 rec = *(const LAS u32x4*)(lds + AUX_SLOT_OFF + u.q * 4096 + r * 16);
                const bool valid = (int)rec.x >= 0; const int tk = valid ? (int)rec.x : 0; const float rstd = __uint_as_float(rec.y) * (1.0f / FP8_WSCALE), w = (u.p1 ? __uint_as_float(rec.w) : __uint_as_float(rec.z)) * FP8_WSCALE;
                const LAS unsigned char* bp = lds + AUX_BIAS_OFF + (tk >> 11) * 512 + (wc * 32 + 8 * fq) * 2;
                const u32x4 b1 = *(const LAS u32x4*)bp, b3 = *(const LAS u32x4*)(bp + 256);
                float o[8];
#define UP1(j_, a1_, a3_, b1_, b3_) do { const float p1_ = __builtin_fmaf((a1_), rstd, (b1_)), p3_ = __builtin_fmaf((a3_), rstd, (b3_)); \
                    const float r_ = __builtin_amdgcn_rcpf(1.0f + __builtin_amdgcn_exp2f(p1_ * -1.4426950408889634f)); o[j_] = (p1_ * r_) * (p3_ * w); } while (0)
                UP1(0, acc[ai][0][m][0][0], acc[ai][1][m][0][0], bflo(b1.x), bflo(b3.x)); UP1(1, acc[ai][0][m][0][1], acc[ai][1][m][0][1], bfhi(b1.x), bfhi(b3.x));
                UP1(2, acc[ai][0][m][0][2], acc[ai][1][m][0][2], bflo(b1.y), bflo(b3.y)); UP1(3, acc[ai][0][m][0][3], acc[ai][1][m][0][3], bfhi(b1.y), bfhi(b3.y));
                UP1(4, acc[ai][0][m][1][0], acc[ai][1][m][1][0], bflo(b1.z), bflo(b3.z)); UP1(5, acc[ai][0][m][1][1], acc[ai][1][m][1][1], bfhi(b1.z), bfhi(b3.z));
                UP1(6, acc[ai][0][m][1][2], acc[ai][1][m][1][2], bflo(b1.w), bflo(b3.w)); UP1(7, acc[ai][0][m][1][3], acc[ai][1][m][1][3], bfhi(b1.w), bfhi(b3.w));
#undef UP1
                u32x2 wv; wv.x = pk4_fp8(o[0], o[1], o[2], o[3]); wv.y = pk4_fp8(o[4], o[5], o[6], o[7]);
                *(u32x2*)(HID + ((size_t)slot * 1024 + u.p1 * 512 + u.p2 * 128 + wc * 32 + 8 * fq)) = wv; }
    }
};

struct SchedDown {
    static constexpr bool GATHER = false, AUX = true, FP8 = true, I8 = false;
    int nt; unsigned lda, ldb; int G, c, ntiles; const char* HID; const char* W2; const char* slotrec; LAS unsigned char* lds;
    DEV bool next(int i, Unit& u) const {
        const int L = i * G + c; if (L >= ntiles * 4) return false;
        const int tile = L >> 2, pn = L & 3; int e0, e1; bucket_experts(__builtin_amdgcn_readfirstlane(*(const LAS int*)(lds + AUX_TILE_OFF + tile * 4)), e0, e1);
        u.A0 = HID + (size_t)tile * 256 * 1024; u.A1 = u.A0; u.ksA = 1 << 20;
        u.B0 = W2 + ((size_t)e0 * 1024 + pn * 256) * 512; u.B1 = W2 + ((size_t)e1 * 1024 + pn * 256) * 512; u.ksB = 4;
        u.p0 = tile; u.p1 = pn; u.p2 = 0; u.p3 = 0; return true;
    }
    DEV void rows(const Unit&, int, unsigned*) const {}
    DEV void aux(const Unit& u, const Unit&, LAS unsigned char* l, int wid, int lane) const {
        if (wid < 4) glds16(slotrec + (size_t)u.p0 * 4096 + wid * 1024 + lane * 16, l + AUX_SLOT_OFF + wid * 1024);
    }
};
struct EpiDown {
    static constexpr bool PERM = true;
    bf16_t* MOE; LAS unsigned char* lds;
    DEV void operator()(const f32x4 (&acc)[2][2][4][2], const Unit& u, int wr, int wc, int fr, int fq) const {
#pragma unroll
        for (int ai = 0; ai < 2; ++ai)
#pragma unroll
            for (int m = 0; m < 4; ++m) { const int r = ai * 128 + wr * 64 + m * 16 + fr; const int tk = *(const LAS int*)(lds + AUX_SLOT_OFF + r * 16);
                if (tk >= 0) { bf16_t* rowp = MOE + (size_t)tk * DM + u.p1 * 256 + wc * 32 + 8 * fq;
#pragma unroll
                    for (int bj = 0; bj < 2; ++bj) { const f32x4 v0 = acc[ai][bj][m][0] * (1.0f / (FP8_WSCALE * FP8_WSCALE)), v1 = acc[ai][bj][m][1] * (1.0f / (FP8_WSCALE * FP8_WSCALE));
                        u32x4 w; w.x = cvt_pk_bf16(v0[0], v0[1]); w.y = cvt_pk_bf16(v0[2], v0[3]); w.z = cvt_pk_bf16(v1[0], v1[1]); w.w = cvt_pk_bf16(v1[2], v1[3]);
                        *(u32x4*)(rowp + bj * 128) = w; } } }
    }
};

DEV void p12_phase(Frame& F) {
    const bf16_t* X1B = WSP(bf16_t, WS_X1B); const bf16_t* MOE = WSP(bf16_t, WS_MOE); const float* mod = WSP(float, WS_MOD); const float* fg = F.in[I_FING];
    const int gw = F.vcu * 8 + F_WAVE, NGW = F.G * 8;
    LAS unsigned char* lz = F.lds + F_WAVE * LZ_WAVE;
#if MK_TIME_A >= 0
    const float tscale = 1.0f + (float)(__hip_atomic_load(WSP(unsigned long long, WS_STAMP) + MK_TIME_A + 1, __ATOMIC_RELAXED, __HIP_MEMORY_SCOPE_AGENT) - __hip_atomic_load(WSP(unsigned long long, WS_STAMP) + MK_TIME_A, __ATOMIC_RELAXED, __HIP_MEMORY_SCOPE_AGENT)) * 1e-5f;
#endif
#if MK_TIME_B >= 0
    const float tspike = (float)(__hip_atomic_load(WSP(unsigned long long, WS_STAMP) + MK_TIME_B + 1, __ATOMIC_RELAXED, __HIP_MEMORY_SCOPE_AGENT) - __hip_atomic_load(WSP(unsigned long long, WS_STAMP) + MK_TIME_B, __ATOMIC_RELAXED, __HIP_MEMORY_SCOPE_AGENT)) * 1e-2f;
#endif
    for (int ch = gw; ch < TOK / 32; ch += NGW) {
        const int b = ch >> 6; const float* gate = mod + b * NMOD + 5 * DM;
        float gq[16], fq_[16];
#pragma unroll
        for (int h = 0; h < 2; ++h) { const int c0 = h * 512 + 8 * F_LANE; const f32x4 g0 = *(const f32x4*)(gate + c0), g1 = *(const f32x4*)(gate + c0 + 4), f0 = *(const f32x4*)(fg + c0), f1 = *(const f32x4*)(fg + c0 + 4);
#pragma unroll
            for (int j = 0; j < 4; ++j) { gq[h * 8 + j] = g0[j]; gq[h * 8 + 4 + j] = g1[j]; fq_[h * 8 + j] = f0[j]; fq_[h * 8 + 4 + j] = f1[j]; } }
#define P12_ISSUE(bb) do { _Pragma("unroll") for (int r = 0; r < 2; ++r) _Pragma("unroll") for (int h = 0; h < 2; ++h) { \
            const size_t off_ = (size_t)(ch * 32 + (bb) * 2 + r) * DM + h * 512 + 8 * F_LANE; \
            lz_issue(X1B + off_, lz, ((bb) & 1) * 8 + r * 4 + h); lz_issue(MOE + off_, lz, ((bb) & 1) * 8 + r * 4 + 2 + h); } } while (0)
        asm volatile("s_waitcnt lgkmcnt(0)" ::: "memory");
        P12_ISSUE(0); P12_ISSUE(1);
#pragma unroll 1
        for (int bb = 0; bb < 16; ++bb) {
            if (bb + 1 < 16) LZ_WAIT(8); else LZ_WAIT(0);
            float v[2][16], ss[2];
#pragma unroll
            for (int r = 0; r < 2; ++r) { float s_ = 0.f;
#pragma unroll
                for (int h = 0; h < 2; ++h) { const u32x4 xv = *(const LAS u32x4*)(lz + ((bb & 1) * 8 + r * 4 + h) * 1024 + F_LANE * 16), mv = *(const LAS u32x4*)(lz + ((bb & 1) * 8 + r * 4 + 2 + h) * 1024 + F_LANE * 16);
#pragma unroll
                    for (int j = 0; j < 4; ++j) { const unsigned xw = xv[j], mw = mv[j];
                        const float lo = bflo(xw) + gq[h * 8 + 2 * j] * bflo(mw), hi = bfhi(xw) + gq[h * 8 + 2 * j + 1] * bfhi(mw);
                        v[r][h * 8 + 2 * j] = lo; v[r][h * 8 + 2 * j + 1] = hi; s_ += lo * lo + hi * hi; } }
                ss[r] = s_; }
#pragma unroll
            for (int o = 1; o < 64; o <<= 1) { ss[0] += __shfl_xor(ss[0], o); ss[1] += __shfl_xor(ss[1], o); }
#pragma unroll
            for (int r = 0; r < 2; ++r) { const float rstd = 1.0f / sqrtf(ss[r] * (1.f / DM) + RMS_EPS); float* op = F.out + (size_t)(ch * 32 + bb * 2 + r) * DM + 8 * F_LANE;
#pragma unroll
                for (int h = 0; h < 2; ++h) { f32x4 o0, o1;
#pragma unroll
                    for (int j = 0; j < 4; ++j) { o0[j] = v[r][h * 8 + j] * rstd * fq_[h * 8 + j]; o1[j] = v[r][h * 8 + 4 + j] * rstd * fq_[h * 8 + 4 + j]; }
#if MK_TIME_A >= 0
                    o0 = o0 * tscale; o1 = o1 * tscale;
#endif
#if MK_TIME_B >= 0
                    if (ch == 0 && bb == 0 && r == 0 && h == 0 && F_LANE == 0) o0[0] += tspike;
#endif
                    *(f32x4*)(op + h * 512) = o0; *(f32x4*)(op + h * 512 + 4) = o1; } }
            if (bb + 2 < 16) P12_ISSUE(bb + 2);
        }
#undef P12_ISSUE
    }
}

#define XB_TMO      128
#define XB_XCNT(j)  (256  + 64 * (j))
#define XB_XSUB(j)  (1280 + 64 * (j))
#define XB_XGEN(j)  (2304 + 64 * (j))
#define XB_TOP      3328
#define XB_TOPGEN   3392
#define XCD_BAR_WORDS 3456
#define XB_SPIN_CAP (1u << 22)
DEV unsigned xb_ld(unsigned* p)              { return __hip_atomic_load(p, __ATOMIC_RELAXED, __HIP_MEMORY_SCOPE_AGENT); }
DEV unsigned xb_add(unsigned* p, unsigned v) { return __hip_atomic_fetch_add(p, v, __ATOMIC_RELAXED, __HIP_MEMORY_SCOPE_AGENT); }
DEV unsigned xb_xcc_id() { return (unsigned)__builtin_amdgcn_s_getreg((3 << 11) | 20) & 0xFu; }
#define XB_SPIN(cond, bar) do { unsigned _sp = 0; while (cond) { __builtin_amdgcn_s_sleep(1); \
    if ((++_sp & 255u) == 0u) { if (xb_ld(&(bar)[XB_TMO])) break; if (_sp > XB_SPIN_CAP) { atomicAdd(&(bar)[XB_TMO], 1u); break; } } } } while (0)
struct XcdBarrier { unsigned* bar; unsigned x; volatile LAS unsigned* st; };
DEV XcdBarrier xcd_barrier_post(unsigned* bar, volatile LAS unsigned* st) {
    XcdBarrier b; b.bar = bar; b.x = xb_xcc_id(); b.st = st;
    if (threadIdx.x == 0) (void)xb_add(&bar[XB_XCNT(b.x)], 1u);
    return b;
}
DEV void xcd_barrier_complete(unsigned* bar, unsigned x, unsigned& nloc, unsigned& nx) {
    const unsigned G = gridDim.x * gridDim.y * gridDim.z;
    unsigned sum, cnt, mine, sp = 0u;
    for (;;) {
        sum = 0u; cnt = 0u; mine = 0u;
#pragma unroll
        for (unsigned j = 0; j < 16; ++j) { const unsigned c = xb_ld(&bar[XB_XCNT(j)]); sum += c; cnt += (c > 0u) ? 1u : 0u; mine = (j == x) ? c : mine; }
        if (sum == G) break;
        __builtin_amdgcn_s_sleep(1);
        if ((++sp & 255u) == 0u) { if (xb_ld(&bar[XB_TMO])) break; if (sp > XB_SPIN_CAP) { atomicAdd(&bar[XB_TMO], 1u); break; } }
    }
    nloc = mine > 0u ? mine : 1u; nx = cnt > 0u ? cnt : 1u;
}
DEV void xcd_barrier(const XcdBarrier& b) {
    asm volatile("s_waitcnt vmcnt(0)" ::: "memory");
    __syncthreads();
    if (threadIdx.x == 0) {
        unsigned* bar = b.bar;
        __builtin_amdgcn_s_waitcnt(0);
        unsigned nloc = b.st[0], nx = b.st[1];
        if (nloc == 0u) { xcd_barrier_complete(bar, b.x, nloc, nx); b.st[0] = nloc; b.st[1] = nx; }
        const unsigned old = xb_add(&bar[XB_XSUB(b.x)], 1u);
        const unsigned gen = old / nloc;
        if (old + 1u == (gen + 1u) * nloc) {
            __builtin_amdgcn_fence(__ATOMIC_RELEASE, "agent");
            asm volatile("s_waitcnt vmcnt(0)" ::: "memory");
            const unsigned og = xb_add(&bar[XB_TOP], 1u);
            const unsigned tg = og / nx;
            if (og + 1u == (tg + 1u) * nx) xb_add(&bar[XB_TOPGEN], 1u);
            else XB_SPIN(xb_ld(&bar[XB_TOPGEN]) == tg, bar);
            __builtin_amdgcn_fence(__ATOMIC_ACQUIRE, "agent");
            xb_add(&bar[XB_XGEN(b.x)], 1u);
            asm volatile("s_waitcnt vmcnt(0)" ::: "memory");
        } else {
            XB_SPIN(xb_ld(&bar[XB_XGEN(b.x)]) == gen, bar);
            __builtin_amdgcn_fence(__ATOMIC_ACQUIRE, "agent");
            asm volatile("s_waitcnt vmcnt(0)" ::: "memory");
        }
    }
    __syncthreads();
}

constexpr int LDS_BYTES = 163840;
static_assert(AUX_TILE_OFF + MAXTILES * 4 <= LDS_BYTES - 256, "LDS map");
constexpr int NPHASE = 13;
constexpr int MISC_OFF = LDS_BYTES - 256;
constexpr int CW_BAR = 4096;
constexpr size_t CTL_ZERO_BYTES = 65536;

__global__ void __launch_bounds__(512, 2) mk_fwd(Args args) {
    extern __shared__ __attribute__((aligned(16))) unsigned char lds_raw[];
    Frame F;
    F.lds = (LAS unsigned char*)lds_raw;
    F.G = gridDim.x; F.bx = blockIdx.x; F.vcu = (F.G % 8 == 0) ? (F.bx % 8) * (F.G / 8) + F.bx / 8 : F.bx;
#pragma unroll
    for (int i = 0; i < 29; ++i) F.in[i] = args.in[i];
    F.out = args.out; F.ws = args.ws; F.flags = args.flags;
    const int lo = args.ph_lo, hi = args.ph_hi;
#if MK_ONE_LAUNCH == 1
    cg::grid_group grid = cg::this_grid();
#define SEAM(k) do { if (lo <= (k) && (k) + 1 < hi) grid.sync(); } while (0)
#elif MK_ONE_LAUNCH == 2
    {
        volatile LAS unsigned* misc = (volatile LAS unsigned*)(F.lds + MISC_OFF);
        if (F_TID < 16) misc[F_TID] = 0u;
        __syncthreads();
    }
    const XcdBarrier xbar = xcd_barrier_post((unsigned*)(F.ws + WS_CTL) + CW_BAR + args.li * XCD_BAR_WORDS, (volatile LAS unsigned*)(F.lds + MISC_OFF));
#if MK_TIME_A >= 0 || MK_TIME_B >= 0
#define STAMP(i) do { if (F.bx == 0 && F_TID == 0) __hip_atomic_store(WSP(unsigned long long, WS_STAMP) + (i), (unsigned long long)__builtin_amdgcn_s_memrealtime(), __ATOMIC_RELAXED, __HIP_MEMORY_SCOPE_AGENT); } while (0)
#else
#define STAMP(i) do { } while (0)
#endif
    STAMP(0);
#define SEAM(k) do { if (lo <= (k) && (k) + 1 < hi) xcd_barrier(xbar); STAMP((k) + 1); } while (0)
#else
#define SEAM(k) do { } while (0)
#endif
#define IN(k) (lo <= (k) && (k) < hi)
#define REPS(k) for (int rep_ = 0; rep_ < 1 + ((MK_REP >> (k)) & 1); ++rep_)

    if (IN(0)) REPS(0) { p0_phase(F); }
    SEAM(0);
    if (IN(1)) REPS(1) {
        if (!(F.flags & 2)) p1_norm_rows(F);
        if (F.flags & 4) { } else
        if (F.bx < 32) {
            asm volatile("s_waitcnt vmcnt(0)" ::: "memory"); __syncthreads();
            SchedIn S{8, 1024u, 1024u, 32, F.bx, (const char*)WSP(bf16_t, WS_HX), (const char*)WSP(bf16_t, WS_WIN), 2560, 2592, (const char*)WSP(float, WS_RSCALE), (const char*)WSP(float, WS_CSCALE)};
            EpiIn E{WSP(bf16_t, WS_UG), WSP(bf16_t, WS_BG), WSP(bf16_t, WS_CV), F.lds};
            pg8::gemm_phase<EpiIn, SchedIn>(F.lds, S, E);
        } else { const int nk = ((F.G - 32) * 4) / 7; if (F.bx < 32 + nk) p1_ktab(F, 32, nk); else p1_tables(F, 32 + nk, F.G - 32 - nk); }
    }
    SEAM(1);
    if (IN(2)) REPS(2) {
        p2_fill_tr(F);
        SchedIn S{8, 1024u, 1024u, F.G, F.bx, (const char*)WSP(bf16_t, WS_HX), (const char*)WSP(bf16_t, WS_WIN), 0, 2560, (const char*)WSP(float, WS_RSCALE), (const char*)WSP(float, WS_CSCALE)};
        EpiIn E{WSP(bf16_t, WS_UG), WSP(bf16_t, WS_BG), WSP(bf16_t, WS_CV), F.lds};
        pg8::gemm_phase<EpiIn, SchedIn>(F.lds, S, E);
    }
    SEAM(2);
    if (IN(3)) REPS(3) {
        int vb0, nvb;
        if (F.bx < 144) { SchedE S{UK / 64, (unsigned)(UGK * 2), (unsigned)(UK * 2), F.bx, (const char*)WSP(bf16_t, WS_UG), (const char*)WSP(bf16_t, WS_WE)}; EpiE E{WSP(float, WS_E)};
            pg8::gemm_phase<EpiE, SchedE>(F.lds, S, E); vb0 = F.bx * 3; nvb = 3; }
        else if (F.bx < 208) { SchedSB S2{8, 1024u, 1024u, F.bx - 144, (const char*)WSP(bf16_t, WS_SH2), (const char*)WSP(bf16_t, WS_W13)}; EpiSB E2{WSP(bf16_t, WS_SB13)};
            pg8::gemm_phase<EpiSB, SchedSB>(F.lds, S2, E2); vb0 = 432 + (F.bx - 144) * 3; nvb = 3; }
        else { vb0 = 624 + (F.bx - 208) * 4; nvb = 4; }
        if (!(F.flags & 2)) for (int v = 0; v < nvb; ++v) conv_items(F, (vb0 + v) * 512 + F_TID, 816 * 512);
    }
    SEAM(3);
    if (IN(4)) REPS(4) { p4_phase(F); }
    SEAM(4);
    if (IN(5)) REPS(5) {
        SchedY S{UGK / 64, (unsigned)(UGK * 2), (unsigned)(UGK * 2), F.bx, (const char*)WSP(bf16_t, WS_UG), (const char*)WSP(bf16_t, WS_TR)}; EpiY E{WSP(bf16_t, WS_G)};
        pg8::gemm_phase<EpiY, SchedY>(F.lds, S, E);
    }
    SEAM(5);
    if (IN(6)) REPS(6) {
        SchedGlu S{4, 512u, 512u, F.G, F.bx, (const char*)WSP(bf16_t, WS_G), (const char*)WSP(bf16_t, WS_WGLU)}; EpiGlu E{WSP(bf16_t, WS_G), WSP(bf16_t, WS_YMIX), F.in[I_BGLU]};
        pg8::gemm_phase<EpiGlu, SchedGlu>(F.lds, S, E);
    }
    SEAM(6);
    if (IN(7)) REPS(7) {
        SchedOut S{16, 2048u, 2048u, F.G, F.bx, (const char*)WSP(bf16_t, WS_YMIX), (const char*)WSP(bf16_t, WS_WOUT)};
        EpiYX E{WSP(bf16_t, WS_YX), args.flags & 1};
        pg8::gemm_phase<EpiYX, SchedOut>(F.lds, S, E);
    }
    SEAM(7);
    if (IN(8)) REPS(8) { p8_phase(F); }
    SEAM(8);
    if (IN(9)) REPS(9) { p9_phase(F); }
    SEAM(9);
    if (IN(10)) REPS(10) {
        const int ntiles = ld_agent_i(WSP(int, WS_TILES));
        moe_setup(F.lds, WSP(int, WS_TILES), ntiles, WSP(u32x4, WS_SLOT), F.vcu >> 3);
        SchedUp S{8, 1024u, 1024u, F.G, F.vcu, ntiles, (const char*)WSP(bf16_t, WS_X1G), (const char*)WSP(bf16_t, WS_W13), (const char*)WSP(u32x4, WS_SLOT), (const char*)WSP(bf16_t, WS_SB13), F.lds};
        EpiUp E{WSP(unsigned char, WS_HID), F.lds};
        pg8::gemm_phase<EpiUp, SchedUp>(F.lds, S, E);
    }
    SEAM(10);
    if (IN(11)) REPS(11) {
        const int ntiles = ld_agent_i(WSP(int, WS_TILES));
        moe_setup(F.lds, WSP(int, WS_TILES), ntiles, WSP(u32x4, WS_SLOT), MAXTILES);
        SchedDown S{8, 1024u, 512u, F.G, F.vcu, ntiles, (const char*)WSP(bf16_t, WS_HID), (const char*)WSP(bf16_t, WS_W2), (const char*)WSP(u32x4, WS_SLOT), F.lds};
        EpiDown E{WSP(bf16_t, WS_MOE), F.lds};
        pg8::gemm_phase<EpiDown, SchedDown>(F.lds, S, E);
    }
    SEAM(11);
    if (IN(12)) REPS(12) { p12_phase(F); }
#undef IN
#undef SEAM
}

extern "C" void kernel_launch(void* const* d_in, const int* in_sizes, int n_in, void* d_out, int out_size, void* d_ws, size_t ws_size, hipStream_t stream) {
    static int grid = 0;
    if (grid == 0) {
        if (n_in != 29 || out_size != TOK * DM || ws_size < WS_END) { fprintf(stderr, "kernel_launch: unexpected problem (n_in %d, out %d, ws %zu)\n", n_in, out_size, ws_size); grid = -1; return; }
        int dev = 0, cus = 0, per_cu = 0;
        if (hipGetDevice(&dev) != hipSuccess || hipDeviceGetAttribute(&cus, hipDeviceAttributeMultiprocessorCount, dev) != hipSuccess) { grid = -1; return; }
        if (hipFuncSetAttribute((const void*)mk_fwd, hipFuncAttributeMaxDynamicSharedMemorySize, LDS_BYTES) != hipSuccess) { fprintf(stderr, "kernel_launch: hipFuncSetAttribute failed\n"); grid = -1; return; }
        if (hipOccupancyMaxActiveBlocksPerMultiprocessor(&per_cu, (const void*)mk_fwd, 512, LDS_BYTES) != hipSuccess || per_cu < 1) { fprintf(stderr, "kernel_launch: occupancy query gives %d\n", per_cu); (void)hipGetLastError(); per_cu = 1; }
        grid = cus;
        if (grid > 256) grid = 256;
    }
    if (grid < 0) return;
    Args a{};
    for (int i = 0; i < 29; ++i) a.in[i] = (const float*)d_in[i];
    a.out = (float*)d_out; a.ws = (unsigned char*)d_ws;
#if MK_ONE_LAUNCH == 1
    a.ph_lo = 0; a.ph_hi = NPHASE;
    void* kargs[] = {&a};
    hipError_t e = hipLaunchCooperativeKernel((const void*)mk_fwd, dim3(grid), dim3(512), kargs, LDS_BYTES, stream);
    if (e != hipSuccess) fprintf(stderr, "cooperative launch failed: %s (grid %d)\n", hipGetErrorString(e), grid);
#elif MK_ONE_LAUNCH == 2
    if (hipMemsetAsync((char*)d_ws + WS_CTL, 0, CTL_ZERO_BYTES, stream) != hipSuccess) { fprintf(stderr, "kernel_launch: memset failed\n"); return; }
#if MK_SPLIT_AT >= 0
    a.ph_lo = 0; a.ph_hi = MK_SPLIT_AT + 1; a.li = 0;
    hipLaunchKernelGGL(mk_fwd, dim3(grid), dim3(512), LDS_BYTES, stream, a);
    a.ph_lo = MK_SPLIT_AT + 1 - MK_SPLIT_DUP; a.ph_hi = NPHASE; a.li = 1;
    hipLaunchKernelGGL(mk_fwd, dim3(grid), dim3(512), LDS_BYTES, stream, a);
#else
    a.ph_lo = 0; a.ph_hi = NPHASE;
    hipLaunchKernelGGL(mk_fwd, dim3(grid), dim3(512), LDS_BYTES, stream, a);
#endif
#if MK_PROBE_PHASE >= 0
    a.ph_lo = MK_PROBE_PHASE; a.ph_hi = MK_PROBE_PHASE + 1; a.flags = MK_PROBE_FLAGS;
    hipLaunchKernelGGL(mk_fwd, dim3(grid), dim3(512), LDS_BYTES, stream, a);
#endif
#else
    for (int p = 0; p < NPHASE; ++p) { a.ph_lo = p; a.ph_hi = p + 1; hipLaunchKernelGGL(mk_fwd, dim3(grid), dim3(512), LDS_BYTES, stream, a); }
#endif
}
```

```cpp
#include <hip/hip_runtime.h>
#include <hip/hip_cooperative_groups.h>
#include <cstdio>
namespace cg = cooperative_groups;

#ifndef MK_SPLIT_AT
#define MK_SPLIT_AT -1
#endif
#ifndef MK_SPLIT_DUP
#define MK_SPLIT_DUP 0
#endif
#ifndef MK_TIME_A
#define MK_TIME_A -1
#endif
#ifndef MK_TIME_B
#define MK_TIME_B -1
#endif
#ifndef MK_PROBE_FLAGS
#define MK_PROBE_FLAGS 0
#endif
#ifndef MK_PROBE_PHASE
#define MK_PROBE_PHASE -1
#endif
#ifndef MK_REP
#define MK_REP 0
#endif
#ifndef MK_ONE_LAUNCH
#define MK_ONE_LAUNCH 2
#endif

#define DEV __device__ __forceinline__
#define LAS __attribute__((address_space(3)))
typedef unsigned short bf16_t;
typedef short bf16x8 __attribute__((ext_vector_type(8)));
typedef float f32x4 __attribute__((ext_vector_type(4)));
typedef float f32x2 __attribute__((ext_vector_type(2)));
typedef unsigned u32x4 __attribute__((ext_vector_type(4)));
typedef unsigned u32x2 __attribute__((ext_vector_type(2)));

constexpr int NB = 32, SEQ = 2048, DM = 1024, TOK = NB * SEQ, CTXL = 256, CTOK = NB * CTXL;
constexpr int NG = 16, NP = 64, NH = 16, LC = 32;
constexpr int NCH_LAT = TOK / LC, NCH_CTX = CTOK / LC, NCH_PAD = 2304, UK = LC * NH, UGK = UK + 256, TRN = LC * NH;
static_assert(NCH_LAT + NCH_CTX == NCH_PAD && NCH_PAD % 256 == 0 && (UGK / 64) % 2 == 0 && (UK / 64) % 2 == 0, "S5 chunk geometry");
constexpr int CONVW = 768, NMOD = 6 * DM;
constexpr int NEXP = 16, DEXP = 512, NBUCKET = 24, MAXTILES = 280;
constexpr float RMS_EPS = 1e-6f;

constexpr size_t MiB = 1u << 20;
constexpr size_t WS_CTL = 0;
constexpr size_t WS_STAMP = 512 * 1024;
constexpr size_t WS_MOD = 1 * MiB;
constexpr size_t WS_APOW = 2 * MiB;
constexpr size_t WS_BBAR = 4 * MiB;
constexpr size_t WS_KTAB = 5 * MiB;
constexpr size_t WS_SB13 = 7 * MiB;
constexpr size_t WS_SH2 = 9 * MiB;
constexpr size_t WS_RB = 10 * MiB;
constexpr size_t WS_TOKB = 10 * MiB + 65536;
constexpr size_t WS_TOKW = 11 * MiB;
constexpr size_t WS_TOKR = 12 * MiB;
constexpr size_t WS_SEGC = 12 * MiB + 512 * 1024;
constexpr size_t WS_PERM = 13 * MiB;
constexpr size_t WS_TILES = 14 * MiB;
constexpr size_t WS_CSCALE = 15 * MiB;
constexpr size_t WS_RSCALE = 15 * MiB + 65536;
constexpr size_t WS_SLOT = 16 * MiB;
constexpr size_t WS_WR = 24 * MiB;
constexpr size_t WS_WGLU = 25 * MiB;
constexpr size_t WS_WIN = 26 * MiB;
constexpr size_t WS_WOUT = 32 * MiB;
constexpr size_t WS_WE = 34 * MiB;
constexpr size_t WS_W2 = 42 * MiB;
constexpr size_t WS_W13 = 58 * MiB;
constexpr size_t WS_TR = 186 * MiB;
constexpr size_t WS_E = 90 * MiB;
constexpr size_t WS_UG = 130 * MiB;
static_assert(WS_E + (size_t)16 * NCH_PAD * 256 * 4 <= WS_UG && WS_UG + (size_t)16 * NCH_PAD * UGK * 2 <= WS_TR && WS_TR + (size_t)16 * TRN * UGK * 2 <= 200 * MiB, "S5 workspace map");
constexpr size_t WS_G = 200 * MiB;
constexpr size_t WS_BG = 232 * MiB;
constexpr size_t WS_CV = 328 * MiB;
constexpr size_t WS_HX = 424 * MiB;
constexpr size_t WS_HID = WS_HX;
constexpr size_t WS_YX = WS_BG;
constexpr size_t WS_YMIX = 568 * MiB;
constexpr size_t WS_X1G = 696 * MiB;
constexpr size_t WS_MOE = WS_YMIX;
constexpr size_t WS_X1B = 824 * MiB;
constexpr size_t WS_END = 952 * MiB;

DEV unsigned cvt_pk_bf16(float lo, float hi) { unsigned r; asm volatile("v_cvt_pk_bf16_f32 %0, %1, %2" : "=v"(r) : "v"(lo), "v"(hi)); return r; }
DEV float bf2f(unsigned short h) { return __uint_as_float(((unsigned)h) << 16); }
DEV float bflo(unsigned w) { return __uint_as_float(w << 16); }
DEV float bfhi(unsigned w) { return __uint_as_float(w & 0xffff0000u); }
DEV float wave_sum(float v) {
#pragma unroll
    for (int o = 1; o < 64; o <<= 1) v += __shfl_xor(v, o);
    return v;
}
DEV float sigmoidf_(float x) { return __builtin_amdgcn_rcpf(1.0f + __expf(-x)); }
DEV float siluf_(float x) { return x * sigmoidf_(x); }
DEV float gelu_tanh(float x) { const float u = 0.7978845608028654f * (x + 0.044715f * x * x * x); return x * sigmoidf_(2.0f * u); }
typedef int v8i_t __attribute__((ext_vector_type(8)));
typedef int v4i_t __attribute__((ext_vector_type(4)));
DEV float clamp_e4m3(float v) { return __builtin_amdgcn_fmed3f(v, -448.0f, 448.0f); }
DEV unsigned pk4_fp8(float a, float b, float c, float d) { int w = 0; w = __builtin_amdgcn_cvt_pk_fp8_f32(clamp_e4m3(a), clamp_e4m3(b), w, false); w = __builtin_amdgcn_cvt_pk_fp8_f32(clamp_e4m3(c), clamp_e4m3(d), w, true); return (unsigned)w; }
constexpr float FP8_WSCALE = 16.0f;
DEV int ld_agent_i(const int* p) { return __hip_atomic_load(p, __ATOMIC_RELAXED, __HIP_MEMORY_SCOPE_AGENT); }

#ifndef PG8_SP2
#define PG8_SP2 true
#endif
namespace pg8 {
constexpr int BM = 256, BK = 64, HALF = 128, HTB = HALF * BK * 2, STAGE_BYTES = 8 * HTB;
__host__ __device__ __forceinline__ int lds_byte(int r, int c) { const int st = (r >> 4) * 2 + (c >> 5), rr = r & 15, cc = c & 31, ob = rr * 64 + cc * 2; return st * 1024 + (ob ^ (((ob >> 9) & 1) << 5)); }
__host__ __device__ __forceinline__ void stage_rc(int b, int& R, int& C) { const int st = b / 1024, sb = b % 1024, swz = sb ^ (((sb >> 9) & 1) << 5); R = (st >> 1) * 16 + swz / 64; C = (st & 1) * 32 + (swz % 64) / 2; }
__host__ __device__ __forceinline__ int perm32(int rho) { const int n = rho >> 4, i = rho & 15; return 8 * (i >> 2) + 4 * n + (i & 3); }

struct Unit {
    const char* A0; const char* A1; const char* B0; const char* B1;
    int ksA, ksB;
    int p0, p1, p2, p3, q;
};
DEV const char* pa(const Unit& u, int kt) { return kt < u.ksA ? u.A0 + (size_t)kt * 128 : u.A1 + (size_t)(kt - u.ksA) * 128; }
DEV const char* pb(const Unit& u, int kt) { return kt < u.ksB ? u.B0 + (size_t)kt * 128 : u.B1 + (size_t)(kt - u.ksB) * 128; }

template <class Epi, class Sched>
DEV void gemm_phase(LAS unsigned char* lds, const Sched& S, const Epi& E) {
    const int tid = threadIdx.x, wid = __builtin_amdgcn_readfirstlane(tid >> 6), lane = tid & 63, wr = wid >> 2, wc = wid & 3, fr = lane & 15, fq = lane >> 4;
    int nt = S.nt; asm volatile("" : "+s"(nt));
    unsigned voffB[2], vA[4];
#pragma unroll
    for (int i = 0; i < 2; ++i) { int R_, C_; stage_rc(tid * 16 + i * 8192, R_, C_); const int Rb = Epi::PERM ? ((R_ & ~31) + perm32(R_ & 31)) : R_;
        voffB[i] = (unsigned)Rb * S.ldb + (unsigned)C_ * 2u; }
    const size_t hstepB = (size_t)HALF * S.ldb;
    const unsigned ldsw = (unsigned)wid * 1024u;
    const int aoff = lds_byte(wr * 64 + fr, fq * 8), boff = lds_byte(wc * 32 + fr, fq * 8);
#define PG8_SA(b, h) (((b) * 2 + (h)) * HTB)
#define PG8_SB(b, h) ((4 + (b) * 2 + (h)) * HTB)
#define PG8_STAGE(bufoff, gbase, v0, v1) do { \
        __builtin_amdgcn_global_load_lds((const unsigned*)((const char*)(gbase) + (v0)), (LAS unsigned*)(lds + (bufoff) + ldsw), 16, 0, 0); \
        __builtin_amdgcn_global_load_lds((const unsigned*)((const char*)(gbase) + (v1)), (LAS unsigned*)(lds + (bufoff) + ldsw + 8192), 16, 0, 0); } while (0)
#define PG8_LDA(dst, b, h) do { if constexpr (Sched::FP8) { _Pragma("unroll") for (int m = 0; m < 4; ++m) { const v4i_t lo_ = *(const LAS v4i_t*)(lds + PG8_SA(b, h) + aoff + m * 2048), hi_ = *(const LAS v4i_t*)(lds + PG8_SA(b, h) + aoff + m * 2048 + 1024); \
            dst##8[m] = __builtin_shufflevector(lo_, hi_, 0, 1, 2, 3, 4, 5, 6, 7); } } \
        else { _Pragma("unroll") for (int m = 0; m < 4; ++m) _Pragma("unroll") for (int k = 0; k < 2; ++k) dst[m][k] = *(const LAS bf16x8*)(lds + PG8_SA(b, h) + aoff + m * 2048 + k * 1024); } } while (0)
#define PG8_LDB(dst, b, h) do { if constexpr (Sched::FP8) { _Pragma("unroll") for (int n = 0; n < 2; ++n) { const v4i_t lo_ = *(const LAS v4i_t*)(lds + PG8_SB(b, h) + boff + n * 2048), hi_ = *(const LAS v4i_t*)(lds + PG8_SB(b, h) + boff + n * 2048 + 1024); \
            dst##8[n] = __builtin_shufflevector(lo_, hi_, 0, 1, 2, 3, 4, 5, 6, 7); } } \
        else { _Pragma("unroll") for (int n = 0; n < 2; ++n) _Pragma("unroll") for (int k = 0; k < 2; ++k) dst[n][k] = *(const LAS bf16x8*)(lds + PG8_SB(b, h) + boff + n * 2048 + k * 1024); } } while (0)
#define PG8_MMA(ai, bj, At, Bt) do { __builtin_amdgcn_s_setprio(1); _Pragma("unroll") for (int m = 0; m < 4; ++m) _Pragma("unroll") for (int n = 0; n < 2; ++n) { \
        if constexpr (Sched::FP8)   \
            asm volatile("v_mfma_scale_f32_16x16x128_f8f6f4 %0, %1, %2, %0, %3, %3 op_sel_hi:[0,0,0]" : "+v"(acc[ai][bj][m][n]) : "v"(Bt##8[n]), "v"(At##8[m]), "v"(sc_one));   \
        else if constexpr (Sched::I8) { _Pragma("unroll") for (int k = 0; k < 2; ++k) acc[ai][bj][m][n] = __builtin_bit_cast(f32x4, __builtin_amdgcn_mfma_i32_16x16x64_i8(__builtin_bit_cast(v4i_t, Bt[n][k]), __builtin_bit_cast(v4i_t, At[m][k]), __builtin_bit_cast(v4i_t, acc[ai][bj][m][n]), 0, 0, 0)); }   \
        else { _Pragma("unroll") for (int k = 0; k < 2; ++k) acc[ai][bj][m][n] = __builtin_amdgcn_mfma_f32_16x16x32_bf16(Bt[n][k], At[m][k], acc[ai][bj][m][n], 0, 0, 0); } } \
        __builtin_amdgcn_s_setprio(0); } while (0)
#define PG8_WAIT_V(n) asm volatile("s_waitcnt vmcnt(" #n ")" ::: "memory")
#define PG8_WAIT_L(n) asm volatile("s_waitcnt lgkmcnt(" #n ")" ::: "memory")
#define PG8_BAR __builtin_amdgcn_s_barrier()
#define PG8_SCHED __builtin_amdgcn_sched_barrier(0)
    Unit cur, nxt; int ui = 0;
    int aux_t = 0; asm volatile("" : "+s"(aux_t));
    if (!S.next(0, cur)) return;
    f32x4 acc[2][2][4][2];
#pragma unroll
    for (int a = 0; a < 2; ++a)
#pragma unroll
        for (int b = 0; b < 2; ++b)
#pragma unroll
            for (int m = 0; m < 4; ++m)
#pragma unroll
                for (int n = 0; n < 2; ++n) acc[a][b][m][n] = (f32x4){0.f, 0.f, 0.f, 0.f};
    bf16x8 At[4][2], B0[2][2], B1[2][2];
    v8i_t At8[4], B08[2], B18[2];
    int sc_one = 0x7f7f7f7f; asm volatile("" : "+v"(sc_one));
    if constexpr (Sched::GATHER) S.rows(cur, tid, vA);
    else {
#pragma unroll
        for (int h = 0; h < 2; ++h)
#pragma unroll
            for (int i = 0; i < 2; ++i) { int R_, C_; stage_rc(tid * 16 + i * 8192, R_, C_); vA[h * 2 + i] = (unsigned)(h * HALF + R_) * S.lda + (unsigned)C_ * 2u; }
    }
    {
        const char* a0 = pa(cur, 0); const char* b0 = pb(cur, 0); const char* a1 = pa(cur, 1); const char* b1 = pb(cur, 1);
        if constexpr (PG8_SP2) {
            PG8_STAGE(PG8_SB(0, 0), b0, voffB[0], voffB[1]); PG8_STAGE(PG8_SB(0, 1), b0 + hstepB, voffB[0], voffB[1]); PG8_STAGE(PG8_SA(0, 0), a0, vA[0], vA[1]); PG8_STAGE(PG8_SA(0, 1), a0, vA[2], vA[3]);
            if (wr == 1) PG8_BAR;
            PG8_WAIT_V(2); PG8_BAR;
            PG8_STAGE(PG8_SB(1, 0), b1, voffB[0], voffB[1]); PG8_STAGE(PG8_SA(1, 0), a1, vA[0], vA[1]); PG8_STAGE(PG8_SB(1, 1), b1 + hstepB, voffB[0], voffB[1]);
            PG8_WAIT_V(6); PG8_BAR;
        } else {
        PG8_STAGE(PG8_SB(0, 0), b0, voffB[0], voffB[1]); PG8_STAGE(PG8_SA(0, 0), a0, vA[0], vA[1]); PG8_STAGE(PG8_SB(0, 1), b0 + hstepB, voffB[0], voffB[1]); PG8_STAGE(PG8_SA(0, 1), a0, vA[2], vA[3]);
        if (wr == 1) PG8_BAR;
        PG8_WAIT_V(4); PG8_BAR;
        PG8_STAGE(PG8_SB(1, 0), b1, voffB[0], voffB[1]); PG8_STAGE(PG8_SA(1, 0), a1, vA[0], vA[1]); PG8_STAGE(PG8_SB(1, 1), b1 + hstepB, voffB[0], voffB[1]);
        PG8_WAIT_V(6); PG8_BAR;
        }
    }
    for (;;) {
        const bool has_next = S.next(ui + 1, nxt);
        if (!has_next) nxt = cur;
#pragma unroll 1
        for (int t = 0; t < nt; t += 2) {
            const bool last = (t == nt - 2);
            const char* a1 = pa(cur, t + 1);
            const char* a2; const char* b2;
            if (last) { a2 = pa(nxt, 0); b2 = pb(nxt, 0); } else { a2 = pa(cur, t + 2); b2 = pb(cur, t + 2); }
            const char* a3 = a2 + 128; const char* b3 = b2 + 128;
            if constexpr (PG8_SP2) {
            PG8_LDB(B0, 0, 0); PG8_LDB(B1, 0, 1); PG8_SCHED; PG8_LDA(At, 0, 0); PG8_STAGE(PG8_SA(1, 1), a1, vA[2], vA[3]);
            if constexpr (Sched::GATHER) { if (last && has_next) S.rows(nxt, tid, vA); }
            PG8_WAIT_V(8); PG8_WAIT_L(0); PG8_BAR; PG8_MMA(0, 0, At, B0); PG8_MMA(0, 1, At, B1); PG8_BAR; PG8_SCHED;
            PG8_LDA(At, 0, 1); PG8_STAGE(PG8_SB(0, 0), b2, voffB[0], voffB[1]); PG8_STAGE(PG8_SB(0, 1), b2 + hstepB, voffB[0], voffB[1]); PG8_STAGE(PG8_SA(0, 0), a2, vA[0], vA[1]);
            if constexpr (Sched::AUX) { if (t == aux_t) S.aux(cur, nxt, lds, wid, lane); }
            PG8_WAIT_V(8); PG8_WAIT_L(0); PG8_BAR; PG8_MMA(1, 0, At, B0); PG8_MMA(1, 1, At, B1); PG8_BAR; PG8_SCHED;
            PG8_LDB(B0, 1, 0); PG8_LDB(B1, 1, 1); PG8_SCHED; PG8_LDA(At, 1, 0); PG8_STAGE(PG8_SA(0, 1), a2, vA[2], vA[3]);
            PG8_WAIT_V(8); PG8_WAIT_L(0); PG8_BAR; PG8_MMA(0, 0, At, B0); PG8_MMA(0, 1, At, B1); PG8_BAR; PG8_SCHED;
            PG8_LDA(At, 1, 1); PG8_STAGE(PG8_SB(1, 0), b3, voffB[0], voffB[1]); PG8_STAGE(PG8_SB(1, 1), b3 + hstepB, voffB[0], voffB[1]); PG8_STAGE(PG8_SA(1, 0), a3, vA[0], vA[1]);
            PG8_WAIT_V(8); PG8_WAIT_L(0); PG8_BAR; PG8_MMA(1, 0, At, B0); PG8_MMA(1, 1, At, B1); PG8_BAR; PG8_SCHED;
            } else {
            PG8_LDB(B0, 0, 0); PG8_SCHED; PG8_LDA(At, 0, 0); PG8_STAGE(PG8_SA(1, 1), a1, vA[2], vA[3]);
            if constexpr (Sched::GATHER) { if (last && has_next) S.rows(nxt, tid, vA); }
            PG8_WAIT_L(8); PG8_BAR; PG8_WAIT_L(0); PG8_MMA(0, 0, At, B0); PG8_BAR; PG8_SCHED;
            PG8_LDB(B1, 0, 1); PG8_STAGE(PG8_SB(0, 0), b2, voffB[0], voffB[1]);
            PG8_BAR; PG8_WAIT_L(0); PG8_MMA(0, 1, At, B1); PG8_BAR;
            PG8_LDA(At, 0, 1); PG8_STAGE(PG8_SA(0, 0), a2, vA[0], vA[1]);
            if constexpr (Sched::AUX) { if (t == aux_t) S.aux(cur, nxt, lds, wid, lane); }
            PG8_BAR; PG8_WAIT_L(0); PG8_MMA(1, 0, At, B0); PG8_BAR; PG8_SCHED;
            PG8_STAGE(PG8_SB(0, 1), b2 + hstepB, voffB[0], voffB[1]);
            PG8_WAIT_V(6); PG8_BAR; PG8_MMA(1, 1, At, B1); PG8_BAR;
            PG8_LDB(B0, 1, 0); PG8_SCHED; PG8_LDA(At, 1, 0); PG8_STAGE(PG8_SA(0, 1), a2, vA[2], vA[3]);
            PG8_WAIT_L(8); PG8_BAR; PG8_WAIT_L(0); PG8_MMA(0, 0, At, B0); PG8_BAR; PG8_SCHED;
            PG8_LDB(B1, 1, 1); PG8_STAGE(PG8_SB(1, 0), b3, voffB[0], voffB[1]);
            PG8_BAR; PG8_WAIT_L(0); PG8_MMA(0, 1, At, B1); PG8_BAR;
            PG8_LDA(At, 1, 1); PG8_STAGE(PG8_SA(1, 0), a3, vA[0], vA[1]);
            PG8_BAR; PG8_WAIT_L(0); PG8_MMA(1, 0, At, B0); PG8_BAR; PG8_SCHED;
            PG8_STAGE(PG8_SB(1, 1), b3 + hstepB, voffB[0], voffB[1]);
            PG8_WAIT_V(6); PG8_BAR; PG8_MMA(1, 1, At, B1); PG8_BAR;
            }
        }
        if (wr == 0) PG8_BAR;
        if constexpr (Sched::FP8) asm volatile("s_nop 15\n\ts_nop 15" ::: "memory");
        E(acc, cur, wr, wc, fr, fq);
        if (!has_next) break;
#pragma unroll
        for (int a = 0; a < 2; ++a)
#pragma unroll
            for (int b = 0; b < 2; ++b)
#pragma unroll
                for (int m = 0; m < 4; ++m)
#pragma unroll
                    for (int n = 0; n < 2; ++n) acc[a][b][m][n] = (f32x4){0.f, 0.f, 0.f, 0.f};
        cur = nxt; ++ui;
        if (wr == 1) PG8_BAR;
    }
    PG8_WAIT_V(0);
    PG8_BAR;
#undef PG8_SA
#undef PG8_SB
#undef PG8_STAGE
#undef PG8_LDA
#undef PG8_LDB
#undef PG8_MMA
#undef PG8_WAIT_V
#undef PG8_WAIT_L
#undef PG8_BAR
#undef PG8_SCHED
}

DEV void static_tile(int L, int nM, int nN, int& pm, int& pn) {
    const int nwg = nM * nN; int wgid = L;
    { const int q = nwg / 8, r = nwg % 8, xcd = wgid % 8, off = wgid / 8; wgid = (xcd < r ? xcd * (q + 1) : r * (q + 1) + (xcd - r) * q) + off; }
    const int nig = 8 * nN, gid = wgid / nig, fm = gid * 8, gsz = (nM - fm) < 8 ? (nM - fm) : 8;
    pm = fm + ((wgid % nig) % gsz); pn = (wgid % nig) / gsz;
}
}
using pg8::Unit;
constexpr int AUX_SLOT_OFF = 131072, AUX_BIAS_OFF = 131072 + 8192, AUX_TILE_OFF = AUX_BIAS_OFF + 16384;
DEV void glds16(const void* g, LAS unsigned char* l) { __builtin_amdgcn_global_load_lds((const unsigned*)g, (LAS unsigned*)l, 16, 0, 0); }

struct Args { const float* in[29]; float* out; unsigned char* ws; int ph_lo, ph_hi, flags, li; };
static_assert(sizeof(Args) == 31 * 8 + 16, "Args has no padding");
enum { I_X = 0, I_C, I_CTX, I_CCTX, I_WMOD, I_BMOD, I_N1G, I_N2G, I_WIN, I_LRE, I_LIM, I_LOGDT, I_BRE, I_BIM, I_CRE, I_CIM, I_S5D, I_WGLU, I_BGLU, I_CONVW, I_WOUT,
       I_RGW, I_RGB, I_REW, I_REB, I_W1, I_W3, I_W2, I_FING };

struct Frame {
    LAS unsigned char* lds;
    int G, bx, vcu, flags;
    const float* in[29]; float* out; unsigned char* ws;
};
#define WSP(T, off) ((T*)(F.ws + (off)))
#define F_TID ((int)threadIdx.x)
#define F_LANE ((int)threadIdx.x & 63)
#define F_WAVE (__builtin_amdgcn_readfirstlane((int)threadIdx.x >> 6))

DEV void p0_mod_item(Frame& F, int item) {
    LAS float* st = (LAS float*)F.lds;
    LAS float* red = (LAS float*)(F.lds + 512 * 36 * 4);
    const float* c = F.in[I_C]; const float* cc = F.in[I_CCTX]; const float* wm = F.in[I_WMOD]; const float* bm = F.in[I_BMOD];
    float* mod = WSP(float, WS_MOD);
    const int col = F_TID & 31, kc = F_TID >> 5, j0 = item * 32;
    float acc[36];
#pragma unroll
    for (int n = 0; n < 36; ++n) acc[n] = 0.f;
    for (int half = 0; half < 2; ++half) {
        __syncthreads();
        { float cv_[33];
#pragma unroll
          for (int n = 0; n < 33; ++n) cv_[n] = (n < 32) ? c[n * DM + half * 512 + F_TID] : cc[half * 512 + F_TID];
#pragma unroll
          for (int n = 0; n < 33; ++n) st[F_TID * 36 + n] = siluf_(cv_[n]); }
        float wv[32];
#pragma unroll
        for (int i = 0; i < 32; ++i) wv[i] = wm[(size_t)(half * 512 + kc + 16 * i) * NMOD + j0 + col];
        __syncthreads();
#pragma unroll 2
        for (int i = 0; i < 32; ++i) { const int kk = kc + 16 * i; const float w = wv[i]; const LAS f32x4* sp = (const LAS f32x4*)(st + kk * 36);
#pragma unroll
            for (int q = 0; q < 9; ++q) { const f32x4 sv = sp[q]; acc[4 * q] += sv.x * w; acc[4 * q + 1] += sv.y * w; acc[4 * q + 2] += sv.z * w; acc[4 * q + 3] += sv.w * w; }
        }
    }
#pragma unroll
    for (int n = 0; n < 33; ++n) red[(kc * 33 + n) * 32 + col] = acc[n];
    __syncthreads();
    for (int idx = F_TID; idx < 33 * 32; idx += 512) { const int n = idx >> 5, cl = idx & 31; float s_ = bm[j0 + cl];
#pragma unroll
        for (int q = 0; q < 16; ++q) s_ += red[(q * 33 + n) * 32 + cl];
        mod[n * NMOD + j0 + cl] = s_; }
    __syncthreads();
}
DEV void p0_transpose_item(const float* W, int N, int k0, int n0, bf16_t* dst, int ldk, LAS float* scr, int lane) {
    float t_[32];
#pragma unroll
    for (int i = 0; i < 32; ++i) t_[i] = W[(size_t)(k0 + 2 * i + (lane >> 5)) * N + n0 + (lane & 31)];
#pragma unroll
    for (int i = 0; i < 32; ++i) scr[(2 * i + (lane >> 5)) * 33 + (lane & 31)] = t_[i];
    asm volatile("s_waitcnt lgkmcnt(0)" ::: "memory");
    const int cch = lane & 7;
#pragma unroll
    for (int j = 0; j < 4; ++j) { const int n = (lane >> 3) + 8 * j; const LAS float* s = scr + (8 * cch) * 33 + n;
        u32x4 o; o.x = cvt_pk_bf16(s[0 * 33], s[1 * 33]); o.y = cvt_pk_bf16(s[2 * 33], s[3 * 33]); o.z = cvt_pk_bf16(s[4 * 33], s[5 * 33]); o.w = cvt_pk_bf16(s[6 * 33], s[7 * 33]);
        *(u32x4*)(dst + (size_t)n * ldk + k0 + 8 * cch) = o; }
    asm volatile("s_waitcnt lgkmcnt(0)" ::: "memory");
}
DEV void p0_transpose_item_fp8(const float* W, int N, int k0, int n0, unsigned char* dst, int ldk, float scale, LAS float* scr, int lane) {
    float t_[32];
#pragma unroll
    for (int i = 0; i < 32; ++i) t_[i] = W[(size_t)(k0 + 2 * i + (lane >> 5)) * N + n0 + (lane & 31)];
#pragma unroll
    for (int i = 0; i < 32; ++i) scr[(2 * i + (lane >> 5)) * 33 + (lane & 31)] = t_[i] * scale;
    asm volatile("s_waitcnt lgkmcnt(0)" ::: "memory");
    const int cch = lane & 7;
#pragma unroll
    for (int j = 0; j < 4; ++j) { const int n = (lane >> 3) + 8 * j; const LAS float* s = scr + (8 * cch) * 33 + n;
        u32x2 o; o.x = pk4_fp8(s[0 * 33], s[1 * 33], s[2 * 33], s[3 * 33]); o.y = pk4_fp8(s[4 * 33], s[5 * 33], s[6 * 33], s[7 * 33]);
        *(u32x2*)(dst + (size_t)n * ldk + k0 + 8 * cch) = o; }
    asm volatile("s_waitcnt lgkmcnt(0)" ::: "memory");
}
DEV void p0_win_group_i8(const float* W, int n0, unsigned char* dst, float* cscale, LAS unsigned char* lds, int wave, int lane) {
    LAS float* scr = (LAS float*)(lds + wave * 8448); LAS float* mxs = (LAS float*)(lds + 8 * 8448);
    float t0[32], t1[32];
#pragma unroll
    for (int i = 0; i < 32; ++i) { t0[i] = W[(size_t)(wave * 128 + 2 * i + (lane >> 5)) * 2560 + n0 + (lane & 31)]; t1[i] = W[(size_t)(wave * 128 + 64 + 2 * i + (lane >> 5)) * 2560 + n0 + (lane & 31)]; }
    float mx = 0.f;
#pragma unroll
    for (int i = 0; i < 32; ++i) mx = fmaxf(mx, fmaxf(fabsf(t0[i]), fabsf(t1[i])));
    mx = fmaxf(mx, __shfl_xor(mx, 32));
    if (lane < 32) mxs[wave * 32 + lane] = mx;
    __syncthreads();
    mx = 0.f;
#pragma unroll
    for (int w = 0; w < 8; ++w) mx = fmaxf(mx, mxs[w * 32 + (lane & 31)]);
    const float sc = (mx > 0.f) ? mx * (1.0f / 127.0f) : 1.0f, inv = 1.0f / sc;
    if (wave == 0 && lane < 32) cscale[lane] = sc;
#pragma unroll
    for (int hb = 0; hb < 2; ++hb) {
#pragma unroll
        for (int i = 0; i < 32; ++i) scr[(2 * i + (lane >> 5)) * 33 + (lane & 31)] = (hb ? t1[i] : t0[i]) * inv;
        asm volatile("s_waitcnt lgkmcnt(0)" ::: "memory");
        const int cch = lane & 7;
#pragma unroll
        for (int j = 0; j < 4; ++j) { const int n = (lane >> 3) + 8 * j; const LAS float* s_ = scr + (8 * cch) * 33 + n; unsigned w0 = 0, w1 = 0;
#pragma unroll
            for (int q = 0; q < 4; ++q) { w0 |= ((unsigned)__float2int_rn(s_[q * 33]) & 0xffu) << (8 * q); w1 |= ((unsigned)__float2int_rn(s_[(4 + q) * 33]) & 0xffu) << (8 * q); }
            *(u32x2*)(dst + (size_t)n * 1024 + wave * 128 + hb * 64 + 8 * cch) = (u32x2){w0, w1}; }
        asm volatile("s_waitcnt lgkmcnt(0)" ::: "memory"); }
    __syncthreads();
}
DEV void sincos_rev(double rev, double& s, double& c) {
    const double fr = rev - __builtin_rint(rev);
    const double q = __builtin_rint(fr * 4.0);
    const double y = (fr - q * 0.25) * 6.283185307179586476925;
    const double y2 = y * y;
    const double sy = y * (1.0 + y2 * (-1.0 / 6 + y2 * (1.0 / 120 + y2 * (-1.0 / 5040 + y2 * (1.0 / 362880 + y2 * (-1.0 / 39916800 + y2 * (1.0 / 6227020800.0)))))));
    const double cy = 1.0 + y2 * (-0.5 + y2 * (1.0 / 24 + y2 * (-1.0 / 720 + y2 * (1.0 / 40320 + y2 * (-1.0 / 3628800 + y2 * (1.0 / 479001600.0 + y2 * (-1.0 / 87178291200.0)))))));
    const int qi = ((int)q) & 3;
    s = (qi == 0) ? sy : (qi == 1) ? cy : (qi == 2) ? -sy : -cy;
    c = (qi == 0) ? cy : (qi == 1) ? -sy : (qi == 2) ? -cy : sy;
}
DEV double exp_d(double x) {
    const double k = __builtin_rint(x * 1.4426950408889634074);
    const double r = x - k * 0.69314718055994530942;
    double p = 1.0 / 6227020800.0;
    p = p * r + 1.0 / 479001600.0; p = p * r + 1.0 / 39916800.0; p = p * r + 1.0 / 3628800.0; p = p * r + 1.0 / 362880.0; p = p * r + 1.0 / 40320.0; p = p * r + 1.0 / 5040.0;
    p = p * r + 1.0 / 720.0; p = p * r + 1.0 / 120.0; p = p * r + 1.0 / 24.0; p = p * r + 1.0 / 6.0; p = p * r + 0.5; p = p * r + 1.0; p = p * r + 1.0;
    const long long e = (long long)k + 1023;
    return p * __builtin_bit_cast(double, (unsigned long long)e << 52);
}
DEV void p0_phase(Frame& F) {
    if (!(F.flags & 2)) for (int it = F.bx; it < NMOD / 32; it += F.G) p0_mod_item(F, it);
    __syncthreads();
    if (!(F.flags & 4)) {
        const int fb = (F.G > NMOD / 32) ? NMOD / 32 : 0, nf = F.G - fb;
        if (F.bx >= fb) for (int grp = F.bx - fb; grp < 80; grp += nf) {
            const int n0 = grp * 32; int drow;
            if (n0 < 1024) drow = n0;
            else if (n0 < 1792) { const int j = n0 - 1024; drow = 1024 + (j >> 7) * 256 + (j & 127); }
            else { const int j = n0 - 1792; drow = 1024 + (j >> 7) * 256 + 128 + (j & 127); }
            p0_win_group_i8(F.in[I_WIN], n0, WSP(unsigned char, WS_WIN) + (size_t)drow * 1024, WSP(float, WS_CSCALE) + drow, F.lds, F_WAVE, F_LANE);
        }
    }
    if (!(F.flags & 4)) {
        LAS float* scr = (LAS float*)(F.lds + F_WAVE * 8448);
        bf16_t* Win = WSP(bf16_t, WS_WIN); bf16_t* Wout = WSP(bf16_t, WS_WOUT); bf16_t* Wglu = WSP(bf16_t, WS_WGLU); unsigned char* W13 = WSP(unsigned char, WS_W13); unsigned char* W2 = WSP(unsigned char, WS_W2);
        const int gw = F.vcu * 8 + F_WAVE, NGW = F.G * 8;
        constexpr int I_IN = 0, I_OUT = 16 * 32, I_GLU = 4 * 8, I_E = 16 * 256;
        for (int it = gw; it < I_IN + I_OUT + I_GLU + 3 * I_E; it += NGW) {
            int r = it;
            r -= I_IN;
            if (r < I_OUT) { const int kb = r / 32, nb = r % 32; p0_transpose_item(F.in[I_WOUT], 1024, kb * 64, nb * 32, Wout + (size_t)(nb * 32) * 1024, 1024, scr, F_LANE); continue; }
            r -= I_OUT;
            if (r < I_GLU) { const int kb = r / 8, nb = r % 8; p0_transpose_item(F.in[I_WGLU], 256, kb * 64, nb * 32, Wglu + (size_t)(nb * 32) * 256, 256, scr, F_LANE); continue; }
            r -= I_GLU;
            if (r < 2 * I_E) { const int which = r / I_E; const int rr = r % I_E; const int e = rr >> 8, rem = rr & 255, kb = rem >> 4, nb = rem & 15, n0 = nb * 32;
                const int drow = (n0 >> 7) * 256 + which * 128 + (n0 & 127);
                p0_transpose_item_fp8(F.in[which ? I_W3 : I_W1] + (size_t)e * 1024 * 512, 512, kb * 64, n0, W13 + ((size_t)e * 1024 + drow) * 1024, 1024, FP8_WSCALE, scr, F_LANE); continue; }
            r -= 2 * I_E;
            { const int e = r >> 8, rem = r & 255, kb = rem >> 5, nb = rem & 31;
                p0_transpose_item_fp8(F.in[I_W2] + (size_t)e * 512 * 1024, 1024, kb * 64, nb * 32, W2 + ((size_t)e * 1024 + nb * 32) * 512, 512, FP8_WSCALE, scr, F_LANE); }
        }
    }
    {
        bf16_t* Wr = WSP(bf16_t, WS_WR);
        for (int idx = F.bx * 512 + F_TID; idx < 32 * 1024; idx += F.G * 512) { const int l = idx >> 10, k = idx & 1023;
            const float v = (l < 4) ? F.in[I_RGW][k * 4 + l] : (l < 20) ? F.in[I_REW][k * 16 + (l - 4)] : 0.f;
            Wr[idx] = (bf16_t)(cvt_pk_bf16(v, 0.f) & 0xffffu); }
    }
    if (!(F.flags & 8)) {
        f32x2* APOW = WSP(f32x2, WS_APOW); f32x2* BBAR = WSP(f32x2, WS_BBAR);
        const int gt = F.bx * 512 + F_TID, NT = F.G * 512;
        for (int idx = gt; idx < 2 * 16 * 65 * 64; idx += NT) {
            const int p = idx & 63, j = (idx >> 6) % 65, dg = idx / (64 * 65);
            const double lre = F.in[I_LRE][dg * 64 + p], lim = F.in[I_LIM][dg * 64 + p], dt = exp_d((double)F.in[I_LOGDT][dg]);
            const double mag = exp_d(lre * dt * j); double s, c; sincos_rev(lim * dt * j * 0.15915494309189533577, s, c);
            APOW[idx] = (f32x2){(float)(mag * c), (float)(mag * s)};
        }
        for (int idx = gt; idx < 2 * 16 * 64 * 16; idx += NT) {
            const int dgp = idx >> 4, dg = dgp >> 6;
            const double lre = F.in[I_LRE][dgp], lim = F.in[I_LIM][dgp], dt = exp_d((double)F.in[I_LOGDT][dg]);
            const double mag = exp_d(lre * dt); double s, c; sincos_rev(lim * dt * 0.15915494309189533577, s, c);
            const double nr = mag * c - 1.0, ni = mag * s, d2 = lre * lre + lim * lim;
            const double qr = (nr * lre + ni * lim) / d2, qi = (ni * lre - nr * lim) / d2;
            const double br = F.in[I_BRE][idx], bi = F.in[I_BIM][idx];
            BBAR[idx] = (f32x2){(float)(qr * br - qi * bi), (float)(qr * bi + qi * br)};
        }
    }
}

constexpr int LZ_WAVE = 16384;
DEV void lz_issue(const void* g, LAS unsigned char* lz, int piece) { __builtin_amdgcn_global_load_lds((const unsigned*)g, (LAS unsigned*)(lz + piece * 1024), 16, 0, 0); }
#define LZ_WAIT(n) asm volatile("s_waitcnt vmcnt(" #n ")" ::: "memory")

DEV void p1_norm_rows(Frame& F) {
    const float* mod = WSP(float, WS_MOD); bf16_t* HX = WSP(bf16_t, WS_HX); const float* g = F.in[I_N1G];
    const bool isctx = F.bx < 32;
    const int nlw = (F.G - 32) * 8, w = (F.bx - 32) * 8 + F_WAVE, rpw = (TOK + nlw - 1) / nlw;
    const int rbeg = isctx ? (TOK + F.bx * 256 + F_WAVE * 32) : (w * rpw < TOK ? w * rpw : TOK), rend = isctx ? rbeg + 32 : ((w + 1) * rpw < TOK ? (w + 1) * rpw : TOK);
    const int nb = (rend - rbeg + 1) >> 1;
    LAS unsigned char* lz = F.lds + F_WAVE * LZ_WAVE;
#define P1_ROW0(b) (rbeg + 2 * (b))
#define P1_ISSUE(b) do { const int r0_ = P1_ROW0(b); _Pragma("unroll") for (int r = 0; r < 2; ++r) { const int m_ = (r0_ + r < rend) ? r0_ + r : rend - 1; \
        const float* xp_ = ((m_ < TOK) ? F.in[I_X] + (size_t)m_ * DM : F.in[I_CTX] + (size_t)(m_ - TOK) * DM) + 4 * F_LANE; \
        _Pragma("unroll") for (int j = 0; j < 4; ++j) lz_issue(xp_ + 256 * j, lz, ((b) & 1) * 8 + r * 4 + j); } } while (0)
    int ncur = -1; f32x4 gs[4], sh[4];
    if (nb > 0) P1_ISSUE(0);
    if (nb > 1) P1_ISSUE(1);
#pragma unroll 1
    for (int b = 0; b < nb; ++b) {
        if (b + 1 < nb) LZ_WAIT(8); else LZ_WAIT(0);
        f32x4 cur[2][4];
#pragma unroll
        for (int r = 0; r < 2; ++r)
#pragma unroll
            for (int j = 0; j < 4; ++j) cur[r][j] = *(const LAS f32x4*)(lz + ((b & 1) * 8 + r * 4 + j) * 1024 + F_LANE * 16);
        float ss[2];
#pragma unroll
        for (int r = 0; r < 2; ++r) { float a = 0.f;
#pragma unroll
            for (int j = 0; j < 4; ++j) a += (cur[r][j].x * cur[r][j].x + cur[r][j].y * cur[r][j].y) + (cur[r][j].z * cur[r][j].z + cur[r][j].w * cur[r][j].w);
            ss[r] = a; }
#pragma unroll
        for (int o = 1; o < 64; o <<= 1) { ss[0] += __shfl_xor(ss[0], o); ss[1] += __shfl_xor(ss[1], o); }
        const int r0 = P1_ROW0(b);
#pragma unroll
        for (int r = 0; r < 2; ++r) {
            const int m = (r0 + r < rend) ? r0 + r : rend - 1; const int n = (m < TOK) ? (m >> 11) : 32;
            if (n != ncur) { ncur = n;
#pragma unroll
                for (int j = 0; j < 4; ++j) { gs[j] = ((const f32x4*)g)[F_LANE + 64 * j] * (1.0f + ((const f32x4*)(mod + n * NMOD + DM))[F_LANE + 64 * j]); sh[j] = ((const f32x4*)(mod + n * NMOD))[F_LANE + 64 * j]; } }
            const float rs = 1.0f / sqrtf(ss[r] * (1.f / DM) + RMS_EPS);
            f32x4 y[4]; float mx = 0.f;
#pragma unroll
            for (int j = 0; j < 4; ++j) { y[j] = (cur[r][j] * rs) * gs[j] + sh[j]; mx = fmaxf(fmaxf(mx, fmaxf(fabsf(y[j].x), fabsf(y[j].y))), fmaxf(fabsf(y[j].z), fabsf(y[j].w))); }
#pragma unroll
            for (int o = 1; o < 64; o <<= 1) mx = fmaxf(mx, __shfl_xor(mx, o));
            const float qs = (mx > 0.f) ? mx * (1.0f / 127.0f) : 1.0f, qi = 1.0f / qs;
            if (F_LANE == 0) WSP(float, WS_RSCALE)[m] = qs;
            unsigned* o4 = (unsigned*)((unsigned char*)HX + (size_t)m * DM) + F_LANE;
#pragma unroll
            for (int j = 0; j < 4; ++j) o4[64 * j] = ((unsigned)__float2int_rn(y[j].x * qi) & 0xffu) | (((unsigned)__float2int_rn(y[j].y * qi) & 0xffu) << 8) | (((unsigned)__float2int_rn(y[j].z * qi) & 0xffu) << 16) | (((unsigned)__float2int_rn(y[j].w * qi) & 0xffu) << 24);
        }
        if (b + 2 < nb) P1_ISSUE(b + 2);
    }
#undef P1_ISSUE
#undef P1_ROW0
}
DEV void p1_ktab(Frame& F, int b0, int nblk) {
    const int gt = (F.bx - b0) * 512 + F_TID, NT = nblk * 512;
    const f32x2* APOW = WSP(f32x2, WS_APOW); const f32x2* BBAR = WSP(f32x2, WS_BBAR);
    float* KT = WSP(float, WS_KTAB);
    for (int idx = gt; idx < 2 * 16 * LC * 16 * 4; idx += NT) {
        const int pq = idx & 3, h = (idx >> 2) & 15, j = (idx >> 6) % LC, dg = idx / (64 * LC);
        float sacc[16];
#pragma unroll
        for (int q = 0; q < 16; ++q) sacc[q] = 0.f;
#pragma unroll 1
        for (int t4 = 0; t4 < 4; ++t4) { const int p4 = pq * 16 + t4 * 4;
            const f32x4 cr4 = *(const f32x4*)(F.in[I_CRE] + (dg * 16 + h) * 64 + p4), ci4 = *(const f32x4*)(F.in[I_CIM] + (dg * 16 + h) * 64 + p4);
            const f32x4 a01 = *(const f32x4*)(APOW + (dg * 65 + j) * 64 + p4), a23 = *(const f32x4*)(APOW + (dg * 65 + j) * 64 + p4 + 2);
            f32x4 bv[4][8];
#pragma unroll
            for (int u = 0; u < 4; ++u)
#pragma unroll
                for (int q = 0; q < 8; ++q) bv[u][q] = ((const f32x4*)(BBAR + (dg * 64 + p4 + u) * 16))[q];
#pragma unroll
            for (int u = 0; u < 4; ++u) { const float cr = cr4[u], ci = ci4[u]; const float ax = (u < 2) ? a01[2 * u] : a23[2 * (u - 2)], ay = (u < 2) ? a01[2 * u + 1] : a23[2 * (u - 2) + 1];
                const float ur = cr * ax - ci * ay, ui = cr * ay + ci * ax;
#pragma unroll
                for (int q = 0; q < 8; ++q) { sacc[2 * q] += ur * bv[u][q].x - ui * bv[u][q].y; sacc[2 * q + 1] += ur * bv[u][q].z - ui * bv[u][q].w; } }
        }
#pragma unroll
        for (int q = 0; q < 16; ++q) { sacc[q] += __shfl_xor(sacc[q], 1); sacc[q] += __shfl_xor(sacc[q], 2); }
        f32x4 o;
#pragma unroll
        for (int r = 0; r < 4; ++r) o[r] = (pq == 0) ? sacc[r] : (pq == 1) ? sacc[4 + r] : (pq == 2) ? sacc[8 + r] : sacc[12 + r];
        *((f32x4*)(KT + ((dg * 64 + j) * 256 + h * 16)) + pq) = o;
    }
}
DEV void p1_tables(Frame& F, int b0, int nblk) {
    const float* mod = WSP(float, WS_MOD);
    const int gw = (F.bx - b0) * 8 + F_WAVE, NGW = nblk * 8;
    const int gt = (F.bx - b0) * 512 + F_TID, NT = nblk * 512;
    const f32x2* APOW = WSP(f32x2, WS_APOW); const f32x2* BBAR = WSP(f32x2, WS_BBAR);
    {
        bf16_t* WE = WSP(bf16_t, WS_WE);
        constexpr int K8 = UK / 8, NWE = 16 * 256 * K8;
        for (int idx0 = gt; idx0 < NWE; idx0 += 6 * NT) {
            f32x2 a[6]; f32x4 bq[6][4];
#pragma unroll
            for (int u = 0; u < 6; ++u) { const int idx = (idx0 + u * NT < NWE) ? idx0 + u * NT : idx0;
                const int k8 = idx % K8, n = (idx / K8) & 255, g = idx / (K8 * 256), part = n >> 6, p = n & 63, dir = part >> 1, k = k8 >> 1, h0 = (k8 & 1) * 8, dg = dir * 16 + g;
                a[u] = APOW[(dg * 65 + (dir ? k : LC - 1 - k)) * 64 + p];
                const f32x4* bp = (const f32x4*)(BBAR + (dg * 64 + p) * 16 + h0);
#pragma unroll
                for (int q = 0; q < 4; ++q) bq[u][q] = bp[q]; }
#pragma unroll
            for (int u = 0; u < 6; ++u) { const int idx = idx0 + u * NT; if (idx < NWE) {
                const int k8 = idx % K8, n = (idx / K8) & 255, g = idx / (K8 * 256), part = n >> 6;
                float v[8];
#pragma unroll
                for (int q = 0; q < 4; ++q) { const f32x4 b = bq[u][q];
                    v[2 * q] = (part & 1) ? (a[u].x * b.y + a[u].y * b.x) : (a[u].x * b.x - a[u].y * b.y); v[2 * q + 1] = (part & 1) ? (a[u].x * b.w + a[u].y * b.z) : (a[u].x * b.z - a[u].y * b.w); }
                u32x4 o; o.x = cvt_pk_bf16(v[0], v[1]); o.y = cvt_pk_bf16(v[2], v[3]); o.z = cvt_pk_bf16(v[4], v[5]); o.w = cvt_pk_bf16(v[6], v[7]);
                *(u32x4*)(WE + ((size_t)(g * 256 + n) * UK + k8 * 8)) = o; } }
        }
    }
    {
        unsigned* SH2 = WSP(unsigned, WS_SH2);
        for (int idx0 = gt; idx0 < 256 * 256; idx0 += 4 * NT) {
            f32x4 mv[4];
#pragma unroll
            for (int u = 0; u < 4; ++u) { const int idx = (idx0 + u * NT < 256 * 256) ? idx0 + u * NT : idx0; const int r = idx >> 8, k = (idx & 255) * 4;
                mv[u] = *(const f32x4*)(mod + (r < 32 ? r : 0) * NMOD + 3 * DM + k); }
#pragma unroll
            for (int u = 0; u < 4; ++u) { const int idx = idx0 + u * NT; if (idx < 256 * 256) SH2[idx] = ((idx >> 8) < 32) ? pk4_fp8(mv[u][0], mv[u][1], mv[u][2], mv[u][3]) : 0u; }
        }
    }
    {
        float* rb = WSP(float, WS_RB);
        for (int idx = gw; idx < 32 * 20; idx += NGW) { const int b = idx / 20, l = idx % 20;
            float mv[16], wv[16];
#pragma unroll
            for (int i = 0; i < 16; ++i) { const int k = F_LANE + 64 * i; mv[i] = mod[b * NMOD + 3 * DM + k]; wv[i] = (l < 4) ? F.in[I_RGW][k * 4 + l] : F.in[I_REW][k * 16 + (l - 4)]; }
            float s = 0.f;
#pragma unroll
            for (int i = 0; i < 16; ++i) s += mv[i] * wv[i];
            s = wave_sum(s) + ((l < 4) ? F.in[I_RGB][l] : F.in[I_REB][l - 4]);
            if (F_LANE == 0) rb[b * 32 + l] = s;
            if (l == 19 && F_LANE >= 1 && F_LANE <= 12) rb[b * 32 + 19 + F_LANE] = 0.f; }
    }
}

DEV void p2_fill_tr(Frame& F, int b0, int nblk) {
    const float* KT = WSP(float, WS_KTAB); const f32x2* APOW = WSP(f32x2, WS_APOW); bf16_t* TR = WSP(bf16_t, WS_TR);
    const int gt = (F.bx - b0) * 512 + F_TID, NT = nblk * 512;
    constexpr int K8 = UK / 8, NT1 = 16 * TRN * K8;
    for (int idx0 = gt; idx0 < NT1; idx0 += 4 * NT) {
        f32x4 fa[4][2], fb[4][2];
#pragma unroll
        for (int u = 0; u < 4; ++u) { const int idx = (idx0 + u * NT < NT1) ? idx0 + u * NT : idx0;
            const int k8 = idx % K8, n = (idx / K8) % TRN, g = idx / (K8 * TRN), t = n >> 4, h = n & 15, k = k8 >> 1, h0 = (k8 & 1) * 8;
            const f32x4* pa_ = (const f32x4*)(KT + (((0 * 16 + g) * 64 + (t > k ? t - k : 0)) * 256 + h * 16 + h0));
            const f32x4* pb_ = (const f32x4*)(KT + (((1 * 16 + g) * 64 + (k > t ? k - t : 0)) * 256 + h * 16 + h0));
            fa[u][0] = pa_[0]; fa[u][1] = pa_[1]; fb[u][0] = pb_[0]; fb[u][1] = pb_[1]; }
#pragma unroll
        for (int u = 0; u < 4; ++u) { const int idx = idx0 + u * NT; if (idx < NT1) {
            const int k8 = idx % K8, n = (idx / K8) % TRN, g = idx / (K8 * TRN), t = n >> 4, h = n & 15, k = k8 >> 1, h0 = (k8 & 1) * 8;
            const float wa = (t >= k) ? 1.f : 0.f, wb = (k >= t) ? 1.f : 0.f, dd = (t == k) ? F.in[I_S5D][g * 16 + h] : 0.f;
            float v[8];
#pragma unroll
            for (int q = 0; q < 8; ++q) v[q] = wa * fa[u][q >> 2][q & 3] + wb * fb[u][q >> 2][q & 3] + ((h0 + q == h) ? dd : 0.f);
            u32x4 o; o.x = cvt_pk_bf16(v[0], v[1]); o.y = cvt_pk_bf16(v[2], v[3]); o.z = cvt_pk_bf16(v[4], v[5]); o.w = cvt_pk_bf16(v[6], v[7]);
            *(u32x4*)(TR + ((size_t)(g * TRN + n) * UGK + k8 * 8)) = o; } }
    }
    constexpr int NT2 = 16 * TRN * 32;
    for (int idx0 = gt; idx0 < NT2; idx0 += 4 * NT) {
        f32x4 cr_[4][2], ci_[4][2], ap_[4][4];
#pragma unroll
        for (int u = 0; u < 4; ++u) { const int idx = (idx0 + u * NT < NT2) ? idx0 + u * NT : idx0;
            const int k8 = idx & 31, n = (idx >> 5) % TRN, g = idx / (32 * TRN), t = n >> 4, h = n & 15, s0 = k8 * 8, part = s0 >> 6, p0 = s0 & 63, dir = part >> 1, dg = dir * 16 + g, j = dir ? (LC - t) : (t + 1);
            const f32x4* pc = (const f32x4*)(F.in[I_CRE] + (dg * 16 + h) * 64 + p0); const f32x4* pi = (const f32x4*)(F.in[I_CIM] + (dg * 16 + h) * 64 + p0); const f32x4* pw = (const f32x4*)(APOW + (dg * 65 + j) * 64 + p0);
            cr_[u][0] = pc[0]; cr_[u][1] = pc[1]; ci_[u][0] = pi[0]; ci_[u][1] = pi[1];
#pragma unroll
            for (int q = 0; q < 4; ++q) ap_[u][q] = pw[q]; }
#pragma unroll
        for (int u = 0; u < 4; ++u) { const int idx = idx0 + u * NT; if (idx < NT2) {
            const int k8 = idx & 31, n = (idx >> 5) % TRN, g = idx / (32 * TRN), part = (k8 * 8) >> 6;
            float v[8];
#pragma unroll
            for (int q = 0; q < 8; ++q) { const float cr = cr_[u][q >> 2][q & 3], ci = ci_[u][q >> 2][q & 3]; const float ax = ap_[u][q >> 1][(q & 1) * 2], ay = ap_[u][q >> 1][(q & 1) * 2 + 1];
                v[q] = (part & 1) ? -(cr * ay + ci * ax) : (cr * ax - ci * ay); }
            u32x4 o; o.x = cvt_pk_bf16(v[0], v[1]); o.y = cvt_pk_bf16(v[2], v[3]); o.z = cvt_pk_bf16(v[4], v[5]); o.w = cvt_pk_bf16(v[6], v[7]);
            *(u32x4*)(TR + ((size_t)(g * TRN + n) * UGK + UK + k8 * 8)) = o; } }
    }
}
struct SchedIn {
    static constexpr bool GATHER = false, AUX = true, FP8 = false, I8 = true;
    int nt; unsigned lda, ldb; int G, c; const char* HX; const char* W; int lo, hi; const char* rscale; const char* cscale;
    DEV bool next(int i, Unit& u) const {
        const int L = lo + i * G + c; if (L >= hi) return false;
        int pm, pn, ctx = 0;
        if (L < 2560) pg8::static_tile(L, 256, 10, pm, pn); else { pm = 256 + (L - 2560); pn = 0; ctx = 1; }
        u.A0 = HX + (size_t)pm * 256 * 1024; u.A1 = u.A0; u.B0 = W + (size_t)pn * 256 * 1024; u.B1 = u.B0; u.ksA = 1 << 20; u.ksB = 1 << 20;
        u.p0 = pm; u.p1 = pn; u.p2 = ctx; u.p3 = 0; return true;
    }
    DEV void rows(const Unit&, int, unsigned*) const {}
    DEV void aux(const Unit& u, const Unit&, LAS unsigned char* l, int wid, int lane) const {
        if (wid == 0) glds16(rscale + (size_t)u.p0 * 1024 + lane * 16, l + AUX_SLOT_OFF);
        if (wid == 1) glds16(cscale + (size_t)u.p1 * 1024 + lane * 16, l + AUX_SLOT_OFF + 1024);
    }
};
struct EpiIn {
    static constexpr bool PERM = true;
    bf16_t* UG; bf16_t* BG; bf16_t* CV; LAS unsigned char* lds;
    DEV void operator()(const f32x4 (&acci)[2][2][4][2], const Unit& u, int wr, int wc, int fr, int fq) const {
        const int pm = u.p0, pn = u.p1;
        f32x4 cs[2][2];
#pragma unroll
        for (int bj = 0; bj < 2; ++bj)
#pragma unroll
            for (int n = 0; n < 2; ++n) cs[bj][n] = *(const LAS f32x4*)(lds + AUX_SLOT_OFF + 1024 + (bj * 128 + wc * 32 + 8 * fq + 4 * n) * 4);
#pragma unroll
        for (int ai = 0; ai < 2; ++ai)
#pragma unroll
            for (int m = 0; m < 4; ++m) {
                const int r = ai * 128 + wr * 64 + m * 16 + fr;
                const float rs = *(const LAS float*)(lds + AUX_SLOT_OFF + r * 4);
                f32x4 a[2][2];
#pragma unroll
                for (int bj = 0; bj < 2; ++bj)
#pragma unroll
                    for (int n = 0; n < 2; ++n) { const v4i_t iv = __builtin_bit_cast(v4i_t, acci[ai][bj][m][n]); a[bj][n] = (f32x4){(float)iv[0], (float)iv[1], (float)iv[2], (float)iv[3]} * (cs[bj][n] * rs); }
                if (pn == 0) {
                    const int mm = pm * 256 + r;
                    const int chunk = mm / LC, k = mm % LC;
#pragma unroll
                    for (int bj = 0; bj < 2; ++bj) { const int c = bj * 128 + wc * 32 + 8 * fq, g = c >> 4, h0 = c & 15;
                        const f32x4 v0 = a[bj][0], v1 = a[bj][1];
                        u32x4 w; w.x = cvt_pk_bf16(v0[0], v0[1]); w.y = cvt_pk_bf16(v0[2], v0[3]); w.z = cvt_pk_bf16(v1[0], v1[1]); w.w = cvt_pk_bf16(v1[2], v1[3]);
                        *(u32x4*)(UG + ((size_t)(g * NCH_PAD + chunk) * UGK + k * 16 + h0)) = w; }
                } else if (pn < 4) {
                    bf16_t* rowp = BG + (size_t)(pm * 256 + r) * CONVW + (pn - 1) * 256 + wc * 32 + 8 * fq;
#pragma unroll
                    for (int bj = 0; bj < 2; ++bj) { const f32x4 v0 = a[bj][0], v1 = a[bj][1];
                        u32x4 w; w.x = cvt_pk_bf16(v0[0], v0[1]); w.y = cvt_pk_bf16(v0[2], v0[3]); w.z = cvt_pk_bf16(v1[0], v1[1]); w.w = cvt_pk_bf16(v1[2], v1[3]);
                        *(u32x4*)(rowp + bj * 128) = w; }
                } else {
                    const f32x4 v0 = a[0][0] * a[1][0], v1 = a[0][1] * a[1][1];
                    u32x4 w; w.x = cvt_pk_bf16(v0[0], v0[1]); w.y = cvt_pk_bf16(v0[2], v0[3]); w.z = cvt_pk_bf16(v1[0], v1[1]); w.w = cvt_pk_bf16(v1[2], v1[3]);
                    *(u32x4*)(CV + (size_t)(pm * 256 + r) * CONVW + (pn - 4) * 128 + wc * 32 + 8 * fq) = w;
                }
            }
    }
};

struct SchedE {
    static constexpr bool GATHER = false, AUX = false, FP8 = false, I8 = false;
    int nt; unsigned lda, ldb; int c; const char* UG; const char* WE;
    DEV bool next(int i, Unit& u) const {
        if (i > 0 || c >= 16 * (NCH_PAD / 256)) return false;
        const int g = c / (NCH_PAD / 256), pm = c % (NCH_PAD / 256);
        u.A0 = UG + ((size_t)g * NCH_PAD + pm * 256) * UGK * 2; u.A1 = u.A0; u.B0 = WE + (size_t)g * 256 * UK * 2; u.B1 = u.B0; u.ksA = 1 << 20; u.ksB = 1 << 20;
        u.p0 = pm; u.p1 = g; u.p2 = 0; u.p3 = 0; return true;
    }
    DEV void rows(const Unit&, int, unsigned*) const {}
    DEV void aux(const Unit&, const Unit&, LAS unsigned char*, int, int) const {}
};
struct EpiE {
    static constexpr bool PERM = false;
    float* E;
    DEV void operator()(const f32x4 (&acc)[2][2][4][2], const Unit& u, int wr, int wc, int fr, int fq) const {
        float* base = E + ((size_t)u.p1 * NCH_PAD + u.p0 * 256) * 256;
#pragma unroll
        for (int ai = 0; ai < 2; ++ai)
#pragma unroll
            for (int m = 0; m < 4; ++m) { float* rowp = base + (size_t)(ai * 128 + wr * 64 + m * 16 + fr) * 256 + wc * 32 + 4 * fq;
#pragma unroll
                for (int bj = 0; bj < 2; ++bj)
#pragma unroll
                    for (int n = 0; n < 2; ++n) *(f32x4*)(rowp + bj * 128 + n * 16) = acc[ai][bj][m][n]; }
    }
};
struct SchedSB {
    static constexpr bool GATHER = false, AUX = false, FP8 = true, I8 = false;
    int nt; unsigned lda, ldb; int c; const char* SH2; const char* W13;
    DEV bool next(int i, Unit& u) const {
        if (i > 0 || c < 0 || c >= 64) return false;
        const int e = c >> 2, ti = c & 3;
        u.A0 = SH2; u.A1 = u.A0; u.B0 = W13 + ((size_t)e * 1024 + ti * 256) * 1024; u.B1 = u.B0; u.ksA = 1 << 20; u.ksB = 1 << 20;
        u.p0 = e; u.p1 = ti; u.p2 = 0; u.p3 = 0; return true;
    }
    DEV void rows(const Unit&, int, unsigned*) const {}
    DEV void aux(const Unit&, const Unit&, LAS unsigned char*, int, int) const {}
};
struct EpiSB {
    static constexpr bool PERM = true;
    bf16_t* SB;
    DEV void operator()(const f32x4 (&acc)[2][2][4][2], const Unit& u, int wr, int wc, int fr, int fq) const {
        if (wr != 0) return;
#pragma unroll
        for (int m = 0; m < 2; ++m) { const int b = m * 16 + fr; bf16_t* rowp = SB + ((size_t)(b * 16 + u.p0) * 1024 + u.p1 * 256 + wc * 32 + 8 * fq);
#pragma unroll
            for (int bj = 0; bj < 2; ++bj) { const f32x4 v0 = acc[0][bj][m][0] * (1.0f / FP8_WSCALE), v1 = acc[0][bj][m][1] * (1.0f / FP8_WSCALE);
                u32x4 w; w.x = cvt_pk_bf16(v0[0], v0[1]); w.y = cvt_pk_bf16(v0[2], v0[3]); w.z = cvt_pk_bf16(v1[0], v1[1]); w.w = cvt_pk_bf16(v1[2], v1[3]);
                *(u32x4*)(rowp + bj * 128) = w; } }
    }
};

DEV void p4_phase(Frame& F, int nblk) {
    const int gt = F.bx * 512 + F_TID, NT = nblk * 512;
    const float* E = WSP(float, WS_E); const f32x2* APOW = WSP(f32x2, WS_APOW); bf16_t* UG = WSP(bf16_t, WS_UG);
    constexpr int CC = CTXL / LC, CL = SEQ / LC;
    for (int idx = gt; idx < NB * NG * 128; idx += NT) {
        const int p = idx & 63, dir = (idx >> 6) & 1, g = (idx >> 7) & 15, b = idx >> 11;
        const f32x2 a = APOW[((dir * 16 + g) * 65 + LC) * 64 + p];
        const float* Eg = E + (size_t)g * NCH_PAD * 256 + dir * 128 + p;
        bf16_t* Ug = UG + (size_t)g * NCH_PAD * UGK + UK + dir * 128 + p;
        float sr = 0.f, si = 0.f;
        {   float er[CC], ei[CC];
#pragma unroll
            for (int c = 0; c < CC; ++c) { const int ch = NCH_LAT + b * CC + (dir ? CC - 1 - c : c); er[c] = Eg[(size_t)ch * 256]; ei[c] = Eg[(size_t)ch * 256 + 64]; }
#pragma unroll
            for (int c = 0; c < CC; ++c) { const float nr = a.x * sr - a.y * si + er[c], ni = a.x * si + a.y * sr + ei[c]; sr = nr; si = ni; } }
#pragma unroll 1
        for (int c0 = 0; c0 < CL; c0 += 32) {
            float er[32], ei[32];
#pragma unroll
            for (int c = 0; c < 32; ++c) { const int ch = b * CL + (dir ? CL - 1 - (c0 + c) : c0 + c); er[c] = Eg[(size_t)ch * 256]; ei[c] = Eg[(size_t)ch * 256 + 64]; }
#pragma unroll
            for (int c = 0; c < 32; ++c) { const int ch = b * CL + (dir ? CL - 1 - (c0 + c) : c0 + c);
                Ug[(size_t)ch * UGK] = (bf16_t)(cvt_pk_bf16(sr, 0.f) & 0xffffu); Ug[(size_t)ch * UGK + 64] = (bf16_t)(cvt_pk_bf16(si, 0.f) & 0xffffu);
                const float nr = a.x * sr - a.y * si + er[c], ni = a.x * si + a.y * sr + ei[c]; sr = nr; si = ni; }
        }
    }
}
DEV void conv_items(Frame& F, int vt, int NVT) {
    const bf16_t* BG = WSP(bf16_t, WS_BG); const bf16_t* CV = WSP(bf16_t, WS_CV); bf16_t* YM = WSP(bf16_t, WS_YMIX); const float* cw = F.in[I_CONVW];
    LAS unsigned char* lz = F.lds + F_WAVE * LZ_WAVE;
    constexpr int NIT = TOK * 96;
    const int nb = (vt < NIT) ? ((NIT - vt + 2 * NVT - 1) / (2 * NVT)) : 0;
    const int jc = (vt % 96) * 8;
    const f32x4 w0a = *(const f32x4*)(cw + jc), w0b = *(const f32x4*)(cw + jc + 4), w1a = *(const f32x4*)(cw + CONVW + jc), w1b = *(const f32x4*)(cw + CONVW + jc + 4), w2a = *(const f32x4*)(cw + 2 * CONVW + jc), w2b = *(const f32x4*)(cw + 2 * CONVW + jc + 4);
#define CV_ISSUE(b) do { _Pragma("unroll") for (int q = 0; q < 2; ++q) { const int idx_ = vt + (2 * (b) + q) * NVT; const bool ok_ = idx_ < NIT; const int j0_ = (idx_ % 96) * 8, m_ = ok_ ? idx_ / 96 : 0; \
        const bool rowp_ = j0_ < 384; const int d_ = rowp_ ? 1 : 64; \
        const bool hasl_ = ok_ && (rowp_ ? ((m_ & 63) > 0) : (((m_ >> 6) & 31) > 0)), hasr_ = ok_ && (rowp_ ? ((m_ & 63) < 63) : (((m_ >> 6) & 31) < 31)); \
        const size_t o_ = (size_t)m_ * CONVW + j0_; \
        lz_issue(CV + (hasl_ ? o_ - (size_t)d_ * CONVW : o_), lz, ((b) & 1) * 8 + q * 4 + 0); lz_issue(CV + o_, lz, ((b) & 1) * 8 + q * 4 + 1); \
        lz_issue(CV + (hasr_ ? o_ + (size_t)d_ * CONVW : o_), lz, ((b) & 1) * 8 + q * 4 + 2); lz_issue(BG + o_, lz, ((b) & 1) * 8 + q * 4 + 3); } } while (0)
    asm volatile("s_waitcnt lgkmcnt(0)" ::: "memory");
    if (nb > 0) CV_ISSUE(0);
    if (nb > 1) CV_ISSUE(1);
#pragma unroll 1
    for (int b = 0; b < nb; ++b) {
        if (b + 1 < nb) LZ_WAIT(8); else LZ_WAIT(0);
#pragma unroll
        for (int q = 0; q < 2; ++q) { const int idx = vt + (2 * b + q) * NVT; const bool ok = idx < NIT; const int j0 = (idx % 96) * 8, m = ok ? idx / 96 : 0;
            const bool rowp = j0 < 384;
            const bool hasl = rowp ? ((m & 63) > 0) : (((m >> 6) & 31) > 0), hasr = rowp ? ((m & 63) < 63) : (((m >> 6) & 31) < 31);
            const LAS unsigned char* zp = lz + ((b & 1) * 8 + q * 4) * 1024 + F_LANE * 16;
            const u32x4 z = (u32x4){0u, 0u, 0u, 0u};
            u32x4 c0 = *(const LAS u32x4*)zp; const u32x4 c1 = *(const LAS u32x4*)(zp + 1024); u32x4 c2 = *(const LAS u32x4*)(zp + 2048); const u32x4 bb = *(const LAS u32x4*)(zp + 3072);
            c0 = hasl ? c0 : z; c2 = hasr ? c2 : z;
            float o[8];
            o[0] = bflo(bb.x) * (bflo(c0.x) * w0a[0] + bflo(c1.x) * w1a[0] + bflo(c2.x) * w2a[0]); o[1] = bfhi(bb.x) * (bfhi(c0.x) * w0a[1] + bfhi(c1.x) * w1a[1] + bfhi(c2.x) * w2a[1]);
            o[2] = bflo(bb.y) * (bflo(c0.y) * w0a[2] + bflo(c1.y) * w1a[2] + bflo(c2.y) * w2a[2]); o[3] = bfhi(bb.y) * (bfhi(c0.y) * w0a[3] + bfhi(c1.y) * w1a[3] + bfhi(c2.y) * w2a[3]);
            o[4] = bflo(bb.z) * (bflo(c0.z) * w0b[0] + bflo(c1.z) * w1b[0] + bflo(c2.z) * w2b[0]); o[5] = bfhi(bb.z) * (bfhi(c0.z) * w0b[1] + bfhi(c1.z) * w1b[1] + bfhi(c2.z) * w2b[1]);
            o[6] = bflo(bb.w) * (bflo(c0.w) * w0b[2] + bflo(c1.w) * w1b[2] + bflo(c2.w) * w2b[2]); o[7] = bfhi(bb.w) * (bfhi(c0.w) * w0b[3] + bfhi(c1.w) * w1b[3] + bfhi(c2.w) * w2b[3]);
            u32x4 w; w.x = cvt_pk_bf16(o[0], o[1]); w.y = cvt_pk_bf16(o[2], o[3]); w.z = cvt_pk_bf16(o[4], o[5]); w.w = cvt_pk_bf16(o[6], o[7]);
            if (ok) *(u32x4*)(YM + (size_t)m * DM + 256 + j0) = w; }
        if (b + 2 < nb) CV_ISSUE(b + 2);
    }
#undef CV_ISSUE
}

struct SchedY {
    static constexpr bool GATHER = false, AUX = false, FP8 = false, I8 = false;
    int nt; unsigned lda, ldb; int c; const char* UG; const char* TR;
    DEV bool next(int i, Unit& u) const {
        if (i > 0 || c >= 256) return false;
        const int x = c & 7, k = c >> 3;
        constexpr int NPM = NCH_LAT / 256, NPN = TRN / 256;
        static_assert(NPM * NPN == 16, "16 units per group");
        const int g = 2 * x + (k >> 4), pm = (k & 15) / NPN, pn = (k & 15) % NPN;
        u.A0 = UG + ((size_t)g * NCH_PAD + pm * 256) * UGK * 2; u.A1 = u.A0; u.B0 = TR + ((size_t)g * TRN + pn * 256) * UGK * 2; u.B1 = u.B0; u.ksA = 1 << 20; u.ksB = 1 << 20;
        u.p0 = pm; u.p1 = pn; u.p2 = g; u.p3 = 0; return true;
    }
    DEV void rows(const Unit&, int, unsigned*) const {}
    DEV void aux(const Unit&, const Unit&, LAS unsigned char*, int, int) const {}
};
struct EpiY {
    static constexpr bool PERM = true;
    bf16_t* Gb;
    DEV void operator()(const f32x4 (&acc)[2][2][4][2], const Unit& u, int wr, int wc, int fr, int fq) const {
#pragma unroll
        for (int ai = 0; ai < 2; ++ai)
#pragma unroll
            for (int m = 0; m < 4; ++m) { const int chunk = u.p0 * 256 + ai * 128 + wr * 64 + m * 16 + fr;
#pragma unroll
                for (int bj = 0; bj < 2; ++bj) { const int n = u.p1 * 256 + bj * 128 + wc * 32 + 8 * fq, t = n >> 4, h0 = n & 15;
                    const f32x4 v0 = acc[ai][bj][m][0], v1 = acc[ai][bj][m][1];
                    u32x4 w; w.x = cvt_pk_bf16(gelu_tanh(v0[0]), gelu_tanh(v0[1])); w.y = cvt_pk_bf16(gelu_tanh(v0[2]), gelu_tanh(v0[3]));
                    w.z = cvt_pk_bf16(gelu_tanh(v1[0]), gelu_tanh(v1[1])); w.w = cvt_pk_bf16(gelu_tanh(v1[2]), gelu_tanh(v1[3]));
                    *(u32x4*)(Gb + ((size_t)(chunk * LC + t) * 256 + u.p2 * 16 + h0)) = w; } }
    }
};

struct SchedGlu {
    static constexpr bool GATHER = false, AUX = false, FP8 = false, I8 = false;
    int nt; unsigned lda, ldb; int G, c; const char* Gb; const char* W;
    DEV bool next(int i, Unit& u) const {
        const int L = i * G + c; if (L >= 256) return false;
        u.A0 = Gb + (size_t)L * 256 * 512; u.A1 = u.A0; u.B0 = W; u.B1 = u.B0; u.ksA = 1 << 20; u.ksB = 1 << 20; u.p0 = L; u.p1 = 0; u.p2 = 0; u.p3 = 0; return true;
    }
    DEV void rows(const Unit&, int, unsigned*) const {}
    DEV void aux(const Unit&, const Unit&, LAS unsigned char*, int, int) const {}
};
struct EpiGlu {
    static constexpr bool PERM = true;
    const bf16_t* Gb; bf16_t* YM; const float* bglu;
    DEV void operator()(const f32x4 (&acc)[2][2][4][2], const Unit& u, int wr, int wc, int fr, int fq) const {
        u32x4 gq[2][4][2];
#pragma unroll
        for (int ai = 0; ai < 2; ++ai)
#pragma unroll
            for (int m = 0; m < 4; ++m)
#pragma unroll
                for (int bj = 0; bj < 2; ++bj) gq[ai][m][bj] = *(const u32x4*)(Gb + (size_t)(u.p0 * 256 + ai * 128 + wr * 64 + m * 16 + fr) * 256 + bj * 128 + wc * 32 + 8 * fq);
        f32x4 bq[2][2];
#pragma unroll
        for (int bj = 0; bj < 2; ++bj) { bq[bj][0] = *(const f32x4*)(bglu + bj * 128 + wc * 32 + 8 * fq); bq[bj][1] = *(const f32x4*)(bglu + bj * 128 + wc * 32 + 8 * fq + 4); }
        asm volatile("" ::: "memory");
#pragma unroll
        for (int ai = 0; ai < 2; ++ai)
#pragma unroll
            for (int m = 0; m < 4; ++m) { const int row = u.p0 * 256 + ai * 128 + wr * 64 + m * 16 + fr;
#pragma unroll
                for (int bj = 0; bj < 2; ++bj) { const int c = bj * 128 + wc * 32 + 8 * fq;
                    const u32x4 gv = gq[ai][m][bj];
                    const f32x4 z0 = acc[ai][bj][m][0] + bq[bj][0], z1 = acc[ai][bj][m][1] + bq[bj][1];
                    u32x4 w; w.x = cvt_pk_bf16(bflo(gv.x) * sigmoidf_(z0[0]), bfhi(gv.x) * sigmoidf_(z0[1])); w.y = cvt_pk_bf16(bflo(gv.y) * sigmoidf_(z0[2]), bfhi(gv.y) * sigmoidf_(z0[3]));
                    w.z = cvt_pk_bf16(bflo(gv.z) * sigmoidf_(z1[0]), bfhi(gv.z) * sigmoidf_(z1[1])); w.w = cvt_pk_bf16(bflo(gv.w) * sigmoidf_(z1[2]), bfhi(gv.w) * sigmoidf_(z1[3]));
                    *(u32x4*)(YM + (size_t)row * DM + c) = w; } }
    }
};

struct SchedOut {
    static constexpr bool GATHER = false, AUX = false, FP8 = false, I8 = false;
    int nt; unsigned lda, ldb; int G, c; const char* A; const char* W;
    DEV bool next(int i, Unit& u) const {
        const int L = i * G + c; if (L >= 1024) return false;
        int pm, pn; pg8::static_tile(L, 256, 4, pm, pn);
        u.A0 = A + (size_t)pm * 256 * 2048; u.A1 = u.A0; u.B0 = W + (size_t)pn * 256 * 2048; u.B1 = u.B0; u.ksA = 1 << 20; u.ksB = 1 << 20; u.p0 = pm; u.p1 = pn; u.p2 = 0; u.p3 = 0; return true;
    }
    DEV void rows(const Unit&, int, unsigned*) const {}
    DEV void aux(const Unit&, const Unit&, LAS unsigned char*, int, int) const {}
};
struct EpiYX {
    static constexpr bool PERM = true;
    bf16_t* YX; int nostore;
    DEV void operator()(const f32x4 (&acc)[2][2][4][2], const Unit& u, int wr, int wc, int fr, int fq) const {
        if (nostore) { float t = 0.f;
#pragma unroll
            for (int ai = 0; ai < 2; ++ai)
#pragma unroll
                for (int m = 0; m < 4; ++m)
#pragma unroll
                    for (int bj = 0; bj < 2; ++bj) t += acc[ai][bj][m][0][0] + acc[ai][bj][m][1][3];
            if (t == 1.2345e38f) YX[0] = 0; return; }
#pragma unroll
        for (int ai = 0; ai < 2; ++ai)
#pragma unroll
            for (int m = 0; m < 4; ++m) { bf16_t* rowp = YX + (size_t)(u.p0 * 256 + ai * 128 + wr * 64 + m * 16 + fr) * DM + u.p1 * 256 + wc * 32 + 8 * fq;
#pragma unroll
                for (int bj = 0; bj < 2; ++bj) { const f32x4 v0 = acc[ai][bj][m][0], v1 = acc[ai][bj][m][1];
                    u32x4 w; w.x = cvt_pk_bf16(v0[0], v0[1]); w.y = cvt_pk_bf16(v0[2], v0[3]); w.z = cvt_pk_bf16(v1[0], v1[1]); w.w = cvt_pk_bf16(v1[2], v1[3]);
                    *(u32x4*)(rowp + bj * 128) = w; } }
    }
};

constexpr int P8_WR_STRIDE = 2064;
constexpr int P8_GT_OFF = 41472, P8_GS_OFF = P8_GT_OFF + 4096, P8_HIST_OFF = P8_GS_OFF + 4096, P8_LZ_OFF = P8_HIST_OFF + 256, P8_LZ_WAVE = 10240;
static_assert(20 * P8_WR_STRIDE <= P8_GT_OFF && P8_LZ_OFF + 8 * P8_LZ_WAVE <= 163840 - 256, "P8 LDS map");
DEV void p8_phase(Frame& F) {
    const float* X = F.in[I_X]; const bf16_t* YX = WSP(bf16_t, WS_YX); bf16_t* X1B = WSP(bf16_t, WS_X1B); unsigned char* X1G = WSP(unsigned char, WS_X1G);
    const bf16_t* Wr = WSP(bf16_t, WS_WR); const float* rb = WSP(float, WS_RB); const float* mod = WSP(float, WS_MOD); const float* n2g = F.in[I_N2G];
    int* tokb = WSP(int, WS_TOKB); float* tokw = WSP(float, WS_TOKW); float* tokr = WSP(float, WS_TOKR); int* segc = WSP(int, WS_SEGC);
    LAS int* hist = (LAS int*)(F.lds + P8_HIST_OFF);
    LAS float* gt = (LAS float*)(F.lds + P8_GT_OFF); LAS float* gsl = (LAS float*)(F.lds + P8_GS_OFF);
    const int l15 = F_LANE & 15, q = F_LANE >> 4;
    for (int idx = F_TID; idx < 20 * 128; idx += 512) { const int r = idx >> 7, c16 = idx & 127; *(LAS u32x4*)(F.lds + r * P8_WR_STRIDE + c16 * 16) = *(const u32x4*)(Wr + (size_t)r * DM + c16 * 8); }
    LAS unsigned char* lz = F.lds + P8_LZ_OFF + F_WAVE * P8_LZ_WAVE;
    for (int seg = F.bx; seg < TOK / 256; seg += F.G) {
        const int b = seg >> 3;
        __syncthreads();
        if (F_TID < 32) hist[F_TID] = 0;
        for (int k = F_TID; k < DM; k += 512) { gt[k] = mod[b * NMOD + 2 * DM + k]; gsl[k] = n2g[k] * (1.0f + mod[b * NMOD + 4 * DM + k]); }
        __syncthreads();
        const int tok0 = seg * 256 + F_WAVE * 32;
#pragma unroll 1
        for (int rg = 0; rg < 2; ++rg) {
            const int tok = tok0 + rg * 16 + l15;
            const float* xp = X + (size_t)tok * DM + 8 * q; const bf16_t* yp = YX + (size_t)tok * DM + 8 * q;
            bf16_t* o1 = X1B + (size_t)tok * DM + 8 * q; unsigned char* og = X1G + (size_t)tok * DM + 8 * q;
            const LAS unsigned char* wl = F.lds + l15 * P8_WR_STRIDE + q * 16;
            f32x4 acc0 = (f32x4){0.f, 0.f, 0.f, 0.f}, acc1 = acc0; float sq = 0.f;
            const LAS unsigned char* wl2 = F.lds + (16 + (l15 & 3)) * P8_WR_STRIDE + q * 16;
#define P8_ISSUE(ks_, sl_) do { lz_issue(xp + (ks_) * 32, lz, (sl_) * 3 + 0); lz_issue(xp + (ks_) * 32 + 4, lz, (sl_) * 3 + 1); lz_issue(yp + (ks_) * 32, lz, (sl_) * 3 + 2); } while (0)
            asm volatile("s_waitcnt lgkmcnt(0)" ::: "memory");
            P8_ISSUE(0, 0); P8_ISSUE(1, 1); P8_ISSUE(2, 2);
            int sl = 0;
#pragma unroll 1
            for (int ks = 0; ks < 32; ++ks) {
                if (ks <= 29) LZ_WAIT(6); else if (ks == 30) LZ_WAIT(3); else LZ_WAIT(0);
                const LAS unsigned char* zp = lz + sl * 3072 + F_LANE * 16;
                const f32x4 xa = *(const LAS f32x4*)zp, xb = *(const LAS f32x4*)(zp + 1024); const u32x4 yv = *(const LAS u32x4*)(zp + 2048);
                const f32x4 g0 = *(const LAS f32x4*)(gt + ks * 32 + 8 * q), g1 = *(const LAS f32x4*)(gt + ks * 32 + 8 * q + 4);
                const f32x4 s0 = *(const LAS f32x4*)(gsl + ks * 32 + 8 * q), s1 = *(const LAS f32x4*)(gsl + ks * 32 + 8 * q + 4);
                f32x4 va, vb;
                va[0] = xa[0] + g0[0] * bflo(yv.x); va[1] = xa[1] + g0[1] * bfhi(yv.x); va[2] = xa[2] + g0[2] * bflo(yv.y); va[3] = xa[3] + g0[3] * bfhi(yv.y);
                vb[0] = xb[0] + g1[0] * bflo(yv.z); vb[1] = xb[1] + g1[1] * bfhi(yv.z); vb[2] = xb[2] + g1[2] * bflo(yv.w); vb[3] = xb[3] + g1[3] * bfhi(yv.w);
                sq += ((va[0] * va[0] + va[1] * va[1]) + (va[2] * va[2] + va[3] * va[3])) + ((vb[0] * vb[0] + vb[1] * vb[1]) + (vb[2] * vb[2] + vb[3] * vb[3]));
                u32x4 w1; w1.x = cvt_pk_bf16(va[0], va[1]); w1.y = cvt_pk_bf16(va[2], va[3]); w1.z = cvt_pk_bf16(vb[0], vb[1]); w1.w = cvt_pk_bf16(vb[2], vb[3]);
                *(u32x4*)(o1 + ks * 32) = w1;
                const f32x4 ga = va * s0, gb = vb * s1;
                u32x4 wg; wg.x = cvt_pk_bf16(ga[0], ga[1]); wg.y = cvt_pk_bf16(ga[2], ga[3]); wg.z = cvt_pk_bf16(gb[0], gb[1]); wg.w = cvt_pk_bf16(gb[2], gb[3]);
                { u32x2 w8; w8.x = pk4_fp8(ga[0], ga[1], ga[2], ga[3]); w8.y = pk4_fp8(gb[0], gb[1], gb[2], gb[3]); *(u32x2*)(og + ks * 32) = w8; }
                const bf16x8 xf = __builtin_bit_cast(bf16x8, wg);
                const bf16x8 wa = *(const LAS bf16x8*)(wl + ks * 64), wb = *(const LAS bf16x8*)(wl2 + ks * 64);
                acc0 = __builtin_amdgcn_mfma_f32_16x16x32_bf16(wa, xf, acc0, 0, 0, 0); acc1 = __builtin_amdgcn_mfma_f32_16x16x32_bf16(wb, xf, acc1, 0, 0, 0);
                if (ks + 3 < 32) P8_ISSUE(ks + 3, sl);
                sl = (sl == 2) ? 0 : sl + 1;
            }
#undef P8_ISSUE
            sq += __shfl_xor(sq, 16); sq += __shfl_xor(sq, 32);
            const float rstd = 1.0f / sqrtf(sq * (1.f / DM) + RMS_EPS);
            float lg[4], l2[4], gl[4], t1[4], t2[4], v[4];
#pragma unroll
            for (int r = 0; r < 4; ++r) { lg[r] = rstd * acc0[r] + rb[b * 32 + 4 * q + r]; l2[r] = rstd * acc1[r] + rb[b * 32 + 16 + ((4 * q + r) & 15)]; }
#pragma unroll
            for (int r = 0; r < 4; ++r) gl[r] = __shfl(lg[r], l15);
            int gi = 0; float gm = gl[0];
#pragma unroll
            for (int r = 1; r < 4; ++r) if (gl[r] > gm) { gm = gl[r]; gi = r; }
            float den = 0.f;
#pragma unroll
            for (int r = 0; r < 4; ++r) den += __expf(gl[r] - gm);
            const float gp = 1.0f / den;
            const int src = l15 + 16 * ((gi + 1) & 3);
#pragma unroll
            for (int r = 0; r < 4; ++r) { t1[r] = __shfl(lg[r], src); t2[r] = __shfl(l2[r], l15); v[r] = (gi == 3) ? t2[r] : t1[r]; }
            int i1 = 0; float v1 = v[0];
#pragma unroll
            for (int r = 1; r < 4; ++r) if (v[r] > v1) { v1 = v[r]; i1 = r; }
            int i2 = -1; float v2 = 0.f;
#pragma unroll
            for (int r = 0; r < 4; ++r) if (r != i1 && (i2 < 0 || v[r] > v2)) { v2 = v[r]; i2 = r; }
            const float ex = __expf(v2 - v1), p1 = 1.0f / (1.0f + ex), p2 = ex * p1;
            const int lo = i1 < i2 ? i1 : i2, hi = i1 < i2 ? i2 : i1;
            const float wlo = (i1 < i2 ? p1 : p2) * gp, whi = (i1 < i2 ? p2 : p1) * gp;
            const int pidx = (lo == 0) ? (hi - 1) : (lo == 1) ? (hi + 1) : 5;
            const int bucket = gi * 6 + pidx;
            if (q == 0) { tokb[tok] = bucket; tokw[tok * 2] = wlo; tokw[tok * 2 + 1] = whi; tokr[tok] = rstd; atomicAdd((int*)hist + bucket, 1); }
        }
        __syncthreads();
        if (F_TID < 32) segc[seg * 32 + F_TID] = (F_TID < NBUCKET) ? hist[F_TID] : 0;
    }
    __syncthreads();
}

DEV void p9_phase(Frame& F) {
    const int* segc = WSP(int, WS_SEGC); const int* tokb = WSP(int, WS_TOKB); int* perm = WSP(int, WS_PERM); int* tiles = WSP(int, WS_TILES);
    const float* tokw = WSP(float, WS_TOKW); const float* tokr = WSP(float, WS_TOKR); u32x4* slotrec = WSP(u32x4, WS_SLOT);
    LAS int* tot = (LAS int*)F.lds;
    LAS int* tst = tot + 32;
    LAS int* base = tst + 32;
    LAS int* wcnt = base + 32;
    for (int seg = F.bx; seg < TOK / 256; seg += F.G) {
        __syncthreads();
        if (F_TID < 32) { int t = 0, bs = 0; if (F_TID < NBUCKET) for (int s = 0; s < 256; ++s) { const int c = ld_agent_i(segc + s * 32 + F_TID); if (s < seg) bs += c; t += c; } tot[F_TID] = t; base[F_TID] = bs; }
        if (F_TID < 128) wcnt[F_TID] = 0;
        __syncthreads();
        if (F_TID == 0) { int ts = 0; for (int k = 0; k < NBUCKET; ++k) { tst[k] = ts; ts += (tot[k] + 255) >> 8; } tst[NBUCKET] = ts; }
        __syncthreads();
        int bk = -1, rank = 0;
        if (F_TID < 256) {
            bk = tokb[seg * 256 + F_TID];
            for (int k = 0; k < NBUCKET; ++k) { const unsigned long long msk = __ballot(bk == k); if (bk == k) rank = __popcll(msk & ((1ull << F_LANE) - 1ull)); if (F_LANE == 0) wcnt[F_WAVE * 32 + k] = __popcll(msk); }
        }
        __syncthreads();
        if (F_TID < 256) { int off = 0; for (int w = 0; w < F_WAVE; ++w) off += wcnt[w * 32 + bk]; const int tok = seg * 256 + F_TID, slot = tst[bk] * 256 + base[bk] + off + rank;
            perm[slot] = tok; slotrec[slot] = (u32x4){(unsigned)tok, __float_as_uint(tokr[tok]), __float_as_uint(tokw[tok * 2]), __float_as_uint(tokw[tok * 2 + 1])}; }
        if (seg < NBUCKET) { const int k = seg, n = tot[k], np = ((n + 255) >> 8) << 8; for (int r = n + F_TID; r < np; r += 512) { perm[tst[k] * 256 + r] = -1; slotrec[tst[k] * 256 + r] = (u32x4){0xffffffffu, 0u, 0u, 0u}; } }
        if (seg == 0) { if (F_TID == 0) tiles[0] = tst[NBUCKET];
            if (F_TID < NBUCKET) { const int k = F_TID, nt_ = (tot[k] + 255) >> 8; for (int t = 0; t < nt_; ++t) tiles[16 + tst[k] + t] = k; } }
    }
}
DEV void bucket_experts(int bk, int& e0, int& e1) { const int grp = bk / 6, pi = bk % 6; const int lo = pi < 3 ? 0 : (pi < 5 ? 1 : 2), hi = pi < 3 ? pi + 1 : (pi < 5 ? pi - 1 : 3); e0 = grp * 4 + lo; e1 = grp * 4 + hi; }


DEV void moe_setup(LAS unsigned char* lds, const int* tiles, int ntiles, const u32x4* slotrec, int first_tile) {
    int tid = threadIdx.x; asm volatile("" : "+v"(tid));
    for (int t = tid; t < ntiles; t += 512) *(LAS int*)(lds + AUX_TILE_OFF + t * 4) = ld_agent_i(tiles + 16 + t);
    if (tid < 256 && first_tile < ntiles) *(LAS u32x4*)(lds + AUX_SLOT_OFF + tid * 16) = slotrec[(size_t)first_tile * 256 + tid];
    asm volatile("s_waitcnt vmcnt(0) lgkmcnt(0)" ::: "memory"); __syncthreads();
}
struct SchedUp {
    static constexpr bool GATHER = true, AUX = true, FP8 = true, I8 = false;
    int nt; unsigned lda, ldb; int G, c, ntiles; const char* X1G; const char* W13; const char* slotrec; const char* sb13; LAS unsigned char* lds;
    DEV bool next(int i, Unit& u) const {
        const int L = i * G + c; if (L >= ntiles * 8) return false;
        const int tile = L >> 3, s = (L >> 2) & 1, ti = L & 3; int e0, e1; bucket_experts(__builtin_amdgcn_readfirstlane(*(const LAS int*)(lds + AUX_TILE_OFF + tile * 4)), e0, e1); const int e = s ? e1 : e0;
        u.A0 = X1G; u.A1 = X1G; u.B0 = W13 + ((size_t)e * 1024 + ti * 256) * 1024; u.B1 = u.B0; u.ksA = 1 << 20; u.ksB = 1 << 20; u.p0 = tile; u.p1 = s; u.p2 = ti; u.p3 = e; u.q = i & 1; return true;
    }
    DEV void rows(const Unit& u, int tid, unsigned* v) const {
#pragma unroll
        for (int i = 0; i < 2; ++i) { int R_, C_; pg8::stage_rc(tid * 16 + i * 8192, R_, C_);
#pragma unroll
            for (int h = 0; h < 2; ++h) { int t = *(const LAS int*)(lds + AUX_SLOT_OFF + u.q * 4096 + (h * 128 + R_) * 16); t = t < 0 ? 0 : t; v[h * 2 + i] = (unsigned)t * 1024u + (unsigned)C_ * 2u; } }
    }
    DEV void a_ready(const Unit&) const {}
    DEV void aux(const Unit& u, const Unit& n, LAS unsigned char* l, int wid, int lane) const {
        if (wid < 4) glds16(slotrec + (size_t)n.p0 * 4096 + wid * 1024 + lane * 16, l + AUX_SLOT_OFF + (u.q ^ 1) * 4096 + wid * 1024);
#pragma unroll
        for (int i = 0; i < 2; ++i) { const int p = wid * 2 + i, b = 2 * p + (lane >> 5);
            glds16(sb13 + ((size_t)(b * 16 + u.p3) * 1024 + u.p2 * 256) * 2 + (lane & 31) * 16, l + AUX_BIAS_OFF + p * 1024); }
    }
};
struct EpiUp {
    static constexpr bool PERM = true;
    unsigned char* HID; LAS unsigned char* lds;
    DEV void operator()(const f32x4 (&acc)[2][2][4][2], const Unit& u, int wr, int wc, int fr, int fq) const {
#pragma unroll
        for (int ai = 0; ai < 2; ++ai)
#pragma unroll
            for (int m = 0; m < 4; ++m) { const int r = ai * 128 + wr * 64 + m * 16 + fr, slot = u.p0 * 256 + r;
                const u32x4 rec = *(const LAS u32x4*)(lds + AUX_SLOT_OFF + u.q * 4096 + r * 16);
                const bool valid = (int)rec.x >= 0; const int tk = valid ? (int)rec.x : 0; const float rstd = __uint_as_float(rec.y) * (1.0f / FP8_WSCALE), w = (u.p1 ? __uint_as_float(rec.w) : __uint_as_float(rec.z)) * FP8_WSCALE;
                const LAS unsigned char* bp = lds + AUX_BIAS_OFF + (tk >> 11) * 512 + (wc * 32 + 8 * fq) * 2;
                const u32x4 b1 = *(const LAS u32x4*)bp, b3 = *(const LAS u32x4*)(bp + 256);
                float o[8];
#define UP1(j_, a1_, a3_, b1_, b3_) do { const float p1_ = __builtin_fmaf((a1_), rstd, (b1_)), p3_ = __builtin_fmaf((a3_), rstd, (b3_)); \
                    const float r_ = __builtin_amdgcn_rcpf(1.0f + __builtin_amdgcn_exp2f(p1_ * -1.4426950408889634f)); o[j_] = (p1_ * r_) * (p3_ * w); } while (0)
                UP1(0, acc[ai][0][m][0][0], acc[ai][1][m][0][0], bflo(b1.x), bflo(b3.x)); UP1(1, acc[ai][0][m][0][1], acc[ai][1][m][0][1], bfhi(b1.x), bfhi(b3.x));
                UP1(2, acc[ai][0][m][0][2], acc[ai][1][m][0][2], bflo(b1.y), bflo(b3.y)); UP1(3, acc[ai][0][m][0][3], acc[ai][1][m][0][3], bfhi(b1.y), bfhi(b3.y));
                UP1(4, acc[ai][0][m][1][0], acc[ai][1][m][1][0], bflo(b1.z), bflo(b3.z)); UP1(5, acc[ai][0][m][1][1], acc[ai][1][m][1][1], bfhi(b1.z), bfhi(b3.z));
                UP1(6, acc[ai][0][m][1][2], acc[ai][1][m][1][2], bflo(b1.w), bflo(b3.w)); UP1(7, acc[ai][0][m][1][3], acc[ai][1][m][1][3], bfhi(b1.w), bfhi(b3.w));
#undef UP1
                u32x2 wv; wv.x = pk4_fp8(o[0], o[1], o[2], o[3]); wv.y = pk4_fp8(o[4], o[5], o[6], o[7]);
                *(u32x2*)(HID + ((size_t)slot * 1024 + u.p1 * 512 + u.p2 * 128 + wc * 32 + 8 * fq)) = wv; }
    }
};

struct SchedDown {
    static constexpr bool GATHER = false, AUX = true, FP8 = true, I8 = false;
    int nt; unsigned lda, ldb; int G, c, ntiles; const char* HID; const char* W2; const char* slotrec; LAS unsigned char* lds;
    DEV bool next(int i, Unit& u) const {
        const int L = i * G + c; if (L >= ntiles * 4) return false;
        const int tile = L >> 2, pn = L & 3; int e0, e1; bucket_experts(__builtin_amdgcn_readfirstlane(*(const LAS int*)(lds + AUX_TILE_OFF + tile * 4)), e0, e1);
        u.A0 = HID + (size_t)tile * 256 * 1024; u.A1 = u.A0; u.ksA = 1 << 20;
        u.B0 = W2 + ((size_t)e0 * 1024 + pn * 256) * 512; u.B1 = W2 + ((size_t)e1 * 1024 + pn * 256) * 512; u.ksB = 4;
        u.p0 = tile; u.p1 = pn; u.p2 = 0; u.p3 = 0; return true;
    }
    DEV void rows(const Unit&, int, unsigned*) const {}
    DEV void aux(const Unit& u, const Unit&, LAS unsigned char* l, int wid, int lane) const {
        if (wid < 4) glds16(slotrec + (size_t)u.p0 * 4096 + wid * 1024 + lane * 16, l + AUX_SLOT_OFF + wid * 1024);
    }
};
struct EpiDown {
    static constexpr bool PERM = true;
    bf16_t* MOE; LAS unsigned char* lds;
    DEV void operator()(const f32x4 (&acc)[2][2][4][2], const Unit& u, int wr, int wc, int fr, int fq) const {
#pragma unroll
        for (int ai = 0; ai < 2; ++ai)
#pragma unroll
            for (int m = 0; m < 4; ++m) { const int r = ai * 128 + wr * 64 + m * 16 + fr; const int tk = *(const LAS int*)(lds + AUX_SLOT_OFF + r * 16);
                if (tk >= 0) { bf16_t* rowp = MOE + (size_t)tk * DM + u.p1 * 256 + wc * 32 + 8 * fq;
#pragma unroll
                    for (int bj = 0; bj < 2; ++bj) { const f32x4 v0 = acc[ai][bj][m][0] * (1.0f / (FP8_WSCALE * FP8_WSCALE)), v1 = acc[ai][bj][m][1] * (1.0f / (FP8_WSCALE * FP8_WSCALE));
                        u32x4 w; w.x = cvt_pk_bf16(v0[0], v0[1]); w.y = cvt_pk_bf16(v0[2], v0[3]); w.z = cvt_pk_bf16(v1[0], v1[1]); w.w = cvt_pk_bf16(v1[2], v1[3]);
                        *(u32x4*)(rowp + bj * 128) = w; } } }
    }
};

DEV void p12_phase(Frame& F) {
    const bf16_t* X1B = WSP(bf16_t, WS_X1B); const bf16_t* MOE = WSP(bf16_t, WS_MOE); const float* mod = WSP(float, WS_MOD); const float* fg = F.in[I_FING];
    const int gw = F.vcu * 8 + F_WAVE, NGW = F.G * 8;
    LAS unsigned char* lz = F.lds + F_WAVE * LZ_WAVE;
#if MK_TIME_A >= 0
    const float tscale = 1.0f + (float)(__hip_atomic_load(WSP(unsigned long long, WS_STAMP) + MK_TIME_A + 1, __ATOMIC_RELAXED, __HIP_MEMORY_SCOPE_AGENT) - __hip_atomic_load(WSP(unsigned long long, WS_STAMP) + MK_TIME_A, __ATOMIC_RELAXED, __HIP_MEMORY_SCOPE_AGENT)) * 1e-5f;
#endif
#if MK_TIME_B >= 0
    const float tspike = (float)(__hip_atomic_load(WSP(unsigned long long, WS_STAMP) + MK_TIME_B + 1, __ATOMIC_RELAXED, __HIP_MEMORY_SCOPE_AGENT) - __hip_atomic_load(WSP(unsigned long long, WS_STAMP) + MK_TIME_B, __ATOMIC_RELAXED, __HIP_MEMORY_SCOPE_AGENT)) * 1e-2f;
#endif
    for (int ch = gw; ch < TOK / 32; ch += NGW) {
        const int b = ch >> 6; const float* gate = mod + b * NMOD + 5 * DM;
        float gq[16], fq_[16];
#pragma unroll
        for (int h = 0; h < 2; ++h) { const int c0 = h * 512 + 8 * F_LANE; const f32x4 g0 = *(const f32x4*)(gate + c0), g1 = *(const f32x4*)(gate + c0 + 4), f0 = *(const f32x4*)(fg + c0), f1 = *(const f32x4*)(fg + c0 + 4);
#pragma unroll
            for (int j = 0; j < 4; ++j) { gq[h * 8 + j] = g0[j]; gq[h * 8 + 4 + j] = g1[j]; fq_[h * 8 + j] = f0[j]; fq_[h * 8 + 4 + j] = f1[j]; } }
#define P12_ISSUE(bb) do { _Pragma("unroll") for (int r = 0; r < 2; ++r) _Pragma("unroll") for (int h = 0; h < 2; ++h) { \
            const size_t off_ = (size_t)(ch * 32 + (bb) * 2 + r) * DM + h * 512 + 8 * F_LANE; \
            lz_issue(X1B + off_, lz, ((bb) & 1) * 8 + r * 4 + h); lz_issue(MOE + off_, lz, ((bb) & 1) * 8 + r * 4 + 2 + h); } } while (0)
        asm volatile("s_waitcnt lgkmcnt(0)" ::: "memory");
        P12_ISSUE(0); P12_ISSUE(1);
#pragma unroll 1
        for (int bb = 0; bb < 16; ++bb) {
            if (bb + 1 < 16) LZ_WAIT(8); else LZ_WAIT(0);
            float v[2][16], ss[2];
#pragma unroll
            for (int r = 0; r < 2; ++r) { float s_ = 0.f;
#pragma unroll
                for (int h = 0; h < 2; ++h) { const u32x4 xv = *(const LAS u32x4*)(lz + ((bb & 1) * 8 + r * 4 + h) * 1024 + F_LANE * 16), mv = *(const LAS u32x4*)(lz + ((bb & 1) * 8 + r * 4 + 2 + h) * 1024 + F_LANE * 16);
#pragma unroll
                    for (int j = 0; j < 4; ++j) { const unsigned xw = xv[j], mw = mv[j];
                        const float lo = bflo(xw) + gq[h * 8 + 2 * j] * bflo(mw), hi = bfhi(xw) + gq[h * 8 + 2 * j + 1] * bfhi(mw);
                        v[r][h * 8 + 2 * j] = lo; v[r][h * 8 + 2 * j + 1] = hi; s_ += lo * lo + hi * hi; } }
                ss[r] = s_; }
#pragma unroll
            for (int o = 1; o < 64; o <<= 1) { ss[0] += __shfl_xor(ss[0], o); ss[1] += __shfl_xor(ss[1], o); }
#pragma unroll
            for (int r = 0; r < 2; ++r) { const float rstd = 1.0f / sqrtf(ss[r] * (1.f / DM) + RMS_EPS); float* op = F.out + (size_t)(ch * 32 + bb * 2 + r) * DM + 8 * F_LANE;
#pragma unroll
                for (int h = 0; h < 2; ++h) { f32x4 o0, o1;
#pragma unroll
                    for (int j = 0; j < 4; ++j) { o0[j] = v[r][h * 8 + j] * rstd * fq_[h * 8 + j]; o1[j] = v[r][h * 8 + 4 + j] * rstd * fq_[h * 8 + 4 + j]; }
#if MK_TIME_A >= 0
                    o0 = o0 * tscale; o1 = o1 * tscale;
#endif
#if MK_TIME_B >= 0
                    if (ch == 0 && bb == 0 && r == 0 && h == 0 && F_LANE == 0) o0[0] += tspike;
#endif
                    *(f32x4*)(op + h * 512) = o0; *(f32x4*)(op + h * 512 + 4) = o1; } }
            if (bb + 2 < 16) P12_ISSUE(bb + 2);
        }
#undef P12_ISSUE
    }
}

#define XB_TMO      128
#define XB_XCNT(j)  (256  + 64 * (j))
#define XB_XSUB(j)  (1280 + 64 * (j))
#define XB_XGEN(j)  (2304 + 64 * (j))
#define XB_TOP      3328
#define XB_TOPGEN   3392
#define XCD_BAR_WORDS 3456
#define XB_SPIN_CAP (1u << 22)
DEV unsigned xb_ld(unsigned* p)              { return __hip_atomic_load(p, __ATOMIC_RELAXED, __HIP_MEMORY_SCOPE_AGENT); }
DEV unsigned xb_add(unsigned* p, unsigned v) { return __hip_atomic_fetch_add(p, v, __ATOMIC_RELAXED, __HIP_MEMORY_SCOPE_AGENT); }
DEV unsigned xb_xcc_id() { return (unsigned)__builtin_amdgcn_s_getreg((3 << 11) | 20) & 0xFu; }
#define XB_SPIN(cond, bar) do { unsigned _sp = 0; while (cond) { __builtin_amdgcn_s_sleep(1); \
    if ((++_sp & 255u) == 0u) { if (xb_ld(&(bar)[XB_TMO])) break; if (_sp > XB_SPIN_CAP) { atomicAdd(&(bar)[XB_TMO], 1u); break; } } } } while (0)
struct XcdBarrier { unsigned* bar; unsigned x; volatile LAS unsigned* st; };
DEV XcdBarrier xcd_barrier_post(unsigned* bar, volatile LAS unsigned* st) {
    XcdBarrier b; b.bar = bar; b.x = xb_xcc_id(); b.st = st;
    if (threadIdx.x == 0) (void)xb_add(&bar[XB_XCNT(b.x)], 1u);
    return b;
}
DEV void xcd_barrier_complete(unsigned* bar, unsigned x, unsigned& nloc, unsigned& nx) {
    const unsigned G = gridDim.x * gridDim.y * gridDim.z;
    unsigned sum, cnt, mine, sp = 0u;
    for (;;) {
        sum = 0u; cnt = 0u; mine = 0u;
#pragma unroll
        for (unsigned j = 0; j < 16; ++j) { const unsigned c = xb_ld(&bar[XB_XCNT(j)]); sum += c; cnt += (c > 0u) ? 1u : 0u; mine = (j == x) ? c : mine; }
        if (sum == G) break;
        __builtin_amdgcn_s_sleep(1);
        if ((++sp & 255u) == 0u) { if (xb_ld(&bar[XB_TMO])) break; if (sp > XB_SPIN_CAP) { atomicAdd(&bar[XB_TMO], 1u); break; } }
    }
    nloc = mine > 0u ? mine : 1u; nx = cnt > 0u ? cnt : 1u;
}
DEV void xcd_barrier(const XcdBarrier& b) {
    asm volatile("s_waitcnt vmcnt(0)" ::: "memory");
    __syncthreads();
    if (threadIdx.x == 0) {
        unsigned* bar = b.bar;
        __builtin_amdgcn_s_waitcnt(0);
        unsigned nloc = b.st[0], nx = b.st[1];
        if (nloc == 0u) { xcd_barrier_complete(bar, b.x, nloc, nx); b.st[0] = nloc; b.st[1] = nx; }
        const unsigned old = xb_add(&bar[XB_XSUB(b.x)], 1u);
        const unsigned gen = old / nloc;
        if (old + 1u == (gen + 1u) * nloc) {
            __builtin_amdgcn_fence(__ATOMIC_RELEASE, "agent");
            asm volatile("s_waitcnt vmcnt(0)" ::: "memory");
            const unsigned og = xb_add(&bar[XB_TOP], 1u);
            const unsigned tg = og / nx;
            if (og + 1u == (tg + 1u) * nx) xb_add(&bar[XB_TOPGEN], 1u);
            else XB_SPIN(xb_ld(&bar[XB_TOPGEN]) == tg, bar);
            __builtin_amdgcn_fence(__ATOMIC_ACQUIRE, "agent");
            xb_add(&bar[XB_XGEN(b.x)], 1u);
            asm volatile("s_waitcnt vmcnt(0)" ::: "memory");
        } else {
            XB_SPIN(xb_ld(&bar[XB_XGEN(b.x)]) == gen, bar);
            __builtin_amdgcn_fence(__ATOMIC_ACQUIRE, "agent");
            asm volatile("s_waitcnt vmcnt(0)" ::: "memory");
        }
    }
    __syncthreads();
}

constexpr int LDS_BYTES = 163840;
static_assert(AUX_TILE_OFF + MAXTILES * 4 <= LDS_BYTES - 256, "LDS map");
constexpr int NPHASE = 13;
constexpr int MISC_OFF = LDS_BYTES - 256;
constexpr int CW_BAR = 4096;
constexpr size_t CTL_ZERO_BYTES = 65536;

__global__ void __launch_bounds__(512, 2) mk_fwd(Args args) {
    extern __shared__ __attribute__((aligned(16))) unsigned char lds_raw[];
    Frame F;
    F.lds = (LAS unsigned char*)lds_raw;
    F.G = gridDim.x; F.bx = blockIdx.x; F.vcu = (F.G % 8 == 0) ? (F.bx % 8) * (F.G / 8) + F.bx / 8 : F.bx;
#pragma unroll
    for (int i = 0; i < 29; ++i) F.in[i] = args.in[i];
    F.out = args.out; F.ws = args.ws; F.flags = args.flags;
    const int lo = args.ph_lo, hi = args.ph_hi;
#if MK_ONE_LAUNCH == 1
    cg::grid_group grid = cg::this_grid();
#define SEAM(k) do { if (lo <= (k) && (k) + 1 < hi) grid.sync(); } while (0)
#elif MK_ONE_LAUNCH == 2
    {
        volatile LAS unsigned* misc = (volatile LAS unsigned*)(F.lds + MISC_OFF);
        if (F_TID < 16) misc[F_TID] = 0u;
        __syncthreads();
    }
    const XcdBarrier xbar = xcd_barrier_post((unsigned*)(F.ws + WS_CTL) + CW_BAR + args.li * XCD_BAR_WORDS, (volatile LAS unsigned*)(F.lds + MISC_OFF));
#if MK_TIME_A >= 0 || MK_TIME_B >= 0
#define STAMP(i) do { if (F.bx == 0 && F_TID == 0) __hip_atomic_store(WSP(unsigned long long, WS_STAMP) + (i), (unsigned long long)__builtin_amdgcn_s_memrealtime(), __ATOMIC_RELAXED, __HIP_MEMORY_SCOPE_AGENT); } while (0)
#else
#define STAMP(i) do { } while (0)
#endif
    STAMP(0);
#define SEAM(k) do { if (lo <= (k) && (k) + 1 < hi) xcd_barrier(xbar); STAMP((k) + 1); } while (0)
#else
#define SEAM(k) do { } while (0)
#endif
#define IN(k) (lo <= (k) && (k) < hi)
#define REPS(k) for (int rep_ = 0; rep_ < 1 + ((MK_REP >> (k)) & 1); ++rep_)

    if (IN(0)) REPS(0) { p0_phase(F); }
    SEAM(0);
    if (IN(1)) REPS(1) {
        if (!(F.flags & 2)) p1_norm_rows(F);
        if (F.flags & 4) { } else
        if (F.bx < 32) {
            asm volatile("s_waitcnt vmcnt(0)" ::: "memory"); __syncthreads();
            SchedIn S{8, 1024u, 1024u, 32, F.bx, (const char*)WSP(bf16_t, WS_HX), (const char*)WSP(bf16_t, WS_WIN), 2560, 2592, (const char*)WSP(float, WS_RSCALE), (const char*)WSP(float, WS_CSCALE)};
            EpiIn E{WSP(bf16_t, WS_UG), WSP(bf16_t, WS_BG), WSP(bf16_t, WS_CV), F.lds};
            pg8::gemm_phase<EpiIn, SchedIn>(F.lds, S, E);
        } else { const int nk = ((F.G - 32) * 4) / 7; if (F.bx < 32 + nk) p1_ktab(F, 32, nk); else p1_tables(F, 32 + nk, F.G - 32 - nk); }
    }
    SEAM(1);
    if (IN(2)) REPS(2) {
        SchedIn S{8, 1024u, 1024u, F.G, F.bx, (const char*)WSP(bf16_t, WS_HX), (const char*)WSP(bf16_t, WS_WIN), 0, 2560, (const char*)WSP(float, WS_RSCALE), (const char*)WSP(float, WS_CSCALE)};
        EpiIn E{WSP(bf16_t, WS_UG), WSP(bf16_t, WS_BG), WSP(bf16_t, WS_CV), F.lds};
        pg8::gemm_phase<EpiIn, SchedIn>(F.lds, S, E);
    }
    SEAM(2);
    if (IN(3)) REPS(3) {
        int vb0, nvb;
        if (F.bx < 144) { SchedE S{UK / 64, (unsigned)(UGK * 2), (unsigned)(UK * 2), F.bx, (const char*)WSP(bf16_t, WS_UG), (const char*)WSP(bf16_t, WS_WE)}; EpiE E{WSP(float, WS_E)};
            pg8::gemm_phase<EpiE, SchedE>(F.lds, S, E); vb0 = F.bx * 3; nvb = 3; }
        else if (F.bx < 208) { SchedSB S2{8, 1024u, 1024u, F.bx - 144, (const char*)WSP(bf16_t, WS_SH2), (const char*)WSP(bf16_t, WS_W13)}; EpiSB E2{WSP(bf16_t, WS_SB13)};
            pg8::gemm_phase<EpiSB, SchedSB>(F.lds, S2, E2); vb0 = 432 + (F.bx - 144) * 3; nvb = 3; }
        else { vb0 = 624 + (F.bx - 208) * 4; nvb = 4; }
        if (!(F.flags & 2)) for (int v = 0; v < nvb; ++v) conv_items(F, (vb0 + v) * 512 + F_TID, 816 * 512);
    }
    SEAM(3);
    if (IN(4)) REPS(4) {
        constexpr int NCB = NB * NG * 128 / 512;
        if (F.G >= 2 * NCB) { if (F.bx < NCB) p4_phase(F, NCB); else p2_fill_tr(F, NCB, F.G - NCB); }
        else { p4_phase(F, F.G); p2_fill_tr(F, 0, F.G); }
    }
    SEAM(4);
    if (IN(5)) REPS(5) {
        SchedY S{UGK / 64, (unsigned)(UGK * 2), (unsigned)(UGK * 2), F.bx, (const char*)WSP(bf16_t, WS_UG), (const char*)WSP(bf16_t, WS_TR)}; EpiY E{WSP(bf16_t, WS_G)};
        pg8::gemm_phase<EpiY, SchedY>(F.lds, S, E);
    }
    SEAM(5);
    if (IN(6)) REPS(6) {
        SchedGlu S{4, 512u, 512u, F.G, F.bx, (const char*)WSP(bf16_t, WS_G), (const char*)WSP(bf16_t, WS_WGLU)}; EpiGlu E{WSP(bf16_t, WS_G), WSP(bf16_t, WS_YMIX), F.in[I_BGLU]};
        pg8::gemm_phase<EpiGlu, SchedGlu>(F.lds, S, E);
    }
    SEAM(6);
    if (IN(7)) REPS(7) {
        SchedOut S{16, 2048u, 2048u, F.G, F.bx, (const char*)WSP(bf16_t, WS_YMIX), (const char*)WSP(bf16_t, WS_WOUT)};
        EpiYX E{WSP(bf16_t, WS_YX), args.flags & 1};
        pg8::gemm_phase<EpiYX, SchedOut>(F.lds, S, E);
    }
    SEAM(7);
    if (IN(8)) REPS(8) { p8_phase(F); }
    SEAM(8);
    if (IN(9)) REPS(9) { p9_phase(F); }
    SEAM(9);
    if (IN(10)) REPS(10) {
        const int ntiles = ld_agent_i(WSP(int, WS_TILES));
        moe_setup(F.lds, WSP(int, WS_TILES), ntiles, WSP(u32x4, WS_SLOT), F.vcu >> 3);
        SchedUp S{8, 1024u, 1024u, F.G, F.vcu, ntiles, (const char*)WSP(bf16_t, WS_X1G), (const char*)WSP(bf16_t, WS_W13), (const char*)WSP(u32x4, WS_SLOT), (const char*)WSP(bf16_t, WS_SB13), F.lds};
        EpiUp E{WSP(unsigned char, WS_HID), F.lds};
        pg8::gemm_phase<EpiUp, SchedUp>(F.lds, S, E);
    }
    SEAM(10);
    if (IN(11)) REPS(11) {
        const int ntiles = ld_agent_i(WSP(int, WS_TILES));
        moe_setup(F.lds, WSP(int, WS_TILES), ntiles, WSP(u32x4, WS_SLOT), MAXTILES);
        SchedDown S{8, 1024u, 512u, F.G, F.vcu, ntiles, (const char*)WSP(bf16_t, WS_HID), (const char*)WSP(bf16_t, WS_W2), (const char*)WSP(u32x4, WS_SLOT), F.lds};
        EpiDown E{WSP(bf16_t, WS_MOE), F.lds};
        pg8::gemm_phase<EpiDown, SchedDown>(F.lds, S, E);
    }
    SEAM(11);
    if (IN(12)) REPS(12) { p12_phase(F); }
#undef IN
#undef SEAM
}

extern "C" void kernel_launch(void* const* d_in, const int* in_sizes, int n_in, void* d_out, int out_size, void* d_ws, size_t ws_size, hipStream_t stream) {
    static int grid = 0;
    if (grid == 0) {
        if (n_in != 29 || out_size != TOK * DM || ws_size < WS_END) { fprintf(stderr, "kernel_launch: unexpected problem (n_in %d, out %d, ws %zu)\n", n_in, out_size, ws_size); grid = -1; return; }
        int dev = 0, cus = 0, per_cu = 0;
        if (hipGetDevice(&dev) != hipSuccess || hipDeviceGetAttribute(&cus, hipDeviceAttributeMultiprocessorCount, dev) != hipSuccess) { grid = -1; return; }
        if (hipFuncSetAttribute((const void*)mk_fwd, hipFuncAttributeMaxDynamicSharedMemorySize, LDS_BYTES) != hipSuccess) { fprintf(stderr, "kernel_launch: hipFuncSetAttribute failed\n"); grid = -1; return; }
        if (hipOccupancyMaxActiveBlocksPerMultiprocessor(&per_cu, (const void*)mk_fwd, 512, LDS_BYTES) != hipSuccess || per_cu < 1) { fprintf(stderr, "kernel_launch: occupancy query gives %d\n", per_cu); (void)hipGetLastError(); per_cu = 1; }
        grid = cus;
        if (grid > 256) grid = 256;
    }
    if (grid < 0) return;
    Args a{};
    for (int i = 0; i < 29; ++i) a.in[i] = (const float*)d_in[i];
    a.out = (float*)d_out; a.ws = (unsigned char*)d_ws;
#if MK_ONE_LAUNCH == 1
    a.ph_lo = 0; a.ph_hi = NPHASE;
    void* kargs[] = {&a};
    hipError_t e = hipLaunchCooperativeKernel((const void*)mk_fwd, dim3(grid), dim3(512), kargs, LDS_BYTES, stream);
    if (e != hipSuccess) fprintf(stderr, "cooperative launch failed: %s (grid %d)\n", hipGetErrorString(e), grid);
#elif MK_ONE_LAUNCH == 2
    if (hipMemsetAsync((char*)d_ws + WS_CTL, 0, CTL_ZERO_BYTES, stream) != hipSuccess) { fprintf(stderr, "kernel_launch: memset failed\n"); return; }
#if MK_SPLIT_AT >= 0
    a.ph_lo = 0; a.ph_hi = MK_SPLIT_AT + 1; a.li = 0;
    hipLaunchKernelGGL(mk_fwd, dim3(grid), dim3(512), LDS_BYTES, stream, a);
    a.ph_lo = MK_SPLIT_AT + 1 - MK_SPLIT_DUP; a.ph_hi = NPHASE; a.li = 1;
    hipLaunchKernelGGL(mk_fwd, dim3(grid), dim3(512), LDS_BYTES, stream, a);
#else
    a.ph_lo = 0; a.ph_hi = NPHASE;
    hipLaunchKernelGGL(mk_fwd, dim3(grid), dim3(512), LDS_BYTES, stream, a);
#endif
#if MK_PROBE_PHASE >= 0
    a.ph_lo = MK_PROBE_PHASE; a.ph_hi = MK_PROBE_PHASE + 1; a.flags = MK_PROBE_FLAGS;
    hipLaunchKernelGGL(mk_fwd, dim3(grid), dim3(512), LDS_BYTES, stream, a);
#endif
#else
    for (int p = 0; p < NPHASE; ++p) { a.ph_lo = p; a.ph_hi = p + 1; hipLaunchKernelGGL(mk_fwd, dim3(grid), dim3(512), LDS_BYTES, stream, a); }
#endif
}
```

```cpp
#include <hip/hip_runtime.h>
#include <hip/hip_cooperative_groups.h>
#include <cstdio>
namespace cg = cooperative_groups;

#ifndef MK_SPLIT_AT
#define MK_SPLIT_AT -1
#endif
#ifndef MK_SPLIT_DUP
#define MK_SPLIT_DUP 0
#endif
#ifndef MK_TIME_A
#define MK_TIME_A -1
#endif
#ifndef MK_TIME_B
#define MK_TIME_B -1
#endif
#ifndef MK_PROBE_FLAGS
#define MK_PROBE_FLAGS 0
#endif
#ifndef MK_PROBE_PHASE
#define MK_PROBE_PHASE -1
#endif
#ifndef MK_REP
#define MK_REP 0
#endif
#ifndef MK_ONE_LAUNCH
#define MK_ONE_LAUNCH 2
#endif

#define DEV __device__ __forceinline__
#define LAS __attribute__((address_space(3)))
typedef unsigned short bf16_t;
typedef short bf16x8 __attribute__((ext_vector_type(8)));
typedef float f32x4 __attribute__((ext_vector_type(4)));
typedef float f32x2 __attribute__((ext_vector_type(2)));
typedef unsigned u32x4 __attribute__((ext_vector_type(4)));
typedef unsigned u32x2 __attribute__((ext_vector_type(2)));

constexpr int NB = 32, SEQ = 2048, DM = 1024, TOK = NB * SEQ, CTXL = 256, CTOK = NB * CTXL;
constexpr int NG = 16, NP = 64, NH = 16, LC = 32;
constexpr int NCH_LAT = TOK / LC, NCH_CTX = CTOK / LC, NCH_PAD = 2304, UK = LC * NH, UGK = UK + 256, TRN = LC * NH;
static_assert(NCH_LAT + NCH_CTX == NCH_PAD && NCH_PAD % 256 == 0 && (UGK / 64) % 2 == 0 && (UK / 64) % 2 == 0, "S5 chunk geometry");
constexpr int CONVW = 768, NMOD = 6 * DM;
constexpr int NEXP = 16, DEXP = 512, NBUCKET = 24, MAXTILES = 280;
constexpr float RMS_EPS = 1e-6f;

constexpr size_t MiB = 1u << 20;
constexpr size_t WS_CTL = 0;
constexpr size_t WS_STAMP = 512 * 1024;
constexpr size_t WS_MOD = 1 * MiB;
constexpr size_t WS_APOW = 2 * MiB;
constexpr size_t WS_BBAR = 4 * MiB;
constexpr size_t WS_KTAB = 5 * MiB;
constexpr size_t WS_SB13 = 7 * MiB;
constexpr size_t WS_SH2 = 9 * MiB;
constexpr size_t WS_RB = 10 * MiB;
constexpr size_t WS_TOKB = 10 * MiB + 65536;
constexpr size_t WS_TOKW = 11 * MiB;
constexpr size_t WS_TOKR = 12 * MiB;
constexpr size_t WS_SEGC = 12 * MiB + 512 * 1024;
constexpr size_t WS_PERM = 13 * MiB;
constexpr size_t WS_TILES = 14 * MiB;
constexpr size_t WS_CSCALE = 15 * MiB;
constexpr size_t WS_RSCALE = 15 * MiB + 65536;
constexpr size_t WS_SLOT = 16 * MiB;
constexpr size_t WS_WR = 24 * MiB;
constexpr size_t WS_WGLU = 25 * MiB;
constexpr size_t WS_WIN = 26 * MiB;
constexpr size_t WS_WOUT = 32 * MiB;
constexpr size_t WS_WE = 34 * MiB;
constexpr size_t WS_W2 = 42 * MiB;
constexpr size_t WS_W13 = 58 * MiB;
constexpr size_t WS_TR = 186 * MiB;
constexpr size_t WS_E = 90 * MiB;
constexpr size_t WS_UG = 130 * MiB;
static_assert(WS_E + (size_t)16 * NCH_PAD * 256 * 4 <= WS_UG && WS_UG + (size_t)16 * NCH_PAD * UGK * 2 <= WS_TR && WS_TR + (size_t)16 * TRN * UGK * 2 <= 200 * MiB, "S5 workspace map");
constexpr size_t WS_G = 200 * MiB;
constexpr size_t WS_BG = 232 * MiB;
constexpr size_t WS_CV = 328 * MiB;
constexpr size_t WS_HX = 424 * MiB;
constexpr size_t WS_HID = WS_HX;
constexpr size_t WS_YMIX = 568 * MiB;
constexpr size_t WS_X1G = 696 * MiB;
constexpr size_t WS_MOE = WS_YMIX;
constexpr size_t WS_X1B = 824 * MiB;
constexpr size_t WS_END = 952 * MiB;

DEV unsigned cvt_pk_bf16(float lo, float hi) { unsigned r; asm volatile("v_cvt_pk_bf16_f32 %0, %1, %2" : "=v"(r) : "v"(lo), "v"(hi)); return r; }
DEV float bf2f(unsigned short h) { return __uint_as_float(((unsigned)h) << 16); }
DEV float bflo(unsigned w) { return __uint_as_float(w << 16); }
DEV float bfhi(unsigned w) { return __uint_as_float(w & 0xffff0000u); }
DEV float wave_sum(float v) {
#pragma unroll
    for (int o = 1; o < 64; o <<= 1) v += __shfl_xor(v, o);
    return v;
}
DEV float sigmoidf_(float x) { return __builtin_amdgcn_rcpf(1.0f + __expf(-x)); }
DEV float siluf_(float x) { return x * sigmoidf_(x); }
DEV float gelu_tanh(float x) { const float u = 0.7978845608028654f * (x + 0.044715f * x * x * x); return x * sigmoidf_(2.0f * u); }
typedef int v8i_t __attribute__((ext_vector_type(8)));
typedef int v4i_t __attribute__((ext_vector_type(4)));
DEV float clamp_e4m3(float v) { return __builtin_amdgcn_fmed3f(v, -448.0f, 448.0f); }
DEV unsigned pk4_fp8(float a, float b, float c, float d) { int w = 0; w = __builtin_amdgcn_cvt_pk_fp8_f32(clamp_e4m3(a), clamp_e4m3(b), w, false); w = __builtin_amdgcn_cvt_pk_fp8_f32(clamp_e4m3(c), clamp_e4m3(d), w, true); return (unsigned)w; }
constexpr float FP8_WSCALE = 16.0f;
DEV int ld_agent_i(const int* p) { return __hip_atomic_load(p, __ATOMIC_RELAXED, __HIP_MEMORY_SCOPE_AGENT); }

#ifndef PG8_SP2
#define PG8_SP2 true
#endif
namespace pg8 {
constexpr int BM = 256, BK = 64, HALF = 128, HTB = HALF * BK * 2, STAGE_BYTES = 8 * HTB;
__host__ __device__ __forceinline__ int lds_byte(int r, int c) { const int st = (r >> 4) * 2 + (c >> 5), rr = r & 15, cc = c & 31, ob = rr * 64 + cc * 2; return st * 1024 + (ob ^ (((ob >> 9) & 1) << 5)); }
__host__ __device__ __forceinline__ void stage_rc(int b, int& R, int& C) { const int st = b / 1024, sb = b % 1024, swz = sb ^ (((sb >> 9) & 1) << 5); R = (st >> 1) * 16 + swz / 64; C = (st & 1) * 32 + (swz % 64) / 2; }
__host__ __device__ __forceinline__ int perm32(int rho) { const int n = rho >> 4, i = rho & 15; return 8 * (i >> 2) + 4 * n + (i & 3); }

struct Unit {
    const char* A0; const char* A1; const char* B0; const char* B1;
    int ksA, ksB;
    int p0, p1, p2, p3, q;
};
DEV const char* pa(const Unit& u, int kt, int rot, int nt) { int k = kt + rot; k = k >= nt ? k - nt : k; return k < u.ksA ? u.A0 + (size_t)k * 128 : u.A1 + (size_t)(k - u.ksA) * 128; }
DEV const char* pb(const Unit& u, int kt, int rot, int nt) { int k = kt + rot; k = k >= nt ? k - nt : k; return k < u.ksB ? u.B0 + (size_t)k * 128 : u.B1 + (size_t)(k - u.ksB) * 128; }

template <class Epi, class Sched>
DEV void gemm_phase(LAS unsigned char* lds, const Sched& S, const Epi& E) {
    const int tid = threadIdx.x, wid = __builtin_amdgcn_readfirstlane(tid >> 6), lane = tid & 63, wr = wid >> 2, wc = wid & 3, fr = lane & 15, fq = lane >> 4;
    int nt = S.nt; asm volatile("" : "+s"(nt));
    const int rot = 2 * ((int)(blockIdx.x & 7) % (nt >> 1));
    unsigned voffB[2], vA[4];
#pragma unroll
    for (int i = 0; i < 2; ++i) { int R_, C_; stage_rc(tid * 16 + i * 8192, R_, C_); const int Rb = Epi::PERM ? ((R_ & ~31) + perm32(R_ & 31)) : R_;
        voffB[i] = (unsigned)Rb * S.ldb + (unsigned)C_ * 2u; }
    const size_t hstepB = (size_t)HALF * S.ldb;
    const unsigned ldsw = (unsigned)wid * 1024u;
    const int aoff = lds_byte(wr * 64 + fr, fq * 8), boff = lds_byte(wc * 32 + fr, fq * 8);
#define PG8_SA(b, h) (((b) * 2 + (h)) * HTB)
#define PG8_SB(b, h) ((4 + (b) * 2 + (h)) * HTB)
#define PG8_STAGE(bufoff, gbase, v0, v1) do { \
        __builtin_amdgcn_global_load_lds((const unsigned*)((const char*)(gbase) + (v0)), (LAS unsigned*)(lds + (bufoff) + ldsw), 16, 0, 0); \
        __builtin_amdgcn_global_load_lds((const unsigned*)((const char*)(gbase) + (v1)), (LAS unsigned*)(lds + (bufoff) + ldsw + 8192), 16, 0, 0); } while (0)
#define PG8_LDA(dst, b, h) do { if constexpr (Sched::FP8) { _Pragma("unroll") for (int m = 0; m < 4; ++m) { const v4i_t lo_ = *(const LAS v4i_t*)(lds + PG8_SA(b, h) + aoff + m * 2048), hi_ = *(const LAS v4i_t*)(lds + PG8_SA(b, h) + aoff + m * 2048 + 1024); \
            dst##8[m] = __builtin_shufflevector(lo_, hi_, 0, 1, 2, 3, 4, 5, 6, 7); } } \
        else { _Pragma("unroll") for (int m = 0; m < 4; ++m) _Pragma("unroll") for (int k = 0; k < 2; ++k) dst[m][k] = *(const LAS bf16x8*)(lds + PG8_SA(b, h) + aoff + m * 2048 + k * 1024); } } while (0)
#define PG8_LDB(dst, b, h) do { if constexpr (Sched::FP8) { _Pragma("unroll") for (int n = 0; n < 2; ++n) { const v4i_t lo_ = *(const LAS v4i_t*)(lds + PG8_SB(b, h) + boff + n * 2048), hi_ = *(const LAS v4i_t*)(lds + PG8_SB(b, h) + boff + n * 2048 + 1024); \
            dst##8[n] = __builtin_shufflevector(lo_, hi_, 0, 1, 2, 3, 4, 5, 6, 7); } } \
        else { _Pragma("unroll") for (int n = 0; n < 2; ++n) _Pragma("unroll") for (int k = 0; k < 2; ++k) dst[n][k] = *(const LAS bf16x8*)(lds + PG8_SB(b, h) + boff + n * 2048 + k * 1024); } } while (0)
#define PG8_MMA(ai, bj, At, Bt) do { __builtin_amdgcn_s_setprio(1); _Pragma("unroll") for (int m = 0; m < 4; ++m) _Pragma("unroll") for (int n = 0; n < 2; ++n) { \
        if constexpr (Sched::FP8)   \
            asm volatile("v_mfma_scale_f32_16x16x128_f8f6f4 %0, %1, %2, %0, %3, %3 op_sel_hi:[0,0,0]" : "+v"(acc[ai][bj][m][n]) : "v"(Bt##8[n]), "v"(At##8[m]), "v"(sc_one));   \
        else if constexpr (Sched::I8) { _Pragma("unroll") for (int k = 0; k < 2; ++k) acc[ai][bj][m][n] = __builtin_bit_cast(f32x4, __builtin_amdgcn_mfma_i32_16x16x64_i8(__builtin_bit_cast(v4i_t, Bt[n][k]), __builtin_bit_cast(v4i_t, At[m][k]), __builtin_bit_cast(v4i_t, acc[ai][bj][m][n]), 0, 0, 0)); }   \
        else { _Pragma("unroll") for (int k = 0; k < 2; ++k) acc[ai][bj][m][n] = __builtin_amdgcn_mfma_f32_16x16x32_bf16(Bt[n][k], At[m][k], acc[ai][bj][m][n], 0, 0, 0); } } \
        __builtin_amdgcn_s_setprio(0); } while (0)
#define PG8_WAIT_V(n) asm volatile("s_waitcnt vmcnt(" #n ")" ::: "memory")
#define PG8_WAIT_L(n) asm volatile("s_waitcnt lgkmcnt(" #n ")" ::: "memory")
#define PG8_BAR __builtin_amdgcn_s_barrier()
#define PG8_SCHED __builtin_amdgcn_sched_barrier(0)
    Unit cur, nxt; int ui = 0;
    int aux_t = 0; asm volatile("" : "+s"(aux_t));
    if (!S.next(0, cur)) return;
    f32x4 acc[2][2][4][2];
#pragma unroll
    for (int a = 0; a < 2; ++a)
#pragma unroll
        for (int b = 0; b < 2; ++b)
#pragma unroll
            for (int m = 0; m < 4; ++m)
#pragma unroll
                for (int n = 0; n < 2; ++n) acc[a][b][m][n] = (f32x4){0.f, 0.f, 0.f, 0.f};
    bf16x8 At[4][2], B0[2][2], B1[2][2];
    v8i_t At8[4], B08[2], B18[2];
    int sc_one = 0x7f7f7f7f; asm volatile("" : "+v"(sc_one));
    if constexpr (Sched::GATHER) S.rows(cur, tid, vA);
    else {
#pragma unroll
        for (int h = 0; h < 2; ++h)
#pragma unroll
            for (int i = 0; i < 2; ++i) { int R_, C_; stage_rc(tid * 16 + i * 8192, R_, C_); vA[h * 2 + i] = (unsigned)(h * HALF + R_) * S.lda + (unsigned)C_ * 2u; }
    }
    {
        const char* a0 = pa(cur, 0, rot, nt); const char* b0 = pb(cur, 0, rot, nt); const char* a1 = pa(cur, 1, rot, nt); const char* b1 = pb(cur, 1, rot, nt);
        if constexpr (PG8_SP2) {
            PG8_STAGE(PG8_SB(0, 0), b0, voffB[0], voffB[1]); PG8_STAGE(PG8_SB(0, 1), b0 + hstepB, voffB[0], voffB[1]); PG8_STAGE(PG8_SA(0, 0), a0, vA[0], vA[1]); PG8_STAGE(PG8_SA(0, 1), a0, vA[2], vA[3]);
            if (wr == 1) PG8_BAR;
            PG8_WAIT_V(2); PG8_BAR;
            PG8_STAGE(PG8_SB(1, 0), b1, voffB[0], voffB[1]); PG8_STAGE(PG8_SA(1, 0), a1, vA[0], vA[1]); PG8_STAGE(PG8_SB(1, 1), b1 + hstepB, voffB[0], voffB[1]);
            PG8_WAIT_V(6); PG8_BAR;
        } else {
        PG8_STAGE(PG8_SB(0, 0), b0, voffB[0], voffB[1]); PG8_STAGE(PG8_SA(0, 0), a0, vA[0], vA[1]); PG8_STAGE(PG8_SB(0, 1), b0 + hstepB, voffB[0], voffB[1]); PG8_STAGE(PG8_SA(0, 1), a0, vA[2], vA[3]);
        if (wr == 1) PG8_BAR;
        PG8_WAIT_V(4); PG8_BAR;
        PG8_STAGE(PG8_SB(1, 0), b1, voffB[0], voffB[1]); PG8_STAGE(PG8_SA(1, 0), a1, vA[0], vA[1]); PG8_STAGE(PG8_SB(1, 1), b1 + hstepB, voffB[0], voffB[1]);
        PG8_WAIT_V(6); PG8_BAR;
        }
    }
    for (;;) {
        const bool has_next = S.next(ui + 1, nxt);
        if (!has_next) nxt = cur;
#pragma unroll 1
        for (int t = 0; t < nt; t += 2) {
            const bool last = (t == nt - 2);
            const char* a1 = pa(cur, t + 1, rot, nt);
            const char* a2; const char* b2;
            if (last) { a2 = pa(nxt, 0, rot, nt); b2 = pb(nxt, 0, rot, nt); } else { a2 = pa(cur, t + 2, rot, nt); b2 = pb(cur, t + 2, rot, nt); }
            const char* a3 = a2 + 128; const char* b3 = b2 + 128;
            if constexpr (PG8_SP2) {
            PG8_LDB(B0, 0, 0); PG8_LDB(B1, 0, 1); PG8_SCHED; PG8_LDA(At, 0, 0); PG8_STAGE(PG8_SA(1, 1), a1, vA[2], vA[3]);
            if constexpr (Sched::GATHER) { if (last && has_next) S.rows(nxt, tid, vA); }
            PG8_WAIT_V(8); PG8_WAIT_L(0); PG8_BAR; PG8_MMA(0, 0, At, B0); PG8_MMA(0, 1, At, B1); PG8_BAR; PG8_SCHED;
            PG8_LDA(At, 0, 1); PG8_STAGE(PG8_SB(0, 0), b2, voffB[0], voffB[1]); PG8_STAGE(PG8_SB(0, 1), b2 + hstepB, voffB[0], voffB[1]); PG8_STAGE(PG8_SA(0, 0), a2, vA[0], vA[1]);
            if constexpr (Sched::AUX) { if (t == aux_t) S.aux(cur, nxt, lds, wid, lane); }
            PG8_WAIT_V(8); PG8_WAIT_L(0); PG8_BAR; PG8_MMA(1, 0, At, B0); PG8_MMA(1, 1, At, B1); PG8_BAR; PG8_SCHED;
            PG8_LDB(B0, 1, 0); PG8_LDB(B1, 1, 1); PG8_SCHED; PG8_LDA(At, 1, 0); PG8_STAGE(PG8_SA(0, 1), a2, vA[2], vA[3]);
            PG8_WAIT_V(8); PG8_WAIT_L(0); PG8_BAR; PG8_MMA(0, 0, At, B0); PG8_MMA(0, 1, At, B1); PG8_BAR; PG8_SCHED;
            PG8_LDA(At, 1, 1); PG8_STAGE(PG8_SB(1, 0), b3, voffB[0], voffB[1]); PG8_STAGE(PG8_SB(1, 1), b3 + hstepB, voffB[0], voffB[1]); PG8_STAGE(PG8_SA(1, 0), a3, vA[0], vA[1]);
            PG8_WAIT_V(8); PG8_WAIT_L(0); PG8_BAR; PG8_MMA(1, 0, At, B0); PG8_MMA(1, 1, At, B1); PG8_BAR; PG8_SCHED;
            } else {
            PG8_LDB(B0, 0, 0); PG8_SCHED; PG8_LDA(At, 0, 0); PG8_STAGE(PG8_SA(1, 1), a1, vA[2], vA[3]);
            if constexpr (Sched::GATHER) { if (last && has_next) S.rows(nxt, tid, vA); }
            PG8_WAIT_L(8); PG8_BAR; PG8_WAIT_L(0); PG8_MMA(0, 0, At, B0); PG8_BAR; PG8_SCHED;
            PG8_LDB(B1, 0, 1); PG8_STAGE(PG8_SB(0, 0), b2, voffB[0], voffB[1]);
            PG8_BAR; PG8_WAIT_L(0); PG8_MMA(0, 1, At, B1); PG8_BAR;
            PG8_LDA(At, 0, 1); PG8_STAGE(PG8_SA(0, 0), a2, vA[0], vA[1]);
            if constexpr (Sched::AUX) { if (t == aux_t) S.aux(cur, nxt, lds, wid, lane); }
            PG8_BAR; PG8_WAIT_L(0); PG8_MMA(1, 0, At, B0); PG8_BAR; PG8_SCHED;
            PG8_STAGE(PG8_SB(0, 1), b2 + hstepB, voffB[0], voffB[1]);
            PG8_WAIT_V(6); PG8_BAR; PG8_MMA(1, 1, At, B1); PG8_BAR;
            PG8_LDB(B0, 1, 0); PG8_SCHED; PG8_LDA(At, 1, 0); PG8_STAGE(PG8_SA(0, 1), a2, vA[2], vA[3]);
            PG8_WAIT_L(8); PG8_BAR; PG8_WAIT_L(0); PG8_MMA(0, 0, At, B0); PG8_BAR; PG8_SCHED;
            PG8_LDB(B1, 1, 1); PG8_STAGE(PG8_SB(1, 0), b3, voffB[0], voffB[1]);
            PG8_BAR; PG8_WAIT_L(0); PG8_MMA(0, 1, At, B1); PG8_BAR;
            PG8_LDA(At, 1, 1); PG8_STAGE(PG8_SA(1, 0), a3, vA[0], vA[1]);
            PG8_BAR; PG8_WAIT_L(0); PG8_MMA(1, 0, At, B0); PG8_BAR; PG8_SCHED;
            PG8_STAGE(PG8_SB(1, 1), b3 + hstepB, voffB[0], voffB[1]);
            PG8_WAIT_V(6); PG8_BAR; PG8_MMA(1, 1, At, B1); PG8_BAR;
            }
        }
        if (wr == 0) PG8_BAR;
        if constexpr (Sched::FP8) asm volatile("s_nop 15\n\ts_nop 15" ::: "memory");
        E(acc, cur, wr, wc, fr, fq);
        if (!has_next) break;
#pragma unroll
        for (int a = 0; a < 2; ++a)
#pragma unroll
            for (int b = 0; b < 2; ++b)
#pragma unroll
                for (int m = 0; m < 4; ++m)
#pragma unroll
                    for (int n = 0; n < 2; ++n) acc[a][b][m][n] = (f32x4){0.f, 0.f, 0.f, 0.f};
        cur = nxt; ++ui;
        if (wr == 1) PG8_BAR;
    }
    PG8_WAIT_V(0);
    PG8_BAR;
#undef PG8_SA
#undef PG8_SB
#undef PG8_STAGE
#undef PG8_LDA
#undef PG8_LDB
#undef PG8_MMA
#undef PG8_WAIT_V
#undef PG8_WAIT_L
#undef PG8_BAR
#undef PG8_SCHED
}

DEV void static_tile(int L, int nM, int nN, int& pm, int& pn) {
    const int nwg = nM * nN; int wgid = L;
    { const int q = nwg / 8, r = nwg % 8, xcd = wgid % 8, off = wgid / 8; wgid = (xcd < r ? xcd * (q + 1) : r * (q + 1) + (xcd - r) * q) + off; }
    const int nig = 8 * nN, gid = wgid / nig, fm = gid * 8, gsz = (nM - fm) < 8 ? (nM - fm) : 8;
    pm = fm + ((wgid % nig) % gsz); pn = (wgid % nig) / gsz;
}
}
using pg8::Unit;
constexpr int AUX_SLOT_OFF = 131072, AUX_BIAS_OFF = 131072 + 8192, AUX_TILE_OFF = AUX_BIAS_OFF + 16384;
DEV void glds16(const void* g, LAS unsigned char* l) { __builtin_amdgcn_global_load_lds((const unsigned*)g, (LAS unsigned*)l, 16, 0, 0); }

struct Args { const float* in[29]; float* out; unsigned char* ws; int ph_lo, ph_hi, flags, li; };
static_assert(sizeof(Args) == 31 * 8 + 16, "Args has no padding");
enum { I_X = 0, I_C, I_CTX, I_CCTX, I_WMOD, I_BMOD, I_N1G, I_N2G, I_WIN, I_LRE, I_LIM, I_LOGDT, I_BRE, I_BIM, I_CRE, I_CIM, I_S5D, I_WGLU, I_BGLU, I_CONVW, I_WOUT,
       I_RGW, I_RGB, I_REW, I_REB, I_W1, I_W3, I_W2, I_FING };

struct Frame {
    LAS unsigned char* lds;
    int G, bx, vcu, flags;
    const float* in[29]; float* out; unsigned char* ws;
};
#define WSP(T, off) ((T*)(F.ws + (off)))
#define F_TID ((int)threadIdx.x)
#define F_LANE ((int)threadIdx.x & 63)
#define F_WAVE (__builtin_amdgcn_readfirstlane((int)threadIdx.x >> 6))

DEV void p0_mod_item(Frame& F, int item) {
    LAS float* st = (LAS float*)F.lds;
    LAS float* red = (LAS float*)(F.lds + 512 * 36 * 4);
    const float* c = F.in[I_C]; const float* cc = F.in[I_CCTX]; const float* wm = F.in[I_WMOD]; const float* bm = F.in[I_BMOD];
    float* mod = WSP(float, WS_MOD);
    const int col = F_TID & 31, kc = F_TID >> 5, j0 = item * 32;
    float acc[36];
#pragma unroll
    for (int n = 0; n < 36; ++n) acc[n] = 0.f;
    for (int half = 0; half < 2; ++half) {
        __syncthreads();
        { float cv_[33];
#pragma unroll
          for (int n = 0; n < 33; ++n) cv_[n] = (n < 32) ? c[n * DM + half * 512 + F_TID] : cc[half * 512 + F_TID];
#pragma unroll
          for (int n = 0; n < 33; ++n) st[F_TID * 36 + n] = siluf_(cv_[n]); }
        float wv[32];
#pragma unroll
        for (int i = 0; i < 32; ++i) wv[i] = __builtin_nontemporal_load(&wm[(size_t)(half * 512 + kc + 16 * i) * NMOD + j0 + col]);
        __syncthreads();
#pragma unroll 2
        for (int i = 0; i < 32; ++i) { const int kk = kc + 16 * i; const float w = wv[i]; const LAS f32x4* sp = (const LAS f32x4*)(st + kk * 36);
#pragma unroll
            for (int q = 0; q < 9; ++q) { const f32x4 sv = sp[q]; acc[4 * q] += sv.x * w; acc[4 * q + 1] += sv.y * w; acc[4 * q + 2] += sv.z * w; acc[4 * q + 3] += sv.w * w; }
        }
    }
#pragma unroll
    for (int n = 0; n < 33; ++n) red[(kc * 33 + n) * 32 + col] = acc[n];
    __syncthreads();
    for (int idx = F_TID; idx < 33 * 32; idx += 512) { const int n = idx >> 5, cl = idx & 31; float s_ = bm[j0 + cl];
#pragma unroll
        for (int q = 0; q < 16; ++q) s_ += red[(q * 33 + n) * 32 + cl];
        mod[n * NMOD + j0 + cl] = s_; }
    __syncthreads();
}
DEV void p0_transpose_item(const float* W, int N, int k0, int n0, bf16_t* dst, int ldk, LAS float* scr, int lane) {
    float t_[32];
#pragma unroll
    for (int i = 0; i < 32; ++i) t_[i] = __builtin_nontemporal_load(&W[(size_t)(k0 + 2 * i + (lane >> 5)) * N + n0 + (lane & 31)]);
#pragma unroll
    for (int i = 0; i < 32; ++i) scr[(2 * i + (lane >> 5)) * 33 + (lane & 31)] = t_[i];
    asm volatile("s_waitcnt lgkmcnt(0)" ::: "memory");
    const int cch = lane & 7;
#pragma unroll
    for (int j = 0; j < 4; ++j) { const int n = (lane >> 3) + 8 * j; const LAS float* s = scr + (8 * cch) * 33 + n;
        u32x4 o; o.x = cvt_pk_bf16(s[0 * 33], s[1 * 33]); o.y = cvt_pk_bf16(s[2 * 33], s[3 * 33]); o.z = cvt_pk_bf16(s[4 * 33], s[5 * 33]); o.w = cvt_pk_bf16(s[6 * 33], s[7 * 33]);
        *(u32x4*)(dst + (size_t)n * ldk + k0 + 8 * cch) = o; }
    asm volatile("s_waitcnt lgkmcnt(0)" ::: "memory");
}
DEV void p0_transpose_item_fp8(const float* W, int N, int k0, int n0, unsigned char* dst, int ldk, float scale, LAS float* scr, int lane) {
    float t_[32];
#pragma unroll
    for (int i = 0; i < 32; ++i) t_[i] = __builtin_nontemporal_load(&W[(size_t)(k0 + 2 * i + (lane >> 5)) * N + n0 + (lane & 31)]);
#pragma unroll
    for (int i = 0; i < 32; ++i) scr[(2 * i + (lane >> 5)) * 33 + (lane & 31)] = t_[i] * scale;
    asm volatile("s_waitcnt lgkmcnt(0)" ::: "memory");
    const int cch = lane & 7;
#pragma unroll
    for (int j = 0; j < 4; ++j) { const int n = (lane >> 3) + 8 * j; const LAS float* s = scr + (8 * cch) * 33 + n;
        u32x2 o; o.x = pk4_fp8(s[0 * 33], s[1 * 33], s[2 * 33], s[3 * 33]); o.y = pk4_fp8(s[4 * 33], s[5 * 33], s[6 * 33], s[7 * 33]);
        *(u32x2*)(dst + (size_t)n * ldk + k0 + 8 * cch) = o; }
    asm volatile("s_waitcnt lgkmcnt(0)" ::: "memory");
}
DEV int win_fcol(int kind, int ch) { return 128 * (kind >> 1) + 32 * (ch >> 4) + 8 * ((ch >> 2) & 3) + 4 * (kind & 1) + (ch & 3); }
DEV int win_drow(int s) {
    if (s < 256) return s;
    if (s < 1024) { const int j = s - 256; return j < 384 ? (1 + (j >> 6)) * 256 + win_fcol(0, j & 63) : (1 + ((j - 384) >> 6)) * 256 + win_fcol(3, (j - 384) & 63); }
    if (s < 1792) { const int j = s - 1024; return j < 384 ? (1 + (j >> 6)) * 256 + win_fcol(1, j & 63) : (7 + ((j - 384) >> 7)) * 256 + ((j - 384) & 127); }
    { const int j = s - 1792; return j < 384 ? (1 + (j >> 6)) * 256 + win_fcol(2, j & 63) : (7 + ((j - 384) >> 7)) * 256 + 128 + ((j - 384) & 127); }
}
DEV void p0_win_group_i8(const float* W, int n0, unsigned char* dst, float* cscale, LAS unsigned char* lds, int wave, int lane) {
    LAS float* scr = (LAS float*)(lds + wave * 8448); LAS float* mxs = (LAS float*)(lds + 8 * 8448);
    float t0[32], t1[32];
#pragma unroll
    for (int i = 0; i < 32; ++i) { t0[i] = __builtin_nontemporal_load(&W[(size_t)(wave * 128 + 2 * i + (lane >> 5)) * 2560 + n0 + (lane & 31)]); t1[i] = __builtin_nontemporal_load(&W[(size_t)(wave * 128 + 64 + 2 * i + (lane >> 5)) * 2560 + n0 + (lane & 31)]); }
    float mx = 0.f;
#pragma unroll
    for (int i = 0; i < 32; ++i) mx = fmaxf(mx, fmaxf(fabsf(t0[i]), fabsf(t1[i])));
    mx = fmaxf(mx, __shfl_xor(mx, 32));
    if (lane < 32) mxs[wave * 32 + lane] = mx;
    __syncthreads();
    mx = 0.f;
#pragma unroll
    for (int w = 0; w < 8; ++w) mx = fmaxf(mx, mxs[w * 32 + (lane & 31)]);
    const float sc = (mx > 0.f) ? mx * (1.0f / 127.0f) : 1.0f, inv = 1.0f / sc;
    if (wave == 0 && lane < 32) cscale[win_drow(n0 + lane)] = sc;
#pragma unroll
    for (int hb = 0; hb < 2; ++hb) {
#pragma unroll
        for (int i = 0; i < 32; ++i) scr[(2 * i + (lane >> 5)) * 33 + (lane & 31)] = (hb ? t1[i] : t0[i]) * inv;
        asm volatile("s_waitcnt lgkmcnt(0)" ::: "memory");
        const int cch = lane & 7;
#pragma unroll
        for (int j = 0; j < 4; ++j) { const int n = (lane >> 3) + 8 * j; const LAS float* s_ = scr + (8 * cch) * 33 + n; unsigned w0 = 0, w1 = 0;
#pragma unroll
            for (int q = 0; q < 4; ++q) { w0 |= ((unsigned)__float2int_rn(s_[q * 33]) & 0xffu) << (8 * q); w1 |= ((unsigned)__float2int_rn(s_[(4 + q) * 33]) & 0xffu) << (8 * q); }
            *(u32x2*)(dst + (size_t)win_drow(n0 + n) * 1024 + wave * 128 + hb * 64 + 8 * cch) = (u32x2){w0, w1}; }
        asm volatile("s_waitcnt lgkmcnt(0)" ::: "memory"); }
    __syncthreads();
}
DEV void sincos_rev(double rev, double& s, double& c) {
    const double fr = rev - __builtin_rint(rev);
    const double q = __builtin_rint(fr * 4.0);
    const double y = (fr - q * 0.25) * 6.283185307179586476925;
    const double y2 = y * y;
    const double sy = y * (1.0 + y2 * (-1.0 / 6 + y2 * (1.0 / 120 + y2 * (-1.0 / 5040 + y2 * (1.0 / 362880 + y2 * (-1.0 / 39916800 + y2 * (1.0 / 6227020800.0)))))));
    const double cy = 1.0 + y2 * (-0.5 + y2 * (1.0 / 24 + y2 * (-1.0 / 720 + y2 * (1.0 / 40320 + y2 * (-1.0 / 3628800 + y2 * (1.0 / 479001600.0 + y2 * (-1.0 / 87178291200.0)))))));
    const int qi = ((int)q) & 3;
    s = (qi == 0) ? sy : (qi == 1) ? cy : (qi == 2) ? -sy : -cy;
    c = (qi == 0) ? cy : (qi == 1) ? -sy : (qi == 2) ? -cy : sy;
}
DEV double exp_d(double x) {
    const double k = __builtin_rint(x * 1.4426950408889634074);
    const double r = x - k * 0.69314718055994530942;
    double p = 1.0 / 6227020800.0;
    p = p * r + 1.0 / 479001600.0; p = p * r + 1.0 / 39916800.0; p = p * r + 1.0 / 3628800.0; p = p * r + 1.0 / 362880.0; p = p * r + 1.0 / 40320.0; p = p * r + 1.0 / 5040.0;
    p = p * r + 1.0 / 720.0; p = p * r + 1.0 / 120.0; p = p * r + 1.0 / 24.0; p = p * r + 1.0 / 6.0; p = p * r + 0.5; p = p * r + 1.0; p = p * r + 1.0;
    const long long e = (long long)k + 1023;
    return p * __builtin_bit_cast(double, (unsigned long long)e << 52);
}
DEV void p0_phase(Frame& F) {
    if (!(F.flags & 2)) for (int it = F.bx; it < NMOD / 32; it += F.G) p0_mod_item(F, it);
    __syncthreads();
    if (!(F.flags & 4)) {
        const int fb = (F.G > NMOD / 32) ? NMOD / 32 : 0, nf = F.G - fb;
        if (F.bx >= fb) for (int grp = F.bx - fb; grp < 80; grp += nf) {
            const int n0 = grp * 32;
            p0_win_group_i8(F.in[I_WIN], n0, WSP(unsigned char, WS_WIN), WSP(float, WS_CSCALE), F.lds, F_WAVE, F_LANE);
        }
    }
    if (!(F.flags & 4)) {
        LAS float* scr = (LAS float*)(F.lds + F_WAVE * 8448);
        bf16_t* Win = WSP(bf16_t, WS_WIN); bf16_t* Wout = WSP(bf16_t, WS_WOUT); bf16_t* Wglu = WSP(bf16_t, WS_WGLU); unsigned char* W13 = WSP(unsigned char, WS_W13); unsigned char* W2 = WSP(unsigned char, WS_W2);
        const int gw = F.vcu * 8 + F_WAVE, NGW = F.G * 8;
        constexpr int I_IN = 0, I_OUT = 16 * 32, I_GLU = 4 * 8, I_E = 16 * 256;
        for (int it = gw; it < I_IN + I_OUT + I_GLU + 3 * I_E; it += NGW) {
            int r = it;
            r -= I_IN;
            if (r < I_OUT) { const int kb = r / 32, nb = r % 32; p0_transpose_item(F.in[I_WOUT], 1024, kb * 64, nb * 32, Wout + (size_t)(nb * 32) * 1024, 1024, scr, F_LANE); continue; }
            r -= I_OUT;
            if (r < I_GLU) { const int kb = r / 8, nb = r % 8; p0_transpose_item(F.in[I_WGLU], 256, kb * 64, nb * 32, Wglu + (size_t)(nb * 32) * 256, 256, scr, F_LANE); continue; }
            r -= I_GLU;
            if (r < 2 * I_E) { const int which = r / I_E; const int rr = r % I_E; const int e = rr >> 8, rem = rr & 255, kb = rem >> 4, nb = rem & 15, n0 = nb * 32;
                const int drow = (n0 >> 7) * 256 + which * 128 + (n0 & 127);
                p0_transpose_item_fp8(F.in[which ? I_W3 : I_W1] + (size_t)e * 1024 * 512, 512, kb * 64, n0, W13 + ((size_t)e * 1024 + drow) * 1024, 1024, FP8_WSCALE, scr, F_LANE); continue; }
            r -= 2 * I_E;
            { const int e = r >> 8, rem = r & 255, kb = rem >> 5, nb = rem & 31;
                p0_transpose_item_fp8(F.in[I_W2] + (size_t)e * 512 * 1024, 1024, kb * 64, nb * 32, W2 + ((size_t)e * 1024 + nb * 32) * 512, 512, FP8_WSCALE, scr, F_LANE); }
        }
    }
    {
        bf16_t* Wr = WSP(bf16_t, WS_WR);
        for (int idx = F.bx * 512 + F_TID; idx < 32 * 1024; idx += F.G * 512) { const int l = idx >> 10, k = idx & 1023;
            const float v = (l < 4) ? F.in[I_RGW][k * 4 + l] : (l < 20) ? F.in[I_REW][k * 16 + (l - 4)] : 0.f;
            Wr[idx] = (bf16_t)(cvt_pk_bf16(v, 0.f) & 0xffffu); }
    }
    if (!(F.flags & 8)) {
        f32x2* APOW = WSP(f32x2, WS_APOW); f32x2* BBAR = WSP(f32x2, WS_BBAR);
        const int gt = F.bx * 512 + F_TID, NT = F.G * 512;
        for (int idx = gt; idx < 2 * 16 * 65 * 64; idx += NT) {
            const int p = idx & 63, j = (idx >> 6) % 65, dg = idx / (64 * 65);
            const double lre = F.in[I_LRE][dg * 64 + p], lim = F.in[I_LIM][dg * 64 + p], dt = exp_d((double)F.in[I_LOGDT][dg]);
            const double mag = exp_d(lre * dt * j); double s, c; sincos_rev(lim * dt * j * 0.15915494309189533577, s, c);
            APOW[idx] = (f32x2){(float)(mag * c), (float)(mag * s)};
        }
        for (int idx = gt; idx < 2 * 16 * 64 * 16; idx += NT) {
            const int dgp = idx >> 4, dg = dgp >> 6;
            const double lre = F.in[I_LRE][dgp], lim = F.in[I_LIM][dgp], dt = exp_d((double)F.in[I_LOGDT][dg]);
            const double mag = exp_d(lre * dt); double s, c; sincos_rev(lim * dt * 0.15915494309189533577, s, c);
            const double nr = mag * c - 1.0, ni = mag * s, d2 = lre * lre + lim * lim;
            const double qr = (nr * lre + ni * lim) / d2, qi = (ni * lre - nr * lim) / d2;
            const double br = F.in[I_BRE][idx], bi = F.in[I_BIM][idx];
            BBAR[idx] = (f32x2){(float)(qr * br - qi * bi), (float)(qr * bi + qi * br)};
        }
    }
}

constexpr int LZ_WAVE = 16384;
DEV void lz_issue(const void* g, LAS unsigned char* lz, int piece) { __builtin_amdgcn_global_load_lds((const unsigned*)g, (LAS unsigned*)(lz + piece * 1024), 16, 0, 0); }
DEV void lz_issue_nt(const void* g, LAS unsigned char* lz, int piece) { __builtin_amdgcn_global_load_lds((const unsigned*)g, (LAS unsigned*)(lz + piece * 1024), 16, 0, 2); }
#define LZ_WAIT(n) asm volatile("s_waitcnt vmcnt(" #n ")" ::: "memory")

DEV void p1_norm_rows(Frame& F) {
    const float* mod = WSP(float, WS_MOD); bf16_t* HX = WSP(bf16_t, WS_HX); const float* g = F.in[I_N1G];
    const bool isctx = F.bx < 32;
    const int nlw = (F.G - 32) * 8, w = (F.bx - 32) * 8 + F_WAVE, rpw = (TOK + nlw - 1) / nlw;
    const int rbeg = isctx ? (TOK + F.bx * 256 + F_WAVE * 32) : (w * rpw < TOK ? w * rpw : TOK), rend = isctx ? rbeg + 32 : ((w + 1) * rpw < TOK ? (w + 1) * rpw : TOK);
    const int nb = (rend - rbeg + 3) >> 2;
    LAS unsigned char* lz = F.lds + F_WAVE * LZ_WAVE;
#define P1_ROW0(b) (rbeg + 4 * (b))
#define P1_ISSUE(b) do { const int r0_ = P1_ROW0(b); _Pragma("unroll") for (int r = 0; r < 4; ++r) { const int m_ = (r0_ + r < rend) ? r0_ + r : rend - 1; \
        const float* xp_ = ((m_ < TOK) ? F.in[I_X] + (size_t)m_ * DM : F.in[I_CTX] + (size_t)(m_ - TOK) * DM) + 4 * F_LANE; \
        _Pragma("unroll") for (int j = 0; j < 4; ++j) lz_issue_nt(xp_ + 256 * j, lz, r * 4 + j); } } while (0)
    int ncur = -1; f32x4 gs[4], sh[4];
    if (nb > 0) P1_ISSUE(0);
#pragma unroll 1
    for (int b = 0; b < nb; ++b) {
        LZ_WAIT(0);
        f32x4 cur[4][4];
#pragma unroll
        for (int r = 0; r < 4; ++r)
#pragma unroll
            for (int j = 0; j < 4; ++j) cur[r][j] = *(const LAS f32x4*)(lz + (r * 4 + (F_LANE >> 4)) * 1024 + (F_LANE & 15) * 64 + j * 16);
        asm volatile("s_waitcnt lgkmcnt(0)" ::: "memory");
        if (b + 1 < nb) P1_ISSUE(b + 1);
        float ss[4];
#pragma unroll
        for (int r = 0; r < 4; ++r) { float a = 0.f;
#pragma unroll
            for (int j = 0; j < 4; ++j) a += (cur[r][j].x * cur[r][j].x + cur[r][j].y * cur[r][j].y) + (cur[r][j].z * cur[r][j].z + cur[r][j].w * cur[r][j].w);
            ss[r] = a; }
#pragma unroll
        for (int o = 1; o < 64; o <<= 1) { ss[0] += __shfl_xor(ss[0], o); ss[1] += __shfl_xor(ss[1], o); ss[2] += __shfl_xor(ss[2], o); ss[3] += __shfl_xor(ss[3], o); }
        const int r0 = P1_ROW0(b);
#pragma unroll
        for (int r = 0; r < 4; ++r) {
            const int m = (r0 + r < rend) ? r0 + r : rend - 1; const int n = (m < TOK) ? (m >> 11) : 32;
            if (n != ncur) { ncur = n;
#pragma unroll
                for (int j = 0; j < 4; ++j) { gs[j] = ((const f32x4*)g)[4 * F_LANE + j] * (1.0f + ((const f32x4*)(mod + n * NMOD + DM))[4 * F_LANE + j]); sh[j] = ((const f32x4*)(mod + n * NMOD))[4 * F_LANE + j]; } }
            if (m < TOK) {
                u32x4 xb0, xb1; xb0.x = cvt_pk_bf16(cur[r][0].x, cur[r][0].y); xb0.y = cvt_pk_bf16(cur[r][0].z, cur[r][0].w); xb0.z = cvt_pk_bf16(cur[r][1].x, cur[r][1].y); xb0.w = cvt_pk_bf16(cur[r][1].z, cur[r][1].w);
                xb1.x = cvt_pk_bf16(cur[r][2].x, cur[r][2].y); xb1.y = cvt_pk_bf16(cur[r][2].z, cur[r][2].w); xb1.z = cvt_pk_bf16(cur[r][3].x, cur[r][3].y); xb1.w = cvt_pk_bf16(cur[r][3].z, cur[r][3].w);
                bf16_t* xbp = WSP(bf16_t, WS_X1B) + (size_t)m * DM + 16 * F_LANE; *(u32x4*)xbp = xb0; *(u32x4*)(xbp + 8) = xb1; }
            const float rs = 1.0f / sqrtf(ss[r] * (1.f / DM) + RMS_EPS);
            f32x4 y[4]; float mx = 0.f;
#pragma unroll
            for (int j = 0; j < 4; ++j) { y[j] = (cur[r][j] * rs) * gs[j] + sh[j]; mx = fmaxf(fmaxf(mx, fmaxf(fabsf(y[j].x), fabsf(y[j].y))), fmaxf(fabsf(y[j].z), fabsf(y[j].w))); }
#pragma unroll
            for (int o = 1; o < 64; o <<= 1) mx = fmaxf(mx, __shfl_xor(mx, o));
            const float qs = (mx > 0.f) ? mx * (1.0f / 127.0f) : 1.0f, qi = 1.0f / qs;
            if (F_LANE == 0) WSP(float, WS_RSCALE)[m] = qs;
            u32x4 ow;
#pragma unroll
            for (int j = 0; j < 4; ++j) ow[j] = ((unsigned)__float2int_rn(y[j].x * qi) & 0xffu) | (((unsigned)__float2int_rn(y[j].y * qi) & 0xffu) << 8) | (((unsigned)__float2int_rn(y[j].z * qi) & 0xffu) << 16) | (((unsigned)__float2int_rn(y[j].w * qi) & 0xffu) << 24);
            *(u32x4*)((unsigned char*)HX + (size_t)m * DM + 16 * F_LANE) = ow;
        }
    }
#undef P1_ISSUE
#undef P1_ROW0
}
constexpr int KT_BS = 131072, KT_CR = KT_BS + 8192, KT_CI = KT_CR + 4096, KT_AP = KT_CI + 4096;
DEV void p1_ktab_stage(Frame& F, int b0, int nblk) {
    int tid_ = threadIdx.x; asm volatile("" : "+v"(tid_)); const int lane_ = tid_ & 63, wave_ = __builtin_amdgcn_readfirstlane(tid_ >> 6);
    const int gt0 = (F.bx - b0) * 512; if (gt0 >= 2 * 16 * LC * 16 * 4) return;
    const int dg = gt0 / (64 * LC), j0 = (gt0 >> 6) % LC;
    const char* srcB = (const char*)(WSP(f32x2, WS_BBAR) + (size_t)dg * 64 * 16); const char* srcR = (const char*)(F.in[I_CRE] + (size_t)dg * 16 * 64); const char* srcI = (const char*)(F.in[I_CIM] + (size_t)dg * 16 * 64);
    const char* srcA = (const char*)(WSP(f32x2, WS_APOW) + (size_t)(dg * 65 + j0) * 64);
    for (int pc = wave_; pc < 20; pc += 8) {
        const char* s_ = pc < 8 ? srcB + pc * 1024 : pc < 12 ? srcR + (pc - 8) * 1024 : pc < 16 ? srcI + (pc - 12) * 1024 : srcA + (pc - 16) * 1024;
        glds16(s_ + lane_ * 16, F.lds + KT_BS + pc * 1024); }
}
DEV void p1_ktab(Frame& F, int b0, int nblk) {
    int tid_ = threadIdx.x; asm volatile("" : "+v"(tid_)); const int lane_ = tid_ & 63, wave_ = __builtin_amdgcn_readfirstlane(tid_ >> 6);
    asm volatile("s_waitcnt vmcnt(0)" ::: "memory"); __syncthreads();
    const int gt = (F.bx - b0) * 512 + tid_;
    if (gt >= 2 * 16 * LC * 16 * 4) return;
    float* KT = WSP(float, WS_KTAB);
    const int pq = gt & 3, h = (gt >> 2) & 15, j = (gt >> 6) % LC, dg = gt / (64 * LC), jl = wave_;
    float sacc[16];
#pragma unroll
    for (int q = 0; q < 16; ++q) sacc[q] = 0.f;
#pragma unroll 1
    for (int t4 = 0; t4 < 4; ++t4) { const int p4 = pq * 16 + t4 * 4;
        const f32x4 cr4 = *(const LAS f32x4*)(F.lds + KT_CR + (h * 64 + p4) * 4), ci4 = *(const LAS f32x4*)(F.lds + KT_CI + (h * 64 + p4) * 4);
        const f32x4 a01 = *(const LAS f32x4*)(F.lds + KT_AP + (jl * 64 + p4) * 8), a23 = *(const LAS f32x4*)(F.lds + KT_AP + (jl * 64 + p4 + 2) * 8);
#pragma unroll
        for (int u = 0; u < 4; ++u) { const float cr = cr4[u], ci = ci4[u]; const float ax = (u < 2) ? a01[2 * u] : a23[2 * (u - 2)], ay = (u < 2) ? a01[2 * u + 1] : a23[2 * (u - 2) + 1];
            const float ur = cr * ax - ci * ay, ui = cr * ay + ci * ax;
#pragma unroll
            for (int q = 0; q < 8; ++q) { const f32x4 bv = *(const LAS f32x4*)(F.lds + KT_BS + ((p4 + u) * 16 + 2 * q) * 8); sacc[2 * q] += ur * bv.x - ui * bv.y; sacc[2 * q + 1] += ur * bv.z - ui * bv.w; } }
    }
#pragma unroll
    for (int q = 0; q < 16; ++q) { sacc[q] += __shfl_xor(sacc[q], 1); sacc[q] += __shfl_xor(sacc[q], 2); }
    f32x4 o;
#pragma unroll
    for (int r = 0; r < 4; ++r) o[r] = (pq == 0) ? sacc[r] : (pq == 1) ? sacc[4 + r] : (pq == 2) ? sacc[8 + r] : sacc[12 + r];
    *((f32x4*)(KT + ((dg * 64 + j) * 256 + h * 16)) + pq) = o;
}
struct P1Pre { f32x4 sh[2]; float rm[16], rw[16]; };
struct P1We { f32x2 a[3]; f32x4 bq[3][4]; };
DEV void p1_we_load(Frame& F, P1We& R) {
    int tid_ = threadIdx.x; asm volatile("" : "+v"(tid_)); const int lane_ = tid_ & 63, wave_ = __builtin_amdgcn_readfirstlane(tid_ >> 6);
    const f32x2* APOW = WSP(f32x2, WS_APOW); const f32x2* BBAR = WSP(f32x2, WS_BBAR);
    {
        const int gt = (F.bx - 32) * 512 + tid_, NT = (F.G - 32) * 512; constexpr int K8 = UK / 8, NWE = 16 * 256 * K8;
#pragma unroll
        for (int u = 0; u < 3; ++u) { const int idx = (gt + u * NT < NWE) ? gt + u * NT : gt;
            const int k8 = idx % K8, n = (idx / K8) & 255, g = idx / (K8 * 256), part = n >> 6, p = n & 63, dir = part >> 1, k = k8 >> 1, h0 = (k8 & 1) * 8, dg = dir * 16 + g;
            R.a[u] = APOW[(dg * 65 + (dir ? k : LC - 1 - k)) * 64 + p];
            const f32x4* bp = (const f32x4*)(BBAR + (dg * 64 + p) * 16 + h0);
#pragma unroll
            for (int q = 0; q < 4; ++q) R.bq[u][q] = bp[q]; }
    }
}
DEV void p1_pre_load(Frame& F, P1Pre& R, int b2, int nblk2) {
    int tid_ = threadIdx.x; asm volatile("" : "+v"(tid_)); const int lane_ = tid_ & 63, wave_ = __builtin_amdgcn_readfirstlane(tid_ >> 6);
    const float* mod = WSP(float, WS_MOD);
    if (F.bx >= b2) {
        const int gt = (F.bx - b2) * 512 + tid_, NT = nblk2 * 512, gw = (F.bx - b2) * 8 + wave_;
#pragma unroll
        for (int u = 0; u < 2; ++u) { const int idx = (gt + u * NT < 256 * 256) ? gt + u * NT : gt; const int r = idx >> 8, k = (idx & 255) * 4;
            R.sh[u] = *(const f32x4*)(mod + (r < 32 ? r : 0) * NMOD + 3 * DM + k); }
        const int idx = gw < 32 * 20 ? gw : 0; const int b = idx / 20, l = idx % 20;
#pragma unroll
        for (int i = 0; i < 16; ++i) { const int k = lane_ + 64 * i; R.rm[i] = mod[b * NMOD + 3 * DM + k]; R.rw[i] = (l < 4) ? F.in[I_RGW][k * 4 + l] : F.in[I_REW][k * 16 + (l - 4)]; }
    }
}
DEV void p1_we_finish(Frame& F, const P1We& R) {
    int tid_ = threadIdx.x; asm volatile("" : "+v"(tid_)); const int lane_ = tid_ & 63, wave_ = __builtin_amdgcn_readfirstlane(tid_ >> 6);
    {
        bf16_t* WE = WSP(bf16_t, WS_WE);
        const int gt = (F.bx - 32) * 512 + tid_, NT = (F.G - 32) * 512; constexpr int K8 = UK / 8, NWE = 16 * 256 * K8;
#pragma unroll
        for (int u = 0; u < 3; ++u) { const int idx = gt + u * NT; if (idx < NWE) {
            const int k8 = idx % K8, n = (idx / K8) & 255, g = idx / (K8 * 256), part = n >> 6;
            float v[8];
#pragma unroll
            for (int q = 0; q < 4; ++q) { const f32x4 b = R.bq[u][q];
                v[2 * q] = (part & 1) ? (R.a[u].x * b.y + R.a[u].y * b.x) : (R.a[u].x * b.x - R.a[u].y * b.y); v[2 * q + 1] = (part & 1) ? (R.a[u].x * b.w + R.a[u].y * b.z) : (R.a[u].x * b.z - R.a[u].y * b.w); }
            u32x4 o; o.x = cvt_pk_bf16(v[0], v[1]); o.y = cvt_pk_bf16(v[2], v[3]); o.z = cvt_pk_bf16(v[4], v[5]); o.w = cvt_pk_bf16(v[6], v[7]);
            *(u32x4*)(WE + ((size_t)(g * 256 + n) * UK + k8 * 8)) = o; } }
    }
}
DEV void p1_pre_finish(Frame& F, const P1Pre& R, int b2, int nblk2) {
    int tid_ = threadIdx.x; asm volatile("" : "+v"(tid_)); const int lane_ = tid_ & 63, wave_ = __builtin_amdgcn_readfirstlane(tid_ >> 6);
    if (F.bx >= b2) {
        const int gt = (F.bx - b2) * 512 + tid_, NT = nblk2 * 512, gw = (F.bx - b2) * 8 + wave_;
        unsigned* SH2 = WSP(unsigned, WS_SH2);
#pragma unroll
        for (int u = 0; u < 2; ++u) { const int idx = gt + u * NT; if (idx < 256 * 256) SH2[idx] = ((idx >> 8) < 32) ? pk4_fp8(R.sh[u][0], R.sh[u][1], R.sh[u][2], R.sh[u][3]) : 0u; }
        float* rb = WSP(float, WS_RB);
        if (gw < 32 * 20) { const int b = gw / 20, l = gw % 20; float s = 0.f;
#pragma unroll
            for (int i = 0; i < 16; ++i) s += R.rm[i] * R.rw[i];
            s = wave_sum(s) + ((l < 4) ? F.in[I_RGB][l] : F.in[I_REB][l - 4]);
            if (lane_ == 0) rb[b * 32 + l] = s;
            if (l == 19 && lane_ >= 1 && lane_ <= 12) rb[b * 32 + 19 + lane_] = 0.f; }
    }
}

DEV void p2_fill_tr(Frame& F, int b0, int nblk) {
    const float* KT = WSP(float, WS_KTAB); const f32x2* APOW = WSP(f32x2, WS_APOW); bf16_t* TR = WSP(bf16_t, WS_TR);
    const int gt = (F.bx - b0) * 512 + F_TID, NT = nblk * 512;
    constexpr int K8 = UK / 8, NT1 = 16 * TRN * K8;
    for (int idx0 = gt; idx0 < NT1; idx0 += 4 * NT) {
        f32x4 fa[4][2], fb[4][2];
#pragma unroll
        for (int u = 0; u < 4; ++u) { const int idx = (idx0 + u * NT < NT1) ? idx0 + u * NT : idx0;
            const int k8 = idx % K8, n = (idx / K8) % TRN, g = idx / (K8 * TRN), t = n >> 4, h = n & 15, k = k8 >> 1, h0 = (k8 & 1) * 8;
            const f32x4* pa_ = (const f32x4*)(KT + (((0 * 16 + g) * 64 + (t > k ? t - k : 0)) * 256 + h * 16 + h0));
            const f32x4* pb_ = (const f32x4*)(KT + (((1 * 16 + g) * 64 + (k > t ? k - t : 0)) * 256 + h * 16 + h0));
            fa[u][0] = pa_[0]; fa[u][1] = pa_[1]; fb[u][0] = pb_[0]; fb[u][1] = pb_[1]; }
#pragma unroll
        for (int u = 0; u < 4; ++u) { const int idx = idx0 + u * NT; if (idx < NT1) {
            const int k8 = idx % K8, n = (idx / K8) % TRN, g = idx / (K8 * TRN), t = n >> 4, h = n & 15, k = k8 >> 1, h0 = (k8 & 1) * 8;
            const float wa = (t >= k) ? 1.f : 0.f, wb = (k >= t) ? 1.f : 0.f, dd = (t == k) ? F.in[I_S5D][g * 16 + h] : 0.f;
            float v[8];
#pragma unroll
            for (int q = 0; q < 8; ++q) v[q] = wa * fa[u][q >> 2][q & 3] + wb * fb[u][q >> 2][q & 3] + ((h0 + q == h) ? dd : 0.f);
            u32x4 o; o.x = cvt_pk_bf16(v[0], v[1]); o.y = cvt_pk_bf16(v[2], v[3]); o.z = cvt_pk_bf16(v[4], v[5]); o.w = cvt_pk_bf16(v[6], v[7]);
            *(u32x4*)(TR + ((size_t)(g * TRN + n) * UGK + k8 * 8)) = o; } }
    }
    constexpr int NT2 = 16 * TRN * 32;
    for (int idx0 = gt; idx0 < NT2; idx0 += 4 * NT) {
        f32x4 cr_[4][2], ci_[4][2], ap_[4][4];
#pragma unroll
        for (int u = 0; u < 4; ++u) { const int idx = (idx0 + u * NT < NT2) ? idx0 + u * NT : idx0;
            const int k8 = idx & 31, n = (idx >> 5) % TRN, g = idx / (32 * TRN), t = n >> 4, h = n & 15, s0 = k8 * 8, part = s0 >> 6, p0 = s0 & 63, dir = part >> 1, dg = dir * 16 + g, j = dir ? (LC - t) : (t + 1);
            const f32x4* pc = (const f32x4*)(F.in[I_CRE] + (dg * 16 + h) * 64 + p0); const f32x4* pi = (const f32x4*)(F.in[I_CIM] + (dg * 16 + h) * 64 + p0); const f32x4* pw = (const f32x4*)(APOW + (dg * 65 + j) * 64 + p0);
            cr_[u][0] = pc[0]; cr_[u][1] = pc[1]; ci_[u][0] = pi[0]; ci_[u][1] = pi[1];
#pragma unroll
            for (int q = 0; q < 4; ++q) ap_[u][q] = pw[q]; }
#pragma unroll
        for (int u = 0; u < 4; ++u) { const int idx = idx0 + u * NT; if (idx < NT2) {
            const int k8 = idx & 31, n = (idx >> 5) % TRN, g = idx / (32 * TRN), part = (k8 * 8) >> 6;
            float v[8];
#pragma unroll
            for (int q = 0; q < 8; ++q) { const float cr = cr_[u][q >> 2][q & 3], ci = ci_[u][q >> 2][q & 3]; const float ax = ap_[u][q >> 1][(q & 1) * 2], ay = ap_[u][q >> 1][(q & 1) * 2 + 1];
                v[q] = (part & 1) ? -(cr * ay + ci * ax) : (cr * ax - ci * ay); }
            u32x4 o; o.x = cvt_pk_bf16(v[0], v[1]); o.y = cvt_pk_bf16(v[2], v[3]); o.z = cvt_pk_bf16(v[4], v[5]); o.w = cvt_pk_bf16(v[6], v[7]);
            *(u32x4*)(TR + ((size_t)(g * TRN + n) * UGK + UK + k8 * 8)) = o; } }
    }
}
struct SchedIn {
    static constexpr bool GATHER = false, AUX = true, FP8 = false, I8 = true;
    int nt; unsigned lda, ldb; int G, c; const char* HX; const char* W; int lo, hi; const char* rscale; const char* cscale; const char* cw;
    DEV bool next(int i, Unit& u) const {
        const int L = lo + i * G + c; if (L >= hi) return false;
        int pm, pn, ctx = 0;
        if (L < 2560) pg8::static_tile(L, 256, 10, pm, pn); else { pm = 256 + (L - 2560); pn = 0; ctx = 1; }
        u.A0 = HX + (size_t)pm * 256 * 1024; u.A1 = u.A0; u.B0 = W + (size_t)pn * 256 * 1024; u.B1 = u.B0; u.ksA = 1 << 20; u.ksB = 1 << 20;
        u.p0 = pm; u.p1 = pn; u.p2 = ctx; u.p3 = 0; return true;
    }
    DEV void rows(const Unit&, int, unsigned*) const {}
    DEV void aux(const Unit& u, const Unit&, LAS unsigned char* l, int wid, int lane) const {
        if (wid == 0) glds16(rscale + (size_t)u.p0 * 1024 + lane * 16, l + AUX_SLOT_OFF);
        if (wid == 1) glds16(cscale + (size_t)u.p1 * 1024 + lane * 16, l + AUX_SLOT_OFF + 1024);
        if (wid == 2 && u.p1 >= 1 && u.p1 <= 6) { const int d = (lane >> 4) < 3 ? (lane >> 4) : 2;
            glds16(cw + ((size_t)d * CONVW + (u.p1 - 1) * 64 + (lane & 15) * 4) * 4, l + AUX_SLOT_OFF + 2048); }
    }
};
template <int CTRL> DEV f32x4 dpp_row(f32x4 v) { f32x4 o;
#pragma unroll
    for (int i = 0; i < 4; ++i) o[i] = __int_as_float(__builtin_amdgcn_update_dpp(0, __float_as_int(v[i]), CTRL, 0xf, 0xf, true));
    return o; }
struct EpiIn {
    static constexpr bool PERM = true;
    bf16_t* UG; bf16_t* BG; bf16_t* CV; bf16_t* YM; LAS unsigned char* lds;
    DEV f32x4 deq(const f32x4& acc, const f32x4& sc) const { const v4i_t iv = __builtin_bit_cast(v4i_t, acc); return (f32x4){(float)iv[0], (float)iv[1], (float)iv[2], (float)iv[3]} * sc; }
    DEV void operator()(const f32x4 (&acci)[2][2][4][2], const Unit& u, int wr, int wc, int fr, int fq) const {
        const int pm = u.p0, pn = u.p1;
        f32x4 cs[2][2];
#pragma unroll
        for (int bj = 0; bj < 2; ++bj)
#pragma unroll
            for (int n = 0; n < 2; ++n) cs[bj][n] = *(const LAS f32x4*)(lds + AUX_SLOT_OFF + 1024 + (bj * 128 + wc * 32 + 8 * fq + 4 * n) * 4);
        if (pn >= 1 && pn <= 6) {
            const int f = pn - 1, ch0 = 64 * f + 16 * wc + 4 * fq;
            const LAS unsigned char* wp = lds + AUX_SLOT_OFF + 2048 + (16 * wc + 4 * fq) * 4;
            const f32x4 w0 = *(const LAS f32x4*)wp, w1 = *(const LAS f32x4*)(wp + 256), w2 = *(const LAS f32x4*)(wp + 512);
#pragma unroll
            for (int ai = 0; ai < 2; ++ai) {
                f32x4 cvv[4];
#pragma unroll
                for (int m = 0; m < 4; ++m) { const float rs = *(const LAS float*)(lds + AUX_SLOT_OFF + (ai * 128 + wr * 64 + m * 16 + fr) * 4);
                    cvv[m] = deq(acci[ai][0][m][1], cs[0][1] * rs) * deq(acci[ai][1][m][0], cs[1][0] * rs); }
#pragma unroll
                for (int m = 0; m < 4; ++m) { const int r = ai * 128 + wr * 64 + m * 16 + fr; const float rs = *(const LAS float*)(lds + AUX_SLOT_OFF + r * 4);
                    const f32x4 b4 = deq(acci[ai][0][m][0], cs[0][0] * rs), x4 = deq(acci[ai][1][m][1], cs[1][1] * rs);
                    f32x4 L = dpp_row<0x111>(cvv[m]), R = dpp_row<0x101>(cvv[m]);
                    if (m > 0) { const f32x4 e_ = dpp_row<0x121>(cvv[m - 1]); L = (fr == 0) ? e_ : L; }
                    if (m < 3) { const f32x4 e_ = dpp_row<0x12F>(cvv[m + 1]); R = (fr == 15) ? e_ : R; }
                    const f32x4 y = b4 * (w0 * L + w1 * cvv[m] + w2 * R);
                    const size_t row = (size_t)(pm * 256 + r);
                    u32x2 yo; yo.x = cvt_pk_bf16(y[0], y[1]); yo.y = cvt_pk_bf16(y[2], y[3]);
                    *(u32x2*)(YM + row * DM + 256 + ch0) = yo;
                    u32x2 xo; xo.x = cvt_pk_bf16(x4[0], x4[1]); xo.y = cvt_pk_bf16(x4[2], x4[3]);
                    *(u32x2*)(BG + row * CONVW + 384 + ch0) = xo; }
            }
            return;
        }
#pragma unroll
        for (int ai = 0; ai < 2; ++ai)
#pragma unroll
            for (int m = 0; m < 4; ++m) {
                const int r = ai * 128 + wr * 64 + m * 16 + fr;
                const float rs = *(const LAS float*)(lds + AUX_SLOT_OFF + r * 4);
                f32x4 a[2][2];
#pragma unroll
                for (int bj = 0; bj < 2; ++bj)
#pragma unroll
                    for (int n = 0; n < 2; ++n) a[bj][n] = deq(acci[ai][bj][m][n], cs[bj][n] * rs);
                if (pn == 0) {
                    const int mm = pm * 256 + r;
                    const int chunk = mm / LC, k = mm % LC;
#pragma unroll
                    for (int bj = 0; bj < 2; ++bj) { const int c = bj * 128 + wc * 32 + 8 * fq, g = c >> 4, h0 = c & 15;
                        const f32x4 v0 = a[bj][0], v1 = a[bj][1];
                        u32x4 w; w.x = cvt_pk_bf16(v0[0], v0[1]); w.y = cvt_pk_bf16(v0[2], v0[3]); w.z = cvt_pk_bf16(v1[0], v1[1]); w.w = cvt_pk_bf16(v1[2], v1[3]);
                        *(u32x4*)(UG + ((size_t)(g * NCH_PAD + chunk) * UGK + k * 16 + h0)) = w; }
                } else {
                    const f32x4 v0 = a[0][0] * a[1][0], v1 = a[0][1] * a[1][1];
                    u32x4 w; w.x = cvt_pk_bf16(v0[0], v0[1]); w.y = cvt_pk_bf16(v0[2], v0[3]); w.z = cvt_pk_bf16(v1[0], v1[1]); w.w = cvt_pk_bf16(v1[2], v1[3]);
                    *(u32x4*)(CV + (size_t)(pm * 256 + r) * CONVW + 384 + (pn - 7) * 128 + wc * 32 + 8 * fq) = w;
                }
            }
    }
};

struct SchedE {
    static constexpr bool GATHER = false, AUX = false, FP8 = false, I8 = false;
    int nt; unsigned lda, ldb; int c; const char* UG; const char* WE;
    DEV bool next(int i, Unit& u) const {
        if (i > 0 || c >= 16 * (NCH_PAD / 256)) return false;
        const int g = c / (NCH_PAD / 256), pm = c % (NCH_PAD / 256);
        u.A0 = UG + ((size_t)g * NCH_PAD + pm * 256) * UGK * 2; u.A1 = u.A0; u.B0 = WE + (size_t)g * 256 * UK * 2; u.B1 = u.B0; u.ksA = 1 << 20; u.ksB = 1 << 20;
        u.p0 = pm; u.p1 = g; u.p2 = 0; u.p3 = 0; return true;
    }
    DEV void rows(const Unit&, int, unsigned*) const {}
    DEV void aux(const Unit&, const Unit&, LAS unsigned char*, int, int) const {}
};
struct EpiE {
    static constexpr bool PERM = true;
    bf16_t* E;
    DEV void operator()(const f32x4 (&acc)[2][2][4][2], const Unit& u, int wr, int wc, int fr, int fq) const {
        bf16_t* base = E + ((size_t)u.p1 * NCH_PAD + u.p0 * 256) * 256;
#pragma unroll
        for (int ai = 0; ai < 2; ++ai)
#pragma unroll
            for (int m = 0; m < 4; ++m) { bf16_t* rowp = base + (size_t)(ai * 128 + wr * 64 + m * 16 + fr) * 256 + wc * 32 + 8 * fq;
#pragma unroll
                for (int bj = 0; bj < 2; ++bj) { const f32x4 v0 = acc[ai][bj][m][0], v1 = acc[ai][bj][m][1];
                    u32x4 w; w.x = cvt_pk_bf16(v0[0], v0[1]); w.y = cvt_pk_bf16(v0[2], v0[3]); w.z = cvt_pk_bf16(v1[0], v1[1]); w.w = cvt_pk_bf16(v1[2], v1[3]);
                    *(u32x4*)(rowp + bj * 128) = w; } }
    }
};
struct SchedSB {
    static constexpr bool GATHER = false, AUX = false, FP8 = true, I8 = false;
    int nt; unsigned lda, ldb; int c; const char* SH2; const char* W13;
    DEV bool next(int i, Unit& u) const {
        if (i > 0 || c < 0 || c >= 64) return false;
        const int e = c >> 2, ti = c & 3;
        u.A0 = SH2; u.A1 = u.A0; u.B0 = W13 + ((size_t)e * 1024 + ti * 256) * 1024; u.B1 = u.B0; u.ksA = 1 << 20; u.ksB = 1 << 20;
        u.p0 = e; u.p1 = ti; u.p2 = 0; u.p3 = 0; return true;
    }
    DEV void rows(const Unit&, int, unsigned*) const {}
    DEV void aux(const Unit&, const Unit&, LAS unsigned char*, int, int) const {}
};
struct EpiSB {
    static constexpr bool PERM = true;
    bf16_t* SB;
    DEV void operator()(const f32x4 (&acc)[2][2][4][2], const Unit& u, int wr, int wc, int fr, int fq) const {
        if (wr != 0) return;
#pragma unroll
        for (int m = 0; m < 2; ++m) { const int b = m * 16 + fr; bf16_t* rowp = SB + ((size_t)(b * 16 + u.p0) * 1024 + u.p1 * 256 + wc * 32 + 8 * fq);
#pragma unroll
            for (int bj = 0; bj < 2; ++bj) { const f32x4 v0 = acc[0][bj][m][0] * (1.0f / FP8_WSCALE), v1 = acc[0][bj][m][1] * (1.0f / FP8_WSCALE);
                u32x4 w; w.x = cvt_pk_bf16(v0[0], v0[1]); w.y = cvt_pk_bf16(v0[2], v0[3]); w.z = cvt_pk_bf16(v1[0], v1[1]); w.w = cvt_pk_bf16(v1[2], v1[3]);
                *(u32x4*)(rowp + bj * 128) = w; } }
    }
};

DEV void p4_phase(Frame& F, int nblk) {
    const int gt = F.bx * 512 + F_TID, NT = nblk * 512;
    const bf16_t* E = WSP(bf16_t, WS_E); const f32x2* APOW = WSP(f32x2, WS_APOW); bf16_t* UG = WSP(bf16_t, WS_UG);
    constexpr int CC = CTXL / LC, CL = SEQ / LC;
    for (int idx = gt; idx < NB * NG * 128; idx += NT) {
        const int p = idx & 63, dir = (idx >> 6) & 1, g = (idx >> 7) & 15, b = idx >> 11;
        const f32x2 a = APOW[((dir * 16 + g) * 65 + LC) * 64 + p];
        const bf16_t* Eg = E + (size_t)g * NCH_PAD * 256 + dir * 128 + p;
        bf16_t* Ug = UG + (size_t)g * NCH_PAD * UGK + UK + dir * 128 + p;
        float sr = 0.f, si = 0.f;
        {   float er[CC], ei[CC];
#pragma unroll
            for (int c = 0; c < CC; ++c) { const int ch = NCH_LAT + b * CC + (dir ? CC - 1 - c : c); er[c] = bf2f(Eg[(size_t)ch * 256]); ei[c] = bf2f(Eg[(size_t)ch * 256 + 64]); }
#pragma unroll
            for (int c = 0; c < CC; ++c) { const float nr = a.x * sr - a.y * si + er[c], ni = a.x * si + a.y * sr + ei[c]; sr = nr; si = ni; } }
#pragma unroll 1
        for (int c0 = 0; c0 < CL; c0 += 32) {
            float er[32], ei[32];
#pragma unroll
            for (int c = 0; c < 32; ++c) { const int ch = b * CL + (dir ? CL - 1 - (c0 + c) : c0 + c); er[c] = bf2f(Eg[(size_t)ch * 256]); ei[c] = bf2f(Eg[(size_t)ch * 256 + 64]); }
#pragma unroll
            for (int c = 0; c < 32; ++c) { const int ch = b * CL + (dir ? CL - 1 - (c0 + c) : c0 + c);
                Ug[(size_t)ch * UGK] = (bf16_t)(cvt_pk_bf16(sr, 0.f) & 0xffffu); Ug[(size_t)ch * UGK + 64] = (bf16_t)(cvt_pk_bf16(si, 0.f) & 0xffffu);
                const float nr = a.x * sr - a.y * si + er[c], ni = a.x * si + a.y * sr + ei[c]; sr = nr; si = ni; }
        }
    }
}
DEV void conv_items(Frame& F, int vt, int NVT) {
    const bf16_t* BG = WSP(bf16_t, WS_BG); const bf16_t* CV = WSP(bf16_t, WS_CV); bf16_t* YM = WSP(bf16_t, WS_YMIX); const float* cw = F.in[I_CONVW];
    LAS unsigned char* lz = F.lds + F_WAVE * LZ_WAVE;
    constexpr int NIT = TOK * 48;
    const int nb = (vt < NIT) ? ((NIT - vt + 2 * NVT - 1) / (2 * NVT)) : 0;
    const int jc = 384 + (vt % 48) * 8;
    const f32x4 w0a = *(const f32x4*)(cw + jc), w0b = *(const f32x4*)(cw + jc + 4), w1a = *(const f32x4*)(cw + CONVW + jc), w1b = *(const f32x4*)(cw + CONVW + jc + 4), w2a = *(const f32x4*)(cw + 2 * CONVW + jc), w2b = *(const f32x4*)(cw + 2 * CONVW + jc + 4);
#define CV_ISSUE(b) do { _Pragma("unroll") for (int q = 0; q < 2; ++q) { const int idx_ = vt + (2 * (b) + q) * NVT; const bool ok_ = idx_ < NIT; const int m_ = ok_ ? idx_ / 48 : 0; \
        const bool hasl_ = ok_ && (((m_ >> 6) & 31) > 0), hasr_ = ok_ && (((m_ >> 6) & 31) < 31); \
        const size_t o_ = (size_t)m_ * CONVW + jc; \
        lz_issue(CV + (hasl_ ? o_ - (size_t)64 * CONVW : o_), lz, ((b) & 1) * 8 + q * 4 + 0); lz_issue(CV + o_, lz, ((b) & 1) * 8 + q * 4 + 1); \
        lz_issue(CV + (hasr_ ? o_ + (size_t)64 * CONVW : o_), lz, ((b) & 1) * 8 + q * 4 + 2); lz_issue_nt(BG + o_, lz, ((b) & 1) * 8 + q * 4 + 3); } } while (0)
    asm volatile("s_waitcnt lgkmcnt(0)" ::: "memory");
    if (nb > 0) CV_ISSUE(0);
    if (nb > 1) CV_ISSUE(1);
#pragma unroll 1
    for (int b = 0; b < nb; ++b) {
        if (b + 1 < nb) LZ_WAIT(8); else LZ_WAIT(0);
#pragma unroll
        for (int q = 0; q < 2; ++q) { const int idx = vt + (2 * b + q) * NVT; const bool ok = idx < NIT; const int m = ok ? idx / 48 : 0;
            const bool hasl = ((m >> 6) & 31) > 0, hasr = ((m >> 6) & 31) < 31;
            const LAS unsigned char* zp = lz + ((b & 1) * 8 + q * 4) * 1024 + F_LANE * 16;
            const u32x4 z = (u32x4){0u, 0u, 0u, 0u};
            u32x4 c0 = *(const LAS u32x4*)zp; const u32x4 c1 = *(const LAS u32x4*)(zp + 1024); u32x4 c2 = *(const LAS u32x4*)(zp + 2048); const u32x4 bb = *(const LAS u32x4*)(zp + 3072);
            c0 = hasl ? c0 : z; c2 = hasr ? c2 : z;
            float o[8];
            o[0] = bflo(bb.x) * (bflo(c0.x) * w0a[0] + bflo(c1.x) * w1a[0] + bflo(c2.x) * w2a[0]); o[1] = bfhi(bb.x) * (bfhi(c0.x) * w0a[1] + bfhi(c1.x) * w1a[1] + bfhi(c2.x) * w2a[1]);
            o[2] = bflo(bb.y) * (bflo(c0.y) * w0a[2] + bflo(c1.y) * w1a[2] + bflo(c2.y) * w2a[2]); o[3] = bfhi(bb.y) * (bfhi(c0.y) * w0a[3] + bfhi(c1.y) * w1a[3] + bfhi(c2.y) * w2a[3]);
            o[4] = bflo(bb.z) * (bflo(c0.z) * w0b[0] + bflo(c1.z) * w1b[0] + bflo(c2.z) * w2b[0]); o[5] = bfhi(bb.z) * (bfhi(c0.z) * w0b[1] + bfhi(c1.z) * w1b[1] + bfhi(c2.z) * w2b[1]);
            o[6] = bflo(bb.w) * (bflo(c0.w) * w0b[2] + bflo(c1.w) * w1b[2] + bflo(c2.w) * w2b[2]); o[7] = bfhi(bb.w) * (bfhi(c0.w) * w0b[3] + bfhi(c1.w) * w1b[3] + bfhi(c2.w) * w2b[3]);
            u32x4 w; w.x = cvt_pk_bf16(o[0], o[1]); w.y = cvt_pk_bf16(o[2], o[3]); w.z = cvt_pk_bf16(o[4], o[5]); w.w = cvt_pk_bf16(o[6], o[7]);
            if (ok) *(u32x4*)(YM + (size_t)m * DM + 256 + jc) = w; }
        if (b + 2 < nb) CV_ISSUE(b + 2);
    }
#undef CV_ISSUE
}

struct SchedY {
    static constexpr bool GATHER = false, AUX = false, FP8 = false, I8 = false;
    int nt; unsigned lda, ldb; int c; const char* UG; const char* TR;
    DEV bool next(int i, Unit& u) const {
        if (i > 0 || c >= 256) return false;
        const int x = c & 7, k = c >> 3;
        constexpr int NPM = NCH_LAT / 256, NPN = TRN / 256;
        static_assert(NPM * NPN == 16, "16 units per group");
        const int g = 2 * x + (k >> 4), pm = (k & 15) / NPN, pn = (k & 15) % NPN;
        u.A0 = UG + ((size_t)g * NCH_PAD + pm * 256) * UGK * 2; u.A1 = u.A0; u.B0 = TR + ((size_t)g * TRN + pn * 256) * UGK * 2; u.B1 = u.B0; u.ksA = 1 << 20; u.ksB = 1 << 20;
        u.p0 = pm; u.p1 = pn; u.p2 = g; u.p3 = 0; return true;
    }
    DEV void rows(const Unit&, int, unsigned*) const {}
    DEV void aux(const Unit&, const Unit&, LAS unsigned char*, int, int) const {}
};
struct EpiY {
    static constexpr bool PERM = true;
    bf16_t* Gb;
    DEV void operator()(const f32x4 (&acc)[2][2][4][2], const Unit& u, int wr, int wc, int fr, int fq) const {
#pragma unroll
        for (int ai = 0; ai < 2; ++ai)
#pragma unroll
            for (int m = 0; m < 4; ++m) { const int chunk = u.p0 * 256 + ai * 128 + wr * 64 + m * 16 + fr;
#pragma unroll
                for (int bj = 0; bj < 2; ++bj) { const int n = u.p1 * 256 + bj * 128 + wc * 32 + 8 * fq, t = n >> 4, h0 = n & 15;
                    const f32x4 v0 = acc[ai][bj][m][0], v1 = acc[ai][bj][m][1];
                    u32x4 w; w.x = cvt_pk_bf16(gelu_tanh(v0[0]), gelu_tanh(v0[1])); w.y = cvt_pk_bf16(gelu_tanh(v0[2]), gelu_tanh(v0[3]));
                    w.z = cvt_pk_bf16(gelu_tanh(v1[0]), gelu_tanh(v1[1])); w.w = cvt_pk_bf16(gelu_tanh(v1[2]), gelu_tanh(v1[3]));
                    *(u32x4*)(Gb + ((size_t)(chunk * LC + t) * 256 + u.p2 * 16 + h0)) = w; } }
    }
};

struct SchedGlu {
    static constexpr bool GATHER = false, AUX = false, FP8 = false, I8 = false;
    int nt; unsigned lda, ldb; int G, c; const char* Gb; const char* W;
    DEV bool next(int i, Unit& u) const {
        const int L = i * G + c; if (L >= 256) return false;
        u.A0 = Gb + (size_t)L * 256 * 512; u.A1 = u.A0; u.B0 = W; u.B1 = u.B0; u.ksA = 1 << 20; u.ksB = 1 << 20; u.p0 = L; u.p1 = 0; u.p2 = 0; u.p3 = 0; return true;
    }
    DEV void rows(const Unit&, int, unsigned*) const {}
    DEV void aux(const Unit&, const Unit&, LAS unsigned char*, int, int) const {}
};
struct EpiGlu {
    static constexpr bool PERM = true;
    const bf16_t* Gb; bf16_t* YM; const float* bglu;
    DEV void operator()(const f32x4 (&acc)[2][2][4][2], const Unit& u, int wr, int wc, int fr, int fq) const {
        u32x4 gq[2][4][2];
#pragma unroll
        for (int ai = 0; ai < 2; ++ai)
#pragma unroll
            for (int m = 0; m < 4; ++m)
#pragma unroll
                for (int bj = 0; bj < 2; ++bj) gq[ai][m][bj] = *(const u32x4*)(Gb + (size_t)(u.p0 * 256 + ai * 128 + wr * 64 + m * 16 + fr) * 256 + bj * 128 + wc * 32 + 8 * fq);
        f32x4 bq[2][2];
#pragma unroll
        for (int bj = 0; bj < 2; ++bj) { bq[bj][0] = *(const f32x4*)(bglu + bj * 128 + wc * 32 + 8 * fq); bq[bj][1] = *(const f32x4*)(bglu + bj * 128 + wc * 32 + 8 * fq + 4); }
        asm volatile("" ::: "memory");
#pragma unroll
        for (int ai = 0; ai < 2; ++ai)
#pragma unroll
            for (int m = 0; m < 4; ++m) { const int row = u.p0 * 256 + ai * 128 + wr * 64 + m * 16 + fr;
#pragma unroll
                for (int bj = 0; bj < 2; ++bj) { const int c = bj * 128 + wc * 32 + 8 * fq;
                    const u32x4 gv = gq[ai][m][bj];
                    const f32x4 z0 = acc[ai][bj][m][0] + bq[bj][0], z1 = acc[ai][bj][m][1] + bq[bj][1];
                    u32x4 w; w.x = cvt_pk_bf16(bflo(gv.x) * sigmoidf_(z0[0]), bfhi(gv.x) * sigmoidf_(z0[1])); w.y = cvt_pk_bf16(bflo(gv.y) * sigmoidf_(z0[2]), bfhi(gv.y) * sigmoidf_(z0[3]));
                    w.z = cvt_pk_bf16(bflo(gv.z) * sigmoidf_(z1[0]), bfhi(gv.z) * sigmoidf_(z1[1])); w.w = cvt_pk_bf16(bflo(gv.w) * sigmoidf_(z1[2]), bfhi(gv.w) * sigmoidf_(z1[3]));
                    *(u32x4*)(YM + (size_t)row * DM + c) = w; } }
    }
};

struct SchedOut {
    static constexpr bool GATHER = false, AUX = false, FP8 = false, I8 = false;
    int nt; unsigned lda, ldb; int G, c; const char* A; const char* W;
    DEV bool next(int i, Unit& u) const {
        const int L = i * G + c; if (L >= 1024) return false;
        int pm, pn; pg8::static_tile(L, 256, 4, pm, pn);
        u.A0 = A + (size_t)pm * 256 * 2048; u.A1 = u.A0; u.B0 = W + (size_t)pn * 256 * 2048; u.B1 = u.B0; u.ksA = 1 << 20; u.ksB = 1 << 20; u.p0 = pm; u.p1 = pn; u.p2 = 0; u.p3 = 0; return true;
    }
    DEV void rows(const Unit&, int, unsigned*) const {}
    DEV void aux(const Unit&, const Unit&, LAS unsigned char*, int, int) const {}
};
struct EpiX1 {
    static constexpr bool PERM = true;
    bf16_t* X1; const float* mod;
    DEV void operator()(const f32x4 (&acc)[2][2][4][2], const Unit& u, int wr, int wc, int fr, int fq) const {
        const int b = u.p0 >> 3;
        bf16_t* base = X1 + (size_t)(u.p0 * 256 + wr * 64 + fr) * DM + u.p1 * 256 + wc * 32 + 8 * fq;
        u32x4 xq[2][4][2];
#pragma unroll
        for (int ai = 0; ai < 2; ++ai)
#pragma unroll
            for (int m = 0; m < 4; ++m)
#pragma unroll
                for (int bj = 0; bj < 2; ++bj) xq[ai][m][bj] = *(const u32x4*)(base + (size_t)(ai * 128 + m * 16) * DM + bj * 128);
        f32x4 g[2][2];
#pragma unroll
        for (int bj = 0; bj < 2; ++bj) { const float* gp = mod + b * NMOD + 2 * DM + u.p1 * 256 + bj * 128 + wc * 32 + 8 * fq; g[bj][0] = *(const f32x4*)gp; g[bj][1] = *(const f32x4*)(gp + 4); }
        asm volatile("" ::: "memory");
#pragma unroll
        for (int ai = 0; ai < 2; ++ai)
#pragma unroll
            for (int m = 0; m < 4; ++m)
#pragma unroll
                for (int bj = 0; bj < 2; ++bj) { const u32x4 xv = xq[ai][m][bj]; const f32x4 y0 = acc[ai][bj][m][0] * g[bj][0], y1 = acc[ai][bj][m][1] * g[bj][1];
                    u32x4 w; w.x = cvt_pk_bf16(bflo(xv.x) + y0[0], bfhi(xv.x) + y0[1]); w.y = cvt_pk_bf16(bflo(xv.y) + y0[2], bfhi(xv.y) + y0[3]);
                    w.z = cvt_pk_bf16(bflo(xv.z) + y1[0], bfhi(xv.z) + y1[1]); w.w = cvt_pk_bf16(bflo(xv.w) + y1[2], bfhi(xv.w) + y1[3]);
                    *(u32x4*)(base + (size_t)(ai * 128 + m * 16) * DM + bj * 128) = w; }
    }
};

constexpr int P8_WR_STRIDE = 2064;
constexpr int P8_GT_OFF = 41472, P8_GS_OFF = P8_GT_OFF + 4096, P8_HIST_OFF = P8_GS_OFF + 4096, P8_LZ_OFF = P8_HIST_OFF + 256, P8_LZ_WAVE = 12288;
static_assert(20 * P8_WR_STRIDE <= P8_GT_OFF && P8_LZ_OFF + 8 * P8_LZ_WAVE <= 163840 - 256, "P8 LDS map");
DEV void p8_phase(Frame& F) {
    const bf16_t* X1B = WSP(bf16_t, WS_X1B); unsigned char* X1G = WSP(unsigned char, WS_X1G);
    const bf16_t* Wr = WSP(bf16_t, WS_WR); const float* rb = WSP(float, WS_RB); const float* mod = WSP(float, WS_MOD); const float* n2g = F.in[I_N2G];
    int* tokb = WSP(int, WS_TOKB); float* tokw = WSP(float, WS_TOKW); float* tokr = WSP(float, WS_TOKR); int* segc = WSP(int, WS_SEGC);
    LAS int* hist = (LAS int*)(F.lds + P8_HIST_OFF);
    LAS float* gsl = (LAS float*)(F.lds + P8_GS_OFF);
    const int l15 = F_LANE & 15, q = F_LANE >> 4;
    for (int idx = F_TID; idx < 20 * 128; idx += 512) { const int r = idx >> 7, c16 = idx & 127; *(LAS u32x4*)(F.lds + r * P8_WR_STRIDE + c16 * 16) = *(const u32x4*)(Wr + (size_t)r * DM + c16 * 8); }
    LAS unsigned char* lz = F.lds + P8_LZ_OFF + F_WAVE * P8_LZ_WAVE;
    for (int seg = F.bx; seg < TOK / 256; seg += F.G) {
        const int b = seg >> 3;
        __syncthreads();
        if (F_TID < 32) hist[F_TID] = 0;
        for (int k = F_TID; k < DM; k += 512) gsl[k] = n2g[k] * (1.0f + mod[b * NMOD + 4 * DM + k]);
        __syncthreads();
        const int tok0 = seg * 256 + F_WAVE * 32;
#pragma unroll 1
        for (int rg = 0; rg < 2; ++rg) {
            const int tok = tok0 + rg * 16 + l15;
            unsigned char* og = X1G + (size_t)tok * DM + 8 * q;
            const LAS unsigned char* wl = F.lds + l15 * P8_WR_STRIDE + q * 16;
            f32x4 acc0 = (f32x4){0.f, 0.f, 0.f, 0.f}, acc1 = acc0; float sq = 0.f;
            const LAS unsigned char* wl2 = F.lds + (16 + (l15 & 3)) * P8_WR_STRIDE + q * 16;
            const bf16_t* xrow = X1B + (size_t)(tok0 + rg * 16 + (F_LANE >> 5)) * DM + 8 * (F_LANE & 31);
            const LAS unsigned char* lzr = lz + (l15 >> 1) * 1056 + (l15 & 1) * 512 + q * 16;
#define P8_ISSUE8(kb_) do { _Pragma("unroll") for (int s_ = 0; s_ < 8; ++s_) lz_issue_nt(xrow + (size_t)(2 * s_) * DM + 256 * (kb_), lz + s_ * 32, s_); } while (0)
            asm volatile("s_waitcnt lgkmcnt(0)" ::: "memory");
            const int rot = (F.bx * 8 + F_WAVE) & 3;
            P8_ISSUE8(rot);
#pragma unroll 1
            for (int kb0 = 0; kb0 < 4; ++kb0) { const int kb = (kb0 + rot) & 3;
                LZ_WAIT(0);
                u32x4 xv8[8];
#pragma unroll
                for (int s = 0; s < 8; ++s) xv8[s] = *(const LAS u32x4*)(lzr + s * 64);
                asm volatile("s_waitcnt lgkmcnt(0)" ::: "memory");
                if (kb0 + 1 < 4) P8_ISSUE8((kb + 1) & 3);
#pragma unroll
                for (int s = 0; s < 8; ++s) { const int ks = 8 * kb + s; const u32x4 xv = xv8[s];
                const f32x4 s0 = *(const LAS f32x4*)(gsl + ks * 32 + 8 * q), s1 = *(const LAS f32x4*)(gsl + ks * 32 + 8 * q + 4);
                const f32x4 va = (f32x4){bflo(xv.x), bfhi(xv.x), bflo(xv.y), bfhi(xv.y)}, vb = (f32x4){bflo(xv.z), bfhi(xv.z), bflo(xv.w), bfhi(xv.w)};
                sq += ((va[0] * va[0] + va[1] * va[1]) + (va[2] * va[2] + va[3] * va[3])) + ((vb[0] * vb[0] + vb[1] * vb[1]) + (vb[2] * vb[2] + vb[3] * vb[3]));
                const f32x4 ga = va * s0, gb = vb * s1;
                u32x4 wg; wg.x = cvt_pk_bf16(ga[0], ga[1]); wg.y = cvt_pk_bf16(ga[2], ga[3]); wg.z = cvt_pk_bf16(gb[0], gb[1]); wg.w = cvt_pk_bf16(gb[2], gb[3]);
                { u32x2 w8; w8.x = pk4_fp8(ga[0], ga[1], ga[2], ga[3]); w8.y = pk4_fp8(gb[0], gb[1], gb[2], gb[3]); *(u32x2*)(og + ks * 32) = w8; }
                const bf16x8 xf = __builtin_bit_cast(bf16x8, wg);
                const bf16x8 wa = *(const LAS bf16x8*)(wl + ks * 64), wb = *(const LAS bf16x8*)(wl2 + ks * 64);
                acc0 = __builtin_amdgcn_mfma_f32_16x16x32_bf16(wa, xf, acc0, 0, 0, 0); acc1 = __builtin_amdgcn_mfma_f32_16x16x32_bf16(wb, xf, acc1, 0, 0, 0);
                }
            }
#undef P8_ISSUE8
            sq += __shfl_xor(sq, 16); sq += __shfl_xor(sq, 32);
            const float rstd = 1.0f / sqrtf(sq * (1.f / DM) + RMS_EPS);
            float lg[4], l2[4], gl[4], t1[4], t2[4], v[4];
#pragma unroll
            for (int r = 0; r < 4; ++r) { lg[r] = rstd * acc0[r] + rb[b * 32 + 4 * q + r]; l2[r] = rstd * acc1[r] + rb[b * 32 + 16 + ((4 * q + r) & 15)]; }
#pragma unroll
            for (int r = 0; r < 4; ++r) gl[r] = __shfl(lg[r], l15);
            int gi = 0; float gm = gl[0];
#pragma unroll
            for (int r = 1; r < 4; ++r) if (gl[r] > gm) { gm = gl[r]; gi = r; }
            float den = 0.f;
#pragma unroll
            for (int r = 0; r < 4; ++r) den += __expf(gl[r] - gm);
            const float gp = 1.0f / den;
            const int src = l15 + 16 * ((gi + 1) & 3);
#pragma unroll
            for (int r = 0; r < 4; ++r) { t1[r] = __shfl(lg[r], src); t2[r] = __shfl(l2[r], l15); v[r] = (gi == 3) ? t2[r] : t1[r]; }
            int i1 = 0; float v1 = v[0];
#pragma unroll
            for (int r = 1; r < 4; ++r) if (v[r] > v1) { v1 = v[r]; i1 = r; }
            int i2 = -1; float v2 = 0.f;
#pragma unroll
            for (int r = 0; r < 4; ++r) if (r != i1 && (i2 < 0 || v[r] > v2)) { v2 = v[r]; i2 = r; }
            const float ex = __expf(v2 - v1), p1 = 1.0f / (1.0f + ex), p2 = ex * p1;
            const int lo = i1 < i2 ? i1 : i2, hi = i1 < i2 ? i2 : i1;
            const float wlo = (i1 < i2 ? p1 : p2) * gp, whi = (i1 < i2 ? p2 : p1) * gp;
            const int pidx = (lo == 0) ? (hi - 1) : (lo == 1) ? (hi + 1) : 5;
            const int bucket = gi * 6 + pidx;
            if (q == 0) { tokb[tok] = bucket; tokw[tok * 2] = wlo; tokw[tok * 2 + 1] = whi; tokr[tok] = rstd; atomicAdd((int*)hist + bucket, 1); }
        }
        __syncthreads();
        if (F_TID < 32) segc[seg * 32 + F_TID] = (F_TID < NBUCKET) ? hist[F_TID] : 0;
    }
    __syncthreads();
}

DEV void p9_phase(Frame& F) {
    const int* segc = WSP(int, WS_SEGC); const int* tokb = WSP(int, WS_TOKB); int* perm = WSP(int, WS_PERM); int* tiles = WSP(int, WS_TILES);
    const float* tokw = WSP(float, WS_TOKW); const float* tokr = WSP(float, WS_TOKR); u32x4* slotrec = WSP(u32x4, WS_SLOT);
    LAS int* tot = (LAS int*)F.lds;
    LAS int* tst = tot + 32;
    LAS int* base = tst + 32;
    LAS int* wcnt = base + 32;
    LAS int* sc = wcnt + 128;
    for (int seg = F.bx; seg < TOK / 256; seg += F.G) {
        __syncthreads();
        int bk = -1; float pr = 0.f, pw0 = 0.f, pw1 = 0.f;
        { int cv_[16];
#pragma unroll
          for (int i = 0; i < 16; ++i) cv_[i] = ld_agent_i(segc + F_TID + 512 * i);
          if (F_TID < 256) { const int tok = seg * 256 + F_TID; bk = tokb[tok]; pr = tokr[tok]; pw0 = tokw[tok * 2]; pw1 = tokw[tok * 2 + 1]; }
#pragma unroll
          for (int i = 0; i < 16; ++i) sc[F_TID + 512 * i] = cv_[i]; }
        if (F_TID < 128) wcnt[F_TID] = 0;
        __syncthreads();
        if (F_TID < 32) { int t = 0, bs = 0; if (F_TID < NBUCKET) for (int s = 0; s < 256; ++s) { const int c = sc[s * 32 + F_TID]; if (s < seg) bs += c; t += c; } tot[F_TID] = t; base[F_TID] = bs; }
        __syncthreads();
        if (F_TID == 0) { int ts = 0; for (int k = 0; k < NBUCKET; ++k) { tst[k] = ts; ts += (tot[k] + 255) >> 8; } tst[NBUCKET] = ts; }
        __syncthreads();
        int rank = 0;
        if (F_TID < 256) {
            for (int k = 0; k < NBUCKET; ++k) { const unsigned long long msk = __ballot(bk == k); if (bk == k) rank = __popcll(msk & ((1ull << F_LANE) - 1ull)); if (F_LANE == 0) wcnt[F_WAVE * 32 + k] = __popcll(msk); }
        }
        __syncthreads();
        if (F_TID < 256) { int off = 0; for (int w = 0; w < F_WAVE; ++w) off += wcnt[w * 32 + bk]; const int tok = seg * 256 + F_TID, slot = tst[bk] * 256 + base[bk] + off + rank;
            perm[slot] = tok; slotrec[slot] = (u32x4){(unsigned)tok, __float_as_uint(pr), __float_as_uint(pw0), __float_as_uint(pw1)}; }
        if (seg < NBUCKET) { const int k = seg, n = tot[k], np = ((n + 255) >> 8) << 8; for (int r = n + F_TID; r < np; r += 512) { perm[tst[k] * 256 + r] = -1; slotrec[tst[k] * 256 + r] = (u32x4){0xffffffffu, 0u, 0u, 0u}; } }
        if (seg == 0) { if (F_TID == 0) tiles[0] = tst[NBUCKET];
            if (F_TID < NBUCKET) { const int k = F_TID, nt_ = (tot[k] + 255) >> 8; for (int t = 0; t < nt_; ++t) tiles[16 + tst[k] + t] = k; } }
    }
}
DEV void bucket_experts(int bk, int& e0, int& e1) { const int grp = bk / 6, pi = bk % 6; const int lo = pi < 3 ? 0 : (pi < 5 ? 1 : 2), hi = pi < 3 ? pi + 1 : (pi < 5 ? pi - 1 : 3); e0 = grp * 4 + lo; e1 = grp * 4 + hi; }


DEV void moe_setup(LAS unsigned char* lds, const int* tiles, int ntiles, const u32x4* slotrec, int first_tile) {
    int tid = threadIdx.x; asm volatile("" : "+v"(tid));
    for (int t = tid; t < ntiles; t += 512) *(LAS int*)(lds + AUX_TILE_OFF + t * 4) = ld_agent_i(tiles + 16 + t);
    if (tid < 256 && first_tile < ntiles) *(LAS u32x4*)(lds + AUX_SLOT_OFF + tid * 16) = slotrec[(size_t)first_tile * 256 + tid];
    asm volatile("s_waitcnt vmcnt(0) lgkmcnt(0)" ::: "memory"); __syncthreads();
}
struct SchedUp {
    static constexpr bool GATHER = true, AUX = true, FP8 = true, I8 = false;
    int nt; unsigned lda, ldb; int G, c, ntiles; const char* X1G; const char* W13; const char* slotrec; const char* sb13; LAS unsigned char* lds;
    DEV bool next(int i, Unit& u) const {
        const int L = i * G + c; if (L >= ntiles * 8) return false;
        const int tile = L >> 3, s = (L >> 2) & 1, ti = L & 3; int e0, e1; bucket_experts(__builtin_amdgcn_readfirstlane(*(const LAS int*)(lds + AUX_TILE_OFF + tile * 4)), e0, e1); const int e = s ? e1 : e0;
        u.A0 = X1G; u.A1 = X1G; u.B0 = W13 + ((size_t)e * 1024 + ti * 256) * 1024; u.B1 = u.B0; u.ksA = 1 << 20; u.ksB = 1 << 20; u.p0 = tile; u.p1 = s; u.p2 = ti; u.p3 = e; u.q = i & 1; return true;
    }
    DEV void rows(const Unit& u, int tid, unsigned* v) const {
#pragma unroll
        for (int i = 0; i < 2; ++i) { int R_, C_; pg8::stage_rc(tid * 16 + i * 8192, R_, C_);
#pragma unroll
            for (int h = 0; h < 2; ++h) { int t = *(const LAS int*)(lds + AUX_SLOT_OFF + u.q * 4096 + (h * 128 + R_) * 16); t = t < 0 ? 0 : t; v[h * 2 + i] = (unsigned)t * 1024u + (unsigned)C_ * 2u; } }
    }
    DEV void a_ready(const Unit&) const {}
    DEV void aux(const Unit& u, const Unit& n, LAS unsigned char* l, int wid, int lane) const {
        if (wid < 4) glds16(slotrec + (size_t)n.p0 * 4096 + wid * 1024 + lane * 16, l + AUX_SLOT_OFF + (u.q ^ 1) * 4096 + wid * 1024);
#pragma unroll
        for (int i = 0; i < 2; ++i) { const int p = wid * 2 + i, b = 2 * p + (lane >> 5);
            glds16(sb13 + ((size_t)(b * 16 + u.p3) * 1024 + u.p2 * 256) * 2 + (lane & 31) * 16, l + AUX_BIAS_OFF + p * 1024); }
    }
};
struct EpiUp {
    static constexpr bool PERM = true;
    unsigned char* HID; LAS unsigned char* lds;
    DEV void operator()(const f32x4 (&acc)[2][2][4][2], const Unit& u, int wr, int wc, int fr, int fq) const {
#pragma unroll
        for (int ai = 0; ai < 2; ++ai)
#pragma unroll
            for (int m = 0; m < 4; ++m) { const int r = ai * 128 + wr * 64 + m * 16 + fr, slot = u.p0 * 256 + r;
                const u32x4 rec = *(const LAS u32x4*)(lds + AUX_SLOT_OFF + u.q * 4096 + r * 16);
                const bool valid = (int)rec.x >= 0; const int tk = valid ? (int)rec.x : 0; const float rstd = __uint_as_float(rec.y) * (1.0f / FP8_WSCALE), w = (u.p1 ? __uint_as_float(rec.w) : __uint_as_float(rec.z)) * FP8_WSCALE;
                const LAS unsigned char* bp = lds + AUX_BIAS_OFF + (tk >> 11) * 512 + (wc * 32 + 8 * fq) * 2;
                const u32x4 b1 = *(const LAS u32x4*)bp, b3 = *(const LAS u32x4*)(bp + 256);
                float o[8];
#define UP1(j_, a1_, a3_, b1_, b3_) do { const float p1_ = __builtin_fmaf((a1_), rstd, (b1_)), p3_ = __builtin_fmaf((a3_), rstd, (b3_)); \
                    const float r_ = __builtin_amdgcn_rcpf(1.0f + __builtin_amdgcn_exp2f(p1_ * -1.4426950408889634f)); o[j_] = (p1_ * r_) * (p3_ * w); } while (0)
                UP1(0, acc[ai][0][m][0][0], acc[ai][1][m][0][0], bflo(b1.x), bflo(b3.x)); UP1(1, acc[ai][0][m][0][1], acc[ai][1][m][0][1], bfhi(b1.x), bfhi(b3.x));
                UP1(2, acc[ai][0][m][0][2], acc[ai][1][m][0][2], bflo(b1.y), bflo(b3.y)); UP1(3, acc[ai][0][m][0][3], acc[ai][1][m][0][3], bfhi(b1.y), bfhi(b3.y));
                UP1(4, acc[ai][0][m][1][0], acc[ai][1][m][1][0], bflo(b1.z), bflo(b3.z)); UP1(5, acc[ai][0][m][1][1], acc[ai][1][m][1][1], bfhi(b1.z), bfhi(b3.z));
                UP1(6, acc[ai][0][m][1][2], acc[ai][1][m][1][2], bflo(b1.w), bflo(b3.w)); UP1(7, acc[ai][0][m][1][3], acc[ai][1][m][1][3], bfhi(b1.w), bfhi(b3.w));
#undef UP1
                u32x2 wv; wv.x = pk4_fp8(o[0], o[1], o[2], o[3]); wv.y = pk4_fp8(o[4], o[5], o[6], o[7]);
                *(u32x2*)(HID + ((size_t)slot * 1024 + u.p1 * 512 + u.p2 * 128 + wc * 32 + 8 * fq)) = wv; }
    }
};

struct SchedDown {
    static constexpr bool GATHER = false, AUX = true, FP8 = true, I8 = false;
    int nt; unsigned lda, ldb; int G, c, ntiles; const char* HID; const char* W2; const char* slotrec; LAS unsigned char* lds;
    DEV bool next(int i, Unit& u) const {
        const int L = i * G + c; if (L >= ntiles * 4) return false;
        const int tile = L >> 2, pn = L & 3; int e0, e1; bucket_experts(__builtin_amdgcn_readfirstlane(*(const LAS int*)(lds + AUX_TILE_OFF + tile * 4)), e0, e1);
        u.A0 = HID + (size_t)tile * 256 * 1024; u.A1 = u.A0; u.ksA = 1 << 20;
        u.B0 = W2 + ((size_t)e0 * 1024 + pn * 256) * 512; u.B1 = W2 + ((size_t)e1 * 1024 + pn * 256) * 512; u.ksB = 4;
        u.p0 = tile; u.p1 = pn; u.p2 = 0; u.p3 = 0; return true;
    }
    DEV void rows(const Unit&, int, unsigned*) const {}
    DEV void aux(const Unit& u, const Unit&, LAS unsigned char* l, int wid, int lane) const {
        if (wid < 4) glds16(slotrec + (size_t)u.p0 * 4096 + wid * 1024 + lane * 16, l + AUX_SLOT_OFF + wid * 1024);
    }
};
struct EpiDown {
    static constexpr bool PERM = true;
    bf16_t* MOE; LAS unsigned char* lds;
    DEV void operator()(const f32x4 (&acc)[2][2][4][2], const Unit& u, int wr, int wc, int fr, int fq) const {
#pragma unroll
        for (int ai = 0; ai < 2; ++ai)
#pragma unroll
            for (int m = 0; m < 4; ++m) { const int r = ai * 128 + wr * 64 + m * 16 + fr; const int tk = *(const LAS int*)(lds + AUX_SLOT_OFF + r * 16);
                if (tk >= 0) { bf16_t* rowp = MOE + (size_t)tk * DM + u.p1 * 256 + wc * 32 + 8 * fq;
#pragma unroll
                    for (int bj = 0; bj < 2; ++bj) { const f32x4 v0 = acc[ai][bj][m][0] * (1.0f / (FP8_WSCALE * FP8_WSCALE)), v1 = acc[ai][bj][m][1] * (1.0f / (FP8_WSCALE * FP8_WSCALE));
                        u32x4 w; w.x = cvt_pk_bf16(v0[0], v0[1]); w.y = cvt_pk_bf16(v0[2], v0[3]); w.z = cvt_pk_bf16(v1[0], v1[1]); w.w = cvt_pk_bf16(v1[2], v1[3]);
                        *(u32x4*)(rowp + bj * 128) = w; } } }
    }
};

DEV void p12_phase(Frame& F) {
    const bf16_t* X1B = WSP(bf16_t, WS_X1B); const bf16_t* MOE = WSP(bf16_t, WS_MOE); const float* mod = WSP(float, WS_MOD); const float* fg = F.in[I_FING];
    const int gw = F.vcu * 8 + F_WAVE, NGW = F.G * 8;
    LAS unsigned char* lz = F.lds + F_WAVE * LZ_WAVE;
#if MK_TIME_A >= 0
    const float tscale = 1.0f + (float)(__hip_atomic_load(WSP(unsigned long long, WS_STAMP) + MK_TIME_A + 1, __ATOMIC_RELAXED, __HIP_MEMORY_SCOPE_AGENT) - __hip_atomic_load(WSP(unsigned long long, WS_STAMP) + MK_TIME_A, __ATOMIC_RELAXED, __HIP_MEMORY_SCOPE_AGENT)) * 1e-5f;
#endif
#if MK_TIME_B >= 0
    const float tspike = (float)(__hip_atomic_load(WSP(unsigned long long, WS_STAMP) + MK_TIME_B + 1, __ATOMIC_RELAXED, __HIP_MEMORY_SCOPE_AGENT) - __hip_atomic_load(WSP(unsigned long long, WS_STAMP) + MK_TIME_B, __ATOMIC_RELAXED, __HIP_MEMORY_SCOPE_AGENT)) * 1e-2f;
#endif
    for (int ch = gw; ch < TOK / 32; ch += NGW) {
        const int b = ch >> 6; const float* gate = mod + b * NMOD + 5 * DM;
        float gq[16], fq_[16];
#pragma unroll
        for (int q = 0; q < 4; ++q) { const int c0 = q * 256 + 4 * F_LANE; const f32x4 g0 = *(const f32x4*)(gate + c0), f0 = *(const f32x4*)(fg + c0);
#pragma unroll
            for (int j = 0; j < 4; ++j) { gq[q * 4 + j] = g0[j]; fq_[q * 4 + j] = f0[j]; } }
#define P12_ISSUE(bb) do { _Pragma("unroll") for (int r = 0; r < 2; ++r) _Pragma("unroll") for (int h = 0; h < 2; ++h) { \
            const size_t off_ = (size_t)(ch * 32 + (bb) * 2 + r) * DM + h * 512 + 8 * F_LANE; \
            lz_issue_nt(X1B + off_, lz, ((bb) & 1) * 8 + r * 4 + h); lz_issue_nt(MOE + off_, lz, ((bb) & 1) * 8 + r * 4 + 2 + h); } } while (0)
        asm volatile("s_waitcnt lgkmcnt(0)" ::: "memory");
        P12_ISSUE(0); P12_ISSUE(1);
#pragma unroll 1
        for (int bb = 0; bb < 16; ++bb) {
            if (bb + 1 < 16) LZ_WAIT(8); else LZ_WAIT(0);
            float v[2][16], ss[2];
#pragma unroll
            for (int r = 0; r < 2; ++r) { float s_ = 0.f;
#pragma unroll
                for (int q = 0; q < 4; ++q) { const u32x2 xv = *(const LAS u32x2*)(lz + ((bb & 1) * 8 + r * 4 + (q >> 1)) * 1024 + (q & 1) * 512 + F_LANE * 8), mv = *(const LAS u32x2*)(lz + ((bb & 1) * 8 + r * 4 + 2 + (q >> 1)) * 1024 + (q & 1) * 512 + F_LANE * 8);
#pragma unroll
                    for (int j = 0; j < 2; ++j) { const unsigned xw = xv[j], mw = mv[j];
                        const float lo = bflo(xw) + gq[q * 4 + 2 * j] * bflo(mw), hi = bfhi(xw) + gq[q * 4 + 2 * j + 1] * bfhi(mw);
                        v[r][q * 4 + 2 * j] = lo; v[r][q * 4 + 2 * j + 1] = hi; s_ += lo * lo + hi * hi; } }
                ss[r] = s_; }
#pragma unroll
            for (int o = 1; o < 64; o <<= 1) { ss[0] += __shfl_xor(ss[0], o); ss[1] += __shfl_xor(ss[1], o); }
#pragma unroll
            for (int r = 0; r < 2; ++r) { const float rstd = 1.0f / sqrtf(ss[r] * (1.f / DM) + RMS_EPS); float* op = F.out + (size_t)(ch * 32 + bb * 2 + r) * DM + 4 * F_LANE;
#pragma unroll
                for (int q = 0; q < 4; ++q) { f32x4 o0;
#pragma unroll
                    for (int j = 0; j < 4; ++j) o0[j] = v[r][q * 4 + j] * rstd * fq_[q * 4 + j];
#if MK_TIME_A >= 0
                    o0 = o0 * tscale;
#endif
#if MK_TIME_B >= 0
                    if (ch == 0 && bb == 0 && r == 0 && q == 0 && F_LANE == 0) o0[0] += tspike;
#endif
                    *(f32x4*)(op + q * 256) = o0; } }
            if (bb + 2 < 16) P12_ISSUE(bb + 2);
        }
#undef P12_ISSUE
    }
}

#define XB_TMO      128
#define XB_XCNT(j)  (256  + 64 * (j))
#define XB_XSUB(j)  (1280 + 64 * (j))
#define XB_XGEN(j)  (2304 + 64 * (j))
#define XB_TOP      3328
#define XB_TOPGEN   3392
#define XCD_BAR_WORDS 3456
#define XB_SPIN_CAP (1u << 22)
DEV unsigned xb_ld(unsigned* p)              { return __hip_atomic_load(p, __ATOMIC_RELAXED, __HIP_MEMORY_SCOPE_AGENT); }
DEV unsigned xb_add(unsigned* p, unsigned v) { return __hip_atomic_fetch_add(p, v, __ATOMIC_RELAXED, __HIP_MEMORY_SCOPE_AGENT); }
DEV unsigned xb_xcc_id() { return (unsigned)__builtin_amdgcn_s_getreg((3 << 11) | 20) & 0xFu; }
#define XB_SPIN(cond, bar) do { unsigned _sp = 0; while (cond) { __builtin_amdgcn_s_sleep(1); \
    if ((++_sp & 255u) == 0u) { if (xb_ld(&(bar)[XB_TMO])) break; if (_sp > XB_SPIN_CAP) { atomicAdd(&(bar)[XB_TMO], 1u); break; } } } } while (0)
struct XcdBarrier { unsigned* bar; unsigned x; volatile LAS unsigned* st; };
DEV XcdBarrier xcd_barrier_post(unsigned* bar, volatile LAS unsigned* st) {
    XcdBarrier b; b.bar = bar; b.x = xb_xcc_id(); b.st = st;
    if (threadIdx.x == 0) (void)xb_add(&bar[XB_XCNT(b.x)], 1u);
    return b;
}
DEV void xcd_barrier_complete(unsigned* bar, unsigned x, unsigned& nloc, unsigned& nx) {
    const unsigned G = gridDim.x * gridDim.y * gridDim.z;
    unsigned sum, cnt, mine, sp = 0u;
    for (;;) {
        sum = 0u; cnt = 0u; mine = 0u;
#pragma unroll
        for (unsigned j = 0; j < 16; ++j) { const unsigned c = xb_ld(&bar[XB_XCNT(j)]); sum += c; cnt += (c > 0u) ? 1u : 0u; mine = (j == x) ? c : mine; }
        if (sum == G) break;
        __builtin_amdgcn_s_sleep(1);
        if ((++sp & 255u) == 0u) { if (xb_ld(&bar[XB_TMO])) break; if (sp > XB_SPIN_CAP) { atomicAdd(&bar[XB_TMO], 1u); break; } }
    }
    nloc = mine > 0u ? mine : 1u; nx = cnt > 0u ? cnt : 1u;
}
DEV void xcd_barrier(const XcdBarrier& b) {
    asm volatile("s_waitcnt vmcnt(0)" ::: "memory");
    __syncthreads();
    if (threadIdx.x == 0) {
        unsigned* bar = b.bar;
        __builtin_amdgcn_s_waitcnt(0);
        unsigned nloc = b.st[0], nx = b.st[1];
        if (nloc == 0u) { xcd_barrier_complete(bar, b.x, nloc, nx); b.st[0] = nloc; b.st[1] = nx; }
        const unsigned old = xb_add(&bar[XB_XSUB(b.x)], 1u);
        const unsigned gen = old / nloc;
        if (old + 1u == (gen + 1u) * nloc) {
            __builtin_amdgcn_fence(__ATOMIC_RELEASE, "agent");
            asm volatile("s_waitcnt vmcnt(0)" ::: "memory");
            const unsigned og = xb_add(&bar[XB_TOP], 1u);
            const unsigned tg = og / nx;
            if (og + 1u == (tg + 1u) * nx) xb_add(&bar[XB_TOPGEN], 1u);
            else XB_SPIN(xb_ld(&bar[XB_TOPGEN]) == tg, bar);
            __builtin_amdgcn_fence(__ATOMIC_ACQUIRE, "agent");
            xb_add(&bar[XB_XGEN(b.x)], 1u);
            asm volatile("s_waitcnt vmcnt(0)" ::: "memory");
        } else {
            XB_SPIN(xb_ld(&bar[XB_XGEN(b.x)]) == gen, bar);
            __builtin_amdgcn_fence(__ATOMIC_ACQUIRE, "agent");
            asm volatile("s_waitcnt vmcnt(0)" ::: "memory");
        }
    }
    __syncthreads();
}

constexpr int LDS_BYTES = 163840;
static_assert(AUX_TILE_OFF + MAXTILES * 4 <= LDS_BYTES - 256, "LDS map");
constexpr int NPHASE = 13;
constexpr int MISC_OFF = LDS_BYTES - 256;
constexpr int CW_BAR = 4096;
constexpr size_t CTL_ZERO_BYTES = 65536;

__global__ void __launch_bounds__(512, 2) mk_fwd(Args args) {
    extern __shared__ __attribute__((aligned(16))) unsigned char lds_raw[];
    Frame F;
    F.lds = (LAS unsigned char*)lds_raw;
    F.G = gridDim.x; F.bx = blockIdx.x; F.vcu = (F.G % 8 == 0) ? (F.bx % 8) * (F.G / 8) + F.bx / 8 : F.bx;
#pragma unroll
    for (int i = 0; i < 29; ++i) F.in[i] = args.in[i];
    F.out = args.out; F.ws = args.ws; F.flags = args.flags;
    const int lo = args.ph_lo, hi = args.ph_hi;
#if MK_ONE_LAUNCH == 1
    cg::grid_group grid = cg::this_grid();
#define SEAM(k) do { if (lo <= (k) && (k) + 1 < hi) grid.sync(); } while (0)
#elif MK_ONE_LAUNCH == 2
    {
        volatile LAS unsigned* misc = (volatile LAS unsigned*)(F.lds + MISC_OFF);
        if (F_TID < 16) misc[F_TID] = 0u;
        __syncthreads();
    }
    const XcdBarrier xbar = xcd_barrier_post((unsigned*)(F.ws + WS_CTL) + CW_BAR + args.li * XCD_BAR_WORDS, (volatile LAS unsigned*)(F.lds + MISC_OFF));
#if MK_TIME_A >= 0 || MK_TIME_B >= 0
#define STAMP(i) do { if (F.bx == 0 && F_TID == 0) __hip_atomic_store(WSP(unsigned long long, WS_STAMP) + (i), (unsigned long long)__builtin_amdgcn_s_memrealtime(), __ATOMIC_RELAXED, __HIP_MEMORY_SCOPE_AGENT); } while (0)
#else
#define STAMP(i) do { } while (0)
#endif
    STAMP(0);
#define SEAM(k) do { if (lo <= (k) && (k) + 1 < hi) xcd_barrier(xbar); STAMP((k) + 1); } while (0)
#else
#define SEAM(k) do { } while (0)
#endif
#define IN(k) (lo <= (k) && (k) < hi)
#define REPS(k) for (int rep_ = 0; rep_ < 1 + ((MK_REP >> (k)) & 1); ++rep_)

    if (IN(0)) REPS(0) { p0_phase(F); }
    SEAM(0);
    if (IN(1)) REPS(1) {
        const int nk = ((F.G - 32) * 4) / 7; const bool lat = F.bx >= 32, tabs = !(F.flags & 4);
        if (lat && tabs) { if (F.bx < 32 + nk) p1_ktab_stage(F, 32, nk); }
        if (!(F.flags & 2)) p1_norm_rows(F);
        if (F.flags & 4) { } else
        if (!lat) {
            asm volatile("s_waitcnt vmcnt(0)" ::: "memory"); __syncthreads();
            SchedIn S{8, 1024u, 1024u, 32, F.bx, (const char*)WSP(bf16_t, WS_HX), (const char*)WSP(bf16_t, WS_WIN), 2560, 2592, (const char*)WSP(float, WS_RSCALE), (const char*)WSP(float, WS_CSCALE), (const char*)F.in[I_CONVW]};
            EpiIn E{WSP(bf16_t, WS_UG), WSP(bf16_t, WS_BG), WSP(bf16_t, WS_CV), WSP(bf16_t, WS_YMIX), F.lds};
            pg8::gemm_phase<EpiIn, SchedIn>(F.lds, S, E);
        } else { if (F.bx < 32 + nk) p1_ktab(F, 32, nk); P1We we; P1Pre pre; p1_we_load(F, we); p1_pre_load(F, pre, 32 + nk, F.G - 32 - nk); p1_we_finish(F, we); p1_pre_finish(F, pre, 32 + nk, F.G - 32 - nk); }
    }
    SEAM(1);
    if (IN(2)) REPS(2) {
        SchedIn S{8, 1024u, 1024u, F.G, F.bx, (const char*)WSP(bf16_t, WS_HX), (const char*)WSP(bf16_t, WS_WIN), 0, 2560, (const char*)WSP(float, WS_RSCALE), (const char*)WSP(float, WS_CSCALE), (const char*)F.in[I_CONVW]};
        EpiIn E{WSP(bf16_t, WS_UG), WSP(bf16_t, WS_BG), WSP(bf16_t, WS_CV), WSP(bf16_t, WS_YMIX), F.lds};
        pg8::gemm_phase<EpiIn, SchedIn>(F.lds, S, E);
    }
    SEAM(2);
    if (IN(3)) REPS(3) {
        int vb0, nvb;
        if (F.bx < 144) { SchedE S{UK / 64, (unsigned)(UGK * 2), (unsigned)(UK * 2), F.bx, (const char*)WSP(bf16_t, WS_UG), (const char*)WSP(bf16_t, WS_WE)}; EpiE E{WSP(bf16_t, WS_E)};
            pg8::gemm_phase<EpiE, SchedE>(F.lds, S, E); vb0 = F.bx * 3; nvb = 3; }
        else if (F.bx < 208) { SchedSB S2{8, 1024u, 1024u, F.bx - 144, (const char*)WSP(bf16_t, WS_SH2), (const char*)WSP(bf16_t, WS_W13)}; EpiSB E2{WSP(bf16_t, WS_SB13)};
            pg8::gemm_phase<EpiSB, SchedSB>(F.lds, S2, E2); vb0 = 432 + (F.bx - 144) * 3; nvb = 3; }
        else { vb0 = 624 + (F.bx - 208) * 4; nvb = 4; }
        if (!(F.flags & 2)) for (int v = 0; v < nvb; ++v) conv_items(F, (vb0 + v) * 512 + F_TID, 816 * 512);
    }
    SEAM(3);
    if (IN(4)) REPS(4) {
        constexpr int NCB = NB * NG * 128 / 512;
        if (F.G >= 2 * NCB) { if (F.bx < NCB) p4_phase(F, NCB); else p2_fill_tr(F, NCB, F.G - NCB); }
        else { p4_phase(F, F.G); p2_fill_tr(F, 0, F.G); }
    }
    SEAM(4);
    if (IN(5)) REPS(5) {
        SchedY S{UGK / 64, (unsigned)(UGK * 2), (unsigned)(UGK * 2), F.bx, (const char*)WSP(bf16_t, WS_UG), (const char*)WSP(bf16_t, WS_TR)}; EpiY E{WSP(bf16_t, WS_G)};
        pg8::gemm_phase<EpiY, SchedY>(F.lds, S, E);
    }
    SEAM(5);
    if (IN(6)) REPS(6) {
        SchedGlu S{4, 512u, 512u, F.G, F.bx, (const char*)WSP(bf16_t, WS_G), (const char*)WSP(bf16_t, WS_WGLU)}; EpiGlu E{WSP(bf16_t, WS_G), WSP(bf16_t, WS_YMIX), F.in[I_BGLU]};
        pg8::gemm_phase<EpiGlu, SchedGlu>(F.lds, S, E);
    }
    SEAM(6);
    if (IN(7)) REPS(7) {
        SchedOut S{16, 2048u, 2048u, F.G, F.bx, (const char*)WSP(bf16_t, WS_YMIX), (const char*)WSP(bf16_t, WS_WOUT)};
        EpiX1 E{WSP(bf16_t, WS_X1B), WSP(float, WS_MOD)};
        pg8::gemm_phase<EpiX1, SchedOut>(F.lds, S, E);
    }
    SEAM(7);
    if (IN(8)) REPS(8) { p8_phase(F); }
    SEAM(8);
    if (IN(9)) REPS(9) { p9_phase(F); }
    SEAM(9);
    if (IN(10)) REPS(10) {
        const int ntiles = ld_agent_i(WSP(int, WS_TILES));
        moe_setup(F.lds, WSP(int, WS_TILES), ntiles, WSP(u32x4, WS_SLOT), F.vcu >> 3);
        SchedUp S{8, 1024u, 1024u, F.G, F.vcu, ntiles, (const char*)WSP(bf16_t, WS_X1G), (const char*)WSP(bf16_t, WS_W13), (const char*)WSP(u32x4, WS_SLOT), (const char*)WSP(bf16_t, WS_SB13), F.lds};
        EpiUp E{WSP(unsigned char, WS_HID), F.lds};
        pg8::gemm_phase<EpiUp, SchedUp>(F.lds, S, E);
    }
    SEAM(10);
    if (IN(11)) REPS(11) {
        const int ntiles = ld_agent_i(WSP(int, WS_TILES));
        moe_setup(F.lds, WSP(int, WS_TILES), ntiles, WSP(u32x4, WS_SLOT), MAXTILES);
        SchedDown S{8, 1024u, 512u, F.G, F.vcu, ntiles, (const char*)WSP(bf16_t, WS_HID), (const char*)WSP(bf16_t, WS_W2), (const char*)WSP(u32x4, WS_SLOT), F.lds};
        EpiDown E{WSP(bf16_t, WS_MOE), F.lds};
        pg8::gemm_phase<EpiDown, SchedDown>(F.lds, S, E);
    }
    SEAM(11);
    if (IN(12)) REPS(12) { p12_phase(F); }
#undef IN
#undef SEAM
}

extern "C" void kernel_launch(void* const* d_in, const int* in_sizes, int n_in, void* d_out, int out_size, void* d_ws, size_t ws_size, hipStream_t stream) {
    static int grid = 0;
    if (grid == 0) {
        if (n_in != 29 || out_size != TOK * DM || ws_size < WS_END) { fprintf(stderr, "kernel_launch: unexpected problem (n_in %d, out %d, ws %zu)\n", n_in, out_size, ws_size); grid = -1; return; }
        int dev = 0, cus = 0, per_cu = 0;
        if (hipGetDevice(&dev) != hipSuccess || hipDeviceGetAttribute(&cus, hipDeviceAttributeMultiprocessorCount, dev) != hipSuccess) { grid = -1; return; }
        if (hipFuncSetAttribute((const void*)mk_fwd, hipFuncAttributeMaxDynamicSharedMemorySize, LDS_BYTES) != hipSuccess) { fprintf(stderr, "kernel_launch: hipFuncSetAttribute failed\n"); grid = -1; return; }
        if (hipOccupancyMaxActiveBlocksPerMultiprocessor(&per_cu, (const void*)mk_fwd, 512, LDS_BYTES) != hipSuccess || per_cu < 1) { fprintf(stderr, "kernel_launch: occupancy query gives %d\n", per_cu); (void)hipGetLastError(); per_cu = 1; }
        grid = cus;
        if (grid > 256) grid = 256;
    }
    if (grid < 0) return;
    Args a{};
    for (int i = 0; i < 29; ++i) a.in[i] = (const float*)d_in[i];
    a.out = (float*)d_out; a.ws = (unsigned char*)d_ws;
#if MK_ONE_LAUNCH == 1
    a.ph_lo = 0; a.ph_hi = NPHASE;
    void* kargs[] = {&a};
    hipError_t e = hipLaunchCooperativeKernel((const void*)mk_fwd, dim3(grid), dim3(512), kargs, LDS_BYTES, stream);
    if (e != hipSuccess) fprintf(stderr, "cooperative launch failed: %s (grid %d)\n", hipGetErrorString(e), grid);
#elif MK_ONE_LAUNCH == 2
    if (hipMemsetAsync((char*)d_ws + WS_CTL, 0, CTL_ZERO_BYTES, stream) != hipSuccess) { fprintf(stderr, "kernel_launch: memset failed\n"); return; }
#if MK_SPLIT_AT >= 0
    a.ph_lo = 0; a.ph_hi = MK_SPLIT_AT + 1; a.li = 0;
    hipLaunchKernelGGL(mk_fwd, dim3(grid), dim3(512), LDS_BYTES, stream, a);
    a.ph_lo = MK_SPLIT_AT + 1 - MK_SPLIT_DUP; a.ph_hi = NPHASE; a.li = 1;
    hipLaunchKernelGGL(mk_fwd, dim3(grid), dim3(512), LDS_BYTES, stream, a);
#else
    a.ph_lo = 0; a.ph_hi = NPHASE;
    hipLaunchKernelGGL(mk_fwd, dim3(grid), dim3(512), LDS_BYTES, stream, a);
#endif
#if MK_PROBE_PHASE >= 0
    a.ph_lo = MK_PROBE_PHASE; a.ph_hi = MK_PROBE_PHASE + 1; a.flags = MK_PROBE_FLAGS;
    hipLaunchKernelGGL(mk_fwd, dim3(grid), dim3(512), LDS_BYTES, stream, a);
#endif
#else
    for (int p = 0; p < NPHASE; ++p) { a.ph_lo = p; a.ph_hi = p + 1; hipLaunchKernelGGL(mk_fwd, dim3(grid), dim3(512), LDS_BYTES, stream, a); }
#endif
}
```
